# Optimizing an MI355X kernel written in HIP

```python
import math
import jax, jax.numpy as jnp
from jax import lax
import numpy as np

D_MODEL = 1024
BATCH = 8
SEQ = 4096
DEPTH = 1

HEAD_DIM = 64
FOX_HEADS = 8
SWA_HEADS = 8
SWA_KV_HEADS = 2
SWA_GROUP = SWA_HEADS // SWA_KV_HEADS
FOX_W = FOX_HEADS * HEAD_DIM
SWA_QW = SWA_HEADS * HEAD_DIM
SWA_KVW = SWA_KV_HEADS * HEAD_DIM
MIX_WIDTH = FOX_W + SWA_QW
WINDOW = 128
Q_BLOCK = 128
ROPE_THETA = 10000.0

OFF_FQ = 0
OFF_FK = OFF_FQ + FOX_W
OFF_FV = OFF_FK + FOX_W
OFF_FF = OFF_FV + FOX_W
OFF_SQ = OFF_FF + FOX_HEADS
OFF_SK = OFF_SQ + SWA_QW
OFF_SV = OFF_SK + SWA_KVW
IN_COLS = OFF_SV + SWA_KVW

PEER_HEADS = 8
N_KEYS = 128
N_EXPERTS = N_KEYS * N_KEYS
PEER_DKEY = 256
PEER_HALF = PEER_DKEY // 2
PEER_TOPK = 16
PEER_TOK_BLOCK = 128

LN_EPS = 1e-5
ALPHA = (2.0 * DEPTH) ** 0.25
BETA = (8.0 * DEPTH) ** -0.25

kernel_name = "hymba_fox_swa_sink_peer_deepnorm"


def layer_norm(x, g, b):
    xf = x.astype(jnp.float32)
    mu = jnp.mean(xf, axis=-1, keepdims=True)
    var = jnp.mean(jnp.square(xf - mu), axis=-1, keepdims=True)
    return ((xf - mu) * lax.rsqrt(var + LN_EPS) * g.astype(jnp.float32) + b.astype(jnp.float32)).astype(x.dtype)


def rope(x, pos):
    half = HEAD_DIM // 2
    inv = ROPE_THETA ** (-jnp.arange(half, dtype=jnp.float32) / half)
    ang = pos.astype(jnp.float32)[:, None] * inv[None, :]
    cos = jnp.cos(ang)[None, :, None, :]
    sin = jnp.sin(ang)[None, :, None, :]
    xf = x.astype(jnp.float32)
    x1, x2 = xf[..., :half], xf[..., half:]
    return jnp.concatenate([x1 * cos - x2 * sin, x2 * cos + x1 * sin], axis=-1).astype(x.dtype)


def forgetting_attention(q, k, v, f_logit):
    B, S, H, D = q.shape
    c = jnp.cumsum(jax.nn.log_sigmoid(f_logit.astype(jnp.float32)), axis=1)
    c = jnp.transpose(c, (0, 2, 1))
    scale = D ** -0.5
    outs = []
    for i in range(S // Q_BLOCK):
        q0, q1 = i * Q_BLOCK, (i + 1) * Q_BLOCK
        s = jnp.einsum('bqhd,bkhd->bhqk', q[:, q0:q1], k[:, :q1],
                       preferred_element_type=jnp.float32) * scale
        bias = c[:, :, q0:q1, None] - c[:, :, None, :q1]
        causal = (q0 + jnp.arange(Q_BLOCK))[:, None] >= jnp.arange(q1)[None, :]
        s = jnp.where(causal[None, None], s + bias, -jnp.inf)
        p = jax.nn.softmax(s, axis=-1)
        outs.append(jnp.einsum('bhqk,bkhd->bqhd', p.astype(v.dtype), v[:, :q1]))
    return jnp.concatenate(outs, axis=1)


def sliding_window_attention(q, k, v, sinks):
    B, S, H, D = q.shape
    nb = S // WINDOW
    scale = D ** -0.5
    qb = q.reshape(B, nb, WINDOW, SWA_KV_HEADS, SWA_GROUP, D)

    def banded(t):
        tb = t.reshape(B, nb, WINDOW, SWA_KV_HEADS, D)
        prev = jnp.pad(tb, ((0, 0), (1, 0), (0, 0), (0, 0), (0, 0)))[:, :-1]
        return jnp.concatenate([prev, tb], axis=2)

    kb, vb = banded(k), banded(v)
    s = jnp.einsum('bnqkgd,bnjkd->bnkgqj', qb, kb, preferred_element_type=jnp.float32) * scale
    r = jnp.arange(WINDOW)[:, None]
    j = jnp.arange(2 * WINDOW)[None, :]
    diff = r + WINDOW - j
    in_window = (diff >= 0) & (diff < WINDOW)
    key_pos = jnp.arange(nb)[:, None] * WINDOW - WINDOW + jnp.arange(2 * WINDOW)[None, :]
    mask = in_window[None] & (key_pos >= 0)[:, None, :]
    s = jnp.where(mask[None, :, None, None], s, -jnp.inf)
    sink = sinks.astype(jnp.float32).reshape(SWA_KV_HEADS, SWA_GROUP)[None, None, :, :, None, None]
    sink = jnp.broadcast_to(sink, s.shape[:-1] + (1,))
    p = jax.nn.softmax(jnp.concatenate([s, sink], axis=-1), axis=-1)[..., :-1]
    o = jnp.einsum('bnkgqj,bnjkd->bnqkgd', p.astype(v.dtype), vb)
    return o.reshape(B, S, H, D)


def peer_ffn(x, w_query, sub_keys, expert_u, expert_v):
    B, S, Dm = x.shape
    xt = x.reshape((B * S) // PEER_TOK_BLOCK, PEER_TOK_BLOCK, Dm)

    def block(xb):
        tb = xb.shape[0]
        q = (xb @ w_query).reshape(tb, PEER_HEADS, 2, PEER_HALF)
        s = jnp.einsum('thpc,hpnc->thpn', q, sub_keys, preferred_element_type=jnp.float32)
        top_s, top_i = lax.top_k(s, PEER_TOPK)
        cand_s = (top_s[:, :, 0, :, None] + top_s[:, :, 1, None, :]).reshape(tb, PEER_HEADS, PEER_TOPK * PEER_TOPK)
        cand_i = (top_i[:, :, 0, :, None] * N_KEYS + top_i[:, :, 1, None, :]).reshape(tb, PEER_HEADS, PEER_TOPK * PEER_TOPK)
        best_s, best_pos = lax.top_k(cand_s, PEER_TOPK)
        idx = jnp.take_along_axis(cand_i, best_pos, axis=-1)
        g = jax.nn.softmax(best_s, axis=-1)
        u = expert_u[idx]
        h = jax.nn.gelu(jnp.einsum('thkd,td->thk', u, xb, preferred_element_type=jnp.float32), approximate=False)
        w = (g * h).astype(xb.dtype)
        return jnp.einsum('thk,thkd->td', w, expert_v[idx])

    return lax.map(block, xt).reshape(B, S, Dm)


def setup_inputs(seed: int = 0) -> dict:
    key = jax.random.key(seed)
    ks = jax.random.split(key, 14)
    f32 = jnp.float32
    nrm = lambda k, shape: jax.random.normal(k, shape, dtype=f32)
    x = nrm(ks[0], (BATCH, SEQ, D_MODEL))
    w_in = nrm(ks[1], (DEPTH, D_MODEL, IN_COLS)) * D_MODEL ** -0.5
    b_forget = 0.1 * nrm(ks[2], (DEPTH, FOX_HEADS))
    swa_sinks = 0.1 * nrm(ks[3], (DEPTH, SWA_HEADS))
    w_out = nrm(ks[4], (DEPTH, MIX_WIDTH, D_MODEL)) * MIX_WIDTH ** -0.5 * BETA
    ln1_g = 1.0 + 0.01 * nrm(ks[5], (DEPTH, D_MODEL))
    ln1_b = 0.01 * nrm(ks[6], (DEPTH, D_MODEL))
    w_query = nrm(ks[7], (DEPTH, D_MODEL, PEER_HEADS * PEER_DKEY)) * D_MODEL ** -0.5
    sub_keys = nrm(ks[8], (DEPTH, PEER_HEADS, 2, N_KEYS, PEER_HALF)) * PEER_HALF ** -0.5
    expert_u = nrm(ks[9], (DEPTH, N_EXPERTS, D_MODEL)) * D_MODEL ** -0.5
    expert_v = nrm(ks[10], (DEPTH, N_EXPERTS, D_MODEL)) * BETA
    ln2_g = 1.0 + 0.01 * nrm(ks[11], (DEPTH, D_MODEL))
    ln2_b = 0.01 * nrm(ks[12], (DEPTH, D_MODEL))
    return {"x": x, "w_in": w_in, "b_forget": b_forget, "swa_sinks": swa_sinks, "w_out": w_out,
            "ln1_g": ln1_g, "ln1_b": ln1_b, "w_query": w_query, "sub_keys": sub_keys,
            "expert_u": expert_u, "expert_v": expert_v, "ln2_g": ln2_g, "ln2_b": ln2_b}


def reference(x, w_in, b_forget, swa_sinks, w_out, ln1_g, ln1_b, w_query, sub_keys,
              expert_u, expert_v, ln2_g, ln2_b):
    B, S, _ = x.shape
    pos = jnp.arange(S)
    for l in range(DEPTH):
        proj = x @ w_in[l]
        fq = proj[..., OFF_FQ:OFF_FK].reshape(B, S, FOX_HEADS, HEAD_DIM)
        fk = proj[..., OFF_FK:OFF_FV].reshape(B, S, FOX_HEADS, HEAD_DIM)
        fv = proj[..., OFF_FV:OFF_FF].reshape(B, S, FOX_HEADS, HEAD_DIM)
        ff = proj[..., OFF_FF:OFF_SQ] + b_forget[l]
        sq = rope(proj[..., OFF_SQ:OFF_SK].reshape(B, S, SWA_HEADS, HEAD_DIM), pos)
        sk = rope(proj[..., OFF_SK:OFF_SV].reshape(B, S, SWA_KV_HEADS, HEAD_DIM), pos)
        sv = proj[..., OFF_SV:IN_COLS].reshape(B, S, SWA_KV_HEADS, HEAD_DIM)
        fox_out = forgetting_attention(fq, fk, fv, ff).reshape(B, S, FOX_W)
        swa_out = sliding_window_attention(sq, sk, sv, swa_sinks[l]).reshape(B, S, SWA_QW)
        mix = jnp.concatenate([fox_out, swa_out], axis=-1) @ w_out[l]
        x = layer_norm(ALPHA * x + mix, ln1_g[l], ln1_b[l])
        ffn = peer_ffn(x, w_query[l], sub_keys[l], expert_u[l], expert_v[l])
        x = layer_norm(ALPHA * x + ffn, ln2_g[l], ln2_b[l])
    return x
```

```cpp
#include <hip/hip_runtime.h>
#include <cstdint>
#include <cstdio>
#include <cmath>

namespace cfg {
constexpr int D_MODEL = 1024, BATCH = 8, SEQ = 4096, T = BATCH * SEQ;
constexpr int HD = 64, FOX_H = 8, SWA_H = 8, SWA_KVH = 2;
constexpr int OFF_FQ = 0, OFF_FK = 512, OFF_FV = 1024, OFF_FF = 1536, OFF_SQ = 1544, OFF_SK = 2056, OFF_SV = 2184, IN_COLS = 2312;
constexpr int WINDOW = 128;
constexpr int PEER_H = 8, NKEYS = 128, PEER_HALF = 128, TOPK = 16, QCOLS = 2048;
constexpr float LN_EPS = 1e-5f;
constexpr float ALPHA = 1.189207115002721f;
}
using namespace cfg;

__global__ void __launch_bounds__(256) nv_gemm(const float* __restrict__ A, int lda, const float* __restrict__ Bm, int ldb, float* __restrict__ C, int ldc, int M, int N, int K) {
    __shared__ float As[8][128 + 4];
    __shared__ float Bs[8][128 + 4];
    const int tid = threadIdx.x, tx = tid & 15, ty = tid >> 4;
    const int m0 = blockIdx.y * 128, n0 = blockIdx.x * 128;
    float acc[8][8];
#pragma unroll
    for (int i = 0; i < 8; ++i)
#pragma unroll
        for (int j = 0; j < 8; ++j) acc[i][j] = 0.f;
    const int ar = tid >> 1, ak = (tid & 1) * 4;
    const int bk = tid >> 5, bn = (tid & 31) * 4;
    for (int k0 = 0; k0 < K; k0 += 8) {
        const float4 av = *(const float4*)(A + (size_t)(m0 + ar) * lda + k0 + ak);
        float4 bv = make_float4(0.f, 0.f, 0.f, 0.f);
        if (n0 + bn < N) bv = *(const float4*)(Bm + (size_t)(k0 + bk) * ldb + n0 + bn);
        __syncthreads();
        As[ak + 0][ar] = av.x; As[ak + 1][ar] = av.y; As[ak + 2][ar] = av.z; As[ak + 3][ar] = av.w;
        *(float4*)&Bs[bk][bn] = bv;
        __syncthreads();
#pragma unroll
        for (int k = 0; k < 8; ++k) {
            float a[8], b[8];
            *(float4*)&a[0] = *(const float4*)&As[k][ty * 8]; *(float4*)&a[4] = *(const float4*)&As[k][ty * 8 + 4];
            *(float4*)&b[0] = *(const float4*)&Bs[k][tx * 8]; *(float4*)&b[4] = *(const float4*)&Bs[k][tx * 8 + 4];
#pragma unroll
            for (int i = 0; i < 8; ++i)
#pragma unroll
                for (int j = 0; j < 8; ++j) acc[i][j] = fmaf(a[i], b[j], acc[i][j]);
        }
    }
#pragma unroll
    for (int i = 0; i < 8; ++i) {
        const int r = m0 + ty * 8 + i;
#pragma unroll
        for (int j = 0; j < 8; j += 4) {
            const int c = n0 + tx * 8 + j;
            if (c < N) *(float4*)(C + (size_t)r * ldc + c) = make_float4(acc[i][j], acc[i][j + 1], acc[i][j + 2], acc[i][j + 3]);
        }
    }
}

__global__ void nv_forget_cumsum(const float* __restrict__ proj, const float* __restrict__ b_forget, float* __restrict__ c) {
    const int bh = blockIdx.x * blockDim.x + threadIdx.x;
    if (bh >= BATCH * FOX_H) return;
    const int b = bh / FOX_H, h = bh % FOX_H;
    float run = 0.f; const float bf = b_forget[h];
    for (int s = 0; s < SEQ; ++s) {
        const float z = proj[(size_t)(b * SEQ + s) * IN_COLS + OFF_FF + h] + bf;
        const float ls = fminf(z, 0.f) - log1pf(expf(-fabsf(z)));
        run += ls;
        c[(size_t)bh * SEQ + s] = run;
    }
}

__global__ void __launch_bounds__(64) nv_fox(const float* __restrict__ proj, const float* __restrict__ c, float* __restrict__ attn) {
    __shared__ float Ks[64][64];
    __shared__ float Vs[64][64];
    __shared__ float Cs[64];
    const int tid = threadIdx.x;
    const int qb = blockIdx.x, h = blockIdx.y, b = blockIdx.z;
    const int t = qb * 64 + tid;
    const float* prow = proj + (size_t)(b * SEQ) * IN_COLS;
    float q[64], o[64];
#pragma unroll
    for (int d = 0; d < 64; d += 4) { const float4 v = *(const float4*)(prow + (size_t)t * IN_COLS + OFF_FQ + h * 64 + d); q[d] = v.x; q[d + 1] = v.y; q[d + 2] = v.z; q[d + 3] = v.w; }
#pragma unroll
    for (int d = 0; d < 64; ++d) o[d] = 0.f;
    const float ct = c[(size_t)(b * FOX_H + h) * SEQ + t];
    float m = -INFINITY, l = 0.f;
    for (int kt = 0; kt <= qb; ++kt) {
        __syncthreads();
        for (int i = tid; i < 64 * 16; i += 64) {
            const int r = i >> 4, d4 = (i & 15) * 4;
            *(float4*)&Ks[r][d4] = *(const float4*)(prow + (size_t)(kt * 64 + r) * IN_COLS + OFF_FK + h * 64 + d4);
            *(float4*)&Vs[r][d4] = *(const float4*)(prow + (size_t)(kt * 64 + r) * IN_COLS + OFF_FV + h * 64 + d4);
        }
        Cs[tid] = c[(size_t)(b * FOX_H + h) * SEQ + kt * 64 + tid];
        __syncthreads();
        for (int j = 0; j < 64; ++j) {
            const int s = kt * 64 + j;
            if (s <= t) {
                float dot = 0.f;
#pragma unroll
                for (int d = 0; d < 64; ++d) dot = fmaf(q[d], Ks[j][d], dot);
                const float sv = dot * 0.125f + (ct - Cs[j]);
                const float mn = fmaxf(m, sv);
                const float corr = expf(m - mn), p = expf(sv - mn);
                l = l * corr + p;
#pragma unroll
                for (int d = 0; d < 64; ++d) o[d] = fmaf(p, Vs[j][d], o[d] * corr);
                m = mn;
            }
        }
    }
    const float inv = 1.f / l;
    float* orow = attn + (size_t)(b * SEQ + t) * D_MODEL + h * 64;
#pragma unroll
    for (int d = 0; d < 64; d += 4) *(float4*)(orow + d) = make_float4(o[d] * inv, o[d + 1] * inv, o[d + 2] * inv, o[d + 3] * inv);
}

__device__ __forceinline__ void rope_cs(int pos, int i, float& cs, float& sn) {
    const float inv = powf(10000.0f, -(float)i / 32.0f);
    const float ang = (float)pos * inv;
    double rev = (double)ang * 0.15915494309189535;
    rev -= floor(rev);
    const float r = (float)rev;
    cs = __builtin_amdgcn_cosf(r); sn = __builtin_amdgcn_sinf(r);
}

__global__ void __launch_bounds__(64) nv_swa(const float* __restrict__ proj, const float* __restrict__ sinks, float* __restrict__ attn) {
    __shared__ float Ks[64][64];
    __shared__ float Vs[64][64];
    const int tid = threadIdx.x;
    const int qb = blockIdx.x, hq = blockIdx.y, b = blockIdx.z, kvh = hq / 4;
    const int t = qb * 64 + tid;
    const float* prow = proj + (size_t)(b * SEQ) * IN_COLS;
    float q[64], o[64];
#pragma unroll
    for (int d = 0; d < 64; d += 4) { const float4 v = *(const float4*)(prow + (size_t)t * IN_COLS + OFF_SQ + hq * 64 + d); q[d] = v.x; q[d + 1] = v.y; q[d + 2] = v.z; q[d + 3] = v.w; }
#pragma unroll
    for (int i = 0; i < 32; ++i) { float cs, sn; rope_cs(t, i, cs, sn); const float x1 = q[i], x2 = q[i + 32]; q[i] = x1 * cs - x2 * sn; q[i + 32] = x2 * cs + x1 * sn; }
#pragma unroll
    for (int d = 0; d < 64; ++d) o[d] = 0.f;
    float m = sinks[hq], l = 1.f;
    const int t0 = qb * 64;
    int kt0 = (t0 - 127) < 0 ? 0 : (t0 - 127) / 64;
    for (int kt = kt0; kt <= qb; ++kt) {
        __syncthreads();
        for (int i = tid; i < 64 * 32; i += 64) {
            const int r = i >> 5, d = i & 31; const int s = kt * 64 + r;
            const float x1 = prow[(size_t)s * IN_COLS + OFF_SK + kvh * 64 + d], x2 = prow[(size_t)s * IN_COLS + OFF_SK + kvh * 64 + d + 32];
            float cs, sn; rope_cs(s, d, cs, sn);
            Ks[r][d] = x1 * cs - x2 * sn; Ks[r][d + 32] = x2 * cs + x1 * sn;
            Vs[r][d] = prow[(size_t)s * IN_COLS + OFF_SV + kvh * 64 + d]; Vs[r][d + 32] = prow[(size_t)s * IN_COLS + OFF_SV + kvh * 64 + d + 32];
        }
        __syncthreads();
        for (int j = 0; j < 64; ++j) {
            const int s = kt * 64 + j;
            if (s <= t && t - s < WINDOW) {
                float dot = 0.f;
#pragma unroll
                for (int d = 0; d < 64; ++d) dot = fmaf(q[d], Ks[j][d], dot);
                const float sv = dot * 0.125f;
                const float mn = fmaxf(m, sv);
                const float corr = expf(m - mn), p = expf(sv - mn);
                l = l * corr + p;
#pragma unroll
                for (int d = 0; d < 64; ++d) o[d] = fmaf(p, Vs[j][d], o[d] * corr);
                m = mn;
            }
        }
    }
    const float inv = 1.f / l;
    float* orow = attn + (size_t)(b * SEQ + t) * D_MODEL + 512 + hq * 64;
#pragma unroll
    for (int d = 0; d < 64; d += 4) *(float4*)(orow + d) = make_float4(o[d] * inv, o[d + 1] * inv, o[d + 2] * inv, o[d + 3] * inv);
}

__device__ __forceinline__ float wave_sum(float v) {
#pragma unroll
    for (int o = 1; o < 64; o <<= 1) v += __shfl_xor(v, o);
    return v;
}

__global__ void __launch_bounds__(256) nv_ln_res(const float* __restrict__ x, const float* y, const float* __restrict__ g, const float* __restrict__ bb, float* out, int rows) {
    const int lane = threadIdx.x & 63, row = blockIdx.x * 4 + (threadIdx.x >> 6);
    if (row >= rows) return;
    float4 v[4]; float s = 0.f;
#pragma unroll
    for (int j = 0; j < 4; ++j) {
        const float4 a = *(const float4*)(x + (size_t)row * D_MODEL + (lane + 64 * j) * 4), c = *(const float4*)(y + (size_t)row * D_MODEL + (lane + 64 * j) * 4);
        v[j] = make_float4(ALPHA * a.x + c.x, ALPHA * a.y + c.y, ALPHA * a.z + c.z, ALPHA * a.w + c.w);
        s += (v[j].x + v[j].y) + (v[j].z + v[j].w);
    }
    const float mean = wave_sum(s) * (1.f / D_MODEL); float s2 = 0.f;
#pragma unroll
    for (int j = 0; j < 4; ++j) { v[j].x -= mean; v[j].y -= mean; v[j].z -= mean; v[j].w -= mean; s2 += (v[j].x * v[j].x + v[j].y * v[j].y) + (v[j].z * v[j].z + v[j].w * v[j].w); }
    const float rstd = 1.f / sqrtf(wave_sum(s2) * (1.f / D_MODEL) + LN_EPS);
#pragma unroll
    for (int j = 0; j < 4; ++j) {
        const float4 gg = *(const float4*)(g + (lane + 64 * j) * 4), b4 = *(const float4*)(bb + (lane + 64 * j) * 4);
        *(float4*)(out + (size_t)row * D_MODEL + (lane + 64 * j) * 4) = make_float4(v[j].x * rstd * gg.x + b4.x, v[j].y * rstd * gg.y + b4.y, v[j].z * rstd * gg.z + b4.z, v[j].w * rstd * gg.w + b4.w);
    }
}

__global__ void __launch_bounds__(64) nv_peer_topk(const float* __restrict__ q, const float* __restrict__ sub_keys, int* __restrict__ idx_out, float* __restrict__ g_out) {
    __shared__ float sc[256][64];
    __shared__ float qs[128][64];
    __shared__ int tis[32][64];
    __shared__ float tvs[32][64];
    const int tid = threadIdx.x, h = blockIdx.y, t = blockIdx.x * 64 + tid;
    for (int p = 0; p < 2; ++p) {
        for (int cidx = 0; cidx < 128; cidx += 4) { const float4 v = *(const float4*)(q + (size_t)t * QCOLS + h * 256 + p * 128 + cidx); qs[cidx][tid] = v.x; qs[cidx + 1][tid] = v.y; qs[cidx + 2][tid] = v.z; qs[cidx + 3][tid] = v.w; }
        const float* kp = sub_keys + (size_t)(h * 2 + p) * NKEYS * PEER_HALF;
        for (int n = 0; n < NKEYS; ++n) {
            float dot = 0.f;
#pragma unroll 8
            for (int cidx = 0; cidx < 128; ++cidx) dot = fmaf(qs[cidx][tid], kp[n * PEER_HALF + cidx], dot);
            sc[n][tid] = dot;
        }
        for (int k = 0; k < 16; ++k) {
            float best = -INFINITY; int bi = 0;
            for (int n = 0; n < NKEYS; ++n) { const float v = sc[n][tid]; if (v > best) { best = v; bi = n; } }
            tvs[p * 16 + k][tid] = best; tis[p * 16 + k][tid] = bi; sc[bi][tid] = -INFINITY;
        }
    }
    for (int i = 0; i < 16; ++i)
        for (int j = 0; j < 16; ++j) sc[i * 16 + j][tid] = tvs[i][tid] + tvs[16 + j][tid];
    float bs0 = 0.f, esum = 0.f;
    int* io = idx_out + ((size_t)t * PEER_H + h) * TOPK;
    float* go = g_out + ((size_t)t * PEER_H + h) * TOPK;
    for (int k = 0; k < 16; ++k) {
        float best = -INFINITY; int bpos = 0;
        for (int n = 0; n < 256; ++n) { const float v = sc[n][tid]; if (v > best) { best = v; bpos = n; } }
        sc[bpos][tid] = -INFINITY;
        const int e = tis[bpos >> 4][tid] * NKEYS + tis[16 + (bpos & 15)][tid];
        if (k == 0) bs0 = best;
        const float ev = expf(best - bs0);
        esum += ev;
        io[k] = e; go[k] = ev;
    }
    const float inv = 1.f / esum;
    for (int k = 0; k < 16; ++k) go[k] *= inv;
}

__global__ void __launch_bounds__(256) nv_peer_expert(const float* __restrict__ x1, const int* __restrict__ idx, const float* __restrict__ gw, const float* __restrict__ eu, const float* __restrict__ ev,
                                                      const float* __restrict__ g2, const float* __restrict__ b2, float* __restrict__ out, int rows) {
    const int lane = threadIdx.x & 63, row = blockIdx.x * 4 + (threadIdx.x >> 6);
    if (row >= rows) return;
    float4 xv[4], acc[4];
#pragma unroll
    for (int j = 0; j < 4; ++j) { xv[j] = *(const float4*)(x1 + (size_t)row * D_MODEL + (lane + 64 * j) * 4); acc[j] = make_float4(0.f, 0.f, 0.f, 0.f); }
    for (int k = 0; k < PEER_H * TOPK; ++k) {
        const int e = idx[(size_t)row * 128 + k]; const float gk = gw[(size_t)row * 128 + k];
        const float* ur = eu + (size_t)e * D_MODEL; const float* vr = ev + (size_t)e * D_MODEL;
        float dot = 0.f;
#pragma unroll
        for (int j = 0; j < 4; ++j) { const float4 u = *(const float4*)(ur + (lane + 64 * j) * 4); dot += (u.x * xv[j].x + u.y * xv[j].y) + (u.z * xv[j].z + u.w * xv[j].w); }
        dot = wave_sum(dot);
        const float hval = 0.5f * dot * (1.f + erff(dot * 0.7071067811865476f));
        const float w = gk * hval;
#pragma unroll
        for (int j = 0; j < 4; ++j) { const float4 v = *(const float4*)(vr + (lane + 64 * j) * 4); acc[j].x = fmaf(w, v.x, acc[j].x); acc[j].y = fmaf(w, v.y, acc[j].y); acc[j].z = fmaf(w, v.z, acc[j].z); acc[j].w = fmaf(w, v.w, acc[j].w); }
    }
    float4 v[4]; float s = 0.f;
#pragma unroll
    for (int j = 0; j < 4; ++j) { v[j] = make_float4(ALPHA * xv[j].x + acc[j].x, ALPHA * xv[j].y + acc[j].y, ALPHA * xv[j].z + acc[j].z, ALPHA * xv[j].w + acc[j].w); s += (v[j].x + v[j].y) + (v[j].z + v[j].w); }
    const float mean = wave_sum(s) * (1.f / D_MODEL); float s2 = 0.f;
#pragma unroll
    for (int j = 0; j < 4; ++j) { v[j].x -= mean; v[j].y -= mean; v[j].z -= mean; v[j].w -= mean; s2 += (v[j].x * v[j].x + v[j].y * v[j].y) + (v[j].z * v[j].z + v[j].w * v[j].w); }
    const float rstd = 1.f / sqrtf(wave_sum(s2) * (1.f / D_MODEL) + LN_EPS);
#pragma unroll
    for (int j = 0; j < 4; ++j) {
        const float4 gg = *(const float4*)(g2 + (lane + 64 * j) * 4), b4 = *(const float4*)(b2 + (lane + 64 * j) * 4);
        *(float4*)(out + (size_t)row * D_MODEL + (lane + 64 * j) * 4) = make_float4(v[j].x * rstd * gg.x + b4.x, v[j].y * rstd * gg.y + b4.y, v[j].z * rstd * gg.z + b4.z, v[j].w * rstd * gg.w + b4.w);
    }
}

extern "C" void kernel_launch(void* const* d_in, const int* in_sizes, int n_in, void* d_out, int out_size, void* d_ws, size_t ws_size, hipStream_t stream) {
    const float* x = (const float*)d_in[0]; const float* w_in = (const float*)d_in[1]; const float* b_forget = (const float*)d_in[2]; const float* sinks = (const float*)d_in[3];
    const float* w_out = (const float*)d_in[4]; const float* ln1_g = (const float*)d_in[5]; const float* ln1_b = (const float*)d_in[6]; const float* w_query = (const float*)d_in[7];
    const float* sub_keys = (const float*)d_in[8]; const float* eu = (const float*)d_in[9]; const float* ev = (const float*)d_in[10]; const float* ln2_g = (const float*)d_in[11]; const float* ln2_b = (const float*)d_in[12];
    float* out = (float*)d_out;
    char* ws = (char*)d_ws;
    constexpr size_t MiB = 1u << 20;
    float* proj = (float*)(ws);
    float* cbuf = (float*)(ws + 292 * MiB);
    float* x1 = (float*)(ws + 296 * MiB);
    int* idx = (int*)(ws + 428 * MiB);
    float* gbuf = (float*)(ws + 444 * MiB);
    if (ws_size < 460 * MiB) { fprintf(stderr, "workspace too small\n"); return; }
    float* attn = out;
    nv_gemm<<<dim3((IN_COLS + 127) / 128, T / 128), 256, 0, stream>>>(x, D_MODEL, w_in, IN_COLS, proj, IN_COLS, T, IN_COLS, D_MODEL);
    nv_forget_cumsum<<<1, 64, 0, stream>>>(proj, b_forget, cbuf);
    nv_fox<<<dim3(SEQ / 64, FOX_H, BATCH), 64, 0, stream>>>(proj, cbuf, attn);
    nv_swa<<<dim3(SEQ / 64, SWA_H, BATCH), 64, 0, stream>>>(proj, sinks, attn);
    nv_gemm<<<dim3(D_MODEL / 128, T / 128), 256, 0, stream>>>(attn, D_MODEL, w_out, D_MODEL, x1, D_MODEL, T, D_MODEL, D_MODEL);
    nv_ln_res<<<T / 4, 256, 0, stream>>>(x, x1, ln1_g, ln1_b, x1, T);
    float* q = proj;
    nv_gemm<<<dim3(QCOLS / 128, T / 128), 256, 0, stream>>>(x1, D_MODEL, w_query, QCOLS, q, QCOLS, T, QCOLS, D_MODEL);
    nv_peer_topk<<<dim3(T / 64, PEER_H), 64, 0, stream>>>(q, sub_keys, idx, gbuf);
    nv_peer_expert<<<T / 4, 256, 0, stream>>>(x1, idx, gbuf, eu, ev, ln2_g, ln2_b, out, T);
}
```

```cpp
#include <hip/hip_runtime.h>
#include <hip/hip_bf16.h>
#include <hip/hip_cooperative_groups.h>
#include <cstdint>
#include <cstdio>
#include <cmath>

#ifndef DBG_STAGE
#define DBG_STAGE 0
#endif

namespace cfg {
constexpr int D_MODEL = 1024, BATCH = 8, SEQ = 4096, T = BATCH * SEQ;
constexpr int HD = 64, FOX_H = 8, SWA_H = 8, SWA_KVH = 2;
constexpr int OFF_FQ = 0, OFF_FK = 512, OFF_FV = 1024, OFF_FF = 1536, OFF_SQ = 1544, OFF_SK = 2056, OFF_SV = 2184, IN_COLS = 2312;
constexpr int NPHYS = 2304;
constexpr int WINDOW = 128;
constexpr int PEER_H = 8, NKEYS = 128, PEER_HALF = 128, TOPK = 16, QCOLS = 2048, NEXP = 16384;
constexpr float LN_EPS = 1e-5f;
constexpr float ALPHA = 1.189207115002721f;
constexpr float LOG2E = 1.4426950408889634f;
constexpr float C2 = 0.125f * LOG2E;
}
using namespace cfg;

namespace pg8 {
#define PG8_LAS __attribute__((address_space(3)))
typedef unsigned short bf16_t;
typedef short bf16x8 __attribute__((ext_vector_type(8)));
typedef float f32x4 __attribute__((ext_vector_type(4)));
typedef unsigned u32x4 __attribute__((ext_vector_type(4)));
constexpr int BM = 256, BK = 64, HALF = 128, HTB = HALF * BK * 2  , STAGE_BYTES = 8 * HTB, NXCD = 8, WGM = 8;

__host__ __device__ __forceinline__ int lds_byte(int r, int c) { const int st = (r >> 4) * 2 + (c >> 5), rr = r & 15, cc = c & 31, ob = rr * 64 + cc * 2; return st * 1024 + (ob ^ (((ob >> 9) & 1) << 5)); }
__host__ __device__ __forceinline__ void stage_rc(int b, int& R, int& C) { const int st = b / 1024, sb = b % 1024, swz = sb ^ (((sb >> 9) & 1) << 5); R = (st >> 1) * 16 + swz / 64; C = (st & 1) * 32 + (swz % 64) / 2; }
__host__ __device__ __forceinline__ int perm32(int rho) { const int n = rho >> 4, i = rho & 15; return 8 * (i >> 2) + 4 * n + (i & 3); }

struct Unit { int pm, pn; };
struct Gemm { const bf16_t* A; const bf16_t* Bt; int M, N, K; };

struct StaticOrder {
    int nM, nN, nwg, G, c;
    __host__ __device__ void init(int M, int N, int G_, int c_) { nM = M / BM; nN = N / BM; nwg = nM * nN; G = G_; c = c_; }
    __host__ __device__ bool next(int i, Unit& u) const {
        const long L = (long)i * G + c; if (L >= nwg) return false;
        int wgid = (int)L; { const int q = nwg / NXCD, r = nwg % NXCD, xcd = wgid % NXCD, off = wgid / NXCD; wgid = (xcd < r ? xcd * (q + 1) : r * (q + 1) + (xcd - r) * q) + off; }
        const int nig = WGM * nN, gid = wgid / nig, fm = gid * WGM, gsz = (nM - fm) < WGM ? (nM - fm) : WGM;
        u.pm = fm + ((wgid % nig) % gsz); u.pn = (wgid % nig) / gsz; return true;
    }
    __device__ __forceinline__ void a_ready(const Unit&) const {}
    __device__ __forceinline__ void done(const Unit&) const {}
};
__device__ __forceinline__ unsigned cvt_pk_bf16(float lo, float hi) { unsigned r; asm volatile("v_cvt_pk_bf16_f32 %0, %1, %2" : "=v"(r) : "v"(lo), "v"(hi)); return r; }
typedef float f32x2 __attribute__((ext_vector_type(2)));
template <bool I8> __device__ __forceinline__ f32x4 pg8_mma(bf16x8 a, bf16x8 b, f32x4 c) {
    if constexpr (I8) { typedef int v4i_ __attribute__((ext_vector_type(4)));
        return __builtin_bit_cast(f32x4, __builtin_amdgcn_mfma_i32_16x16x64_i8(__builtin_bit_cast(v4i_, a), __builtin_bit_cast(v4i_, b), __builtin_bit_cast(v4i_, c), 0, 0, 0)); }
    else return __builtin_amdgcn_mfma_f32_16x16x32_bf16(a, b, c, 0, 0, 0);
}
template <class Epi, class Sched, bool ALIGN_EPI = false, bool SP2 = false, bool I8 = false>
__device__ __forceinline__ void gemm_phase(PG8_LAS unsigned char* lds, const Gemm g, const Sched& S, const Epi& E) {
    const int tid = threadIdx.x, wid = __builtin_amdgcn_readfirstlane(tid >> 6), lane = tid & 63, wr = wid >> 2, wc = wid & 3, fr = lane & 15, fq = lane >> 4;
    const int K = g.K, nt = K / BK;
    unsigned voffA[2], voffB[2];
#pragma unroll
    for (int i = 0; i < 2; ++i) { int R, C; stage_rc(tid * 16 + i * 8192, R, C); const int Rb = Epi::PERM ? ((R & ~31) + perm32(R & 31)) : R;
        voffA[i] = (unsigned)(R * K + C) * 2u; voffB[i] = (unsigned)(Rb * K + C) * 2u; }
    const size_t kstep = (size_t)(BK * 2);
    const size_t hstep = (size_t)HALF * K * 2;
    const size_t tstep = 2 * hstep;
    const unsigned ldsw = (unsigned)wid * 1024u;
    const int aoff = lds_byte(wr * 64 + fr, fq * 8), boff = lds_byte(wc * 32 + fr, fq * 8);
#define PG8_SA(b, h) (((b) * 2 + (h)) * HTB)
#define PG8_SB(b, h) ((4 + (b) * 2 + (h)) * HTB)
#define PG8_STAGE(bufoff, gbase, voff) do { _Pragma("unroll") for (int _i = 0; _i < 2; ++_i) \
        __builtin_amdgcn_global_load_lds((const unsigned*)((const char*)(gbase) + (voff)[_i]), (PG8_LAS unsigned*)(lds + (bufoff) + ldsw + _i * 8192), 16, 0, 0); } while (0)
#define PG8_LDA(dst, b, h) do { _Pragma("unroll") for (int m = 0; m < 4; ++m) _Pragma("unroll") for (int k = 0; k < 2; ++k) dst[m][k] = *(const PG8_LAS bf16x8*)(lds + PG8_SA(b, h) + aoff + m * 2048 + k * 1024); } while (0)
#define PG8_LDB(dst, b, h) do { _Pragma("unroll") for (int n = 0; n < 2; ++n) _Pragma("unroll") for (int k = 0; k < 2; ++k) dst[n][k] = *(const PG8_LAS bf16x8*)(lds + PG8_SB(b, h) + boff + n * 2048 + k * 1024); } while (0)
#define PG8_MMA(ai, bj, At, Bt) do { __builtin_amdgcn_s_setprio(1); _Pragma("unroll") for (int m = 0; m < 4; ++m) _Pragma("unroll") for (int n = 0; n < 2; ++n) _Pragma("unroll") for (int k = 0; k < 2; ++k) \
        acc[ai][bj][m][n] = pg8_mma<I8>(Bt[n][k], At[m][k], acc[ai][bj][m][n]); __builtin_amdgcn_s_setprio(0); } while (0)
#define PG8_WAIT_V(n) asm volatile("s_waitcnt vmcnt(" #n ")" ::: "memory")
#define PG8_WAIT_L(n) asm volatile("s_waitcnt lgkmcnt(" #n ")" ::: "memory")
#define PG8_BAR __builtin_amdgcn_s_barrier()
#define PG8_SCHED __builtin_amdgcn_sched_barrier(0)
    Unit cur, nxt; int ui = 0;
    if (!S.next(0, cur)) return;
    f32x4 acc[2][2][4][2];
#pragma unroll
    for (int a = 0; a < 2; ++a)
#pragma unroll
        for (int b = 0; b < 2; ++b)
#pragma unroll
            for (int m = 0; m < 4; ++m)
#pragma unroll
                for (int n = 0; n < 2; ++n) acc[a][b][m][n] = (f32x4){0.f, 0.f, 0.f, 0.f};
    bf16x8 At[4][2], B0[2][2], B1[2][2];
    const char* cA = (const char*)g.A + (size_t)cur.pm * tstep; const char* cB = (const char*)g.Bt + (size_t)cur.pn * tstep;
    S.a_ready(cur);
    if constexpr (SP2) {
        PG8_STAGE(PG8_SB(0, 0), cB, voffB); PG8_STAGE(PG8_SB(0, 1), cB + hstep, voffB); PG8_STAGE(PG8_SA(0, 0), cA, voffA); PG8_STAGE(PG8_SA(0, 1), cA + hstep, voffA);
        if (wr == 1) PG8_BAR;
        PG8_WAIT_V(2); PG8_BAR;
        PG8_STAGE(PG8_SB(1, 0), cB + kstep, voffB); PG8_STAGE(PG8_SA(1, 0), cA + kstep, voffA); PG8_STAGE(PG8_SB(1, 1), cB + hstep + kstep, voffB);
        PG8_WAIT_V(6); PG8_BAR;
    } else {
        PG8_STAGE(PG8_SB(0, 0), cB, voffB); PG8_STAGE(PG8_SA(0, 0), cA, voffA); PG8_STAGE(PG8_SB(0, 1), cB + hstep, voffB); PG8_STAGE(PG8_SA(0, 1), cA + hstep, voffA);
        if (wr == 1) PG8_BAR;
        PG8_WAIT_V(4); PG8_BAR;
        PG8_STAGE(PG8_SB(1, 0), cB + kstep, voffB); PG8_STAGE(PG8_SA(1, 0), cA + kstep, voffA); PG8_STAGE(PG8_SB(1, 1), cB + hstep + kstep, voffB);
        PG8_WAIT_V(6); PG8_BAR;
    }
    for (;;) {
        const bool has_next = S.next(ui + 1, nxt);
        const char* nA = has_next ? (const char*)g.A + (size_t)nxt.pm * tstep : cA; const char* nB = has_next ? (const char*)g.Bt + (size_t)nxt.pn * tstep : cB;
        for (int t = 0; t < nt; t += 2) {
            const bool last = (t == nt - 2);
            const char* a1 = cA + (size_t)(t + 1) * kstep;
            const char* a2 = last ? nA : cA + (size_t)(t + 2) * kstep; const char* b2 = last ? nB : cB + (size_t)(t + 2) * kstep;
            const char* a3 = a2 + kstep; const char* b3 = b2 + kstep;
            if (last && has_next) S.a_ready(nxt);
            if constexpr (SP2) {
            PG8_LDB(B0, 0, 0); PG8_LDB(B1, 0, 1); PG8_SCHED; PG8_LDA(At, 0, 0); PG8_STAGE(PG8_SA(1, 1), a1 + hstep, voffA);
            PG8_WAIT_V(8); PG8_WAIT_L(0); PG8_BAR; PG8_MMA(0, 0, At, B0); PG8_MMA(0, 1, At, B1); PG8_BAR; PG8_SCHED;
            PG8_LDA(At, 0, 1); PG8_STAGE(PG8_SB(0, 0), b2, voffB); PG8_STAGE(PG8_SB(0, 1), b2 + hstep, voffB); PG8_STAGE(PG8_SA(0, 0), a2, voffA);
            PG8_WAIT_V(8); PG8_WAIT_L(0); PG8_BAR; PG8_MMA(1, 0, At, B0); PG8_MMA(1, 1, At, B1); PG8_BAR; PG8_SCHED;
            PG8_LDB(B0, 1, 0); PG8_LDB(B1, 1, 1); PG8_SCHED; PG8_LDA(At, 1, 0); PG8_STAGE(PG8_SA(0, 1), a2 + hstep, voffA);
            PG8_WAIT_V(8); PG8_WAIT_L(0); PG8_BAR; PG8_MMA(0, 0, At, B0); PG8_MMA(0, 1, At, B1); PG8_BAR; PG8_SCHED;
            PG8_LDA(At, 1, 1); PG8_STAGE(PG8_SB(1, 0), b3, voffB); PG8_STAGE(PG8_SB(1, 1), b3 + hstep, voffB); PG8_STAGE(PG8_SA(1, 0), a3, voffA);
            PG8_WAIT_V(8); PG8_WAIT_L(0); PG8_BAR; PG8_MMA(1, 0, At, B0); PG8_MMA(1, 1, At, B1); PG8_BAR; PG8_SCHED;
            } else {
            PG8_LDB(B0, 0, 0); PG8_SCHED; PG8_LDA(At, 0, 0); PG8_STAGE(PG8_SA(1, 1), a1 + hstep, voffA);
            PG8_WAIT_L(8); PG8_BAR; PG8_WAIT_L(0); PG8_MMA(0, 0, At, B0); PG8_BAR; PG8_SCHED;
            PG8_LDB(B1, 0, 1); PG8_STAGE(PG8_SB(0, 0), b2, voffB);
            PG8_BAR; PG8_WAIT_L(0); PG8_MMA(0, 1, At, B1); PG8_BAR;
            PG8_LDA(At, 0, 1); PG8_STAGE(PG8_SA(0, 0), a2, voffA);
            PG8_BAR; PG8_WAIT_L(0); PG8_MMA(1, 0, At, B0); PG8_BAR; PG8_SCHED;
            PG8_STAGE(PG8_SB(0, 1), b2 + hstep, voffB);
            PG8_WAIT_V(6); PG8_BAR; PG8_MMA(1, 1, At, B1); PG8_BAR;
            PG8_LDB(B0, 1, 0); PG8_SCHED; PG8_LDA(At, 1, 0); PG8_STAGE(PG8_SA(0, 1), a2 + hstep, voffA);
            PG8_WAIT_L(8); PG8_BAR; PG8_WAIT_L(0); PG8_MMA(0, 0, At, B0); PG8_BAR; PG8_SCHED;
            PG8_LDB(B1, 1, 1); PG8_STAGE(PG8_SB(1, 0), b3, voffB);
            PG8_BAR; PG8_WAIT_L(0); PG8_MMA(0, 1, At, B1); PG8_BAR;
            PG8_LDA(At, 1, 1); PG8_STAGE(PG8_SA(1, 0), a3, voffA);
            PG8_BAR; PG8_WAIT_L(0); PG8_MMA(1, 0, At, B0); PG8_BAR; PG8_SCHED;
            PG8_STAGE(PG8_SB(1, 1), b3 + hstep, voffB);
            PG8_WAIT_V(6); PG8_BAR; PG8_MMA(1, 1, At, B1); PG8_BAR;
            }
        }
        if constexpr (ALIGN_EPI) { if (wr == 0) PG8_BAR; }
        if constexpr (!Epi::AFTER_DRAIN) { E(acc, cur, wr, wc, fr, fq); S.done(cur); }
        if (!has_next) break;
#pragma unroll
        for (int a = 0; a < 2; ++a)
#pragma unroll
            for (int b = 0; b < 2; ++b)
#pragma unroll
                for (int m = 0; m < 4; ++m)
#pragma unroll
                    for (int n = 0; n < 2; ++n) acc[a][b][m][n] = (f32x4){0.f, 0.f, 0.f, 0.f};
        cur = nxt; cA = nA; cB = nB; ++ui;
        if constexpr (ALIGN_EPI) { if (wr == 1) PG8_BAR; }
    }
    PG8_WAIT_V(0);
    if constexpr (!ALIGN_EPI) { if (wr == 0) PG8_BAR; }
    PG8_BAR;
    if constexpr (Epi::AFTER_DRAIN) { E.fused(acc, cur, wr, wc, fr, fq, lds, wid, lane); S.done(cur); }
#undef PG8_SA
#undef PG8_SB
#undef PG8_STAGE
#undef PG8_LDA
#undef PG8_LDB
#undef PG8_MMA
#undef PG8_WAIT_V
#undef PG8_WAIT_L
#undef PG8_BAR
#undef PG8_SCHED
}
}
#define GAS __attribute__((address_space(1)))
#define LAS __attribute__((address_space(3)))
typedef unsigned short bf16;
typedef unsigned v4u __attribute__((ext_vector_type(4)));
typedef float f32x4 __attribute__((ext_vector_type(4)));
typedef short bf16x8 __attribute__((ext_vector_type(8)));
typedef GAS unsigned gu32;
typedef GAS unsigned long long gu64;
#define RLX_AGENT __ATOMIC_RELAXED, __HIP_MEMORY_SCOPE_AGENT
#define LDS_WAIT() asm volatile("s_waitcnt lgkmcnt(0)" ::: "memory")
#define VM_WAIT() asm volatile("s_waitcnt vmcnt(0)" ::: "memory")
__device__ __forceinline__ unsigned long long rt() { return __builtin_amdgcn_s_memrealtime(); }
__device__ __forceinline__ unsigned f2bf(float f) { unsigned u = __builtin_bit_cast(unsigned, f); return (u + 0x7fffu + ((u >> 16) & 1u)) >> 16; }
__device__ __forceinline__ unsigned pk2(float lo, float hi) { return f2bf(lo) | (f2bf(hi) << 16); }
#define XB_TMO      128
#define XB_XCNT(j)  (256  + 64 * (j))
#define XB_XSUB(j)  (1280 + 64 * (j))
#define XB_XGEN(j)  (2304 + 64 * (j))
#define XB_TOP      3328
#define XB_TOPGEN   3392
#define XCD_BAR_WORDS 3456
#define XB_SPIN_CAP (1u << 18)

__device__ __forceinline__ unsigned xb_ld(unsigned* p)              { return __hip_atomic_load(p, __ATOMIC_RELAXED, __HIP_MEMORY_SCOPE_AGENT); }
__device__ __forceinline__ unsigned xb_add(unsigned* p, unsigned v) { return __hip_atomic_fetch_add(p, v, __ATOMIC_RELAXED, __HIP_MEMORY_SCOPE_AGENT); }
__device__ __forceinline__ unsigned xb_xcc_id() { return (unsigned)__builtin_amdgcn_s_getreg((3 << 11) | 20) & 0xFu; }
#define XB_SPIN(cond, bar) do { unsigned _sp = 0; while (cond) { __builtin_amdgcn_s_sleep(1); \
    if ((++_sp & 255u) == 0u) { if (xb_ld(&(bar)[XB_TMO])) break; if (_sp > XB_SPIN_CAP) { atomicAdd(&(bar)[XB_TMO], 1u); break; } } } } while (0)

struct XcdBarrier {
    unsigned* bar; unsigned x;
    volatile LAS unsigned* st;
};

__device__ __forceinline__ XcdBarrier xcd_barrier_post(unsigned* bar, volatile LAS unsigned* st) {
    XcdBarrier b; b.bar = bar; b.x = xb_xcc_id(); b.st = st;
    if (threadIdx.x == 0) (void)xb_add(&bar[XB_XCNT(b.x)], 1u);
    return b;
}
__device__ __forceinline__ void xcd_barrier_complete(unsigned* bar, unsigned x, unsigned& nloc, unsigned& nx) {
    const unsigned G = gridDim.x * gridDim.y * gridDim.z;
    unsigned sum, cnt, mine, sp = 0u;
    for (;;) {
        sum = 0u; cnt = 0u; mine = 0u;
#pragma unroll
        for (unsigned j = 0; j < 16; ++j) { const unsigned c = xb_ld(&bar[XB_XCNT(j)]); sum += c; cnt += (c > 0u) ? 1u : 0u; mine = (j == x) ? c : mine; }
        if (sum == G) break;
        __builtin_amdgcn_s_sleep(1);
        if ((++sp & 255u) == 0u) { if (xb_ld(&bar[XB_TMO])) break; if (sp > XB_SPIN_CAP) { atomicAdd(&bar[XB_TMO], 1u); break; } }
    }
    nloc = mine > 0u ? mine : 1u; nx = cnt > 0u ? cnt : 1u;
}

__device__ __forceinline__ void xcd_barrier(const XcdBarrier& b) {
    asm volatile("s_waitcnt vmcnt(0)" ::: "memory");
    __syncthreads();
    if (threadIdx.x == 0) {
        unsigned* bar = b.bar;
        __builtin_amdgcn_s_waitcnt(0);
        unsigned nloc = b.st[0], nx = b.st[1];
        if (nloc == 0u) { xcd_barrier_complete(bar, b.x, nloc, nx); b.st[0] = nloc; b.st[1] = nx; }
        const unsigned old = xb_add(&bar[XB_XSUB(b.x)], 1u);
        const unsigned gen = old / nloc;
        if (old + 1u == (gen + 1u) * nloc) {
            __builtin_amdgcn_fence(__ATOMIC_RELEASE, "agent");
            asm volatile("s_waitcnt vmcnt(0)" ::: "memory");
            const unsigned og = xb_add(&bar[XB_TOP], 1u);
            const unsigned tg = og / nx;
            if (og + 1u == (tg + 1u) * nx) xb_add(&bar[XB_TOPGEN], 1u);
            else XB_SPIN(xb_ld(&bar[XB_TOPGEN]) == tg, bar);
            __builtin_amdgcn_fence(__ATOMIC_ACQUIRE, "agent");
            xb_add(&bar[XB_XGEN(b.x)], 1u);
            asm volatile("s_waitcnt vmcnt(0)" ::: "memory");
        } else {
            XB_SPIN(xb_ld(&bar[XB_XGEN(b.x)]) == gen, bar);
            __builtin_amdgcn_fence(__ATOMIC_ACQUIRE, "agent");
            asm volatile("s_waitcnt vmcnt(0)" ::: "memory");
        }
    }
    __syncthreads();
}

constexpr size_t MiB = 1u << 20;
constexpr size_t WS_CTL = 0, CTL_ZERO_BYTES = 64 * 1024;
constexpr size_t WS_GW = 1 * MiB;
constexpr size_t WS_ROPE = 2 * MiB;
constexpr size_t WS_LF = 3 * MiB;
constexpr size_t WS_C = 4 * MiB;
constexpr size_t WS_QN2 = 5 * MiB, WS_KN2 = 5 * MiB + 64 * 1024;
constexpr size_t WS_STATS = 6 * MiB;
constexpr size_t WS_WIN = 10 * MiB;
constexpr size_t WS_WOUT = 15 * MiB;
constexpr size_t WS_WQ = 17 * MiB;
constexpr size_t WS_SUBK = 21 * MiB;
constexpr size_t WS_EU = 22 * MiB, WS_EV = 54 * MiB;
constexpr size_t WS_XB = 86 * MiB;
constexpr size_t WS_FQ = 150 * MiB, WS_FKT = 182 * MiB, WS_FVT = 214 * MiB, WS_SQ = 246 * MiB, WS_SKT = 278 * MiB, WS_SVT = 286 * MiB;
constexpr size_t WS_Q = 150 * MiB;
constexpr size_t WS_ATTN = 294 * MiB;
constexpr size_t WS_IDX = 294 * MiB, WS_G = 310 * MiB;
constexpr size_t WS_END = 358 * MiB;
constexpr size_t WS_MR = 5 * MiB + 128 * 1024;
constexpr size_t WS_STATS2 = 10 * MiB;
constexpr size_t WS_X1B = 86 * MiB;
constexpr size_t WS_HP = 150 * MiB;
constexpr size_t WS_V2 = 214 * MiB;
constexpr size_t EXP_SLICE_BYTES = (size_t)NEXP * 128;
constexpr float U_QS = 768.f, X_QS = 20.f, V_SCALE = 1.f;
constexpr size_t WS_XQ = 326 * MiB;
constexpr float SQ_X = 24.f, SQ_A = 24.f, SQ_WIN = 768.f, SQ_WOUT = 1280.f;
constexpr size_t WS_W16 = 358 * MiB;
constexpr size_t WS_X1Q = 326 * MiB;
constexpr int CW_QU = 8192, CW_QV = 8192 + 1024;
constexpr int EXP_SPLIT = 16384;
constexpr int CW_BAR = 1024;
static_assert((CW_BAR + XCD_BAR_WORDS) * 4 <= (int)CTL_ZERO_BYTES, "ctl");

constexpr int NWAVES = 8;
constexpr int RING_BYTES = 131072, MISC_OFF = RING_BYTES + 320, LDS_BYTES = 147456;

struct Frame {
    LAS unsigned char* lds;
    volatile LAS unsigned* MISC;
    gu32* ctl;
    int tid, lane, wave, vcu, G;
    const float* in[13]; float* out; unsigned char* ws;
};

__device__ __forceinline__ float wave_sum(float v) {
#pragma unroll
    for (int o = 1; o < 64; o <<= 1) v += __shfl_xor(v, o);
    return v;
}
__device__ __forceinline__ float wave_max(float v) {
#pragma unroll
    for (int o = 1; o < 64; o <<= 1) v = fmaxf(v, __shfl_xor(v, o));
    return v;
}

typedef unsigned u32x2 __attribute__((ext_vector_type(2)));
__device__ __forceinline__ unsigned q8x4(float a, float b, float c, float d_) {
    const int ia = (int)fminf(fmaxf(rintf(a), -127.f), 127.f), ib = (int)fminf(fmaxf(rintf(b), -127.f), 127.f), ic = (int)fminf(fmaxf(rintf(c), -127.f), 127.f), id = (int)fminf(fmaxf(rintf(d_), -127.f), 127.f);
    return ((unsigned)ia & 0xFFu) | (((unsigned)ib & 0xFFu) << 8) | (((unsigned)ic & 0xFFu) << 16) | ((unsigned)id << 24);
}
__device__ __forceinline__ int win_src_col(int pc) {
    if (pc < 1536) return pc;
    int r, base;
    if (pc < 2048) { r = pc - 1536; base = OFF_SQ; }
    else if (pc < 2176) { r = pc - 2048; base = OFF_SK; }
    else return OFF_SV + (pc - 2176);
    const int hd = r >> 6, p = r & 63;
    const int g = p >> 5, fq = (p >> 3) & 3, n = (p >> 2) & 1, e = p & 3;
    return base + hd * 64 + 16 * g + 4 * fq + e + 32 * n;
}
template <bool I8, class SrcCol, class Scale>
__device__ __forceinline__ void p0_transpose_item(const float* W, int ldw, int K, bf16* WT, LAS float* scr, int nblk, int item, int lane, SrcCol sc, Scale sk) {
    const int kb = item / nblk, nb = item % nblk, k0 = 64 * kb, n0 = 32 * nb;
    const int scol = sc(n0 + (lane & 31));
#pragma unroll 8
    for (int i = 0; i < 32; ++i) { const int kk = 2 * i + (lane >> 5); scr[kk * 33 + (lane & 31)] = W[(size_t)(k0 + kk) * ldw + scol] * sk(k0 + kk); }
    LDS_WAIT(); asm volatile("" ::: "memory");
    const int c = lane & 7;
#pragma unroll
    for (int j = 0; j < 4; ++j) { const int n = (lane >> 3) + 8 * j; const LAS float* s = scr + (8 * c) * 33 + n;
        if constexpr (I8) { u32x2 o; o.x = q8x4(s[0 * 33], s[1 * 33], s[2 * 33], s[3 * 33]); o.y = q8x4(s[4 * 33], s[5 * 33], s[6 * 33], s[7 * 33]);
            *(GAS u32x2*)((unsigned char*)WT + (size_t)(n0 + n) * K + k0 + 8 * c) = o; }
        else { v4u o; o.x = pk2(s[0 * 33], s[1 * 33]); o.y = pk2(s[2 * 33], s[3 * 33]); o.z = pk2(s[4 * 33], s[5 * 33]); o.w = pk2(s[6 * 33], s[7 * 33]);
            *(GAS v4u*)(WT + (size_t)(n0 + n) * K + k0 + 8 * c) = o; } }
    LDS_WAIT(); asm volatile("" ::: "memory");
}
__device__ __forceinline__ float log_sigmoid(float z) { return fminf(z, 0.f) - log1pf(__expf(-fabsf(z))); }

__device__ __forceinline__ void p0_prologue(Frame& F) {
    LAS float* scr = (LAS float*)(F.lds + F.wave * 16384);
    const int gw = F.vcu * NWAVES + F.wave, NGW = F.G * NWAVES, lane = F.lane;
    const float* x = F.in[0]; const float* w_in = F.in[1]; const float* b_forget = F.in[2]; const float* w_out = F.in[4]; const float* ln1_g = F.in[5];
    const float* w_query = F.in[7]; const float* sub_keys = F.in[8];
    bf16* WIN = (bf16*)(F.ws + WS_WIN); bf16* WOUT = (bf16*)(F.ws + WS_WOUT); bf16* WQ = (bf16*)(F.ws + WS_WQ); bf16* SUBK = (bf16*)(F.ws + WS_SUBK);
    bf16* XB = (bf16*)(F.ws + WS_XB);
    float2* ROPE = (float2*)(F.ws + WS_ROPE); float* LF = (float*)(F.ws + WS_LF);
    constexpr int I_IN = 16 * (NPHYS / 32), I_OUT = 16 * 32, I_Q = 16 * 64;
    for (int it = gw; it < I_IN + I_OUT + I_Q; it += NGW) {
        if (it < I_IN) p0_transpose_item<true>(w_in, IN_COLS, 1024, WIN, scr, NPHYS / 32, it, lane, [](int pc) { return win_src_col(pc); }, [](int) { return SQ_WIN; });
        else if (it < I_IN + I_OUT) p0_transpose_item<true>(w_out, 1024, 1024, WOUT, scr, 32, it - I_IN, lane, [](int pc) { return pc; }, [](int) { return SQ_WOUT; });
        else p0_transpose_item<false>(w_query, QCOLS, 1024, WQ, scr, 64, it - I_IN - I_OUT, lane, [](int pc) { return pc; }, [=](int k) { return ln1_g[k]; });
    }
    for (int it = gw; it < (PEER_H * 2 * NKEYS * PEER_HALF) / 512; it += NGW) {
        const size_t o = (size_t)it * 512 + lane * 8; const f32x4 a = *(const GAS f32x4*)(sub_keys + o), b = *(const GAS f32x4*)(sub_keys + o + 4);
        v4u w; w.x = pk2(a.x, a.y); w.y = pk2(a.z, a.w); w.z = pk2(b.x, b.y); w.w = pk2(b.z, b.w); *(GAS v4u*)(SUBK + o) = w;
    }
    for (int it = gw; it < (SEQ * 32) / 64; it += NGW) {
        const int e = it * 64 + lane, pos = e >> 5, i = e & 31;
        const float inv = powf(10000.0f, -(float)i / 32.0f), ang = (float)pos * inv;
        double rev = (double)ang * 0.15915494309189535; rev -= floor(rev);
        const float r = (float)rev;
        ROPE[e] = make_float2(__builtin_amdgcn_cosf(r), __builtin_amdgcn_sinf(r));
    }
    {
        float wff[16][8];
#pragma unroll
        for (int j = 0; j < 2; ++j)
#pragma unroll
            for (int e = 0; e < 8; ++e) { const float* wr_ = w_in + (size_t)(512 * j + 8 * lane + e) * IN_COLS + OFF_FF; const f32x4 a = *(const GAS f32x4*)wr_, b = *(const GAS f32x4*)(wr_ + 4);
                wff[j * 8 + e][0] = a.x; wff[j * 8 + e][1] = a.y; wff[j * 8 + e][2] = a.z; wff[j * 8 + e][3] = a.w; wff[j * 8 + e][4] = b.x; wff[j * 8 + e][5] = b.y; wff[j * 8 + e][6] = b.z; wff[j * 8 + e][7] = b.w; }
        const float bfl = b_forget[lane & 7];
        for (int m = gw; m < T; m += NGW) {
            const float* src = x + (size_t)m * D_MODEL; bf16* dst = XB + (size_t)m * D_MODEL;
            float xv[16];
#pragma unroll
            for (int j = 0; j < 2; ++j) { const f32x4 a = *(const GAS f32x4*)(src + 512 * j + 8 * lane), b = *(const GAS f32x4*)(src + 512 * j + 8 * lane + 4);
                xv[8 * j + 0] = a.x; xv[8 * j + 1] = a.y; xv[8 * j + 2] = a.z; xv[8 * j + 3] = a.w; xv[8 * j + 4] = b.x; xv[8 * j + 5] = b.y; xv[8 * j + 6] = b.z; xv[8 * j + 7] = b.w;
                v4u w; w.x = pk2(a.x, a.y); w.y = pk2(a.z, a.w); w.z = pk2(b.x, b.y); w.w = pk2(b.z, b.w); *(GAS v4u*)(dst + 512 * j + 8 * lane) = w;
                u32x2 wq; wq.x = q8x4(a.x * SQ_X, a.y * SQ_X, a.z * SQ_X, a.w * SQ_X); wq.y = q8x4(b.x * SQ_X, b.y * SQ_X, b.z * SQ_X, b.w * SQ_X);
                *(GAS u32x2*)(F.ws + WS_XQ + (size_t)m * D_MODEL + 512 * j + 8 * lane) = wq; }
            float acc[8];
#pragma unroll
            for (int h = 0; h < 8; ++h) { float s = 0.f;
#pragma unroll
                for (int d = 0; d < 16; ++d) s = fmaf(xv[d], wff[d][h], s);
                acc[h] = wave_sum(s); }
            float mine = acc[0];
#pragma unroll
            for (int h = 1; h < 8; ++h) mine = ((lane & 7) == h) ? acc[h] : mine;
            if (lane < 8) LF[(size_t)m * 8 + lane] = log_sigmoid(mine + bfl);
        }
    }
}

__device__ __forceinline__ pg8::f32x4 iacc(pg8::f32x4 a, float s) { typedef int v4i_ __attribute__((ext_vector_type(4))); const v4i_ i = __builtin_bit_cast(v4i_, a); return (pg8::f32x4){(float)i[0] * s, (float)i[1] * s, (float)i[2] * s, (float)i[3] * s}; }
struct EpiInProj {
    static constexpr bool PERM = true, AFTER_DRAIN = false;
    static constexpr float SI = 1.f / (SQ_X * SQ_WIN);
    bf16 *fq, *fkt, *fvt, *sq, *skt, *svt; const float2* rope; float *qn2, *kn2;
    static __device__ __forceinline__ size_t tile_off(int nh, int t, int head) { const int b = t >> 12, s = t & 4095; return ((size_t)(b * nh + head) * 64 + (s >> 6)) * 8192; }
    __device__ __forceinline__ void operator()(const pg8::f32x4 (&acc)[2][2][4][2], const pg8::Unit& u, int wr, int wc, int fr, int fq_) const {
        const int pn = u.pn, g = wc & 1, hsub = wc >> 1;
        const int trow0 = u.pm * 256 + wr * 64 + fr;
        const bool lane0 = (fr == 0) && (fq_ == 0);
#pragma unroll
        for (int ai = 0; ai < 2; ++ai)
#pragma unroll
            for (int bj = 0; bj < 2; ++bj) {
                const int blk64 = (u.pm * 256 + ai * 128 + wr * 64) >> 6;
                if (pn < 6) {
                    const int head = 4 * (pn & 1) + 2 * bj + hsub;
                    float nrm = 0.f;
#pragma unroll
                    for (int m = 0; m < 4; ++m) {
                        const int t = trow0 + ai * 128 + m * 16;
                        pg8::f32x4 v0 = iacc(acc[ai][bj][m][0], SI), v1 = iacc(acc[ai][bj][m][1], SI);
                        if (pn < 2) { v0 = v0 * C2; v1 = v1 * C2; }
                        v4u w; w.x = pg8::cvt_pk_bf16(v0[0], v0[1]); w.y = pg8::cvt_pk_bf16(v0[2], v0[3]); w.z = pg8::cvt_pk_bf16(v1[0], v1[1]); w.w = pg8::cvt_pk_bf16(v1[2], v1[3]);
                        if (pn < 4) { float ss = (v0[0] * v0[0] + v0[1] * v0[1]) + (v0[2] * v0[2] + v0[3] * v0[3]) + (v1[0] * v1[0] + v1[1] * v1[1]) + (v1[2] * v1[2] + v1[3] * v1[3]);
                            ss += __shfl_xor(ss, 16); ss += __shfl_xor(ss, 32); nrm = fmaxf(nrm, ss); }
                        if (pn < 2) *(GAS v4u*)(fq + (size_t)t * 512 + head * 64 + 32 * g + 8 * fq_) = w;
                        else if (pn < 4) *(GAS v4u*)((GAS unsigned char*)fkt + tile_off(8, t, head) + (size_t)((4 * g + fq_) * 64 + (t & 63)) * 16) = w;
                        else *(GAS v4u*)((GAS unsigned char*)fvt + tile_off(8, t, head) + (size_t)(g * 4 + ((t & 63) >> 4)) * 1024 + (t & 15) * 64 + fq_ * 16) = w;
                    }
                    if (pn < 4) {
                        nrm = fmaxf(nrm, __shfl_xor(nrm, 1)); nrm = fmaxf(nrm, __shfl_xor(nrm, 2)); nrm = fmaxf(nrm, __shfl_xor(nrm, 4)); nrm = fmaxf(nrm, __shfl_xor(nrm, 8));
                        if (lane0) (pn < 2 ? qn2 : kn2)[(blk64 * 8 + head) * 2 + g] = nrm;
                    }
                } else if (pn < 8 || bj == 0) {
                    const int head = (pn < 8) ? 4 * (pn & 1) + 2 * bj + hsub : hsub;
                    const int i0 = 16 * g + 4 * fq_;
#pragma unroll
                    for (int m = 0; m < 4; ++m) {
                        const int t = trow0 + ai * 128 + m * 16, pos = t & 4095;
                        const pg8::f32x4 x1 = iacc(acc[ai][bj][m][0], SI), x2 = iacc(acc[ai][bj][m][1], SI);
                        const f32x4 cs01 = *(const GAS f32x4*)(rope + pos * 32 + i0), cs23 = *(const GAS f32x4*)(rope + pos * 32 + i0 + 2);
                        float o1[4], o2[4];
                        o1[0] = x1[0] * cs01.x - x2[0] * cs01.y; o2[0] = x2[0] * cs01.x + x1[0] * cs01.y;
                        o1[1] = x1[1] * cs01.z - x2[1] * cs01.w; o2[1] = x2[1] * cs01.z + x1[1] * cs01.w;
                        o1[2] = x1[2] * cs23.x - x2[2] * cs23.y; o2[2] = x2[2] * cs23.x + x1[2] * cs23.y;
                        o1[3] = x1[3] * cs23.z - x2[3] * cs23.w; o2[3] = x2[3] * cs23.z + x1[3] * cs23.w;
                        if (pn < 8) {
#pragma unroll
                            for (int e = 0; e < 4; ++e) { o1[e] *= C2; o2[e] *= C2; }
                        }
                        u32x2 w1, w2; w1.x = pg8::cvt_pk_bf16(o1[0], o1[1]); w1.y = pg8::cvt_pk_bf16(o1[2], o1[3]); w2.x = pg8::cvt_pk_bf16(o2[0], o2[1]); w2.y = pg8::cvt_pk_bf16(o2[2], o2[3]);
                        if (pn < 8) { bf16* p = sq + (size_t)t * 512 + head * 64 + i0; *(GAS u32x2*)p = w1; *(GAS u32x2*)(p + 32) = w2; }
                        else { GAS unsigned char* p = (GAS unsigned char*)skt + tile_off(2, t, head) + (size_t)((2 * g + (fq_ >> 1)) * 64 + (t & 63)) * 16 + (fq_ & 1) * 8;
                            *(GAS u32x2*)p = w1; *(GAS u32x2*)(p + 4 * 1024) = w2; }
                    }
                } else {
                    const int head = hsub;
#pragma unroll
                    for (int m = 0; m < 4; ++m) {
                        const int t = trow0 + ai * 128 + m * 16;
                        const pg8::f32x4 v0 = iacc(acc[ai][bj][m][0], SI), v1 = iacc(acc[ai][bj][m][1], SI);
                        v4u w; w.x = pg8::cvt_pk_bf16(v0[0], v0[1]); w.y = pg8::cvt_pk_bf16(v0[2], v0[3]); w.z = pg8::cvt_pk_bf16(v1[0], v1[1]); w.w = pg8::cvt_pk_bf16(v1[2], v1[3]);
                        *(GAS v4u*)((GAS unsigned char*)svt + tile_off(2, t, head) + (size_t)(g * 4 + ((t & 63) >> 4)) * 1024 + (t & 15) * 64 + fq_ * 16) = w;
                    }
                }
            }
    }
};

__device__ __forceinline__ void convert_experts(Frame& F, int w, int nw, int r0, int r1) {
    const float* eu = F.in[9]; const float* ev = F.in[10]; const int lane = F.lane;
    for (int m0 = r0 + 4 * w; m0 < r1; m0 += 4 * nw) {
        const bool isu = m0 < NEXP; const int e0 = m0 % NEXP;
        const float* src = (isu ? eu : ev) + (size_t)e0 * D_MODEL; unsigned char* dst = F.ws + (isu ? WS_EU : WS_EV); const float sc = isu ? U_QS : V_SCALE;
        f32x4 va[4][2], vb[4][2];
#pragma unroll
        for (int r = 0; r < 4; ++r)
#pragma unroll
            for (int j = 0; j < 2; ++j) { va[r][j] = *(const GAS f32x4*)(src + r * D_MODEL + 512 * j + 8 * lane); vb[r][j] = *(const GAS f32x4*)(src + r * D_MODEL + 512 * j + 8 * lane + 4); }
#pragma unroll
        for (int r = 0; r < 4; ++r)
#pragma unroll
            for (int j = 0; j < 2; ++j) { const f32x4 a = va[r][j] * sc, b = vb[r][j] * sc;
                int w0, w1;
                if (isu) { w0 = (int)q8x4(a.x, a.y, a.z, a.w); w1 = (int)q8x4(b.x, b.y, b.z, b.w); }
                else { w0 = __builtin_amdgcn_cvt_pk_fp8_f32(a.x, a.y, 0, false); w0 = __builtin_amdgcn_cvt_pk_fp8_f32(a.z, a.w, w0, true);
                       w1 = __builtin_amdgcn_cvt_pk_fp8_f32(b.x, b.y, 0, false); w1 = __builtin_amdgcn_cvt_pk_fp8_f32(b.z, b.w, w1, true); }
                u32x2 wd; wd.x = (unsigned)w0; wd.y = (unsigned)w1;
                *(GAS u32x2*)(dst + (size_t)(4 * j + (lane >> 4)) * EXP_SLICE_BYTES + (size_t)(e0 + r) * 128 + 8 * (lane & 15)) = wd; }
    }
}
__device__ __forceinline__ void p1_slack_jobs(Frame& F, int sb, int nsb) {
    const float* LF = (const float*)(F.ws + WS_LF); float* C = (float*)(F.ws + WS_C);
    LAS float* red = (LAS float*)F.lds;
    const int lane = F.lane;
    for (int job = sb; job < BATCH * FOX_H; job += nsb) {
        const int b = job >> 3, h = job & 7;
        float v[8]; float run = 0.f;
#pragma unroll
        for (int i = 0; i < 8; ++i) { run += LF[(size_t)(b * SEQ + F.tid * 8 + i) * 8 + h]; v[i] = run; }
        float inc = run;
#pragma unroll
        for (int o = 1; o < 64; o <<= 1) { const float n = __shfl_up(inc, o); if (lane >= o) inc += n; }
        __syncthreads();
        if (lane == 63) red[F.wave] = inc;
        __syncthreads();
        float base = inc - run;
        for (int w = 0; w < F.wave; ++w) base += red[w];
#pragma unroll
        for (int i = 0; i < 8; ++i) C[(size_t)job * SEQ + F.tid * 8 + i] = (base + v[i]) * LOG2E;
    }
    const int w = sb * NWAVES + F.wave, nw = nsb * NWAVES;
    {
        const bf16* WQ = (const bf16*)(F.ws + WS_WQ); const float* w_query = F.in[7]; const float* ln1_b = F.in[6];
        float* GW = (float*)(F.ws + WS_GW); float* BW = GW + QCOLS;
        for (int n = w; n < QCOLS; n += nw) {
            const v4u a = *(const GAS v4u*)(WQ + (size_t)n * 1024 + 8 * lane), b = *(const GAS v4u*)(WQ + (size_t)n * 1024 + 512 + 8 * lane);
            float s = 0.f;
#pragma unroll
            for (int i = 0; i < 4; ++i) { s += __uint_as_float(a[i] << 16) + __uint_as_float(a[i] & 0xffff0000u); s += __uint_as_float(b[i] << 16) + __uint_as_float(b[i] & 0xffff0000u); }
            s = wave_sum(s);
            if (lane == 0) GW[n] = s;
        }
    }
    for (int c64 = sb; c64 < QCOLS / 64; c64 += nsb) {
        const float* w_query = F.in[7]; const float* ln1_b = F.in[6]; float* BW = (float*)(F.ws + WS_GW) + QCOLS;
        const int n = c64 * 64 + lane; float s = 0.f;
        for (int k0 = F.wave * 128; k0 < F.wave * 128 + 128; k0 += 16) {
            float wv_[16];
#pragma unroll
            for (int i = 0; i < 16; ++i) wv_[i] = w_query[(size_t)(k0 + i) * QCOLS + n];
#pragma unroll
            for (int i = 0; i < 16; ++i) s = fmaf(ln1_b[k0 + i], wv_[i], s);
        }
        __syncthreads();
        red[F.wave * 64 + lane] = s;
        __syncthreads();
        if (F.wave == 0) { float t_ = 0.f;
#pragma unroll
            for (int w8 = 0; w8 < 8; ++w8) t_ += red[w8 * 64 + lane];
            BW[n] = t_; }
    }
    convert_experts(F, w, nw, 0, EXP_SPLIT);
}

namespace att {
typedef float f32x16 __attribute__((ext_vector_type(16)));
typedef short s16x4 __attribute__((ext_vector_type(4)));
constexpr int LDS_K = 0, LDS_V = 16384, LDS_WS = 32768, LDS_OST = LDS_WS + 8 * 256, LDS_TOTAL = LDS_OST + 8 * 4096;
__device__ __forceinline__ int crow(int r, int hi) { return (r & 3) + 8 * (r >> 2) + 4 * hi; }
__device__ __forceinline__ float max3f(float a, float b, float c) { float r; asm("v_max3_f32 %0, %1, %2, %3" : "=v"(r) : "v"(a), "v"(b), "v"(c)); return r; }
__device__ __forceinline__ unsigned cvtpk(float lo, float hi) { unsigned r; asm("v_cvt_pk_bf16_f32 %0, %1, %2" : "=v"(r) : "v"(lo), "v"(hi)); return r; }
__device__ __forceinline__ float rowmax(const f32x16& p0, const f32x16& p1) {
    float a = max3f(p0[0], p0[1], p1[0]), b = max3f(p0[2], p0[3], p1[1]); a = max3f(a, p1[2], p1[3]);
#pragma unroll
    for (int r = 4; r < 16; r += 4) { a = max3f(a, p0[r], p0[r + 1]); b = max3f(b, p0[r + 2], p0[r + 3]); a = max3f(a, p1[r], p1[r + 1]); b = max3f(b, p1[r + 2], p1[r + 3]); }
    const float m = fmaxf(a, b);
    auto rr = __builtin_amdgcn_permlane32_swap(__float_as_uint(m), __float_as_uint(m), false, false);
    return fmaxf(__uint_as_float(rr[0]), __uint_as_float(rr[1]));
}
__device__ __forceinline__ void qkt(f32x16& p0, f32x16& p1, const LAS unsigned char* Kslot, const bf16x8* qr, int r32, int hi) {
    const LAS unsigned char* kb = Kslot + hi * 1024 + r32 * 16;
#pragma unroll
    for (int d0 = 0; d0 < 4; ++d0) {
        const bf16x8 b0 = *(const LAS bf16x8*)(kb + d0 * 2048), b1 = *(const LAS bf16x8*)(kb + d0 * 2048 + 512);
        p0 = __builtin_amdgcn_mfma_f32_32x32x16_bf16(b0, qr[d0], p0, 0, 0, 0);
        p1 = __builtin_amdgcn_mfma_f32_32x32x16_bf16(b1, qr[d0], p1, 0, 0, 0);
    }
}
__device__ __forceinline__ void pv(f32x16* o, int vb, bf16x8 pa0, bf16x8 pa1, bf16x8 pa2, bf16x8 pa3) {
#pragma unroll
    for (int d0 = 0; d0 < 2; ++d0) {
        s16x4 lo[4], hi[4];
#pragma unroll
        for (int ks = 0; ks < 4; ++ks) {
            asm volatile("ds_read_b64_tr_b16 %0,%1 offset:%c2" : "=&v"(lo[ks]) : "v"(vb), "i"(d0 * 4096 + ks * 1024) : "memory");
            asm volatile("ds_read_b64_tr_b16 %0,%1 offset:%c2" : "=&v"(hi[ks]) : "v"(vb), "i"(d0 * 4096 + ks * 1024 + 512) : "memory");
        }
        asm volatile("s_waitcnt lgkmcnt(0)" ::: "memory"); __builtin_amdgcn_sched_barrier(0);
#define ATT_PK(k) (bf16x8){lo[k][0], lo[k][1], lo[k][2], lo[k][3], hi[k][0], hi[k][1], hi[k][2], hi[k][3]}
        o[d0] = __builtin_amdgcn_mfma_f32_32x32x16_bf16(pa0, ATT_PK(0), o[d0], 0, 0, 0);
        o[d0] = __builtin_amdgcn_mfma_f32_32x32x16_bf16(pa1, ATT_PK(1), o[d0], 0, 0, 0);
        o[d0] = __builtin_amdgcn_mfma_f32_32x32x16_bf16(pa2, ATT_PK(2), o[d0], 0, 0, 0);
        o[d0] = __builtin_amdgcn_mfma_f32_32x32x16_bf16(pa3, ATT_PK(3), o[d0], 0, 0, 0);
#undef ATT_PK
    }
}

template <int KIND>
__device__ __forceinline__ void attn_unit(Frame& F, int b, int h, int qb) {
    const int tid = F.tid, lane = F.lane, r32 = lane & 31, hi = lane >> 5, wid = F.wave;
    const int q0 = qb * 256, w0 = q0 + wid * 32, myq = w0 + r32;
    const bf16* Qg = (const bf16*)(F.ws + (KIND == 0 ? WS_FQ : WS_SQ)) + (size_t)(b * SEQ + myq) * 512 + h * 64;
    const int kvh = (KIND == 0) ? h : (h >> 2), nkv = (KIND == 0) ? 8 : 2;
    const unsigned char* KT = F.ws + (KIND == 0 ? WS_FKT : WS_SKT) + (size_t)(b * nkv + kvh) * 64 * 8192;
    const unsigned char* VT = F.ws + (KIND == 0 ? WS_FVT : WS_SVT) + (size_t)(b * nkv + kvh) * 64 * 8192;
    const float* Cg = (const float*)(F.ws + WS_C) + (size_t)(b * 8 + h) * SEQ;
    LAS unsigned char* lds = F.lds;
    LAS float* wsf = (LAS float*)(lds + LDS_WS) + wid * 64;
#define ATT_LOAD(j, buf) do { \
        __builtin_amdgcn_global_load_lds((const unsigned*)(KT + (size_t)(j) * 8192 + tid * 16), (LAS unsigned*)(lds + LDS_K + (buf) * 8192 + wid * 1024), 16, 0, 0); \
        __builtin_amdgcn_global_load_lds((const unsigned*)(VT + (size_t)(j) * 8192 + tid * 16), (LAS unsigned*)(lds + LDS_V + (buf) * 8192 + wid * 1024), 16, 0, 0); } while (0)
    const int jhi = qb * 4 + 3; int jlo; float cref = 0.f, cw0 = 0.f, TH = 0.f;
    ATT_LOAD(jhi, 0);
    bf16x8 qr[4];
#pragma unroll
    for (int d0 = 0; d0 < 4; ++d0) qr[d0] = *(const GAS bf16x8*)(Qg + d0 * 16 + hi * 8);
    if (KIND == 0) {
        const float* QN2 = (const float*)(F.ws + WS_QN2); const float* KN2 = (const float*)(F.ws + WS_KN2);
        const int kblk = b * 64 + lane; const float knl = KN2[(kblk * 8 + h) * 2] + KN2[(kblk * 8 + h) * 2 + 1];
        const int qblk = (b * SEQ + q0) / 64 + (lane & 3); const float qnl = QN2[(qblk * 8 + h) * 2] + QN2[(qblk * 8 + h) * 2 + 1];
        const int jt = qb * 4 - 1 - lane; const float cl = Cg[jt >= 0 ? 64 * jt + 63 : 0];
        cref = Cg[q0]; cw0 = Cg[w0];
        const float kn = wave_max(knl), qn = wave_max(qnl);
        TH = 160.f + 2.05f * sqrtf(qn * kn);
        const unsigned long long keep = __ballot(lane < 16 && jt >= 0 && (cref - cl) >= -TH);
        const int nkeep = __builtin_ctzll(~keep);
        jlo = qb * 4 - nkeep;
        if (nkeep == 16) { while (jlo > 0 && (cref - Cg[64 * (jlo - 1) + 63]) >= -TH) --jlo; }
        jlo = __builtin_amdgcn_readfirstlane(jlo);
    } else {
        jlo = (q0 - 127) < 0 ? 0 : ((q0 - 127) >> 6);
    }
    float m_run, l_run;
    if (KIND == 0) { m_run = -INFINITY; l_run = 0.f; }
    else { m_run = F.in[3][h] * LOG2E; l_run = (hi == 0) ? 1.f : 0.f; }
    f32x16 o[2];
#pragma unroll
    for (int r = 0; r < 16; ++r) { o[0][r] = 0.f; o[1][r] = 0.f; }
    const int vb0 = (int)(unsigned)(uintptr_t)(lds + LDS_V) + ((lane >> 4) & 1) * 32 + (lane & 3) * 8 + (4 * hi + ((lane & 15) >> 2)) * 64;
    int cur = 0;
    for (int j = jhi; j >= jlo; --j, cur ^= 1) {
        asm volatile("s_waitcnt vmcnt(0)" ::: "memory");
        __syncthreads();
        if (j > jlo) ATT_LOAD(j - 1, cur ^ 1);
        const int k0 = 64 * j;
        bool active = k0 <= w0 + 31;
        if (KIND == 1) active = active && (k0 + 63 >= w0 - 127);
        if (KIND == 0 && k0 + 63 < w0) active = active && ((cw0 - Cg[k0 + 63]) >= -TH);
        if (active) {
            f32x16 p0, p1;
            if (KIND == 0) {
#pragma unroll
                for (int g = 0; g < 4; ++g) {
                    const f32x4 c0 = *(const GAS f32x4*)(Cg + k0 + 8 * g + 4 * hi), c1 = *(const GAS f32x4*)(Cg + k0 + 32 + 8 * g + 4 * hi);
#pragma unroll
                    for (int e = 0; e < 4; ++e) { p0[4 * g + e] = cref - c0[e]; p1[4 * g + e] = cref - c1[e]; }
                }
            } else {
#pragma unroll
                for (int r = 0; r < 16; ++r) { p0[r] = 0.f; p1[r] = 0.f; }
            }
            qkt(p0, p1, lds + LDS_K + cur * 8192, qr, r32, hi);
            if (k0 + 63 > w0) {
#pragma unroll
                for (int r = 0; r < 16; ++r) { const int kv = k0 + crow(r, hi); if (kv > myq) p0[r] = -INFINITY; if (kv + 32 > myq) p1[r] = -INFINITY; }
            }
            if (KIND == 1 && k0 < w0 + 31 - 127) {
#pragma unroll
                for (int r = 0; r < 16; ++r) { const int kv = k0 + crow(r, hi); if (kv < myq - 127) p0[r] = -INFINITY; if (kv + 32 < myq - 127) p1[r] = -INFINITY; }
            }
            const float rm = rowmax(p0, p1);
            const float m_new = fmaxf(m_run, rm);
            const bool resc = __any(m_new > m_run);
            const float alpha = __builtin_amdgcn_exp2f(m_run - m_new);
            m_run = m_new;
            float ps = 0.f;
#pragma unroll
            for (int r = 0; r < 16; ++r) { p0[r] = __builtin_amdgcn_exp2f(p0[r] - m_new); p1[r] = __builtin_amdgcn_exp2f(p1[r] - m_new); ps += p0[r] + p1[r]; }
            l_run = l_run * alpha + ps;
            v4u pw0, pw1, pw2, pw3;
#pragma unroll
            for (int i = 0; i < 4; ++i) { pw0[i] = cvtpk(p0[2 * i], p0[2 * i + 1]); pw1[i] = cvtpk(p0[8 + 2 * i], p0[9 + 2 * i]); pw2[i] = cvtpk(p1[2 * i], p1[2 * i + 1]); pw3[i] = cvtpk(p1[8 + 2 * i], p1[9 + 2 * i]); }
            if (resc) {
                if (hi == 0) wsf[r32] = alpha;
#pragma unroll
                for (int r = 0; r < 16; ++r) { const float a = wsf[crow(r, hi)]; o[0][r] *= a; o[1][r] *= a; }
            }
            pv(o, vb0 + cur * 8192, __builtin_bit_cast(bf16x8, pw0), __builtin_bit_cast(bf16x8, pw1), __builtin_bit_cast(bf16x8, pw2), __builtin_bit_cast(bf16x8, pw3));
        }
    }
#undef ATT_LOAD
    { auto rr = __builtin_amdgcn_permlane32_swap(__float_as_uint(l_run), __float_as_uint(l_run), false, false); l_run = __uint_as_float(rr[0]) + __uint_as_float(rr[1]); }
    if (hi == 0) wsf[32 + r32] = l_run;
    float rli[16];
#pragma unroll
    for (int r = 0; r < 16; ++r) rli[r] = __builtin_amdgcn_rcpf(wsf[32 + crow(r, hi)]);
    LAS unsigned char* stg = lds + LDS_OST + wid * 2048;
#pragma unroll
    for (int r = 0; r < 16; ++r) { const int orow = crow(r, hi);
#pragma unroll
        for (int d0 = 0; d0 < 2; ++d0) { const float qv = fminf(fmaxf(rintf(o[d0][r] * rli[r] * SQ_A), -127.f), 127.f); stg[orow * 64 + d0 * 32 + r32] = (unsigned char)(int)qv; } }
    unsigned char* Ow = F.ws + WS_ATTN + (size_t)(b * SEQ + w0) * 1024 + (KIND == 0 ? 0 : 512) + h * 64;
#pragma unroll
    for (int i = 0; i < 2; ++i) { const int row = i * 16 + (lane >> 2), ch = lane & 3; const v4u v = *(const LAS v4u*)(stg + row * 64 + ch * 16); *(GAS v4u*)(Ow + (size_t)row * 1024 + ch * 16) = v; }
    __syncthreads();
}

__device__ __forceinline__ void attn_phase(Frame& F) {
    for (int u = (int)blockIdx.x; u < 2048; u += F.G) {
        const int kind = u >> 10, rem = u & 1023, b = rem >> 7, h = (rem >> 4) & 7, qb = ((rem & 15) + (rem >> 8)) & 15;
        if (kind == 0) attn_unit<0>(F, b, h, qb); else attn_unit<1>(F, b, h, qb);
    }
}
}

struct EpiOutProj {
    static constexpr bool PERM = true, AFTER_DRAIN = false;
    bf16* yb; float2* stats;
    __device__ __forceinline__ void operator()(const pg8::f32x4 (&acc)[2][2][4][2], const pg8::Unit& u, int wr, int wc, int fr, int fq_) const {
        const int trow0 = u.pm * 256 + wr * 64 + fr;
#pragma unroll
        for (int ai = 0; ai < 2; ++ai)
#pragma unroll
            for (int m = 0; m < 4; ++m) {
                const int t = trow0 + ai * 128 + m * 16;
                float s = 0.f, ss = 0.f;
#pragma unroll
                for (int bj = 0; bj < 2; ++bj) {
                    const size_t off = (size_t)t * D_MODEL + u.pn * 256 + bj * 128 + wc * 32 + 8 * fq_;
                    const v4u xw = *(const GAS v4u*)(yb + off);
                    f32x4 x0, x1;
                    x0[0] = __uint_as_float(xw[0] << 16); x0[1] = __uint_as_float(xw[0] & 0xffff0000u); x0[2] = __uint_as_float(xw[1] << 16); x0[3] = __uint_as_float(xw[1] & 0xffff0000u);
                    x1[0] = __uint_as_float(xw[2] << 16); x1[1] = __uint_as_float(xw[2] & 0xffff0000u); x1[2] = __uint_as_float(xw[3] << 16); x1[3] = __uint_as_float(xw[3] & 0xffff0000u);
                    const f32x4 v0 = x0 * ALPHA + iacc(acc[ai][bj][m][0], 1.f / (SQ_A * SQ_WOUT)), v1 = x1 * ALPHA + iacc(acc[ai][bj][m][1], 1.f / (SQ_A * SQ_WOUT));
                    v4u w; w.x = pg8::cvt_pk_bf16(v0[0], v0[1]); w.y = pg8::cvt_pk_bf16(v0[2], v0[3]); w.z = pg8::cvt_pk_bf16(v1[0], v1[1]); w.w = pg8::cvt_pk_bf16(v1[2], v1[3]);
                    *(GAS v4u*)(yb + off) = w;
                    s += (v0[0] + v0[1]) + (v0[2] + v0[3]) + (v1[0] + v1[1]) + (v1[2] + v1[3]);
                    ss += (v0[0] * v0[0] + v0[1] * v0[1]) + (v0[2] * v0[2] + v0[3] * v0[3]) + (v1[0] * v1[0] + v1[1] * v1[1]) + (v1[2] * v1[2] + v1[3] * v1[3]);
                }
                s += __shfl_xor(s, 16); s += __shfl_xor(s, 32); ss += __shfl_xor(ss, 16); ss += __shfl_xor(ss, 32);
                if (fq_ == 0) stats[(size_t)t * 16 + u.pn * 4 + wc] = make_float2(s, ss);
            }
    }
};
__device__ __forceinline__ float2 ln1_row_stats(const float2* stats, int t) {
    float s = 0.f, ss = 0.f;
#pragma unroll
    for (int i = 0; i < 16; i += 2) { const f32x4 a = *(const GAS f32x4*)(stats + (size_t)t * 16 + i); s += a.x + a.z; ss += a.y + a.w; }
    const float mean = s * (1.f / D_MODEL), var = fmaxf(ss * (1.f / D_MODEL) - mean * mean, 0.f);
    return make_float2(mean, 1.f / sqrtf(var + LN_EPS));
}
struct EpiQuery {
    static constexpr bool PERM = true, AFTER_DRAIN = false;
    const float2* stats; const float* gw; const float* bw; bf16* q;
    __device__ __forceinline__ void operator()(const pg8::f32x4 (&acc)[2][2][4][2], const pg8::Unit& u, int wr, int wc, int fr, int fq_) const {
        const int trow0 = u.pm * 256 + wr * 64 + fr, lane = fr + 16 * fq_;
        const int k0 = 2 * fq_, k1 = 2 * fq_ + 1;
        const float2 sa = ln1_row_stats(stats, trow0 + (k0 >> 2) * 128 + (k0 & 3) * 16), sb = ln1_row_stats(stats, trow0 + (k1 >> 2) * 128 + (k1 & 3) * 16);
        float mean[8], rstd[8];
#pragma unroll
        for (int k = 0; k < 8; ++k) { const int src = fr + 16 * (k >> 1); mean[k] = __shfl((k & 1) ? sb.x : sa.x, src); rstd[k] = __shfl((k & 1) ? sb.y : sa.y, src); }
        (void)lane;
#pragma unroll
        for (int bj = 0; bj < 2; ++bj) {
            const int col0 = u.pn * 256 + bj * 128 + wc * 32 + 8 * fq_;
            const f32x4 g0 = *(const GAS f32x4*)(gw + col0), g1 = *(const GAS f32x4*)(gw + col0 + 4), b0 = *(const GAS f32x4*)(bw + col0), b1 = *(const GAS f32x4*)(bw + col0 + 4);
#pragma unroll
            for (int ai = 0; ai < 2; ++ai)
#pragma unroll
                for (int m = 0; m < 4; ++m) {
                    const int t = trow0 + ai * 128 + m * 16; const float mu = mean[4 * ai + m], rs = rstd[4 * ai + m];
                    const f32x4 v0 = (acc[ai][bj][m][0] - g0 * mu) * rs + b0, v1 = (acc[ai][bj][m][1] - g1 * mu) * rs + b1;
                    v4u w; w.x = pg8::cvt_pk_bf16(v0[0], v0[1]); w.y = pg8::cvt_pk_bf16(v0[2], v0[3]); w.z = pg8::cvt_pk_bf16(v1[0], v1[1]); w.w = pg8::cvt_pk_bf16(v1[2], v1[3]);
                    *(GAS v4u*)(q + ((size_t)(t >> 5) * 8192 + (size_t)(col0 >> 3) * 32 + (t & 31)) * 8) = w;
                }
        }
    }
};
#define TOPK_SORT128(v) do { \
  CE(v[0],v[1]);CE(v[3],v[2]);CE(v[4],v[5]);CE(v[7],v[6]);CE(v[8],v[9]);CE(v[11],v[10]);CE(v[12],v[13]);CE(v[15],v[14]);CE(v[0],v[2]);CE(v[1],v[3]);CE(v[6],v[4]);CE(v[7],v[5]);CE(v[8],v[10]);CE(v[9],v[11]);CE(v[14],v[12]);CE(v[15],v[13]);CE(v[0],v[1]);CE(v[2],v[3]);CE(v[5],v[4]);CE(v[7],v[6]);CE(v[8],v[9]);CE(v[10],v[11]);CE(v[13],v[12]);CE(v[15],v[14]);CE(v[0],v[4]);CE(v[1],v[5]);CE(v[2],v[6]);CE(v[3],v[7]);CE(v[12],v[8]);CE(v[13],v[9]);CE(v[14],v[10]);CE(v[15],v[11]);CE(v[0],v[2]);CE(v[1],v[3]);CE(v[4],v[6]);CE(v[5],v[7]);CE(v[10],v[8]);CE(v[11],v[9]);CE(v[14],v[12]);CE(v[15],v[13]);CE(v[0],v[1]);CE(v[2],v[3]);CE(v[4],v[5]);CE(v[6],v[7]);CE(v[9],v[8]);CE(v[11],v[10]);CE(v[13],v[12]);CE(v[15],v[14]);CE(v[0],v[8]);CE(v[1],v[9]);CE(v[2],v[10]);CE(v[3],v[11]);CE(v[4],v[12]);CE(v[5],v[13]);CE(v[6],v[14]);CE(v[7],v[15]);CE(v[0],v[4]);CE(v[1],v[5]);CE(v[2],v[6]);CE(v[3],v[7]);CE(v[8],v[12]);CE(v[9],v[13]);CE(v[10],v[14]);CE(v[11],v[15]);CE(v[0],v[2]);CE(v[1],v[3]);CE(v[4],v[6]);CE(v[5],v[7]);CE(v[8],v[10]);CE(v[9],v[11]);CE(v[12],v[14]);CE(v[13],v[15]);CE(v[0],v[1]);CE(v[2],v[3]);CE(v[4],v[5]);CE(v[6],v[7]);CE(v[8],v[9]);CE(v[10],v[11]);CE(v[12],v[13]);CE(v[14],v[15]); \
  CE(v[16],v[17]);CE(v[19],v[18]);CE(v[20],v[21]);CE(v[23],v[22]);CE(v[24],v[25]);CE(v[27],v[26]);CE(v[28],v[29]);CE(v[31],v[30]);CE(v[16],v[18]);CE(v[17],v[19]);CE(v[22],v[20]);CE(v[23],v[21]);CE(v[24],v[26]);CE(v[25],v[27]);CE(v[30],v[28]);CE(v[31],v[29]);CE(v[16],v[17]);CE(v[18],v[19]);CE(v[21],v[20]);CE(v[23],v[22]);CE(v[24],v[25]);CE(v[26],v[27]);CE(v[29],v[28]);CE(v[31],v[30]);CE(v[16],v[20]);CE(v[17],v[21]);CE(v[18],v[22]);CE(v[19],v[23]);CE(v[28],v[24]);CE(v[29],v[25]);CE(v[30],v[26]);CE(v[31],v[27]);CE(v[16],v[18]);CE(v[17],v[19]);CE(v[20],v[22]);CE(v[21],v[23]);CE(v[26],v[24]);CE(v[27],v[25]);CE(v[30],v[28]);CE(v[31],v[29]);CE(v[16],v[17]);CE(v[18],v[19]);CE(v[20],v[21]);CE(v[22],v[23]);CE(v[25],v[24]);CE(v[27],v[26]);CE(v[29],v[28]);CE(v[31],v[30]);CE(v[16],v[24]);CE(v[17],v[25]);CE(v[18],v[26]);CE(v[19],v[27]);CE(v[20],v[28]);CE(v[21],v[29]);CE(v[22],v[30]);CE(v[23],v[31]);CE(v[16],v[20]);CE(v[17],v[21]);CE(v[18],v[22]);CE(v[19],v[23]);CE(v[24],v[28]);CE(v[25],v[29]);CE(v[26],v[30]);CE(v[27],v[31]);CE(v[16],v[18]);CE(v[17],v[19]);CE(v[20],v[22]);CE(v[21],v[23]);CE(v[24],v[26]);CE(v[25],v[27]);CE(v[28],v[30]);CE(v[29],v[31]);CE(v[16],v[17]);CE(v[18],v[19]);CE(v[20],v[21]);CE(v[22],v[23]);CE(v[24],v[25]);CE(v[26],v[27]);CE(v[28],v[29]);CE(v[30],v[31]); \
  CE(v[32],v[33]);CE(v[35],v[34]);CE(v[36],v[37]);CE(v[39],v[38]);CE(v[40],v[41]);CE(v[43],v[42]);CE(v[44],v[45]);CE(v[47],v[46]);CE(v[32],v[34]);CE(v[33],v[35]);CE(v[38],v[36]);CE(v[39],v[37]);CE(v[40],v[42]);CE(v[41],v[43]);CE(v[46],v[44]);CE(v[47],v[45]);CE(v[32],v[33]);CE(v[34],v[35]);CE(v[37],v[36]);CE(v[39],v[38]);CE(v[40],v[41]);CE(v[42],v[43]);CE(v[45],v[44]);CE(v[47],v[46]);CE(v[32],v[36]);CE(v[33],v[37]);CE(v[34],v[38]);CE(v[35],v[39]);CE(v[44],v[40]);CE(v[45],v[41]);CE(v[46],v[42]);CE(v[47],v[43]);CE(v[32],v[34]);CE(v[33],v[35]);CE(v[36],v[38]);CE(v[37],v[39]);CE(v[42],v[40]);CE(v[43],v[41]);CE(v[46],v[44]);CE(v[47],v[45]);CE(v[32],v[33]);CE(v[34],v[35]);CE(v[36],v[37]);CE(v[38],v[39]);CE(v[41],v[40]);CE(v[43],v[42]);CE(v[45],v[44]);CE(v[47],v[46]);CE(v[32],v[40]);CE(v[33],v[41]);CE(v[34],v[42]);CE(v[35],v[43]);CE(v[36],v[44]);CE(v[37],v[45]);CE(v[38],v[46]);CE(v[39],v[47]);CE(v[32],v[36]);CE(v[33],v[37]);CE(v[34],v[38]);CE(v[35],v[39]);CE(v[40],v[44]);CE(v[41],v[45]);CE(v[42],v[46]);CE(v[43],v[47]);CE(v[32],v[34]);CE(v[33],v[35]);CE(v[36],v[38]);CE(v[37],v[39]);CE(v[40],v[42]);CE(v[41],v[43]);CE(v[44],v[46]);CE(v[45],v[47]);CE(v[32],v[33]);CE(v[34],v[35]);CE(v[36],v[37]);CE(v[38],v[39]);CE(v[40],v[41]);CE(v[42],v[43]);CE(v[44],v[45]);CE(v[46],v[47]); \
  CE(v[48],v[49]);CE(v[51],v[50]);CE(v[52],v[53]);CE(v[55],v[54]);CE(v[56],v[57]);CE(v[59],v[58]);CE(v[60],v[61]);CE(v[63],v[62]);CE(v[48],v[50]);CE(v[49],v[51]);CE(v[54],v[52]);CE(v[55],v[53]);CE(v[56],v[58]);CE(v[57],v[59]);CE(v[62],v[60]);CE(v[63],v[61]);CE(v[48],v[49]);CE(v[50],v[51]);CE(v[53],v[52]);CE(v[55],v[54]);CE(v[56],v[57]);CE(v[58],v[59]);CE(v[61],v[60]);CE(v[63],v[62]);CE(v[48],v[52]);CE(v[49],v[53]);CE(v[50],v[54]);CE(v[51],v[55]);CE(v[60],v[56]);CE(v[61],v[57]);CE(v[62],v[58]);CE(v[63],v[59]);CE(v[48],v[50]);CE(v[49],v[51]);CE(v[52],v[54]);CE(v[53],v[55]);CE(v[58],v[56]);CE(v[59],v[57]);CE(v[62],v[60]);CE(v[63],v[61]);CE(v[48],v[49]);CE(v[50],v[51]);CE(v[52],v[53]);CE(v[54],v[55]);CE(v[57],v[56]);CE(v[59],v[58]);CE(v[61],v[60]);CE(v[63],v[62]);CE(v[48],v[56]);CE(v[49],v[57]);CE(v[50],v[58]);CE(v[51],v[59]);CE(v[52],v[60]);CE(v[53],v[61]);CE(v[54],v[62]);CE(v[55],v[63]);CE(v[48],v[52]);CE(v[49],v[53]);CE(v[50],v[54]);CE(v[51],v[55]);CE(v[56],v[60]);CE(v[57],v[61]);CE(v[58],v[62]);CE(v[59],v[63]);CE(v[48],v[50]);CE(v[49],v[51]);CE(v[52],v[54]);CE(v[53],v[55]);CE(v[56],v[58]);CE(v[57],v[59]);CE(v[60],v[62]);CE(v[61],v[63]);CE(v[48],v[49]);CE(v[50],v[51]);CE(v[52],v[53]);CE(v[54],v[55]);CE(v[56],v[57]);CE(v[58],v[59]);CE(v[60],v[61]);CE(v[62],v[63]); \
  CE(v[64],v[65]);CE(v[67],v[66]);CE(v[68],v[69]);CE(v[71],v[70]);CE(v[72],v[73]);CE(v[75],v[74]);CE(v[76],v[77]);CE(v[79],v[78]);CE(v[64],v[66]);CE(v[65],v[67]);CE(v[70],v[68]);CE(v[71],v[69]);CE(v[72],v[74]);CE(v[73],v[75]);CE(v[78],v[76]);CE(v[79],v[77]);CE(v[64],v[65]);CE(v[66],v[67]);CE(v[69],v[68]);CE(v[71],v[70]);CE(v[72],v[73]);CE(v[74],v[75]);CE(v[77],v[76]);CE(v[79],v[78]);CE(v[64],v[68]);CE(v[65],v[69]);CE(v[66],v[70]);CE(v[67],v[71]);CE(v[76],v[72]);CE(v[77],v[73]);CE(v[78],v[74]);CE(v[79],v[75]);CE(v[64],v[66]);CE(v[65],v[67]);CE(v[68],v[70]);CE(v[69],v[71]);CE(v[74],v[72]);CE(v[75],v[73]);CE(v[78],v[76]);CE(v[79],v[77]);CE(v[64],v[65]);CE(v[66],v[67]);CE(v[68],v[69]);CE(v[70],v[71]);CE(v[73],v[72]);CE(v[75],v[74]);CE(v[77],v[76]);CE(v[79],v[78]);CE(v[64],v[72]);CE(v[65],v[73]);CE(v[66],v[74]);CE(v[67],v[75]);CE(v[68],v[76]);CE(v[69],v[77]);CE(v[70],v[78]);CE(v[71],v[79]);CE(v[64],v[68]);CE(v[65],v[69]);CE(v[66],v[70]);CE(v[67],v[71]);CE(v[72],v[76]);CE(v[73],v[77]);CE(v[74],v[78]);CE(v[75],v[79]);CE(v[64],v[66]);CE(v[65],v[67]);CE(v[68],v[70]);CE(v[69],v[71]);CE(v[72],v[74]);CE(v[73],v[75]);CE(v[76],v[78]);CE(v[77],v[79]);CE(v[64],v[65]);CE(v[66],v[67]);CE(v[68],v[69]);CE(v[70],v[71]);CE(v[72],v[73]);CE(v[74],v[75]);CE(v[76],v[77]);CE(v[78],v[79]); \
  CE(v[80],v[81]);CE(v[83],v[82]);CE(v[84],v[85]);CE(v[87],v[86]);CE(v[88],v[89]);CE(v[91],v[90]);CE(v[92],v[93]);CE(v[95],v[94]);CE(v[80],v[82]);CE(v[81],v[83]);CE(v[86],v[84]);CE(v[87],v[85]);CE(v[88],v[90]);CE(v[89],v[91]);CE(v[94],v[92]);CE(v[95],v[93]);CE(v[80],v[81]);CE(v[82],v[83]);CE(v[85],v[84]);CE(v[87],v[86]);CE(v[88],v[89]);CE(v[90],v[91]);CE(v[93],v[92]);CE(v[95],v[94]);CE(v[80],v[84]);CE(v[81],v[85]);CE(v[82],v[86]);CE(v[83],v[87]);CE(v[92],v[88]);CE(v[93],v[89]);CE(v[94],v[90]);CE(v[95],v[91]);CE(v[80],v[82]);CE(v[81],v[83]);CE(v[84],v[86]);CE(v[85],v[87]);CE(v[90],v[88]);CE(v[91],v[89]);CE(v[94],v[92]);CE(v[95],v[93]);CE(v[80],v[81]);CE(v[82],v[83]);CE(v[84],v[85]);CE(v[86],v[87]);CE(v[89],v[88]);CE(v[91],v[90]);CE(v[93],v[92]);CE(v[95],v[94]);CE(v[80],v[88]);CE(v[81],v[89]);CE(v[82],v[90]);CE(v[83],v[91]);CE(v[84],v[92]);CE(v[85],v[93]);CE(v[86],v[94]);CE(v[87],v[95]);CE(v[80],v[84]);CE(v[81],v[85]);CE(v[82],v[86]);CE(v[83],v[87]);CE(v[88],v[92]);CE(v[89],v[93]);CE(v[90],v[94]);CE(v[91],v[95]);CE(v[80],v[82]);CE(v[81],v[83]);CE(v[84],v[86]);CE(v[85],v[87]);CE(v[88],v[90]);CE(v[89],v[91]);CE(v[92],v[94]);CE(v[93],v[95]);CE(v[80],v[81]);CE(v[82],v[83]);CE(v[84],v[85]);CE(v[86],v[87]);CE(v[88],v[89]);CE(v[90],v[91]);CE(v[92],v[93]);CE(v[94],v[95]); \
  CE(v[96],v[97]);CE(v[99],v[98]);CE(v[100],v[101]);CE(v[103],v[102]);CE(v[104],v[105]);CE(v[107],v[106]);CE(v[108],v[109]);CE(v[111],v[110]);CE(v[96],v[98]);CE(v[97],v[99]);CE(v[102],v[100]);CE(v[103],v[101]);CE(v[104],v[106]);CE(v[105],v[107]);CE(v[110],v[108]);CE(v[111],v[109]);CE(v[96],v[97]);CE(v[98],v[99]);CE(v[101],v[100]);CE(v[103],v[102]);CE(v[104],v[105]);CE(v[106],v[107]);CE(v[109],v[108]);CE(v[111],v[110]);CE(v[96],v[100]);CE(v[97],v[101]);CE(v[98],v[102]);CE(v[99],v[103]);CE(v[108],v[104]);CE(v[109],v[105]);CE(v[110],v[106]);CE(v[111],v[107]);CE(v[96],v[98]);CE(v[97],v[99]);CE(v[100],v[102]);CE(v[101],v[103]);CE(v[106],v[104]);CE(v[107],v[105]);CE(v[110],v[108]);CE(v[111],v[109]);CE(v[96],v[97]);CE(v[98],v[99]);CE(v[100],v[101]);CE(v[102],v[103]);CE(v[105],v[104]);CE(v[107],v[106]);CE(v[109],v[108]);CE(v[111],v[110]);CE(v[96],v[104]);CE(v[97],v[105]);CE(v[98],v[106]);CE(v[99],v[107]);CE(v[100],v[108]);CE(v[101],v[109]);CE(v[102],v[110]);CE(v[103],v[111]);CE(v[96],v[100]);CE(v[97],v[101]);CE(v[98],v[102]);CE(v[99],v[103]);CE(v[104],v[108]);CE(v[105],v[109]);CE(v[106],v[110]);CE(v[107],v[111]);CE(v[96],v[98]);CE(v[97],v[99]);CE(v[100],v[102]);CE(v[101],v[103]);CE(v[104],v[106]);CE(v[105],v[107]);CE(v[108],v[110]);CE(v[109],v[111]);CE(v[96],v[97]);CE(v[98],v[99]);CE(v[100],v[101]);CE(v[102],v[103]);CE(v[104],v[105]);CE(v[106],v[107]);CE(v[108],v[109]);CE(v[110],v[111]); \
  CE(v[112],v[113]);CE(v[115],v[114]);CE(v[116],v[117]);CE(v[119],v[118]);CE(v[120],v[121]);CE(v[123],v[122]);CE(v[124],v[125]);CE(v[127],v[126]);CE(v[112],v[114]);CE(v[113],v[115]);CE(v[118],v[116]);CE(v[119],v[117]);CE(v[120],v[122]);CE(v[121],v[123]);CE(v[126],v[124]);CE(v[127],v[125]);CE(v[112],v[113]);CE(v[114],v[115]);CE(v[117],v[116]);CE(v[119],v[118]);CE(v[120],v[121]);CE(v[122],v[123]);CE(v[125],v[124]);CE(v[127],v[126]);CE(v[112],v[116]);CE(v[113],v[117]);CE(v[114],v[118]);CE(v[115],v[119]);CE(v[124],v[120]);CE(v[125],v[121]);CE(v[126],v[122]);CE(v[127],v[123]);CE(v[112],v[114]);CE(v[113],v[115]);CE(v[116],v[118]);CE(v[117],v[119]);CE(v[122],v[120]);CE(v[123],v[121]);CE(v[126],v[124]);CE(v[127],v[125]);CE(v[112],v[113]);CE(v[114],v[115]);CE(v[116],v[117]);CE(v[118],v[119]);CE(v[121],v[120]);CE(v[123],v[122]);CE(v[125],v[124]);CE(v[127],v[126]);CE(v[112],v[120]);CE(v[113],v[121]);CE(v[114],v[122]);CE(v[115],v[123]);CE(v[116],v[124]);CE(v[117],v[125]);CE(v[118],v[126]);CE(v[119],v[127]);CE(v[112],v[116]);CE(v[113],v[117]);CE(v[114],v[118]);CE(v[115],v[119]);CE(v[120],v[124]);CE(v[121],v[125]);CE(v[122],v[126]);CE(v[123],v[127]);CE(v[112],v[114]);CE(v[113],v[115]);CE(v[116],v[118]);CE(v[117],v[119]);CE(v[120],v[122]);CE(v[121],v[123]);CE(v[124],v[126]);CE(v[125],v[127]);CE(v[112],v[113]);CE(v[114],v[115]);CE(v[116],v[117]);CE(v[118],v[119]);CE(v[120],v[121]);CE(v[122],v[123]);CE(v[124],v[125]);CE(v[126],v[127]); \
  v[0]=vmaxf(v[0],v[31]);v[1]=vmaxf(v[1],v[30]);v[2]=vmaxf(v[2],v[29]);v[3]=vmaxf(v[3],v[28]);v[4]=vmaxf(v[4],v[27]);v[5]=vmaxf(v[5],v[26]);v[6]=vmaxf(v[6],v[25]);v[7]=vmaxf(v[7],v[24]);v[8]=vmaxf(v[8],v[23]);v[9]=vmaxf(v[9],v[22]);v[10]=vmaxf(v[10],v[21]);v[11]=vmaxf(v[11],v[20]);v[12]=vmaxf(v[12],v[19]);v[13]=vmaxf(v[13],v[18]);v[14]=vmaxf(v[14],v[17]);v[15]=vmaxf(v[15],v[16]);CE(v[0],v[8]);CE(v[1],v[9]);CE(v[2],v[10]);CE(v[3],v[11]);CE(v[4],v[12]);CE(v[5],v[13]);CE(v[6],v[14]);CE(v[7],v[15]);CE(v[0],v[4]);CE(v[1],v[5]);CE(v[2],v[6]);CE(v[3],v[7]);CE(v[8],v[12]);CE(v[9],v[13]);CE(v[10],v[14]);CE(v[11],v[15]);CE(v[0],v[2]);CE(v[1],v[3]);CE(v[4],v[6]);CE(v[5],v[7]);CE(v[8],v[10]);CE(v[9],v[11]);CE(v[12],v[14]);CE(v[13],v[15]);CE(v[0],v[1]);CE(v[2],v[3]);CE(v[4],v[5]);CE(v[6],v[7]);CE(v[8],v[9]);CE(v[10],v[11]);CE(v[12],v[13]);CE(v[14],v[15]); \
  v[32]=vmaxf(v[32],v[63]);v[33]=vmaxf(v[33],v[62]);v[34]=vmaxf(v[34],v[61]);v[35]=vmaxf(v[35],v[60]);v[36]=vmaxf(v[36],v[59]);v[37]=vmaxf(v[37],v[58]);v[38]=vmaxf(v[38],v[57]);v[39]=vmaxf(v[39],v[56]);v[40]=vmaxf(v[40],v[55]);v[41]=vmaxf(v[41],v[54]);v[42]=vmaxf(v[42],v[53]);v[43]=vmaxf(v[43],v[52]);v[44]=vmaxf(v[44],v[51]);v[45]=vmaxf(v[45],v[50]);v[46]=vmaxf(v[46],v[49]);v[47]=vmaxf(v[47],v[48]);CE(v[32],v[40]);CE(v[33],v[41]);CE(v[34],v[42]);CE(v[35],v[43]);CE(v[36],v[44]);CE(v[37],v[45]);CE(v[38],v[46]);CE(v[39],v[47]);CE(v[32],v[36]);CE(v[33],v[37]);CE(v[34],v[38]);CE(v[35],v[39]);CE(v[40],v[44]);CE(v[41],v[45]);CE(v[42],v[46]);CE(v[43],v[47]);CE(v[32],v[34]);CE(v[33],v[35]);CE(v[36],v[38]);CE(v[37],v[39]);CE(v[40],v[42]);CE(v[41],v[43]);CE(v[44],v[46]);CE(v[45],v[47]);CE(v[32],v[33]);CE(v[34],v[35]);CE(v[36],v[37]);CE(v[38],v[39]);CE(v[40],v[41]);CE(v[42],v[43]);CE(v[44],v[45]);CE(v[46],v[47]); \
  v[64]=vmaxf(v[64],v[95]);v[65]=vmaxf(v[65],v[94]);v[66]=vmaxf(v[66],v[93]);v[67]=vmaxf(v[67],v[92]);v[68]=vmaxf(v[68],v[91]);v[69]=vmaxf(v[69],v[90]);v[70]=vmaxf(v[70],v[89]);v[71]=vmaxf(v[71],v[88]);v[72]=vmaxf(v[72],v[87]);v[73]=vmaxf(v[73],v[86]);v[74]=vmaxf(v[74],v[85]);v[75]=vmaxf(v[75],v[84]);v[76]=vmaxf(v[76],v[83]);v[77]=vmaxf(v[77],v[82]);v[78]=vmaxf(v[78],v[81]);v[79]=vmaxf(v[79],v[80]);CE(v[64],v[72]);CE(v[65],v[73]);CE(v[66],v[74]);CE(v[67],v[75]);CE(v[68],v[76]);CE(v[69],v[77]);CE(v[70],v[78]);CE(v[71],v[79]);CE(v[64],v[68]);CE(v[65],v[69]);CE(v[66],v[70]);CE(v[67],v[71]);CE(v[72],v[76]);CE(v[73],v[77]);CE(v[74],v[78]);CE(v[75],v[79]);CE(v[64],v[66]);CE(v[65],v[67]);CE(v[68],v[70]);CE(v[69],v[71]);CE(v[72],v[74]);CE(v[73],v[75]);CE(v[76],v[78]);CE(v[77],v[79]);CE(v[64],v[65]);CE(v[66],v[67]);CE(v[68],v[69]);CE(v[70],v[71]);CE(v[72],v[73]);CE(v[74],v[75]);CE(v[76],v[77]);CE(v[78],v[79]); \
  v[96]=vmaxf(v[96],v[127]);v[97]=vmaxf(v[97],v[126]);v[98]=vmaxf(v[98],v[125]);v[99]=vmaxf(v[99],v[124]);v[100]=vmaxf(v[100],v[123]);v[101]=vmaxf(v[101],v[122]);v[102]=vmaxf(v[102],v[121]);v[103]=vmaxf(v[103],v[120]);v[104]=vmaxf(v[104],v[119]);v[105]=vmaxf(v[105],v[118]);v[106]=vmaxf(v[106],v[117]);v[107]=vmaxf(v[107],v[116]);v[108]=vmaxf(v[108],v[115]);v[109]=vmaxf(v[109],v[114]);v[110]=vmaxf(v[110],v[113]);v[111]=vmaxf(v[111],v[112]);CE(v[96],v[104]);CE(v[97],v[105]);CE(v[98],v[106]);CE(v[99],v[107]);CE(v[100],v[108]);CE(v[101],v[109]);CE(v[102],v[110]);CE(v[103],v[111]);CE(v[96],v[100]);CE(v[97],v[101]);CE(v[98],v[102]);CE(v[99],v[103]);CE(v[104],v[108]);CE(v[105],v[109]);CE(v[106],v[110]);CE(v[107],v[111]);CE(v[96],v[98]);CE(v[97],v[99]);CE(v[100],v[102]);CE(v[101],v[103]);CE(v[104],v[106]);CE(v[105],v[107]);CE(v[108],v[110]);CE(v[109],v[111]);CE(v[96],v[97]);CE(v[98],v[99]);CE(v[100],v[101]);CE(v[102],v[103]);CE(v[104],v[105]);CE(v[106],v[107]);CE(v[108],v[109]);CE(v[110],v[111]); \
  v[0]=vmaxf(v[0],v[47]);v[1]=vmaxf(v[1],v[46]);v[2]=vmaxf(v[2],v[45]);v[3]=vmaxf(v[3],v[44]);v[4]=vmaxf(v[4],v[43]);v[5]=vmaxf(v[5],v[42]);v[6]=vmaxf(v[6],v[41]);v[7]=vmaxf(v[7],v[40]);v[8]=vmaxf(v[8],v[39]);v[9]=vmaxf(v[9],v[38]);v[10]=vmaxf(v[10],v[37]);v[11]=vmaxf(v[11],v[36]);v[12]=vmaxf(v[12],v[35]);v[13]=vmaxf(v[13],v[34]);v[14]=vmaxf(v[14],v[33]);v[15]=vmaxf(v[15],v[32]);CE(v[0],v[8]);CE(v[1],v[9]);CE(v[2],v[10]);CE(v[3],v[11]);CE(v[4],v[12]);CE(v[5],v[13]);CE(v[6],v[14]);CE(v[7],v[15]);CE(v[0],v[4]);CE(v[1],v[5]);CE(v[2],v[6]);CE(v[3],v[7]);CE(v[8],v[12]);CE(v[9],v[13]);CE(v[10],v[14]);CE(v[11],v[15]);CE(v[0],v[2]);CE(v[1],v[3]);CE(v[4],v[6]);CE(v[5],v[7]);CE(v[8],v[10]);CE(v[9],v[11]);CE(v[12],v[14]);CE(v[13],v[15]);CE(v[0],v[1]);CE(v[2],v[3]);CE(v[4],v[5]);CE(v[6],v[7]);CE(v[8],v[9]);CE(v[10],v[11]);CE(v[12],v[13]);CE(v[14],v[15]); \
  v[64]=vmaxf(v[64],v[111]);v[65]=vmaxf(v[65],v[110]);v[66]=vmaxf(v[66],v[109]);v[67]=vmaxf(v[67],v[108]);v[68]=vmaxf(v[68],v[107]);v[69]=vmaxf(v[69],v[106]);v[70]=vmaxf(v[70],v[105]);v[71]=vmaxf(v[71],v[104]);v[72]=vmaxf(v[72],v[103]);v[73]=vmaxf(v[73],v[102]);v[74]=vmaxf(v[74],v[101]);v[75]=vmaxf(v[75],v[100]);v[76]=vmaxf(v[76],v[99]);v[77]=vmaxf(v[77],v[98]);v[78]=vmaxf(v[78],v[97]);v[79]=vmaxf(v[79],v[96]);CE(v[64],v[72]);CE(v[65],v[73]);CE(v[66],v[74]);CE(v[67],v[75]);CE(v[68],v[76]);CE(v[69],v[77]);CE(v[70],v[78]);CE(v[71],v[79]);CE(v[64],v[68]);CE(v[65],v[69]);CE(v[66],v[70]);CE(v[67],v[71]);CE(v[72],v[76]);CE(v[73],v[77]);CE(v[74],v[78]);CE(v[75],v[79]);CE(v[64],v[66]);CE(v[65],v[67]);CE(v[68],v[70]);CE(v[69],v[71]);CE(v[72],v[74]);CE(v[73],v[75]);CE(v[76],v[78]);CE(v[77],v[79]);CE(v[64],v[65]);CE(v[66],v[67]);CE(v[68],v[69]);CE(v[70],v[71]);CE(v[72],v[73]);CE(v[74],v[75]);CE(v[76],v[77]);CE(v[78],v[79]); \
  v[0]=vmaxf(v[0],v[79]);v[1]=vmaxf(v[1],v[78]);v[2]=vmaxf(v[2],v[77]);v[3]=vmaxf(v[3],v[76]);v[4]=vmaxf(v[4],v[75]);v[5]=vmaxf(v[5],v[74]);v[6]=vmaxf(v[6],v[73]);v[7]=vmaxf(v[7],v[72]);v[8]=vmaxf(v[8],v[71]);v[9]=vmaxf(v[9],v[70]);v[10]=vmaxf(v[10],v[69]);v[11]=vmaxf(v[11],v[68]);v[12]=vmaxf(v[12],v[67]);v[13]=vmaxf(v[13],v[66]);v[14]=vmaxf(v[14],v[65]);v[15]=vmaxf(v[15],v[64]);CE(v[0],v[8]);CE(v[1],v[9]);CE(v[2],v[10]);CE(v[3],v[11]);CE(v[4],v[12]);CE(v[5],v[13]);CE(v[6],v[14]);CE(v[7],v[15]);CE(v[0],v[4]);CE(v[1],v[5]);CE(v[2],v[6]);CE(v[3],v[7]);CE(v[8],v[12]);CE(v[9],v[13]);CE(v[10],v[14]);CE(v[11],v[15]);CE(v[0],v[2]);CE(v[1],v[3]);CE(v[4],v[6]);CE(v[5],v[7]);CE(v[8],v[10]);CE(v[9],v[11]);CE(v[12],v[14]);CE(v[13],v[15]);CE(v[0],v[1]);CE(v[2],v[3]);CE(v[4],v[5]);CE(v[6],v[7]);CE(v[8],v[9]);CE(v[10],v[11]);CE(v[12],v[13]);CE(v[14],v[15]); \
} while (0)
#define TOPK_SORT32(v) do { \
  CE(v[0],v[1]);CE(v[3],v[2]);CE(v[4],v[5]);CE(v[7],v[6]);CE(v[8],v[9]);CE(v[11],v[10]);CE(v[12],v[13]);CE(v[15],v[14]);CE(v[0],v[2]);CE(v[1],v[3]);CE(v[6],v[4]);CE(v[7],v[5]);CE(v[8],v[10]);CE(v[9],v[11]);CE(v[14],v[12]);CE(v[15],v[13]);CE(v[0],v[1]);CE(v[2],v[3]);CE(v[5],v[4]);CE(v[7],v[6]);CE(v[8],v[9]);CE(v[10],v[11]);CE(v[13],v[12]);CE(v[15],v[14]);CE(v[0],v[4]);CE(v[1],v[5]);CE(v[2],v[6]);CE(v[3],v[7]);CE(v[12],v[8]);CE(v[13],v[9]);CE(v[14],v[10]);CE(v[15],v[11]);CE(v[0],v[2]);CE(v[1],v[3]);CE(v[4],v[6]);CE(v[5],v[7]);CE(v[10],v[8]);CE(v[11],v[9]);CE(v[14],v[12]);CE(v[15],v[13]);CE(v[0],v[1]);CE(v[2],v[3]);CE(v[4],v[5]);CE(v[6],v[7]);CE(v[9],v[8]);CE(v[11],v[10]);CE(v[13],v[12]);CE(v[15],v[14]);CE(v[0],v[8]);CE(v[1],v[9]);CE(v[2],v[10]);CE(v[3],v[11]);CE(v[4],v[12]);CE(v[5],v[13]);CE(v[6],v[14]);CE(v[7],v[15]);CE(v[0],v[4]);CE(v[1],v[5]);CE(v[2],v[6]);CE(v[3],v[7]);CE(v[8],v[12]);CE(v[9],v[13]);CE(v[10],v[14]);CE(v[11],v[15]);CE(v[0],v[2]);CE(v[1],v[3]);CE(v[4],v[6]);CE(v[5],v[7]);CE(v[8],v[10]);CE(v[9],v[11]);CE(v[12],v[14]);CE(v[13],v[15]);CE(v[0],v[1]);CE(v[2],v[3]);CE(v[4],v[5]);CE(v[6],v[7]);CE(v[8],v[9]);CE(v[10],v[11]);CE(v[12],v[13]);CE(v[14],v[15]); \
  CE(v[16],v[17]);CE(v[19],v[18]);CE(v[20],v[21]);CE(v[23],v[22]);CE(v[24],v[25]);CE(v[27],v[26]);CE(v[28],v[29]);CE(v[31],v[30]);CE(v[16],v[18]);CE(v[17],v[19]);CE(v[22],v[20]);CE(v[23],v[21]);CE(v[24],v[26]);CE(v[25],v[27]);CE(v[30],v[28]);CE(v[31],v[29]);CE(v[16],v[17]);CE(v[18],v[19]);CE(v[21],v[20]);CE(v[23],v[22]);CE(v[24],v[25]);CE(v[26],v[27]);CE(v[29],v[28]);CE(v[31],v[30]);CE(v[16],v[20]);CE(v[17],v[21]);CE(v[18],v[22]);CE(v[19],v[23]);CE(v[28],v[24]);CE(v[29],v[25]);CE(v[30],v[26]);CE(v[31],v[27]);CE(v[16],v[18]);CE(v[17],v[19]);CE(v[20],v[22]);CE(v[21],v[23]);CE(v[26],v[24]);CE(v[27],v[25]);CE(v[30],v[28]);CE(v[31],v[29]);CE(v[16],v[17]);CE(v[18],v[19]);CE(v[20],v[21]);CE(v[22],v[23]);CE(v[25],v[24]);CE(v[27],v[26]);CE(v[29],v[28]);CE(v[31],v[30]);CE(v[16],v[24]);CE(v[17],v[25]);CE(v[18],v[26]);CE(v[19],v[27]);CE(v[20],v[28]);CE(v[21],v[29]);CE(v[22],v[30]);CE(v[23],v[31]);CE(v[16],v[20]);CE(v[17],v[21]);CE(v[18],v[22]);CE(v[19],v[23]);CE(v[24],v[28]);CE(v[25],v[29]);CE(v[26],v[30]);CE(v[27],v[31]);CE(v[16],v[18]);CE(v[17],v[19]);CE(v[20],v[22]);CE(v[21],v[23]);CE(v[24],v[26]);CE(v[25],v[27]);CE(v[28],v[30]);CE(v[29],v[31]);CE(v[16],v[17]);CE(v[18],v[19]);CE(v[20],v[21]);CE(v[22],v[23]);CE(v[24],v[25]);CE(v[26],v[27]);CE(v[28],v[29]);CE(v[30],v[31]); \
  v[0]=vmaxf(v[0],v[31]);v[1]=vmaxf(v[1],v[30]);v[2]=vmaxf(v[2],v[29]);v[3]=vmaxf(v[3],v[28]);v[4]=vmaxf(v[4],v[27]);v[5]=vmaxf(v[5],v[26]);v[6]=vmaxf(v[6],v[25]);v[7]=vmaxf(v[7],v[24]);v[8]=vmaxf(v[8],v[23]);v[9]=vmaxf(v[9],v[22]);v[10]=vmaxf(v[10],v[21]);v[11]=vmaxf(v[11],v[20]);v[12]=vmaxf(v[12],v[19]);v[13]=vmaxf(v[13],v[18]);v[14]=vmaxf(v[14],v[17]);v[15]=vmaxf(v[15],v[16]);CE(v[0],v[8]);CE(v[1],v[9]);CE(v[2],v[10]);CE(v[3],v[11]);CE(v[4],v[12]);CE(v[5],v[13]);CE(v[6],v[14]);CE(v[7],v[15]);CE(v[0],v[4]);CE(v[1],v[5]);CE(v[2],v[6]);CE(v[3],v[7]);CE(v[8],v[12]);CE(v[9],v[13]);CE(v[10],v[14]);CE(v[11],v[15]);CE(v[0],v[2]);CE(v[1],v[3]);CE(v[4],v[6]);CE(v[5],v[7]);CE(v[8],v[10]);CE(v[9],v[11]);CE(v[12],v[14]);CE(v[13],v[15]);CE(v[0],v[1]);CE(v[2],v[3]);CE(v[4],v[5]);CE(v[6],v[7]);CE(v[8],v[9]);CE(v[10],v[11]);CE(v[12],v[13]);CE(v[14],v[15]); \
} while (0)
#define TOPK_MERGE_BITONIC16(v) do { \
  CE(v[0],v[8]);CE(v[1],v[9]);CE(v[2],v[10]);CE(v[3],v[11]);CE(v[4],v[12]);CE(v[5],v[13]);CE(v[6],v[14]);CE(v[7],v[15]);CE(v[0],v[4]);CE(v[1],v[5]);CE(v[2],v[6]);CE(v[3],v[7]);CE(v[8],v[12]);CE(v[9],v[13]);CE(v[10],v[14]);CE(v[11],v[15]);CE(v[0],v[2]);CE(v[1],v[3]);CE(v[4],v[6]);CE(v[5],v[7]);CE(v[8],v[10]);CE(v[9],v[11]);CE(v[12],v[14]);CE(v[13],v[15]);CE(v[0],v[1]);CE(v[2],v[3]);CE(v[4],v[5]);CE(v[6],v[7]);CE(v[8],v[9]);CE(v[10],v[11]);CE(v[12],v[13]);CE(v[14],v[15]); \
} while (0)
#define TOPK_PAIRS(X) \
  X(0,0,0) X(1,0,1) X(2,0,2) X(3,0,3) X(4,0,4) X(5,0,5) X(6,0,6) X(7,0,7) X(8,0,8) X(9,0,9) X(10,0,10) X(11,0,11) X(12,0,12) X(13,0,13) X(14,0,14) X(15,0,15) X(16,1,1) X(17,1,2) X(18,1,3) X(19,1,4) X(20,1,5) X(21,1,6) X(22,1,7) X(23,2,2) X(24,2,3) X(25,2,4) X(26,3,3)

namespace tk {
typedef float f32x16 __attribute__((ext_vector_type(16)));
__device__ __forceinline__ float vmaxf(float a, float b) { float r; asm("v_max_f32 %0, %1, %2" : "=v"(r) : "v"(a), "v"(b)); return r; }
__device__ __forceinline__ float vminf(float a, float b) { float r; asm("v_min_f32 %0, %1, %2" : "=v"(r) : "v"(a), "v"(b)); return r; }
#define CE(x, y) do { const float h_ = vmaxf(x, y); y = vminf(x, y); x = h_; } while (0)
__device__ __forceinline__ unsigned fbits(float f) { return __float_as_uint(f); }
__device__ __forceinline__ float bitsf(unsigned u) { return __uint_as_float(u); }
__device__ __forceinline__ unsigned byte_lookup(const unsigned (&pk)[4], unsigned i) {
    const unsigned long long lo = (unsigned long long)pk[0] | ((unsigned long long)pk[1] << 32), hi_ = (unsigned long long)pk[2] | ((unsigned long long)pk[3] << 32);
    const unsigned long long s = (i & 8u) ? hi_ : lo;
    return (unsigned)(s >> ((i & 7u) * 8u)) & 0x7Fu;
}
constexpr float PADV = -3.0e38f;

template <int VAR>
__device__ __forceinline__ void topk_phase(Frame& F) {
    const int lane = F.lane, r32 = lane & 31, hi = lane >> 5, wid = F.wave, tid = F.tid;
    LAS unsigned char* lds = F.lds;
    const unsigned char* SUBK = F.ws + WS_SUBK; const bf16* Q = (const bf16*)(F.ws + WS_Q);
    int* IDX = (int*)(F.ws + (VAR ? 360 * MiB : WS_IDX)); float* G = (float*)(F.ws + (VAR ? 376 * MiB : WS_G));
    int cur_h = -1;
    for (int it = (int)blockIdx.x; it < 8 * (T / 256); it += F.G) {
        const int h = it & 7, chunk = it >> 3;
        if (h != cur_h) {
            __syncthreads();
            for (int i = tid; i < 4096; i += NWAVES * 64) { const int ch = i & 15, pn = i >> 4;
                *(LAS v4u*)(lds + (pn >> 7) * 32768 + ch * 2048 + (pn & 127) * 16) = *(const GAS v4u*)(SUBK + (size_t)h * 65536 + (size_t)pn * 256 + ch * 16); }
            __syncthreads();
            cur_h = h;
        }
        asm volatile("; TOPK_BEGIN");
        const int t = chunk * 256 + wid * 32 + r32;
        if (VAR == 0 || VAR == 1 || VAR == 4)
        {
            const float2 st = ln1_row_stats((const float2*)(F.ws + WS_STATS), t);
            const int dcol = 128 * h + 4 * r32;
            const f32x4 g1 = *(const GAS f32x4*)(F.in[5] + dcol), b1 = *(const GAS f32x4*)(F.in[6] + dcol);
            bf16* X1B = (bf16*)(F.ws + WS_X1B);
#pragma unroll
            for (int i = 0; i < 16; ++i) {
                const float m0_ = __uint_as_float(__builtin_amdgcn_readlane(__float_as_uint(st.x), 2 * i)), m1_ = __uint_as_float(__builtin_amdgcn_readlane(__float_as_uint(st.x), 2 * i + 1));
                const float r0_ = __uint_as_float(__builtin_amdgcn_readlane(__float_as_uint(st.y), 2 * i)), r1_ = __uint_as_float(__builtin_amdgcn_readlane(__float_as_uint(st.y), 2 * i + 1));
                const float mu = hi ? m1_ : m0_, rs = hi ? r1_ : r0_;
                const size_t off = (size_t)(chunk * 256 + wid * 32 + 2 * i + hi) * D_MODEL + dcol;
                const u32x2 yw = *(const GAS u32x2*)(X1B + off);
                const f32x4 y4 = {__uint_as_float(yw.x << 16), __uint_as_float(yw.x & 0xffff0000u), __uint_as_float(yw.y << 16), __uint_as_float(yw.y & 0xffff0000u)};
                const f32x4 x4 = (y4 - mu) * rs * g1 + b1;
                u32x2 w; w.x = pk2(x4.x, x4.y); w.y = pk2(x4.z, x4.w);
                const unsigned wq = q8x4(x4.x * X_QS, x4.y * X_QS, x4.z * X_QS, x4.w * X_QS);
                if (VAR == 0) { *(GAS u32x2*)(X1B + off) = w; *(GAS unsigned*)(F.ws + WS_X1Q + off) = wq; } else asm volatile("" :: "v"(w.x), "v"(w.y), "v"(wq));
            }
        }
        float v[128];
        {
            f32x16 acc[2][4];
#pragma unroll
            for (int p = 0; p < 2; ++p)
#pragma unroll
                for (int nt = 0; nt < 4; ++nt)
#pragma unroll
                    for (int r = 0; r < 16; ++r) acc[p][nt][r] = 0.f;
#pragma unroll
            for (int p = 0; p < 2; ++p) {
                bf16x8 bq[8];
#pragma unroll
                for (int ks = 0; ks < 8; ++ks) bq[ks] = *(const GAS bf16x8*)(Q + ((size_t)(t >> 5) * 8192 + (size_t)(h * 32 + p * 16 + ks * 2 + hi) * 32 + r32) * 8);
#pragma unroll
                for (int ks = 0; ks < 8; ++ks)
#pragma unroll
                    for (int nt = 0; nt < 4; ++nt) {
                        const bf16x8 a = *(const LAS bf16x8*)(lds + p * 32768 + (2 * ks + hi) * 2048 + (nt * 32 + r32) * 16);
                        acc[p][nt] = __builtin_amdgcn_mfma_f32_32x32x16_bf16(a, bq[ks], acc[p][nt], 0, 0, 0);
                    }
            }
#pragma unroll
            for (int nt = 0; nt < 4; ++nt)
#pragma unroll
                for (int r = 0; r < 16; ++r) {
                    auto rr = __builtin_amdgcn_permlane32_swap(fbits(acc[0][nt][r]), fbits(acc[1][nt][r]), false, false);
                    const unsigned n0 = 32 * nt + (r & 3) + 8 * (r >> 2);
                    v[nt * 32 + r] = bitsf((rr[0] & 0xFFFFFF80u) | n0);
                    v[nt * 32 + 16 + r] = bitsf((rr[1] & 0xFFFFFF80u) | (n0 + 4u));
                }
        }
        unsigned pf0 = 0, pf1 = 0, pf2 = 0, pf3 = 0;
        if (it + F.G < 8 * (T / 256)) {
            const int hn = (it + F.G) & 7, chn = (it + F.G) >> 3, tgn = chn * 8 + wid;
            const unsigned char* qn_ = (const unsigned char*)Q + ((size_t)tgn * 8192 + (size_t)hn * 1024) * 16;
            pf0 = *(const GAS unsigned*)(qn_ + lane * 128); pf1 = *(const GAS unsigned*)(qn_ + (64 + lane) * 128);
            pf2 = *(const GAS unsigned*)((const unsigned char*)(F.ws + WS_X1B) + ((size_t)(tgn * 32 + (lane >> 1)) * D_MODEL + 128 * hn) * 2 + (lane & 1) * 128);
            pf3 = *(const GAS unsigned*)((const unsigned char*)(F.ws + WS_STATS) + (size_t)(tgn * 32 + (lane & 31)) * 128);
        }
        if (VAR == 2 || VAR == 4 || VAR == 5) { _Pragma("unroll") for (int i_ = 16; i_ < 128; ++i_) asm volatile("" :: "v"(v[i_])); } else
        TOPK_SORT128(v);
        unsigned ak[16], bk[16]; float uval[16], wval[16];
#pragma unroll
        for (int i = 0; i < 16; ++i) {
            auto rr = __builtin_amdgcn_permlane32_swap(fbits(v[i]), fbits(v[i]), false, false);
            ak[i] = rr[0]; bk[i] = rr[1];
            const unsigned oth = hi ? rr[0] : rr[1];
            uval[i] = bitsf(fbits(v[i]) & 0xFFFFFF80u); wval[i] = bitsf(oth & 0xFFFFFF80u);
        }
        unsigned na_pack[4], nb_pack[4];
#pragma unroll
        for (int q = 0; q < 4; ++q) {
            na_pack[q] = (ak[4 * q] & 0x7Fu) | ((ak[4 * q + 1] & 0x7Fu) << 8) | ((ak[4 * q + 2] & 0x7Fu) << 16) | ((ak[4 * q + 3] & 0x7Fu) << 24);
            nb_pack[q] = (bk[4 * q] & 0x7Fu) | ((bk[4 * q + 1] & 0x7Fu) << 8) | ((bk[4 * q + 2] & 0x7Fu) << 16) | ((bk[4 * q + 3] & 0x7Fu) << 24);
        }
        float cand[32];
        const unsigned hb = (unsigned)hi << 8;
#define TK_X(k, i, j) { const float s_ = uval[i] + wval[j]; unsigned kb_ = (fbits(s_) & 0xFFFFFE00u) | hb | (unsigned)((i) * 16 + (j)); if ((i) == (j)) kb_ = hi ? fbits(PADV) : kb_; cand[k] = bitsf(kb_); }
        TOPK_PAIRS(TK_X)
#undef TK_X
#pragma unroll
        for (int k = 27; k < 32; ++k) cand[k] = PADV;
        if (VAR == 3 || VAR == 4 || VAR == 5) { _Pragma("unroll") for (int i_ = 16; i_ < 32; ++i_) asm volatile("" :: "v"(cand[i_])); } else
        TOPK_SORT32(cand);
        float fin[16];
        {
            unsigned oc[16];
#pragma unroll
            for (int i = 0; i < 16; ++i) { auto rr = __builtin_amdgcn_permlane32_swap(fbits(cand[i]), fbits(cand[i]), false, false); oc[i] = hi ? rr[0] : rr[1]; }
#pragma unroll
            for (int i = 0; i < 16; ++i) fin[i] = vmaxf(cand[i], bitsf(oc[15 - i]));
        }
        TOPK_MERGE_BITONIC16(fin);
        float e[16]; float esum = 0.f; const float m0 = bitsf(fbits(fin[0]) & 0xFFFFFE00u);
#pragma unroll
        for (int k = 0; k < 16; ++k) { e[k] = __builtin_amdgcn_exp2f((bitsf(fbits(fin[k]) & 0xFFFFFE00u) - m0) * LOG2E); esum += e[k]; }
        const float inv = 1.f / esum;
        int oi[8]; float og[8];
#pragma unroll
        for (int kk = 0; kk < 8; ++kk) {
            const unsigned key = hi ? fbits(fin[8 + kk]) : fbits(fin[kk]); og[kk] = (hi ? e[8 + kk] : e[kk]) * inv;
            const unsigned code = key & 0x1FFu, f = code >> 8, ci = (code >> 4) & 15u, cj = code & 15u;
            const unsigned ia = f ? cj : ci, jb = f ? ci : cj;
            oi[kk] = (int)(byte_lookup(na_pack, ia) * 128u + byte_lookup(nb_pack, jb));
        }
        int* ip = IDX + ((size_t)t * PEER_H + h) * TOPK + 8 * hi; float* gp = G + ((size_t)t * PEER_H + h) * TOPK + 8 * hi;
        *(GAS v4u*)ip = (v4u){(unsigned)oi[0], (unsigned)oi[1], (unsigned)oi[2], (unsigned)oi[3]}; *(GAS v4u*)(ip + 4) = (v4u){(unsigned)oi[4], (unsigned)oi[5], (unsigned)oi[6], (unsigned)oi[7]};
        *(GAS f32x4*)gp = (f32x4){og[0], og[1], og[2], og[3]}; *(GAS f32x4*)(gp + 4) = (f32x4){og[4], og[5], og[6], og[7]};
        asm volatile("" :: "v"(pf0), "v"(pf1), "v"(pf2), "v"(pf3));
        asm volatile("; TOPK_END");
    }
}
#undef CE
}


namespace ex {
typedef float f32x2 __attribute__((ext_vector_type(2)));
typedef _Float16 h16x2 __attribute__((ext_vector_type(2)));
__device__ __forceinline__ float gelu_erf(float v) {
    const float av = fabsf(v), t = __builtin_amdgcn_rcpf(fmaf(av, 0.2316418882f, 1.0f));
    float q = fmaf(t, 0.5307027145f, -0.7265760135f); q = fmaf(q, t, 0.7107068705f); q = fmaf(q, t, -0.142248368f); q = fmaf(q, t, 0.127414796f); q = q * t;
    const float ee = __builtin_amdgcn_exp2f(v * v * -0.72134752044f);
    const float mm = v * (q * ee);
    return v < 0.f ? mm : v - mm;
}
__device__ __forceinline__ f32x2 bf2_to_f2(unsigned w) { return (f32x2){__uint_as_float(w << 16), __uint_as_float(w & 0xffff0000u)}; }

template <int PH> struct Aux;
template <> struct Aux<0> { v4u xq; };
template <> struct Aux<1> { v4u wv[2]; unsigned x2; };

template <int PH>
__device__ __forceinline__ void gather_issue(Frame& F, v4u (&rw)[16], Aux<PH>& ax, const LAS unsigned* ixl, const unsigned char* tab, unsigned loff, int t, int i, int g, int dl) {
    v4u ix[4];
#pragma unroll
    for (int jj = 0; jj < 4; ++jj) ix[jj] = *(const LAS v4u*)(ixl + i * 128 + 16 * g + 4 * jj);
#pragma unroll
    for (int j = 0; j < 16; ++j) rw[j] = *(const GAS v4u*)(tab + (unsigned)(ix[j >> 2][j & 3] * 128u + loff));
    if constexpr (PH == 0) {
        ax.xq = *(const GAS v4u*)(F.ws + WS_X1Q + (size_t)t * D_MODEL + dl);
    } else {
        const _Float16* W = (const _Float16*)(F.ws + WS_W16);
        ax.wv[0] = *(const GAS v4u*)(W + (size_t)t * 128 + 16 * g); ax.wv[1] = *(const GAS v4u*)(W + (size_t)t * 128 + 16 * g + 8);
        ax.x2 = *(const GAS unsigned*)((const bf16*)(F.ws + WS_X1B) + (size_t)t * D_MODEL + dl + 2 * g);
    }
}
template <int PH, int VAR>
__device__ __forceinline__ void gather_compute(Frame& F, const v4u (&rw)[16], const Aux<PH>& ax, int slice, int t, int lane, int g, int sub, int dl) {
    if constexpr (PH == 0) {
        int p[16];
#pragma unroll
        for (int j = 0; j < 16; ++j) {
            int a_ = __builtin_amdgcn_sdot4((int)rw[j][0], (int)ax.xq[0], 0, false);
#pragma unroll
            for (int c = 1; c < 4; ++c) a_ = __builtin_amdgcn_sdot4((int)rw[j][c], (int)ax.xq[c], a_, false);
            p[j] = a_;
        }
        const bool b2 = (lane & 4) != 0, b1 = (lane & 2) != 0, b0 = (lane & 1) != 0;
#pragma unroll
        for (int k = 0; k < 8; ++k) { const int send = b2 ? p[k] : p[k + 8], keep = b2 ? p[k + 8] : p[k]; p[k] = keep + __builtin_amdgcn_update_dpp(0, send, 0x141, 0xF, 0xF, false); }
#pragma unroll
        for (int k = 0; k < 4; ++k) { const int send = b1 ? p[k] : p[k + 4], keep = b1 ? p[k + 4] : p[k]; p[k] = keep + __builtin_amdgcn_update_dpp(0, send, 0x4E, 0xF, 0xF, false); }
#pragma unroll
        for (int k = 0; k < 2; ++k) { const int send = b0 ? p[k] : p[k + 2], keep = b0 ? p[k + 2] : p[k]; p[k] = keep + __builtin_amdgcn_update_dpp(0, send, 0xB1, 0xF, 0xF, false); }
        const float pf0 = (float)p[0] * (1.f / (U_QS * X_QS)), pf1 = (float)p[1] * (1.f / (U_QS * X_QS));
        const h16x2 ph = {(_Float16)pf0, (_Float16)pf1};
        if (VAR == 0) *(GAS unsigned*)((_Float16*)(F.ws + WS_HP) + ((size_t)slice * T + t) * 128 + 16 * g + 2 * sub) = __builtin_bit_cast(unsigned, ph); else asm volatile("" :: "v"(pf0), "v"(pf1));
    } else {
        const f32x2 x2 = bf2_to_f2(ax.x2);
        h16x2 a2[8];
#pragma unroll
        for (int c = 0; c < 8; ++c) a2[c] = (h16x2){(_Float16)0.f, (_Float16)0.f};
#pragma unroll
        for (int j = 0; j < 16; ++j) {
            const unsigned wd_ = ax.wv[j >> 3][(j >> 1) & 3];
            const h16x2 w2 = __builtin_bit_cast(h16x2, (j & 1) ? ((wd_ >> 16) | (wd_ & 0xFFFF0000u)) : ((wd_ & 0xFFFFu) | (wd_ << 16)));
#pragma unroll
            for (int c = 0; c < 4; ++c) {
                a2[2 * c] = __builtin_elementwise_fma(__builtin_bit_cast(h16x2, __builtin_amdgcn_cvt_scalef32_pk_f16_fp8((int)rw[j][c], 1.0f, false)), w2, a2[2 * c]);
                a2[2 * c + 1] = __builtin_elementwise_fma(__builtin_bit_cast(h16x2, __builtin_amdgcn_cvt_scalef32_pk_f16_fp8((int)rw[j][c], 1.0f, true)), w2, a2[2 * c + 1]);
            }
        }
        unsigned pa[8];
#pragma unroll
        for (int c = 0; c < 8; ++c) pa[c] = __builtin_bit_cast(unsigned, a2[c]);
#define PKADD(u, v) __builtin_bit_cast(unsigned, __builtin_bit_cast(h16x2, (unsigned)(u)) + __builtin_bit_cast(h16x2, (unsigned)(v)))
#pragma unroll
        for (int k = 0; k < 4; ++k) { auto rr = __builtin_amdgcn_permlane32_swap(pa[k], pa[k + 4], false, false); pa[k] = PKADD(rr[0], rr[1]); }
#pragma unroll
        for (int k = 0; k < 2; ++k) { auto rr = __builtin_amdgcn_permlane16_swap(pa[k], pa[k + 2], false, false); pa[k] = PKADD(rr[0], rr[1]); }
        const bool b3 = (lane & 8) != 0;
        { const unsigned send = b3 ? pa[0] : pa[1], keep = b3 ? pa[1] : pa[0]; pa[0] = PKADD(keep, (unsigned)__builtin_amdgcn_update_dpp(0, (int)send, 0x128, 0xF, 0xF, false)); }
#undef PKADD
        float a[2];
        a[0] = (float)__builtin_bit_cast(_Float16, (unsigned short)(pa[0] & 0xFFFFu)); a[1] = (float)__builtin_bit_cast(_Float16, (unsigned short)(pa[0] >> 16));
        f32x2 v2;
        v2.x = fmaf(ALPHA, x2.x, a[0] * (1.f / V_SCALE));
        v2.y = fmaf(ALPHA, x2.y, a[1] * (1.f / V_SCALE));
        if (VAR == 0) *(GAS unsigned*)((bf16*)(F.ws + WS_V2) + (size_t)t * D_MODEL + dl + 2 * g) = pk2(v2.x, v2.y);
    }
}

constexpr int GTW = 32;
template <int PH, int VAR>
__device__ __forceinline__ void gather_item(Frame& F, int slice_, int chunk_) {
    const int lane = F.lane, g = lane >> 3, sub = lane & 7;
    const int slice = __builtin_amdgcn_readfirstlane(slice_), chunk = __builtin_amdgcn_readfirstlane(chunk_);
    const unsigned char* tab = F.ws + (PH == 0 ? WS_EU : WS_EV) + (size_t)slice * EXP_SLICE_BYTES;
    const unsigned loff = 16u * (unsigned)sub;
    const int tbase = chunk * (8 * GTW) + F.wave * GTW;
    const int dl = 128 * slice + 16 * sub;
    LAS unsigned* ixl = (LAS unsigned*)(F.lds + F.wave * 16384);
    {
        const v4u* src = (const v4u*)((const int*)(F.ws + WS_IDX) + (size_t)tbase * 128);
        v4u tmp[GTW / 2];
#pragma unroll
        for (int k = 0; k < GTW / 2; ++k) tmp[k] = *(const GAS v4u*)(src + k * 64 + lane);
#pragma unroll
        for (int k = 0; k < GTW / 2; ++k) *(LAS v4u*)(ixl + (k * 64 + lane) * 4) = tmp[k];
    }
    v4u rwA[16], rwB[16]; Aux<PH> axA, axB;
    gather_issue<PH>(F, rwA, axA, ixl, tab, loff, tbase, 0, g, dl);
    if (VAR == 2) gather_issue<PH>(F, rwB, axB, ixl, tab, loff, tbase + 1, 1, g, dl);
#pragma unroll 4
    for (int i = 0; i < GTW; i += 2) {
        if (VAR != 2) gather_issue<PH>(F, rwB, axB, ixl, tab, loff, tbase + i + 1, i + 1, g, dl);
        if (VAR != 1) gather_compute<PH, VAR>(F, rwA, axA, slice, tbase + i, lane, g, sub, dl);
        else { _Pragma("unroll") for (int j = 0; j < 16; ++j) asm volatile("" :: "v"(rwA[j])); }
        const int in = (i + 2 < GTW) ? i + 2 : GTW - 1;
        if (VAR != 2) gather_issue<PH>(F, rwA, axA, ixl, tab, loff, tbase + in, in, g, dl);
        if (VAR != 1) gather_compute<PH, VAR>(F, rwB, axB, slice, tbase + i + 1, lane, g, sub, dl);
        else { _Pragma("unroll") for (int j = 0; j < 16; ++j) asm volatile("" :: "v"(rwB[j])); }
        if (VAR == 2) { _Pragma("unroll") for (int j = 0; j < 16; ++j) asm volatile("" : "+v"(rwA[j]), "+v"(rwB[j])); }
    }
}

template <int PH, int VAR = 0>
__device__ __forceinline__ void gather_phase(Frame& F) {
    LAS int* sh = (LAS int*)(F.lds + RING_BYTES + 1024);
    const unsigned xcc = xb_xcc_id() & 7u;
    gu32* qbase = F.ctl + (VAR ? CW_QV + 1024 : (PH == 0 ? CW_QU : CW_QV));
    for (int r = 0; r < 8; ++r) {
        const int qi = (int)((xcc + (unsigned)r) & 7u);
        for (;;) {
            if (F.tid == 0) sh[0] = (int)__hip_atomic_fetch_add(qbase + 64 * qi, 1u, __ATOMIC_RELAXED, __HIP_MEMORY_SCOPE_AGENT);
            __syncthreads();
            const int n = sh[0];
            __syncthreads();
            if (n >= T / (8 * GTW)) break;
            gather_item<PH, VAR>(F, qi, n);
        }
    }
}

__device__ __forceinline__ void combine_phase(Frame& F) {
    const _Float16* HP = (const _Float16*)(F.ws + WS_HP); const float* W = (const float*)(F.ws + WS_G); _Float16* W16 = (_Float16*)(F.ws + WS_W16);
    const int nthr = F.G * NWAVES * 64;
    for (int i = F.vcu * NWAVES * 64 + F.tid; i < T * 128 / 4; i += nthr) {
        f32x4 s = {0.f, 0.f, 0.f, 0.f};
#pragma unroll
        for (int sl = 0; sl < 8; ++sl) {
            const u32x2 hw = *(const GAS u32x2*)(HP + (size_t)sl * T * 128 + (size_t)i * 4);
            s[0] += (float)__builtin_bit_cast(_Float16, (unsigned short)(hw.x & 0xFFFFu)); s[1] += (float)__builtin_bit_cast(_Float16, (unsigned short)(hw.x >> 16));
            s[2] += (float)__builtin_bit_cast(_Float16, (unsigned short)(hw.y & 0xFFFFu)); s[3] += (float)__builtin_bit_cast(_Float16, (unsigned short)(hw.y >> 16));
        }
        const f32x4 gv = *(const GAS f32x4*)(W + (size_t)i * 4);
        h16x2 o0, o1;
        o0.x = (_Float16)(gv[0] * gelu_erf(s[0])); o0.y = (_Float16)(gv[1] * gelu_erf(s[1])); o1.x = (_Float16)(gv[2] * gelu_erf(s[2])); o1.y = (_Float16)(gv[3] * gelu_erf(s[3]));
        u32x2 ow; ow.x = __builtin_bit_cast(unsigned, o0); ow.y = __builtin_bit_cast(unsigned, o1);
        *(GAS u32x2*)(W16 + (size_t)i * 4) = ow;
    }
}

__device__ __forceinline__ void ln2_phase(Frame& F) {
    const int lane = F.lane, gw = F.vcu * NWAVES + F.wave, NGW = F.G * NWAVES;
    const float* ln2_g = F.in[11]; const float* ln2_b = F.in[12];
    f32x4 gg[4], bb[4];
#pragma unroll
    for (int j = 0; j < 2; ++j) { gg[2 * j] = *(const GAS f32x4*)(ln2_g + 512 * j + 8 * lane); gg[2 * j + 1] = *(const GAS f32x4*)(ln2_g + 512 * j + 8 * lane + 4);
                                  bb[2 * j] = *(const GAS f32x4*)(ln2_b + 512 * j + 8 * lane); bb[2 * j + 1] = *(const GAS f32x4*)(ln2_b + 512 * j + 8 * lane + 4); }
    for (int t = gw; t < T; t += NGW) {
        const bf16* vrow = (const bf16*)(F.ws + WS_V2) + (size_t)t * D_MODEL;
        f32x4 v[4]; float s = 0.f;
#pragma unroll
        for (int j = 0; j < 2; ++j) { const v4u w = *(const GAS v4u*)(vrow + 512 * j + 8 * lane);
            v[2 * j] = (f32x4){__uint_as_float(w[0] << 16), __uint_as_float(w[0] & 0xffff0000u), __uint_as_float(w[1] << 16), __uint_as_float(w[1] & 0xffff0000u)};
            v[2 * j + 1] = (f32x4){__uint_as_float(w[2] << 16), __uint_as_float(w[2] & 0xffff0000u), __uint_as_float(w[3] << 16), __uint_as_float(w[3] & 0xffff0000u)}; }
#pragma unroll
        for (int j = 0; j < 4; ++j) s += (v[j].x + v[j].y) + (v[j].z + v[j].w);
        const float mean = wave_sum(s) * (1.f / D_MODEL); float s2 = 0.f;
#pragma unroll
        for (int j = 0; j < 4; ++j) { v[j] = v[j] - mean; s2 += (v[j].x * v[j].x + v[j].y * v[j].y) + (v[j].z * v[j].z + v[j].w * v[j].w); }
        const float rstd = 1.f / sqrtf(wave_sum(s2) * (1.f / D_MODEL) + LN_EPS);
        float* row = F.out + (size_t)t * D_MODEL;
#pragma unroll
        for (int j = 0; j < 2; ++j) { *(GAS f32x4*)(row + 512 * j + 8 * lane) = v[2 * j] * rstd * gg[2 * j] + bb[2 * j]; *(GAS f32x4*)(row + 512 * j + 8 * lane + 4) = v[2 * j + 1] * rstd * gg[2 * j + 1] + bb[2 * j + 1]; }
    }
}
}

struct Args { const float* in[13]; float* out; unsigned char* ws; int ph_lo, ph_hi; };
static_assert(sizeof(Args) == 13 * 8 + 8 + 8 + 8, "Args has no padding");
constexpr int N_PHASES = 10;

__global__ void __launch_bounds__(NWAVES * 64, 2) mk_fwd(Args args) {
    extern __shared__ __attribute__((aligned(16))) unsigned char lds[];
    Frame F;
    F.lds = (LAS unsigned char*)lds;
    F.MISC = (volatile LAS unsigned*)(F.lds + MISC_OFF);
    F.tid = threadIdx.x; F.lane = F.tid & 63; F.wave = __builtin_amdgcn_readfirstlane(F.tid >> 6);
    F.G = gridDim.x; { const int bx = blockIdx.x; F.vcu = (F.G % 8 == 0) ? (bx % 8) * (F.G / 8) + bx / 8 : bx; }
    F.ws = args.ws; F.out = args.out; F.ctl = (gu32*)(args.ws + WS_CTL);
#pragma unroll
    for (int i = 0; i < 13; ++i) F.in[i] = args.in[i];
    for (int u = F.tid; u < (LDS_BYTES - RING_BYTES) / 4; u += NWAVES * 64) ((LAS unsigned*)(F.lds + RING_BYTES))[u] = 0u;
    __syncthreads();
    XcdBarrier bar = xcd_barrier_post((unsigned*)(F.ctl + CW_BAR), F.MISC + 8);
    const int lo = args.ph_lo, hi = args.ph_hi;
#define IN(k) (lo <= (k) && (k) < hi)
#define SEAM(k) do { if (IN(k) && IN((k) + 1)) xcd_barrier(bar); } while (0)

    if (IN(0)) { p0_prologue(F); }
    SEAM(0);
    if (IN(1)) {
        pg8::Gemm g{(const pg8::bf16_t*)(F.ws + WS_XQ), (const pg8::bf16_t*)(F.ws + WS_WIN), T, NPHYS, D_MODEL / 2};
        pg8::StaticOrder S; S.init(T, NPHYS, F.G, (int)blockIdx.x);
        EpiInProj E{(bf16*)(F.ws + WS_FQ), (bf16*)(F.ws + WS_FKT), (bf16*)(F.ws + WS_FVT), (bf16*)(F.ws + WS_SQ), (bf16*)(F.ws + WS_SKT), (bf16*)(F.ws + WS_SVT),
                    (const float2*)(F.ws + WS_ROPE), (float*)(F.ws + WS_QN2), (float*)(F.ws + WS_KN2)};
        pg8::gemm_phase<EpiInProj, pg8::StaticOrder, true, true, true>(F.lds, g, S, E);
        if ((int)blockIdx.x >= F.G / 2) p1_slack_jobs(F, (int)blockIdx.x - F.G / 2, F.G - F.G / 2);
        else convert_experts(F, (int)blockIdx.x * NWAVES + F.wave, (F.G / 2) * NWAVES, EXP_SPLIT, 2 * NEXP);
    }
    SEAM(1);
    if (IN(2)) { att::attn_phase(F); }
    SEAM(2);
    if (IN(3)) {
        pg8::Gemm g{(const pg8::bf16_t*)(F.ws + WS_ATTN), (const pg8::bf16_t*)(F.ws + WS_WOUT), T, D_MODEL, D_MODEL / 2};
        pg8::StaticOrder S; S.init(T, D_MODEL, F.G, (int)blockIdx.x);
        EpiOutProj E{(bf16*)(F.ws + WS_XB), (float2*)(F.ws + WS_STATS)};
        pg8::gemm_phase<EpiOutProj, pg8::StaticOrder, true, true, true>(F.lds, g, S, E);
    }
    SEAM(3);
    if (IN(4)) {
        pg8::Gemm g{(const pg8::bf16_t*)(F.ws + WS_XB), (const pg8::bf16_t*)(F.ws + WS_WQ), T, QCOLS, D_MODEL};
        pg8::StaticOrder S; S.init(T, QCOLS, F.G, (int)blockIdx.x);
        EpiQuery E{(const float2*)(F.ws + WS_STATS), (const float*)(F.ws + WS_GW), (const float*)(F.ws + WS_GW) + QCOLS, (bf16*)(F.ws + WS_Q)};
        pg8::gemm_phase<EpiQuery, pg8::StaticOrder, true, true>(F.lds, g, S, E);
    }
    SEAM(4);
    if (IN(5)) { tk::topk_phase<0>(F); }
#ifdef P5_PROBE
    if (IN(5)) { xcd_barrier(bar); tk::topk_phase<P5_PROBE>(F); }
#endif
    SEAM(5);
    if (IN(6)) { ex::gather_phase<0>(F); }
    SEAM(6);
    if (IN(7)) { ex::combine_phase(F); }
    SEAM(7);
    if (IN(8)) { ex::gather_phase<1>(F); }
    SEAM(8);
#ifdef G_PROBE_PH
    if (IN(8)) { ex::gather_phase<G_PROBE_PH, G_PROBE_VAR>(F); xcd_barrier(bar); }
#endif
#ifdef EXTRA_BAR
    for (int eb = 0; eb < EXTRA_BAR; ++eb) xcd_barrier(bar);
#endif
    if (IN(9)) { ex::ln2_phase(F); }
#undef IN
#undef SEAM
}

#if DBG_STAGE > 0
constexpr int DBG_B = 5;
constexpr size_t DBG_BASE = 360 * MiB;
constexpr size_t DBG_ACC = 511 * MiB;
__device__ __forceinline__ float bf2f(bf16 v) { return __uint_as_float((unsigned)v << 16); }
__device__ __forceinline__ void dbg_acc(double* acc, int slot, float opt, float ref) {
    float d2 = (opt - ref) * (opt - ref), r2 = ref * ref;
    if (!(d2 == d2)) d2 = 1e30f;
    d2 = wave_sum(d2); r2 = wave_sum(r2);
    if ((threadIdx.x & 63) == 0) { atomicAdd(acc + 2 * slot, (double)d2); atomicAdd(acc + 2 * slot + 1, (double)r2); }
}
__global__ void __launch_bounds__(256) dbg_check_inproj(const float* __restrict__ proj, const unsigned char* __restrict__ ws, const float* __restrict__ cn, double* acc) {
    const int s = blockIdx.x, t = DBG_B * SEQ + s;
    const float* pr = proj + (size_t)s * IN_COLS;
    for (int j = threadIdx.x; j < 2304; j += 256) {
        float ref, opt; int slot;
        if (j < 1536) {
            const int which = j >> 9, hd = (j >> 6) & 7, d = j & 63;
            ref = pr[j];
            if (which == 0) { opt = bf2f(((const bf16*)(ws + WS_FQ))[(size_t)t * 512 + hd * 64 + d]) / C2; slot = 0; }
            else if (which == 1) { opt = bf2f(*(const bf16*)(ws + WS_FKT + EpiInProj::tile_off(8, t, hd) + (size_t)((d >> 3) * 64 + (t & 63)) * 16 + (d & 7) * 2)); slot = 1; }
            else { opt = bf2f(*(const bf16*)(ws + WS_FVT + EpiInProj::tile_off(8, t, hd) + (size_t)((d >> 5) * 4 + ((t & 63) >> 4)) * 1024 + (t & 15) * 64 + (d & 31) * 2)); slot = 2; }
        } else if (j < 2176) {
            const bool isq = j < 2048; const int r = isq ? j - 1536 : j - 2048, hd = r >> 6, d = r & 63, base = (isq ? OFF_SQ : OFF_SK) + hd * 64;
            float cs, sn; rope_cs(s, d & 31, cs, sn);
            ref = (d < 32) ? pr[base + d] * cs - pr[base + d + 32] * sn : pr[base + d] * cs + pr[base + d - 32] * sn;
            if (isq) { opt = bf2f(((const bf16*)(ws + WS_SQ))[(size_t)t * 512 + hd * 64 + d]) / C2; slot = 3; }
            else { opt = bf2f(*(const bf16*)(ws + WS_SKT + EpiInProj::tile_off(2, t, hd) + (size_t)((d >> 3) * 64 + (t & 63)) * 16 + (d & 7) * 2)); slot = 4; }
        } else {
            const int r = j - 2176, hd = r >> 6, d = r & 63;
            ref = pr[OFF_SV + r];
            opt = bf2f(*(const bf16*)(ws + WS_SVT + EpiInProj::tile_off(2, t, hd) + (size_t)((d >> 5) * 4 + ((t & 63) >> 4)) * 1024 + (t & 15) * 64 + (d & 31) * 2)); slot = 5;
        }
#pragma unroll
        for (int sl = 0; sl < 6; ++sl) dbg_acc(acc, sl, slot == sl ? opt : 0.f, slot == sl ? ref : 0.f);
    }
    if (threadIdx.x < 64) {
        const int h = threadIdx.x & 7;
        const float opt = (threadIdx.x < 8) ? ((const float*)(ws + WS_C))[(size_t)(DBG_B * 8 + h) * SEQ + s] : 0.f, ref = (threadIdx.x < 8) ? cn[(size_t)h * SEQ + s] : 0.f;
        dbg_acc(acc, 6, opt, ref);
    }
}
__global__ void __launch_bounds__(256) dbg_check_attn(const float* __restrict__ attn_n, const unsigned char* __restrict__ ws, double* acc) {
    const int s = blockIdx.x, t = DBG_B * SEQ + s;
    for (int j = threadIdx.x; j < 1024; j += 256) {
        const float ref = attn_n[(size_t)s * 1024 + j], opt = bf2f(((const bf16*)(ws + WS_ATTN))[(size_t)t * 1024 + j]);
        dbg_acc(acc, j >> 9, opt, ref);
    }
}
__global__ void __launch_bounds__(256) dbg_check_q(const float* __restrict__ qn, const float* __restrict__ x1n, const float* __restrict__ y, const float* __restrict__ g1, const float* __restrict__ b1, const unsigned char* __restrict__ ws, double* acc) {
    const int s = blockIdx.x, t = DBG_B * SEQ + s;
    for (int j = threadIdx.x; j < 2048; j += 256) dbg_acc(acc, 0, bf2f(((const bf16*)(ws + WS_Q))[(size_t)t * QCOLS + j]), qn[(size_t)s * QCOLS + j]);
    const float2 st = ln1_row_stats((const float2*)(ws + WS_STATS), t);
    for (int j = threadIdx.x; j < 1024; j += 256) dbg_acc(acc, 1, (y[(size_t)t * 1024 + j] - st.x) * st.y * g1[j] + b1[j], x1n[(size_t)s * 1024 + j]);
}
__global__ void __launch_bounds__(256) dbg_check_picks(const int* __restrict__ idxn, const float* __restrict__ gn, const unsigned char* __restrict__ ws, double* acc) {
    const int i = blockIdx.x * 256 + threadIdx.x;
    const int s = i >> 3, h = i & 7, t = DBG_B * SEQ + s;
    const int* io = (const int*)(ws + WS_IDX) + ((size_t)t * 8 + h) * 16; const float* go = (const float*)(ws + WS_G) + ((size_t)t * 8 + h) * 16;
    const int* in_ = idxn + ((size_t)s * 8 + h) * 16; const float* gn_ = gn + ((size_t)s * 8 + h) * 16;
    float miss = 0.f, d2 = 0.f, r2 = 0.f;
    for (int a = 0; a < 16; ++a) { const int e = in_[a]; bool found = false;
        for (int b = 0; b < 16; ++b) if (io[b] == e) { found = true; d2 += (go[b] - gn_[a]) * (go[b] - gn_[a]); r2 += gn_[a] * gn_[a]; }
        if (!found) miss += 1.f; }
    miss = wave_sum(miss); d2 = wave_sum(d2); r2 = wave_sum(r2);
    if ((threadIdx.x & 63) == 0) { atomicAdd(acc + 0, (double)miss); atomicAdd(acc + 1, 16.0 * 64.0); atomicAdd(acc + 2, (double)d2); atomicAdd(acc + 3, (double)r2); }
}
__global__ void dbg_code_picks(const double* acc, float* code) {
    if (threadIdx.x != 0 || blockIdx.x != 0) return;
    const float frac = (float)(acc[0] / acc[1]), gerr = (float)sqrt(acc[2] / acc[3]);
    *code = 10.f * frac + (gerr > 0.05f ? 100.f : 0.f) + (frac != frac ? 1000.f : 0.f);
}
__global__ void dbg_code(const double* acc, float* code, int nslots) {
    if (threadIdx.x != 0 || blockIdx.x != 0) return;
    float worst = 0.f; int mask = 0;
    for (int i = 0; i < nslots; ++i) { const double r = acc[2 * i + 1] > 0 ? sqrt(acc[2 * i] / acc[2 * i + 1]) : 99.0; if (r > 0.02) mask |= 1 << i; if ((float)r > worst) worst = (float)r; }
    *code = mask ? (float)mask : worst * 10.f;
}
__global__ void dbg_scale(float* out, const float* code, int n) { const int i = blockIdx.x * blockDim.x + threadIdx.x; if (i < n) out[i] *= (1.f + *code); }

static void launch_naive(const float* const* in, float* out, char* ws, int b0, int nb, hipStream_t stream, float** proj_o, float** c_o, float** x1_o, int** idx_o, float** g_o, float* attn_tmp) {
    const int Tn = nb * SEQ;
    float* proj = (float*)ws; size_t off = (size_t)Tn * IN_COLS * 4; off = (off + 255) & ~(size_t)255;
    float* cbuf = (float*)(ws + off); off += (size_t)nb * FOX_H * SEQ * 4;
    float* x1 = (float*)(ws + off); off += (size_t)Tn * D_MODEL * 4;
    int* idx = (int*)(ws + off); off += (size_t)Tn * 128 * 4;
    float* gbuf = (float*)(ws + off); off += (size_t)Tn * 128 * 4;
    const float* x = in[0] + (size_t)b0 * SEQ * D_MODEL;
    float* attn = attn_tmp ? attn_tmp : out + (size_t)b0 * SEQ * D_MODEL;
    nv_gemm<<<dim3((IN_COLS + 127) / 128, Tn / 128), 256, 0, stream>>>(x, D_MODEL, in[1], IN_COLS, proj, IN_COLS, Tn, IN_COLS, D_MODEL);
    nv_forget_cumsum<<<1, 64, 0, stream>>>(proj, in[2], cbuf, nb);
    nv_fox<<<dim3(SEQ / 64, FOX_H, nb), 64, 0, stream>>>(proj, cbuf, attn);
    nv_swa<<<dim3(SEQ / 64, SWA_H, nb), 64, 0, stream>>>(proj, in[3], attn);
    nv_gemm<<<dim3(D_MODEL / 128, Tn / 128), 256, 0, stream>>>(attn, D_MODEL, in[4], D_MODEL, x1, D_MODEL, Tn, D_MODEL, D_MODEL);
    nv_ln_res<<<Tn / 4, 256, 0, stream>>>(x, x1, in[5], in[6], x1, Tn);
    float* q = proj;
    if (proj_o) {
        *proj_o = proj; *c_o = cbuf; *x1_o = x1; *idx_o = idx; *g_o = gbuf;
        q = attn_tmp + (size_t)Tn * D_MODEL + (1u << 18);
        nv_gemm<<<dim3(QCOLS / 128, Tn / 128), 256, 0, stream>>>(x1, D_MODEL, in[7], QCOLS, q, QCOLS, Tn, QCOLS, D_MODEL);
        nv_peer_topk<<<dim3(Tn / 64, PEER_H), 64, 0, stream>>>(q, in[8], idx, gbuf);
        return;
    }
    nv_gemm<<<dim3(QCOLS / 128, Tn / 128), 256, 0, stream>>>(x1, D_MODEL, in[7], QCOLS, q, QCOLS, Tn, QCOLS, D_MODEL);
    nv_peer_topk<<<dim3(Tn / 64, PEER_H), 64, 0, stream>>>(q, in[8], idx, gbuf);
    nv_peer_expert<<<Tn / 4, 256, 0, stream>>>(x1, idx, gbuf, in[9], in[10], in[11], in[12], out + (size_t)b0 * SEQ * D_MODEL, Tn);
}
#endif

extern "C" void kernel_launch(void* const* d_in, const int* in_sizes, int n_in, void* d_out, int out_size, void* d_ws, size_t ws_size, hipStream_t stream) {
    static int grid = 0;
    if (grid == 0) {
        if (n_in != 13 || out_size != T * D_MODEL || ws_size < 512 * MiB) { fprintf(stderr, "kernel_launch: unexpected shapes / workspace (%d inputs, out %d, ws %zu)\n", n_in, out_size, ws_size); grid = -1; return; }
        int dev = 0, cus = 0, per_cu = 0;
        if (hipGetDevice(&dev) != hipSuccess || hipDeviceGetAttribute(&cus, hipDeviceAttributeMultiprocessorCount, dev) != hipSuccess) { grid = -1; return; }
        if (hipFuncSetAttribute((const void*)mk_fwd, hipFuncAttributeMaxDynamicSharedMemorySize, LDS_BYTES) != hipSuccess) { fprintf(stderr, "kernel_launch: hipFuncSetAttribute failed\n"); grid = -1; return; }
        if (hipOccupancyMaxActiveBlocksPerMultiprocessor(&per_cu, (const void*)mk_fwd, NWAVES * 64, LDS_BYTES) != hipSuccess || per_cu < 1) { fprintf(stderr, "kernel_launch: occupancy query says %d blocks per CU\n", per_cu); (void)hipGetLastError(); grid = -1; return; }
        grid = cus;
    }
    if (grid < 0) return;
    const float* in[13]; for (int i = 0; i < 13; ++i) in[i] = (const float*)d_in[i];
    (void)hipMemsetAsync((char*)d_ws + WS_CTL, 0, CTL_ZERO_BYTES, stream);
    Args a{};
    for (int i = 0; i < 13; ++i) a.in[i] = in[i];
    a.out = (float*)d_out; a.ws = (unsigned char*)d_ws;
#if DBG_STAGE == 0 && defined(TIME_LO)
    a.ph_lo = 0; a.ph_hi = TIME_HI;
    { void* k1[] = {&a}; (void)hipLaunchCooperativeKernel((const void*)mk_fwd, dim3(grid), dim3(NWAVES * 64), k1, LDS_BYTES, stream); }
    (void)hipMemsetAsync((char*)d_ws + WS_CTL, 0, CTL_ZERO_BYTES, stream);
    a.ph_lo = TIME_LO; a.ph_hi = N_PHASES;
#elif DBG_STAGE == 0
    a.ph_lo = 0; a.ph_hi = N_PHASES;
#else
    a.ph_lo = 0; a.ph_hi = DBG_STAGE + 1;
#endif
    void* kargs[] = {&a};
    hipError_t le = hipLaunchCooperativeKernel((const void*)mk_fwd, dim3(grid), dim3(NWAVES * 64), kargs, LDS_BYTES, stream);
    if (le != hipSuccess) fprintf(stderr, "kernel_launch: cooperative launch failed: %s (grid %d)\n", hipGetErrorName(le), grid);
#if DBG_STAGE > 0
    char* ws = (char*)d_ws;
    double* acc = (double*)(ws + DBG_ACC); float* code = (float*)(ws + DBG_ACC + 512);
    (void)hipMemsetAsync(acc, 0, 1024, stream);
    float *proj, *cn, *x1n, *gn; int* idxn;
    launch_naive(in, (float*)d_out, ws + DBG_BASE, DBG_B, 1, stream, &proj, &cn, &x1n, &idxn, &gn, (float*)(ws + DBG_BASE + 100 * MiB));
#if DBG_STAGE == 1
    dbg_check_inproj<<<SEQ, 256, 0, stream>>>(proj, (const unsigned char*)d_ws, cn, acc);
    dbg_code<<<1, 1, 0, stream>>>(acc, code, 7);
#elif DBG_STAGE == 4
    dbg_check_q<<<SEQ, 256, 0, stream>>>((const float*)(ws + DBG_BASE + 100 * MiB) + (size_t)SEQ * D_MODEL + (1u << 18), x1n, (const float*)d_out, in[5], in[6], (const unsigned char*)d_ws, acc);
    dbg_code<<<1, 1, 0, stream>>>(acc, code, 2);
#elif DBG_STAGE == 5
    dbg_check_picks<<<SEQ * 8 / 256, 256, 0, stream>>>(idxn, gn, (const unsigned char*)d_ws, acc);
    dbg_code_picks<<<1, 1, 0, stream>>>(acc, code);
#elif DBG_STAGE == 2
    dbg_check_attn<<<SEQ, 256, 0, stream>>>((const float*)(ws + DBG_BASE + 100 * MiB), (const unsigned char*)d_ws, acc);
    dbg_code<<<1, 1, 0, stream>>>(acc, code, 2);
#endif
    launch_naive(in, (float*)d_out, ws, 0, BATCH, stream, nullptr, nullptr, nullptr, nullptr, nullptr, nullptr);
    dbg_scale<<<(T * D_MODEL + 255) / 256, 256, 0, stream>>>((float*)d_out, code, T * D_MODEL);
#endif
}
```

```cpp
#include <hip/hip_runtime.h>
#include <hip/hip_bf16.h>
#include <hip/hip_cooperative_groups.h>
#include <cstdint>
#include <cstdio>
#include <cmath>

#ifndef DBG_STAGE
#define DBG_STAGE 0
#endif

namespace cfg {
constexpr int D_MODEL = 1024, BATCH = 8, SEQ = 4096, T = BATCH * SEQ;
constexpr int HD = 64, FOX_H = 8, SWA_H = 8, SWA_KVH = 2;
constexpr int OFF_FQ = 0, OFF_FK = 512, OFF_FV = 1024, OFF_FF = 1536, OFF_SQ = 1544, OFF_SK = 2056, OFF_SV = 2184, IN_COLS = 2312;
constexpr int NPHYS = 2304;
constexpr int WINDOW = 128;
constexpr int PEER_H = 8, NKEYS = 128, PEER_HALF = 128, TOPK = 16, QCOLS = 2048, NEXP = 16384;
constexpr float LN_EPS = 1e-5f;
constexpr float ALPHA = 1.189207115002721f;
constexpr float LOG2E = 1.4426950408889634f;
constexpr float C2 = 0.125f * LOG2E;
}
using namespace cfg;

namespace pg8 {
#define PG8_LAS __attribute__((address_space(3)))
typedef unsigned short bf16_t;
typedef short bf16x8 __attribute__((ext_vector_type(8)));
typedef float f32x4 __attribute__((ext_vector_type(4)));
typedef unsigned u32x4 __attribute__((ext_vector_type(4)));
constexpr int BM = 256, BK = 64, HALF = 128, HTB = HALF * BK * 2  , STAGE_BYTES = 8 * HTB, NXCD = 8, WGM = 8;

__host__ __device__ __forceinline__ int lds_byte(int r, int c) { const int st = (r >> 4) * 2 + (c >> 5), rr = r & 15, cc = c & 31, ob = rr * 64 + cc * 2; return st * 1024 + (ob ^ (((ob >> 9) & 1) << 5)); }
__host__ __device__ __forceinline__ void stage_rc(int b, int& R, int& C) { const int st = b / 1024, sb = b % 1024, swz = sb ^ (((sb >> 9) & 1) << 5); R = (st >> 1) * 16 + swz / 64; C = (st & 1) * 32 + (swz % 64) / 2; }
__host__ __device__ __forceinline__ int perm32(int rho) { const int n = rho >> 4, i = rho & 15; return 8 * (i >> 2) + 4 * n + (i & 3); }

struct Unit { int pm, pn; };
struct Gemm { const bf16_t* A; const bf16_t* Bt; int M, N, K; };

struct StaticOrder {
    int nM, nN, nwg, G, c;
    __host__ __device__ void init(int M, int N, int G_, int c_) { nM = M / BM; nN = N / BM; nwg = nM * nN; G = G_; c = c_; }
    __host__ __device__ bool next(int i, Unit& u) const {
        const long L = (long)i * G + c; if (L >= nwg) return false;
        int wgid = (int)L; { const int q = nwg / NXCD, r = nwg % NXCD, xcd = wgid % NXCD, off = wgid / NXCD; wgid = (xcd < r ? xcd * (q + 1) : r * (q + 1) + (xcd - r) * q) + off; }
        const int nig = WGM * nN, gid = wgid / nig, fm = gid * WGM, gsz = (nM - fm) < WGM ? (nM - fm) : WGM;
        u.pm = fm + ((wgid % nig) % gsz); u.pn = (wgid % nig) / gsz; return true;
    }
    __device__ __forceinline__ void a_ready(const Unit&) const {}
    __device__ __forceinline__ void done(const Unit&) const {}
};
__device__ __forceinline__ unsigned cvt_pk_bf16(float lo, float hi) { unsigned r; asm volatile("v_cvt_pk_bf16_f32 %0, %1, %2" : "=v"(r) : "v"(lo), "v"(hi)); return r; }
typedef float f32x2 __attribute__((ext_vector_type(2)));
template <bool I8> __device__ __forceinline__ f32x4 pg8_mma(bf16x8 a, bf16x8 b, f32x4 c) {
    if constexpr (I8) { typedef int v4i_ __attribute__((ext_vector_type(4)));
        return __builtin_bit_cast(f32x4, __builtin_amdgcn_mfma_i32_16x16x64_i8(__builtin_bit_cast(v4i_, a), __builtin_bit_cast(v4i_, b), __builtin_bit_cast(v4i_, c), 0, 0, 0)); }
    else return __builtin_amdgcn_mfma_f32_16x16x32_bf16(a, b, c, 0, 0, 0);
}
template <class Epi, class Sched, bool ALIGN_EPI = false, bool SP2 = false, bool I8 = false>
__device__ __forceinline__ void gemm_phase(PG8_LAS unsigned char* lds, const Gemm g, const Sched& S, const Epi& E) {
    const int tid = threadIdx.x, wid = __builtin_amdgcn_readfirstlane(tid >> 6), lane = tid & 63, wr = wid >> 2, wc = wid & 3, fr = lane & 15, fq = lane >> 4;
    const int K = g.K, nt = K / BK;
    unsigned voffA[2], voffB[2];
#pragma unroll
    for (int i = 0; i < 2; ++i) { int R, C; stage_rc(tid * 16 + i * 8192, R, C); const int Rb = Epi::PERM ? ((R & ~31) + perm32(R & 31)) : R;
        voffA[i] = (unsigned)(R * K + C) * 2u; voffB[i] = (unsigned)(Rb * K + C) * 2u; }
    const size_t kstep = (size_t)(BK * 2);
    const size_t hstep = (size_t)HALF * K * 2;
    const size_t tstep = 2 * hstep;
    const unsigned ldsw = (unsigned)wid * 1024u;
    const int aoff = lds_byte(wr * 64 + fr, fq * 8), boff = lds_byte(wc * 32 + fr, fq * 8);
#define PG8_SA(b, h) (((b) * 2 + (h)) * HTB)
#define PG8_SB(b, h) ((4 + (b) * 2 + (h)) * HTB)
#define PG8_STAGE(bufoff, gbase, voff) do { _Pragma("unroll") for (int _i = 0; _i < 2; ++_i) \
        __builtin_amdgcn_global_load_lds((const unsigned*)((const char*)(gbase) + (voff)[_i]), (PG8_LAS unsigned*)(lds + (bufoff) + ldsw + _i * 8192), 16, 0, 0); } while (0)
#define PG8_LDA(dst, b, h) do { _Pragma("unroll") for (int m = 0; m < 4; ++m) _Pragma("unroll") for (int k = 0; k < 2; ++k) dst[m][k] = *(const PG8_LAS bf16x8*)(lds + PG8_SA(b, h) + aoff + m * 2048 + k * 1024); } while (0)
#define PG8_LDB(dst, b, h) do { _Pragma("unroll") for (int n = 0; n < 2; ++n) _Pragma("unroll") for (int k = 0; k < 2; ++k) dst[n][k] = *(const PG8_LAS bf16x8*)(lds + PG8_SB(b, h) + boff + n * 2048 + k * 1024); } while (0)
#define PG8_MMA(ai, bj, At, Bt) do { __builtin_amdgcn_s_setprio(1); _Pragma("unroll") for (int m = 0; m < 4; ++m) _Pragma("unroll") for (int n = 0; n < 2; ++n) _Pragma("unroll") for (int k = 0; k < 2; ++k) \
        acc[ai][bj][m][n] = pg8_mma<I8>(Bt[n][k], At[m][k], acc[ai][bj][m][n]); __builtin_amdgcn_s_setprio(0); } while (0)
#define PG8_WAIT_V(n) asm volatile("s_waitcnt vmcnt(" #n ")" ::: "memory")
#define PG8_WAIT_L(n) asm volatile("s_waitcnt lgkmcnt(" #n ")" ::: "memory")
#define PG8_BAR __builtin_amdgcn_s_barrier()
#define PG8_SCHED __builtin_amdgcn_sched_barrier(0)
    Unit cur, nxt; int ui = 0;
    if (!S.next(0, cur)) return;
    f32x4 acc[2][2][4][2];
#pragma unroll
    for (int a = 0; a < 2; ++a)
#pragma unroll
        for (int b = 0; b < 2; ++b)
#pragma unroll
            for (int m = 0; m < 4; ++m)
#pragma unroll
                for (int n = 0; n < 2; ++n) acc[a][b][m][n] = (f32x4){0.f, 0.f, 0.f, 0.f};
    bf16x8 At[4][2], B0[2][2], B1[2][2];
    const char* cA = (const char*)g.A + (size_t)cur.pm * tstep; const char* cB = (const char*)g.Bt + (size_t)cur.pn * tstep;
    S.a_ready(cur);
    if constexpr (SP2) {
        PG8_STAGE(PG8_SB(0, 0), cB, voffB); PG8_STAGE(PG8_SB(0, 1), cB + hstep, voffB); PG8_STAGE(PG8_SA(0, 0), cA, voffA); PG8_STAGE(PG8_SA(0, 1), cA + hstep, voffA);
        if (wr == 1) PG8_BAR;
        PG8_WAIT_V(2); PG8_BAR;
        PG8_STAGE(PG8_SB(1, 0), cB + kstep, voffB); PG8_STAGE(PG8_SA(1, 0), cA + kstep, voffA); PG8_STAGE(PG8_SB(1, 1), cB + hstep + kstep, voffB);
        PG8_WAIT_V(6); PG8_BAR;
    } else {
        PG8_STAGE(PG8_SB(0, 0), cB, voffB); PG8_STAGE(PG8_SA(0, 0), cA, voffA); PG8_STAGE(PG8_SB(0, 1), cB + hstep, voffB); PG8_STAGE(PG8_SA(0, 1), cA + hstep, voffA);
        if (wr == 1) PG8_BAR;
        PG8_WAIT_V(4); PG8_BAR;
        PG8_STAGE(PG8_SB(1, 0), cB + kstep, voffB); PG8_STAGE(PG8_SA(1, 0), cA + kstep, voffA); PG8_STAGE(PG8_SB(1, 1), cB + hstep + kstep, voffB);
        PG8_WAIT_V(6); PG8_BAR;
    }
    for (;;) {
        const bool has_next = S.next(ui + 1, nxt);
        const char* nA = has_next ? (const char*)g.A + (size_t)nxt.pm * tstep : cA; const char* nB = has_next ? (const char*)g.Bt + (size_t)nxt.pn * tstep : cB;
        for (int t = 0; t < nt; t += 2) {
            const bool last = (t == nt - 2);
            const char* a1 = cA + (size_t)(t + 1) * kstep;
            const char* a2 = last ? nA : cA + (size_t)(t + 2) * kstep; const char* b2 = last ? nB : cB + (size_t)(t + 2) * kstep;
            const char* a3 = a2 + kstep; const char* b3 = b2 + kstep;
            if (last && has_next) S.a_ready(nxt);
            if constexpr (SP2) {
            PG8_LDB(B0, 0, 0); PG8_LDB(B1, 0, 1); PG8_SCHED; PG8_LDA(At, 0, 0); PG8_STAGE(PG8_SA(1, 1), a1 + hstep, voffA);
            PG8_WAIT_V(8); PG8_WAIT_L(0); PG8_BAR; PG8_MMA(0, 0, At, B0); PG8_MMA(0, 1, At, B1); PG8_BAR; PG8_SCHED;
            PG8_LDA(At, 0, 1); PG8_STAGE(PG8_SB(0, 0), b2, voffB); PG8_STAGE(PG8_SB(0, 1), b2 + hstep, voffB); PG8_STAGE(PG8_SA(0, 0), a2, voffA);
            PG8_WAIT_V(8); PG8_WAIT_L(0); PG8_BAR; PG8_MMA(1, 0, At, B0); PG8_MMA(1, 1, At, B1); PG8_BAR; PG8_SCHED;
            PG8_LDB(B0, 1, 0); PG8_LDB(B1, 1, 1); PG8_SCHED; PG8_LDA(At, 1, 0); PG8_STAGE(PG8_SA(0, 1), a2 + hstep, voffA);
            PG8_WAIT_V(8); PG8_WAIT_L(0); PG8_BAR; PG8_MMA(0, 0, At, B0); PG8_MMA(0, 1, At, B1); PG8_BAR; PG8_SCHED;
            PG8_LDA(At, 1, 1); PG8_STAGE(PG8_SB(1, 0), b3, voffB); PG8_STAGE(PG8_SB(1, 1), b3 + hstep, voffB); PG8_STAGE(PG8_SA(1, 0), a3, voffA);
            PG8_WAIT_V(8); PG8_WAIT_L(0); PG8_BAR; PG8_MMA(1, 0, At, B0); PG8_MMA(1, 1, At, B1); PG8_BAR; PG8_SCHED;
            } else {
            PG8_LDB(B0, 0, 0); PG8_SCHED; PG8_LDA(At, 0, 0); PG8_STAGE(PG8_SA(1, 1), a1 + hstep, voffA);
            PG8_WAIT_L(8); PG8_BAR; PG8_WAIT_L(0); PG8_MMA(0, 0, At, B0); PG8_BAR; PG8_SCHED;
            PG8_LDB(B1, 0, 1); PG8_STAGE(PG8_SB(0, 0), b2, voffB);
            PG8_BAR; PG8_WAIT_L(0); PG8_MMA(0, 1, At, B1); PG8_BAR;
            PG8_LDA(At, 0, 1); PG8_STAGE(PG8_SA(0, 0), a2, voffA);
            PG8_BAR; PG8_WAIT_L(0); PG8_MMA(1, 0, At, B0); PG8_BAR; PG8_SCHED;
            PG8_STAGE(PG8_SB(0, 1), b2 + hstep, voffB);
            PG8_WAIT_V(6); PG8_BAR; PG8_MMA(1, 1, At, B1); PG8_BAR;
            PG8_LDB(B0, 1, 0); PG8_SCHED; PG8_LDA(At, 1, 0); PG8_STAGE(PG8_SA(0, 1), a2 + hstep, voffA);
            PG8_WAIT_L(8); PG8_BAR; PG8_WAIT_L(0); PG8_MMA(0, 0, At, B0); PG8_BAR; PG8_SCHED;
            PG8_LDB(B1, 1, 1); PG8_STAGE(PG8_SB(1, 0), b3, voffB);
            PG8_BAR; PG8_WAIT_L(0); PG8_MMA(0, 1, At, B1); PG8_BAR;
            PG8_LDA(At, 1, 1); PG8_STAGE(PG8_SA(1, 0), a3, voffA);
            PG8_BAR; PG8_WAIT_L(0); PG8_MMA(1, 0, At, B0); PG8_BAR; PG8_SCHED;
            PG8_STAGE(PG8_SB(1, 1), b3 + hstep, voffB);
            PG8_WAIT_V(6); PG8_BAR; PG8_MMA(1, 1, At, B1); PG8_BAR;
            }
        }
        if constexpr (ALIGN_EPI) { if (wr == 0) PG8_BAR; }
        if constexpr (!Epi::AFTER_DRAIN) { E(acc, cur, wr, wc, fr, fq); S.done(cur); }
        if (!has_next) break;
#pragma unroll
        for (int a = 0; a < 2; ++a)
#pragma unroll
            for (int b = 0; b < 2; ++b)
#pragma unroll
                for (int m = 0; m < 4; ++m)
#pragma unroll
                    for (int n = 0; n < 2; ++n) acc[a][b][m][n] = (f32x4){0.f, 0.f, 0.f, 0.f};
        cur = nxt; cA = nA; cB = nB; ++ui;
        if constexpr (ALIGN_EPI) { if (wr == 1) PG8_BAR; }
    }
    PG8_WAIT_V(0);
    if constexpr (!ALIGN_EPI) { if (wr == 0) PG8_BAR; }
    PG8_BAR;
    if constexpr (Epi::AFTER_DRAIN) { E.fused(acc, cur, wr, wc, fr, fq, lds, wid, lane); S.done(cur); }
#undef PG8_SA
#undef PG8_SB
#undef PG8_STAGE
#undef PG8_LDA
#undef PG8_LDB
#undef PG8_MMA
#undef PG8_WAIT_V
#undef PG8_WAIT_L
#undef PG8_BAR
#undef PG8_SCHED
}
}
#define GAS __attribute__((address_space(1)))
#define LAS __attribute__((address_space(3)))
typedef unsigned short bf16;
typedef unsigned v4u __attribute__((ext_vector_type(4)));
typedef float f32x4 __attribute__((ext_vector_type(4)));
typedef short bf16x8 __attribute__((ext_vector_type(8)));
typedef GAS unsigned gu32;
typedef GAS unsigned long long gu64;
#define RLX_AGENT __ATOMIC_RELAXED, __HIP_MEMORY_SCOPE_AGENT
#define LDS_WAIT() asm volatile("s_waitcnt lgkmcnt(0)" ::: "memory")
#define VM_WAIT() asm volatile("s_waitcnt vmcnt(0)" ::: "memory")
__device__ __forceinline__ unsigned long long rt() { return __builtin_amdgcn_s_memrealtime(); }
__device__ __forceinline__ unsigned f2bf(float f) { unsigned u = __builtin_bit_cast(unsigned, f); return (u + 0x7fffu + ((u >> 16) & 1u)) >> 16; }
__device__ __forceinline__ unsigned pk2(float lo, float hi) { return f2bf(lo) | (f2bf(hi) << 16); }
#define XB_TMO      128
#define XB_XCNT(j)  (256  + 64 * (j))
#define XB_XSUB(j)  (1280 + 64 * (j))
#define XB_XGEN(j)  (2304 + 64 * (j))
#define XB_TOP      3328
#define XB_TOPGEN   3392
#define XCD_BAR_WORDS 3456
#define XB_SPIN_CAP (1u << 18)

__device__ __forceinline__ unsigned xb_ld(unsigned* p)              { return __hip_atomic_load(p, __ATOMIC_RELAXED, __HIP_MEMORY_SCOPE_AGENT); }
__device__ __forceinline__ unsigned xb_add(unsigned* p, unsigned v) { return __hip_atomic_fetch_add(p, v, __ATOMIC_RELAXED, __HIP_MEMORY_SCOPE_AGENT); }
__device__ __forceinline__ unsigned xb_xcc_id() { return (unsigned)__builtin_amdgcn_s_getreg((3 << 11) | 20) & 0xFu; }
#define XB_SPIN(cond, bar) do { unsigned _sp = 0; while (cond) { __builtin_amdgcn_s_sleep(1); \
    if ((++_sp & 255u) == 0u) { if (xb_ld(&(bar)[XB_TMO])) break; if (_sp > XB_SPIN_CAP) { atomicAdd(&(bar)[XB_TMO], 1u); break; } } } } while (0)

struct XcdBarrier {
    unsigned* bar; unsigned x;
    volatile LAS unsigned* st;
};

__device__ __forceinline__ XcdBarrier xcd_barrier_post(unsigned* bar, volatile LAS unsigned* st) {
    XcdBarrier b; b.bar = bar; b.x = xb_xcc_id(); b.st = st;
    if (threadIdx.x == 0) (void)xb_add(&bar[XB_XCNT(b.x)], 1u);
    return b;
}
__device__ __forceinline__ void xcd_barrier_complete(unsigned* bar, unsigned x, unsigned& nloc, unsigned& nx) {
    const unsigned G = gridDim.x * gridDim.y * gridDim.z;
    unsigned sum, cnt, mine, sp = 0u;
    for (;;) {
        sum = 0u; cnt = 0u; mine = 0u;
#pragma unroll
        for (unsigned j = 0; j < 16; ++j) { const unsigned c = xb_ld(&bar[XB_XCNT(j)]); sum += c; cnt += (c > 0u) ? 1u : 0u; mine = (j == x) ? c : mine; }
        if (sum == G) break;
        __builtin_amdgcn_s_sleep(1);
        if ((++sp & 255u) == 0u) { if (xb_ld(&bar[XB_TMO])) break; if (sp > XB_SPIN_CAP) { atomicAdd(&bar[XB_TMO], 1u); break; } }
    }
    nloc = mine > 0u ? mine : 1u; nx = cnt > 0u ? cnt : 1u;
}

__device__ __forceinline__ void xcd_barrier(const XcdBarrier& b) {
    asm volatile("s_waitcnt vmcnt(0)" ::: "memory");
    __syncthreads();
    if (threadIdx.x == 0) {
        unsigned* bar = b.bar;
        __builtin_amdgcn_s_waitcnt(0);
        unsigned nloc = b.st[0], nx = b.st[1];
        if (nloc == 0u) { xcd_barrier_complete(bar, b.x, nloc, nx); b.st[0] = nloc; b.st[1] = nx; }
        const unsigned old = xb_add(&bar[XB_XSUB(b.x)], 1u);
        const unsigned gen = old / nloc;
        if (old + 1u == (gen + 1u) * nloc) {
            __builtin_amdgcn_fence(__ATOMIC_RELEASE, "agent");
            asm volatile("s_waitcnt vmcnt(0)" ::: "memory");
            const unsigned og = xb_add(&bar[XB_TOP], 1u);
            const unsigned tg = og / nx;
            if (og + 1u == (tg + 1u) * nx) xb_add(&bar[XB_TOPGEN], 1u);
            else XB_SPIN(xb_ld(&bar[XB_TOPGEN]) == tg, bar);
            __builtin_amdgcn_fence(__ATOMIC_ACQUIRE, "agent");
            xb_add(&bar[XB_XGEN(b.x)], 1u);
            asm volatile("s_waitcnt vmcnt(0)" ::: "memory");
        } else {
            XB_SPIN(xb_ld(&bar[XB_XGEN(b.x)]) == gen, bar);
            __builtin_amdgcn_fence(__ATOMIC_ACQUIRE, "agent");
            asm volatile("s_waitcnt vmcnt(0)" ::: "memory");
        }
    }
    __syncthreads();
}

constexpr size_t MiB = 1u << 20;
constexpr size_t WS_CTL = 0, CTL_ZERO_BYTES = 64 * 1024;
constexpr size_t WS_GW = 1 * MiB;
constexpr size_t WS_ROPE = 2 * MiB;
constexpr size_t WS_LF = 3 * MiB;
constexpr size_t WS_C = 4 * MiB;
constexpr size_t WS_QN2 = 5 * MiB, WS_KN2 = 5 * MiB + 64 * 1024;
constexpr size_t WS_STATS = 6 * MiB;
constexpr size_t WS_WIN = 10 * MiB;
constexpr size_t WS_WOUT = 15 * MiB;
constexpr size_t WS_WQ = 17 * MiB;
constexpr size_t WS_SUBK = 21 * MiB;
constexpr size_t WS_EU = 22 * MiB, WS_EV = 54 * MiB;
constexpr size_t WS_XB = 86 * MiB;
constexpr size_t WS_FQ = 150 * MiB, WS_FKT = 182 * MiB, WS_FVT = 214 * MiB, WS_SQ = 246 * MiB, WS_SKT = 278 * MiB, WS_SVT = 286 * MiB;
constexpr size_t WS_Q = 150 * MiB;
constexpr size_t WS_ATTN = 294 * MiB;
constexpr size_t WS_IDX = 294 * MiB, WS_G = 310 * MiB;
constexpr size_t WS_END = 358 * MiB;
constexpr size_t WS_MR = 5 * MiB + 128 * 1024;
constexpr size_t WS_STATS2 = 10 * MiB;
constexpr size_t WS_X1B = 86 * MiB;
constexpr size_t WS_HP = 150 * MiB;
constexpr size_t WS_V2 = 214 * MiB;
constexpr size_t EXP_SLICE_BYTES = (size_t)NEXP * 128;
constexpr float U_QS = 768.f, X_QS = 20.f, SQ_V = 40.f;
constexpr size_t WS_XQ = 326 * MiB;
constexpr float SQ_X = 24.f, SQ_A = 24.f, SQ_WIN = 768.f, SQ_WOUT = 1280.f;
constexpr size_t WS_W16 = 358 * MiB;
constexpr size_t WS_X1Q = 326 * MiB;
constexpr int CW_QU = 8192, CW_QV = 8192 + 1024;
constexpr int EXP_SPLIT = 16384;
constexpr int CW_BAR = 1024;
static_assert((CW_BAR + XCD_BAR_WORDS) * 4 <= (int)CTL_ZERO_BYTES, "ctl");

constexpr int NWAVES = 8;
constexpr int RING_BYTES = 131072, MISC_OFF = RING_BYTES + 320, LDS_BYTES = 147456;

struct Frame {
    LAS unsigned char* lds;
    volatile LAS unsigned* MISC;
    gu32* ctl;
    int tid, lane, wave, vcu, G;
    const float* in[13]; float* out; unsigned char* ws;
};

__device__ __forceinline__ float wave_sum(float v) {
#pragma unroll
    for (int o = 1; o < 64; o <<= 1) v += __shfl_xor(v, o);
    return v;
}
__device__ __forceinline__ float wave_max(float v) {
#pragma unroll
    for (int o = 1; o < 64; o <<= 1) v = fmaxf(v, __shfl_xor(v, o));
    return v;
}

typedef unsigned u32x2 __attribute__((ext_vector_type(2)));
__device__ __forceinline__ unsigned q8x4(float a, float b, float c, float d_) {
    const int ia = (int)fminf(fmaxf(rintf(a), -127.f), 127.f), ib = (int)fminf(fmaxf(rintf(b), -127.f), 127.f), ic = (int)fminf(fmaxf(rintf(c), -127.f), 127.f), id = (int)fminf(fmaxf(rintf(d_), -127.f), 127.f);
    return ((unsigned)ia & 0xFFu) | (((unsigned)ib & 0xFFu) << 8) | (((unsigned)ic & 0xFFu) << 16) | ((unsigned)id << 24);
}
__device__ __forceinline__ int win_src_col(int pc) {
    if (pc < 1536) return pc;
    int r, base;
    if (pc < 2048) { r = pc - 1536; base = OFF_SQ; }
    else if (pc < 2176) { r = pc - 2048; base = OFF_SK; }
    else return OFF_SV + (pc - 2176);
    const int hd = r >> 6, p = r & 63;
    const int g = p >> 5, fq = (p >> 3) & 3, n = (p >> 2) & 1, e = p & 3;
    return base + hd * 64 + 16 * g + 4 * fq + e + 32 * n;
}
template <bool I8, class SrcCol, class Scale>
__device__ __forceinline__ void p0_transpose_item(const float* W, int ldw, int K, bf16* WT, LAS float* scr, int nblk, int item, int lane, SrcCol sc, Scale sk) {
    const int kb = item / nblk, nb = item % nblk, k0 = 64 * kb, n0 = 32 * nb;
    const int scol = sc(n0 + (lane & 31));
#pragma unroll 8
    for (int i = 0; i < 32; ++i) { const int kk = 2 * i + (lane >> 5); scr[kk * 33 + (lane & 31)] = W[(size_t)(k0 + kk) * ldw + scol] * sk(k0 + kk); }
    LDS_WAIT(); asm volatile("" ::: "memory");
    const int c = lane & 7;
#pragma unroll
    for (int j = 0; j < 4; ++j) { const int n = (lane >> 3) + 8 * j; const LAS float* s = scr + (8 * c) * 33 + n;
        if constexpr (I8) { u32x2 o; o.x = q8x4(s[0 * 33], s[1 * 33], s[2 * 33], s[3 * 33]); o.y = q8x4(s[4 * 33], s[5 * 33], s[6 * 33], s[7 * 33]);
            *(GAS u32x2*)((unsigned char*)WT + (size_t)(n0 + n) * K + k0 + 8 * c) = o; }
        else { v4u o; o.x = pk2(s[0 * 33], s[1 * 33]); o.y = pk2(s[2 * 33], s[3 * 33]); o.z = pk2(s[4 * 33], s[5 * 33]); o.w = pk2(s[6 * 33], s[7 * 33]);
            *(GAS v4u*)(WT + (size_t)(n0 + n) * K + k0 + 8 * c) = o; } }
    LDS_WAIT(); asm volatile("" ::: "memory");
}
__device__ __forceinline__ float log_sigmoid(float z) { return fminf(z, 0.f) - log1pf(__expf(-fabsf(z))); }

__device__ __forceinline__ void p0_prologue(Frame& F) {
    LAS float* scr = (LAS float*)(F.lds + F.wave * 16384);
    const int gw = F.vcu * NWAVES + F.wave, NGW = F.G * NWAVES, lane = F.lane;
    const float* x = F.in[0]; const float* w_in = F.in[1]; const float* b_forget = F.in[2]; const float* w_out = F.in[4]; const float* ln1_g = F.in[5];
    const float* w_query = F.in[7]; const float* sub_keys = F.in[8];
    bf16* WIN = (bf16*)(F.ws + WS_WIN); bf16* WOUT = (bf16*)(F.ws + WS_WOUT); bf16* WQ = (bf16*)(F.ws + WS_WQ); bf16* SUBK = (bf16*)(F.ws + WS_SUBK);
    bf16* XB = (bf16*)(F.ws + WS_XB);
    float2* ROPE = (float2*)(F.ws + WS_ROPE); float* LF = (float*)(F.ws + WS_LF);
    constexpr int I_IN = 16 * (NPHYS / 32), I_OUT = 16 * 32, I_Q = 16 * 64;
    for (int it = gw; it < I_IN + I_OUT + I_Q; it += NGW) {
        if (it < I_IN) p0_transpose_item<true>(w_in, IN_COLS, 1024, WIN, scr, NPHYS / 32, it, lane, [](int pc) { return win_src_col(pc); }, [](int) { return SQ_WIN; });
        else if (it < I_IN + I_OUT) p0_transpose_item<true>(w_out, 1024, 1024, WOUT, scr, 32, it - I_IN, lane, [](int pc) { return pc; }, [](int) { return SQ_WOUT; });
        else p0_transpose_item<false>(w_query, QCOLS, 1024, WQ, scr, 64, it - I_IN - I_OUT, lane, [](int pc) { return pc; }, [=](int k) { return ln1_g[k]; });
    }
    for (int it = gw; it < (PEER_H * 2 * NKEYS * PEER_HALF) / 512; it += NGW) {
        const size_t o = (size_t)it * 512 + lane * 8; const f32x4 a = *(const GAS f32x4*)(sub_keys + o), b = *(const GAS f32x4*)(sub_keys + o + 4);
        v4u w; w.x = pk2(a.x, a.y); w.y = pk2(a.z, a.w); w.z = pk2(b.x, b.y); w.w = pk2(b.z, b.w); *(GAS v4u*)(SUBK + o) = w;
    }
    for (int it = gw; it < (SEQ * 32) / 64; it += NGW) {
        const int e = it * 64 + lane, pos = e >> 5, i = e & 31;
        const float inv = powf(10000.0f, -(float)i / 32.0f), ang = (float)pos * inv;
        double rev = (double)ang * 0.15915494309189535; rev -= floor(rev);
        const float r = (float)rev;
        ROPE[e] = make_float2(__builtin_amdgcn_cosf(r), __builtin_amdgcn_sinf(r));
    }
    {
        float wff[16][8];
#pragma unroll
        for (int j = 0; j < 2; ++j)
#pragma unroll
            for (int e = 0; e < 8; ++e) { const float* wr_ = w_in + (size_t)(512 * j + 8 * lane + e) * IN_COLS + OFF_FF; const f32x4 a = *(const GAS f32x4*)wr_, b = *(const GAS f32x4*)(wr_ + 4);
                wff[j * 8 + e][0] = a.x; wff[j * 8 + e][1] = a.y; wff[j * 8 + e][2] = a.z; wff[j * 8 + e][3] = a.w; wff[j * 8 + e][4] = b.x; wff[j * 8 + e][5] = b.y; wff[j * 8 + e][6] = b.z; wff[j * 8 + e][7] = b.w; }
        const float bfl = b_forget[lane & 7];
        for (int m = gw; m < T; m += NGW) {
            const float* src = x + (size_t)m * D_MODEL; bf16* dst = XB + (size_t)m * D_MODEL;
            float xv[16];
#pragma unroll
            for (int j = 0; j < 2; ++j) { const f32x4 a = *(const GAS f32x4*)(src + 512 * j + 8 * lane), b = *(const GAS f32x4*)(src + 512 * j + 8 * lane + 4);
                xv[8 * j + 0] = a.x; xv[8 * j + 1] = a.y; xv[8 * j + 2] = a.z; xv[8 * j + 3] = a.w; xv[8 * j + 4] = b.x; xv[8 * j + 5] = b.y; xv[8 * j + 6] = b.z; xv[8 * j + 7] = b.w;
                v4u w; w.x = pk2(a.x, a.y); w.y = pk2(a.z, a.w); w.z = pk2(b.x, b.y); w.w = pk2(b.z, b.w); *(GAS v4u*)(dst + 512 * j + 8 * lane) = w;
                u32x2 wq; wq.x = q8x4(a.x * SQ_X, a.y * SQ_X, a.z * SQ_X, a.w * SQ_X); wq.y = q8x4(b.x * SQ_X, b.y * SQ_X, b.z * SQ_X, b.w * SQ_X);
                *(GAS u32x2*)(F.ws + WS_XQ + (size_t)m * D_MODEL + 512 * j + 8 * lane) = wq; }
            float acc[8];
#pragma unroll
            for (int h = 0; h < 8; ++h) { float s = 0.f;
#pragma unroll
                for (int d = 0; d < 16; ++d) s = fmaf(xv[d], wff[d][h], s);
                acc[h] = wave_sum(s); }
            float mine = acc[0];
#pragma unroll
            for (int h = 1; h < 8; ++h) mine = ((lane & 7) == h) ? acc[h] : mine;
            if (lane < 8) LF[(size_t)m * 8 + lane] = log_sigmoid(mine + bfl);
        }
    }
}

__device__ __forceinline__ pg8::f32x4 iacc(pg8::f32x4 a, float s) { typedef int v4i_ __attribute__((ext_vector_type(4))); const v4i_ i = __builtin_bit_cast(v4i_, a); return (pg8::f32x4){(float)i[0] * s, (float)i[1] * s, (float)i[2] * s, (float)i[3] * s}; }
struct EpiInProj {
    static constexpr bool PERM = true, AFTER_DRAIN = false;
    static constexpr float SI = 1.f / (SQ_X * SQ_WIN);
    bf16 *fq, *fkt, *fvt, *sq, *skt, *svt; const float2* rope; float *qn2, *kn2;
    static __device__ __forceinline__ size_t tile_off(int nh, int t, int head) { const int b = t >> 12, s = t & 4095; return ((size_t)(b * nh + head) * 64 + (s >> 6)) * 8192; }
    __device__ __forceinline__ void operator()(const pg8::f32x4 (&acc)[2][2][4][2], const pg8::Unit& u, int wr, int wc, int fr, int fq_) const {
        const int pn = u.pn, g = wc & 1, hsub = wc >> 1;
        const int trow0 = u.pm * 256 + wr * 64 + fr;
        const bool lane0 = (fr == 0) && (fq_ == 0);
#pragma unroll
        for (int ai = 0; ai < 2; ++ai)
#pragma unroll
            for (int bj = 0; bj < 2; ++bj) {
                const int blk64 = (u.pm * 256 + ai * 128 + wr * 64) >> 6;
                if (pn < 6) {
                    const int head = 4 * (pn & 1) + 2 * bj + hsub;
                    float nrm = 0.f;
#pragma unroll
                    for (int m = 0; m < 4; ++m) {
                        const int t = trow0 + ai * 128 + m * 16;
                        pg8::f32x4 v0 = iacc(acc[ai][bj][m][0], SI), v1 = iacc(acc[ai][bj][m][1], SI);
                        if (pn < 2) { v0 = v0 * C2; v1 = v1 * C2; }
                        v4u w; w.x = pg8::cvt_pk_bf16(v0[0], v0[1]); w.y = pg8::cvt_pk_bf16(v0[2], v0[3]); w.z = pg8::cvt_pk_bf16(v1[0], v1[1]); w.w = pg8::cvt_pk_bf16(v1[2], v1[3]);
                        if (pn < 4) { float ss = (v0[0] * v0[0] + v0[1] * v0[1]) + (v0[2] * v0[2] + v0[3] * v0[3]) + (v1[0] * v1[0] + v1[1] * v1[1]) + (v1[2] * v1[2] + v1[3] * v1[3]);
                            ss += __shfl_xor(ss, 16); ss += __shfl_xor(ss, 32); nrm = fmaxf(nrm, ss); }
                        if (pn < 2) *(GAS v4u*)(fq + (size_t)t * 512 + head * 64 + 32 * g + 8 * fq_) = w;
                        else if (pn < 4) *(GAS v4u*)((GAS unsigned char*)fkt + tile_off(8, t, head) + (size_t)((4 * g + fq_) * 64 + (t & 63)) * 16) = w;
                        else *(GAS v4u*)((GAS unsigned char*)fvt + tile_off(8, t, head) + (size_t)(g * 4 + ((t & 63) >> 4)) * 1024 + (t & 15) * 64 + fq_ * 16) = w;
                    }
                    if (pn < 4) {
                        nrm = fmaxf(nrm, __shfl_xor(nrm, 1)); nrm = fmaxf(nrm, __shfl_xor(nrm, 2)); nrm = fmaxf(nrm, __shfl_xor(nrm, 4)); nrm = fmaxf(nrm, __shfl_xor(nrm, 8));
                        if (lane0) (pn < 2 ? qn2 : kn2)[(blk64 * 8 + head) * 2 + g] = nrm;
                    }
                } else if (pn < 8 || bj == 0) {
                    const int head = (pn < 8) ? 4 * (pn & 1) + 2 * bj + hsub : hsub;
                    const int i0 = 16 * g + 4 * fq_;
#pragma unroll
                    for (int m = 0; m < 4; ++m) {
                        const int t = trow0 + ai * 128 + m * 16, pos = t & 4095;
                        const pg8::f32x4 x1 = iacc(acc[ai][bj][m][0], SI), x2 = iacc(acc[ai][bj][m][1], SI);
                        const f32x4 cs01 = *(const GAS f32x4*)(rope + pos * 32 + i0), cs23 = *(const GAS f32x4*)(rope + pos * 32 + i0 + 2);
                        float o1[4], o2[4];
                        o1[0] = x1[0] * cs01.x - x2[0] * cs01.y; o2[0] = x2[0] * cs01.x + x1[0] * cs01.y;
                        o1[1] = x1[1] * cs01.z - x2[1] * cs01.w; o2[1] = x2[1] * cs01.z + x1[1] * cs01.w;
                        o1[2] = x1[2] * cs23.x - x2[2] * cs23.y; o2[2] = x2[2] * cs23.x + x1[2] * cs23.y;
                        o1[3] = x1[3] * cs23.z - x2[3] * cs23.w; o2[3] = x2[3] * cs23.z + x1[3] * cs23.w;
                        if (pn < 8) {
#pragma unroll
                            for (int e = 0; e < 4; ++e) { o1[e] *= C2; o2[e] *= C2; }
                        }
                        u32x2 w1, w2; w1.x = pg8::cvt_pk_bf16(o1[0], o1[1]); w1.y = pg8::cvt_pk_bf16(o1[2], o1[3]); w2.x = pg8::cvt_pk_bf16(o2[0], o2[1]); w2.y = pg8::cvt_pk_bf16(o2[2], o2[3]);
                        if (pn < 8) { bf16* p = sq + (size_t)t * 512 + head * 64 + i0; *(GAS u32x2*)p = w1; *(GAS u32x2*)(p + 32) = w2; }
                        else { GAS unsigned char* p = (GAS unsigned char*)skt + tile_off(2, t, head) + (size_t)((2 * g + (fq_ >> 1)) * 64 + (t & 63)) * 16 + (fq_ & 1) * 8;
                            *(GAS u32x2*)p = w1; *(GAS u32x2*)(p + 4 * 1024) = w2; }
                    }
                } else {
                    const int head = hsub;
#pragma unroll
                    for (int m = 0; m < 4; ++m) {
                        const int t = trow0 + ai * 128 + m * 16;
                        const pg8::f32x4 v0 = iacc(acc[ai][bj][m][0], SI), v1 = iacc(acc[ai][bj][m][1], SI);
                        v4u w; w.x = pg8::cvt_pk_bf16(v0[0], v0[1]); w.y = pg8::cvt_pk_bf16(v0[2], v0[3]); w.z = pg8::cvt_pk_bf16(v1[0], v1[1]); w.w = pg8::cvt_pk_bf16(v1[2], v1[3]);
                        *(GAS v4u*)((GAS unsigned char*)svt + tile_off(2, t, head) + (size_t)(g * 4 + ((t & 63) >> 4)) * 1024 + (t & 15) * 64 + fq_ * 16) = w;
                    }
                }
            }
    }
};

__device__ __forceinline__ void convert_experts(Frame& F, int w, int nw, int r0, int r1) {
    const float* eu = F.in[9]; const float* ev = F.in[10]; const int lane = F.lane;
    for (int m0 = r0 + 4 * w; m0 < r1; m0 += 4 * nw) {
        const bool isu = m0 < NEXP; const int e0 = m0 % NEXP;
        const float* src = (isu ? eu : ev) + (size_t)e0 * D_MODEL; unsigned char* dst = F.ws + (isu ? WS_EU : WS_EV); const float sc = isu ? U_QS : SQ_V;
        f32x4 va[4][2], vb[4][2];
#pragma unroll
        for (int r = 0; r < 4; ++r)
#pragma unroll
            for (int j = 0; j < 2; ++j) { va[r][j] = *(const GAS f32x4*)(src + r * D_MODEL + 512 * j + 8 * lane); vb[r][j] = *(const GAS f32x4*)(src + r * D_MODEL + 512 * j + 8 * lane + 4); }
#pragma unroll
        for (int r = 0; r < 4; ++r)
#pragma unroll
            for (int j = 0; j < 2; ++j) { const f32x4 a = va[r][j] * sc, b = vb[r][j] * sc;
                const int w0 = (int)q8x4(a.x, a.y, a.z, a.w), w1 = (int)q8x4(b.x, b.y, b.z, b.w);
                u32x2 wd; wd.x = (unsigned)w0; wd.y = (unsigned)w1;
                *(GAS u32x2*)(dst + (size_t)(4 * j + (lane >> 4)) * EXP_SLICE_BYTES + (size_t)(e0 + r) * 128 + 8 * (lane & 15)) = wd; }
    }
}
__device__ __forceinline__ void p1_slack_jobs(Frame& F, int sb, int nsb) {
    const float* LF = (const float*)(F.ws + WS_LF); float* C = (float*)(F.ws + WS_C);
    LAS float* red = (LAS float*)F.lds;
    const int lane = F.lane;
    for (int job = sb; job < BATCH * FOX_H; job += nsb) {
        const int b = job >> 3, h = job & 7;
        float v[8]; float run = 0.f;
#pragma unroll
        for (int i = 0; i < 8; ++i) { run += LF[(size_t)(b * SEQ + F.tid * 8 + i) * 8 + h]; v[i] = run; }
        float inc = run;
#pragma unroll
        for (int o = 1; o < 64; o <<= 1) { const float n = __shfl_up(inc, o); if (lane >= o) inc += n; }
        __syncthreads();
        if (lane == 63) red[F.wave] = inc;
        __syncthreads();
        float base = inc - run;
        for (int w = 0; w < F.wave; ++w) base += red[w];
#pragma unroll
        for (int i = 0; i < 8; ++i) C[(size_t)job * SEQ + F.tid * 8 + i] = (base + v[i]) * LOG2E;
    }
    const int w = sb * NWAVES + F.wave, nw = nsb * NWAVES;
    {
        const bf16* WQ = (const bf16*)(F.ws + WS_WQ); const float* w_query = F.in[7]; const float* ln1_b = F.in[6];
        float* GW = (float*)(F.ws + WS_GW); float* BW = GW + QCOLS;
        for (int n = w; n < QCOLS; n += nw) {
            const v4u a = *(const GAS v4u*)(WQ + (size_t)n * 1024 + 8 * lane), b = *(const GAS v4u*)(WQ + (size_t)n * 1024 + 512 + 8 * lane);
            float s = 0.f;
#pragma unroll
            for (int i = 0; i < 4; ++i) { s += __uint_as_float(a[i] << 16) + __uint_as_float(a[i] & 0xffff0000u); s += __uint_as_float(b[i] << 16) + __uint_as_float(b[i] & 0xffff0000u); }
            s = wave_sum(s);
            if (lane == 0) GW[n] = s;
        }
    }
    for (int c64 = sb; c64 < QCOLS / 64; c64 += nsb) {
        const float* w_query = F.in[7]; const float* ln1_b = F.in[6]; float* BW = (float*)(F.ws + WS_GW) + QCOLS;
        const int n = c64 * 64 + lane; float s = 0.f;
        for (int k0 = F.wave * 128; k0 < F.wave * 128 + 128; k0 += 16) {
            float wv_[16];
#pragma unroll
            for (int i = 0; i < 16; ++i) wv_[i] = w_query[(size_t)(k0 + i) * QCOLS + n];
#pragma unroll
            for (int i = 0; i < 16; ++i) s = fmaf(ln1_b[k0 + i], wv_[i], s);
        }
        __syncthreads();
        red[F.wave * 64 + lane] = s;
        __syncthreads();
        if (F.wave == 0) { float t_ = 0.f;
#pragma unroll
            for (int w8 = 0; w8 < 8; ++w8) t_ += red[w8 * 64 + lane];
            BW[n] = t_; }
    }
    convert_experts(F, w, nw, 0, EXP_SPLIT);
}

namespace att {
typedef float f32x16 __attribute__((ext_vector_type(16)));
typedef short s16x4 __attribute__((ext_vector_type(4)));
constexpr int LDS_K = 0, LDS_V = 16384, LDS_WS = 32768, LDS_OST = LDS_WS + 8 * 256, LDS_TOTAL = LDS_OST + 8 * 4096;
__device__ __forceinline__ int crow(int r, int hi) { return (r & 3) + 8 * (r >> 2) + 4 * hi; }
__device__ __forceinline__ float max3f(float a, float b, float c) { float r; asm("v_max3_f32 %0, %1, %2, %3" : "=v"(r) : "v"(a), "v"(b), "v"(c)); return r; }
__device__ __forceinline__ unsigned cvtpk(float lo, float hi) { unsigned r; asm("v_cvt_pk_bf16_f32 %0, %1, %2" : "=v"(r) : "v"(lo), "v"(hi)); return r; }
__device__ __forceinline__ float rowmax(const f32x16& p0, const f32x16& p1) {
    float a = max3f(p0[0], p0[1], p1[0]), b = max3f(p0[2], p0[3], p1[1]); a = max3f(a, p1[2], p1[3]);
#pragma unroll
    for (int r = 4; r < 16; r += 4) { a = max3f(a, p0[r], p0[r + 1]); b = max3f(b, p0[r + 2], p0[r + 3]); a = max3f(a, p1[r], p1[r + 1]); b = max3f(b, p1[r + 2], p1[r + 3]); }
    const float m = fmaxf(a, b);
    auto rr = __builtin_amdgcn_permlane32_swap(__float_as_uint(m), __float_as_uint(m), false, false);
    return fmaxf(__uint_as_float(rr[0]), __uint_as_float(rr[1]));
}
__device__ __forceinline__ void qkt(f32x16& p0, f32x16& p1, const LAS unsigned char* Kslot, const bf16x8* qr, int r32, int hi) {
    const LAS unsigned char* kb = Kslot + hi * 1024 + r32 * 16;
#pragma unroll
    for (int d0 = 0; d0 < 4; ++d0) {
        const bf16x8 b0 = *(const LAS bf16x8*)(kb + d0 * 2048), b1 = *(const LAS bf16x8*)(kb + d0 * 2048 + 512);
        p0 = __builtin_amdgcn_mfma_f32_32x32x16_bf16(b0, qr[d0], p0, 0, 0, 0);
        p1 = __builtin_amdgcn_mfma_f32_32x32x16_bf16(b1, qr[d0], p1, 0, 0, 0);
    }
}
__device__ __forceinline__ void pv(f32x16* o, int vb, bf16x8 pa0, bf16x8 pa1, bf16x8 pa2, bf16x8 pa3) {
#pragma unroll
    for (int d0 = 0; d0 < 2; ++d0) {
        s16x4 lo[4], hi[4];
#pragma unroll
        for (int ks = 0; ks < 4; ++ks) {
            asm volatile("ds_read_b64_tr_b16 %0,%1 offset:%c2" : "=&v"(lo[ks]) : "v"(vb), "i"(d0 * 4096 + ks * 1024) : "memory");
            asm volatile("ds_read_b64_tr_b16 %0,%1 offset:%c2" : "=&v"(hi[ks]) : "v"(vb), "i"(d0 * 4096 + ks * 1024 + 512) : "memory");
        }
        asm volatile("s_waitcnt lgkmcnt(0)" ::: "memory"); __builtin_amdgcn_sched_barrier(0);
#define ATT_PK(k) (bf16x8){lo[k][0], lo[k][1], lo[k][2], lo[k][3], hi[k][0], hi[k][1], hi[k][2], hi[k][3]}
        o[d0] = __builtin_amdgcn_mfma_f32_32x32x16_bf16(pa0, ATT_PK(0), o[d0], 0, 0, 0);
        o[d0] = __builtin_amdgcn_mfma_f32_32x32x16_bf16(pa1, ATT_PK(1), o[d0], 0, 0, 0);
        o[d0] = __builtin_amdgcn_mfma_f32_32x32x16_bf16(pa2, ATT_PK(2), o[d0], 0, 0, 0);
        o[d0] = __builtin_amdgcn_mfma_f32_32x32x16_bf16(pa3, ATT_PK(3), o[d0], 0, 0, 0);
#undef ATT_PK
    }
}

template <int KIND>
__device__ __forceinline__ void attn_unit(Frame& F, int b, int h, int qb) {
    const int tid = F.tid, lane = F.lane, r32 = lane & 31, hi = lane >> 5, wid = F.wave;
    const int q0 = qb * 256, w0 = q0 + wid * 32, myq = w0 + r32;
    const bf16* Qg = (const bf16*)(F.ws + (KIND == 0 ? WS_FQ : WS_SQ)) + (size_t)(b * SEQ + myq) * 512 + h * 64;
    const int kvh = (KIND == 0) ? h : (h >> 2), nkv = (KIND == 0) ? 8 : 2;
    const unsigned char* KT = F.ws + (KIND == 0 ? WS_FKT : WS_SKT) + (size_t)(b * nkv + kvh) * 64 * 8192;
    const unsigned char* VT = F.ws + (KIND == 0 ? WS_FVT : WS_SVT) + (size_t)(b * nkv + kvh) * 64 * 8192;
    const float* Cg = (const float*)(F.ws + WS_C) + (size_t)(b * 8 + h) * SEQ;
    LAS unsigned char* lds = F.lds;
    LAS float* wsf = (LAS float*)(lds + LDS_WS) + wid * 64;
#define ATT_LOAD(j, buf) do { \
        __builtin_amdgcn_global_load_lds((const unsigned*)(KT + (size_t)(j) * 8192 + tid * 16), (LAS unsigned*)(lds + LDS_K + (buf) * 8192 + wid * 1024), 16, 0, 0); \
        __builtin_amdgcn_global_load_lds((const unsigned*)(VT + (size_t)(j) * 8192 + tid * 16), (LAS unsigned*)(lds + LDS_V + (buf) * 8192 + wid * 1024), 16, 0, 0); } while (0)
    const int jhi = qb * 4 + 3; int jlo; float cref = 0.f, cw0 = 0.f, TH = 0.f;
    ATT_LOAD(jhi, 0);
    bf16x8 qr[4];
#pragma unroll
    for (int d0 = 0; d0 < 4; ++d0) qr[d0] = *(const GAS bf16x8*)(Qg + d0 * 16 + hi * 8);
    if (KIND == 0) {
        const float* QN2 = (const float*)(F.ws + WS_QN2); const float* KN2 = (const float*)(F.ws + WS_KN2);
        const int kblk = b * 64 + lane; const float knl = KN2[(kblk * 8 + h) * 2] + KN2[(kblk * 8 + h) * 2 + 1];
        const int qblk = (b * SEQ + q0) / 64 + (lane & 3); const float qnl = QN2[(qblk * 8 + h) * 2] + QN2[(qblk * 8 + h) * 2 + 1];
        const int jt = qb * 4 - 1 - lane; const float cl = Cg[jt >= 0 ? 64 * jt + 63 : 0];
        cref = Cg[q0]; cw0 = Cg[w0];
        const float kn = wave_max(knl), qn = wave_max(qnl);
        TH = 160.f + 2.05f * sqrtf(qn * kn);
        const unsigned long long keep = __ballot(lane < 16 && jt >= 0 && (cref - cl) >= -TH);
        const int nkeep = __builtin_ctzll(~keep);
        jlo = qb * 4 - nkeep;
        if (nkeep == 16) { while (jlo > 0 && (cref - Cg[64 * (jlo - 1) + 63]) >= -TH) --jlo; }
        jlo = __builtin_amdgcn_readfirstlane(jlo);
    } else {
        jlo = (q0 - 127) < 0 ? 0 : ((q0 - 127) >> 6);
    }
    float m_run, l_run;
    if (KIND == 0) { m_run = -INFINITY; l_run = 0.f; }
    else { m_run = F.in[3][h] * LOG2E; l_run = (hi == 0) ? 1.f : 0.f; }
    f32x16 o[2];
#pragma unroll
    for (int r = 0; r < 16; ++r) { o[0][r] = 0.f; o[1][r] = 0.f; }
    const int vb0 = (int)(unsigned)(uintptr_t)(lds + LDS_V) + ((lane >> 4) & 1) * 32 + (lane & 3) * 8 + (4 * hi + ((lane & 15) >> 2)) * 64;
    int cur = 0;
    for (int j = jhi; j >= jlo; --j, cur ^= 1) {
        asm volatile("s_waitcnt vmcnt(0)" ::: "memory");
        __syncthreads();
        if (j > jlo) ATT_LOAD(j - 1, cur ^ 1);
        const int k0 = 64 * j;
        bool active = k0 <= w0 + 31;
        if (KIND == 1) active = active && (k0 + 63 >= w0 - 127);
        if (KIND == 0 && k0 + 63 < w0) active = active && ((cw0 - Cg[k0 + 63]) >= -TH);
        if (active) {
            f32x16 p0, p1;
            if (KIND == 0) {
#pragma unroll
                for (int g = 0; g < 4; ++g) {
                    const f32x4 c0 = *(const GAS f32x4*)(Cg + k0 + 8 * g + 4 * hi), c1 = *(const GAS f32x4*)(Cg + k0 + 32 + 8 * g + 4 * hi);
#pragma unroll
                    for (int e = 0; e < 4; ++e) { p0[4 * g + e] = cref - c0[e]; p1[4 * g + e] = cref - c1[e]; }
                }
            } else {
#pragma unroll
                for (int r = 0; r < 16; ++r) { p0[r] = 0.f; p1[r] = 0.f; }
            }
            qkt(p0, p1, lds + LDS_K + cur * 8192, qr, r32, hi);
            if (k0 + 63 > w0) {
#pragma unroll
                for (int r = 0; r < 16; ++r) { const int kv = k0 + crow(r, hi); if (kv > myq) p0[r] = -INFINITY; if (kv + 32 > myq) p1[r] = -INFINITY; }
            }
            if (KIND == 1 && k0 < w0 + 31 - 127) {
#pragma unroll
                for (int r = 0; r < 16; ++r) { const int kv = k0 + crow(r, hi); if (kv < myq - 127) p0[r] = -INFINITY; if (kv + 32 < myq - 127) p1[r] = -INFINITY; }
            }
            const float rm = rowmax(p0, p1);
            const float m_new = fmaxf(m_run, rm);
            const bool resc = __any(m_new > m_run);
            const float alpha = __builtin_amdgcn_exp2f(m_run - m_new);
            m_run = m_new;
            float ps = 0.f;
#pragma unroll
            for (int r = 0; r < 16; ++r) { p0[r] = __builtin_amdgcn_exp2f(p0[r] - m_new); p1[r] = __builtin_amdgcn_exp2f(p1[r] - m_new); ps += p0[r] + p1[r]; }
            l_run = l_run * alpha + ps;
            v4u pw0, pw1, pw2, pw3;
#pragma unroll
            for (int i = 0; i < 4; ++i) { pw0[i] = cvtpk(p0[2 * i], p0[2 * i + 1]); pw1[i] = cvtpk(p0[8 + 2 * i], p0[9 + 2 * i]); pw2[i] = cvtpk(p1[2 * i], p1[2 * i + 1]); pw3[i] = cvtpk(p1[8 + 2 * i], p1[9 + 2 * i]); }
            if (resc) {
                if (hi == 0) wsf[r32] = alpha;
#pragma unroll
                for (int r = 0; r < 16; ++r) { const float a = wsf[crow(r, hi)]; o[0][r] *= a; o[1][r] *= a; }
            }
            pv(o, vb0 + cur * 8192, __builtin_bit_cast(bf16x8, pw0), __builtin_bit_cast(bf16x8, pw1), __builtin_bit_cast(bf16x8, pw2), __builtin_bit_cast(bf16x8, pw3));
        }
    }
#undef ATT_LOAD
    { auto rr = __builtin_amdgcn_permlane32_swap(__float_as_uint(l_run), __float_as_uint(l_run), false, false); l_run = __uint_as_float(rr[0]) + __uint_as_float(rr[1]); }
    if (hi == 0) wsf[32 + r32] = l_run;
    float rli[16];
#pragma unroll
    for (int r = 0; r < 16; ++r) rli[r] = __builtin_amdgcn_rcpf(wsf[32 + crow(r, hi)]);
    LAS unsigned char* stg = lds + LDS_OST + wid * 2048;
#pragma unroll
    for (int r = 0; r < 16; ++r) { const int orow = crow(r, hi);
#pragma unroll
        for (int d0 = 0; d0 < 2; ++d0) { const float qv = fminf(fmaxf(rintf(o[d0][r] * rli[r] * SQ_A), -127.f), 127.f); stg[orow * 64 + d0 * 32 + r32] = (unsigned char)(int)qv; } }
    unsigned char* Ow = F.ws + WS_ATTN + (size_t)(b * SEQ + w0) * 1024 + (KIND == 0 ? 0 : 512) + h * 64;
#pragma unroll
    for (int i = 0; i < 2; ++i) { const int row = i * 16 + (lane >> 2), ch = lane & 3; const v4u v = *(const LAS v4u*)(stg + row * 64 + ch * 16); *(GAS v4u*)(Ow + (size_t)row * 1024 + ch * 16) = v; }
    __syncthreads();
}

__device__ __forceinline__ void attn_phase(Frame& F) {
    for (int u = (int)blockIdx.x; u < 2048; u += F.G) {
        const int kind = u >> 10, rem = u & 1023, b = rem >> 7, h = (rem >> 4) & 7, qb = ((rem & 15) + (rem >> 8)) & 15;
        if (kind == 0) attn_unit<0>(F, b, h, qb); else attn_unit<1>(F, b, h, qb);
    }
}
}

struct EpiOutProj {
    static constexpr bool PERM = true, AFTER_DRAIN = false;
    bf16* yb; float2* stats;
    __device__ __forceinline__ void operator()(const pg8::f32x4 (&acc)[2][2][4][2], const pg8::Unit& u, int wr, int wc, int fr, int fq_) const {
        const int trow0 = u.pm * 256 + wr * 64 + fr;
#pragma unroll
        for (int ai = 0; ai < 2; ++ai)
#pragma unroll
            for (int m = 0; m < 4; ++m) {
                const int t = trow0 + ai * 128 + m * 16;
                float s = 0.f, ss = 0.f;
#pragma unroll
                for (int bj = 0; bj < 2; ++bj) {
                    const size_t off = (size_t)t * D_MODEL + u.pn * 256 + bj * 128 + wc * 32 + 8 * fq_;
                    const v4u xw = *(const GAS v4u*)(yb + off);
                    f32x4 x0, x1;
                    x0[0] = __uint_as_float(xw[0] << 16); x0[1] = __uint_as_float(xw[0] & 0xffff0000u); x0[2] = __uint_as_float(xw[1] << 16); x0[3] = __uint_as_float(xw[1] & 0xffff0000u);
                    x1[0] = __uint_as_float(xw[2] << 16); x1[1] = __uint_as_float(xw[2] & 0xffff0000u); x1[2] = __uint_as_float(xw[3] << 16); x1[3] = __uint_as_float(xw[3] & 0xffff0000u);
                    const f32x4 v0 = x0 * ALPHA + iacc(acc[ai][bj][m][0], 1.f / (SQ_A * SQ_WOUT)), v1 = x1 * ALPHA + iacc(acc[ai][bj][m][1], 1.f / (SQ_A * SQ_WOUT));
                    v4u w; w.x = pg8::cvt_pk_bf16(v0[0], v0[1]); w.y = pg8::cvt_pk_bf16(v0[2], v0[3]); w.z = pg8::cvt_pk_bf16(v1[0], v1[1]); w.w = pg8::cvt_pk_bf16(v1[2], v1[3]);
                    *(GAS v4u*)(yb + off) = w;
                    s += (v0[0] + v0[1]) + (v0[2] + v0[3]) + (v1[0] + v1[1]) + (v1[2] + v1[3]);
                    ss += (v0[0] * v0[0] + v0[1] * v0[1]) + (v0[2] * v0[2] + v0[3] * v0[3]) + (v1[0] * v1[0] + v1[1] * v1[1]) + (v1[2] * v1[2] + v1[3] * v1[3]);
                }
                s += __shfl_xor(s, 16); s += __shfl_xor(s, 32); ss += __shfl_xor(ss, 16); ss += __shfl_xor(ss, 32);
                if (fq_ == 0) stats[(size_t)t * 16 + u.pn * 4 + wc] = make_float2(s, ss);
            }
    }
};
__device__ __forceinline__ float2 ln1_row_stats(const float2* stats, int t) {
    float s = 0.f, ss = 0.f;
#pragma unroll
    for (int i = 0; i < 16; i += 2) { const f32x4 a = *(const GAS f32x4*)(stats + (size_t)t * 16 + i); s += a.x + a.z; ss += a.y + a.w; }
    const float mean = s * (1.f / D_MODEL), var = fmaxf(ss * (1.f / D_MODEL) - mean * mean, 0.f);
    return make_float2(mean, 1.f / sqrtf(var + LN_EPS));
}
struct EpiQuery {
    static constexpr bool PERM = true, AFTER_DRAIN = false;
    const float2* stats; const float* gw; const float* bw; bf16* q;
    __device__ __forceinline__ void operator()(const pg8::f32x4 (&acc)[2][2][4][2], const pg8::Unit& u, int wr, int wc, int fr, int fq_) const {
        const int trow0 = u.pm * 256 + wr * 64 + fr, lane = fr + 16 * fq_;
        const int k0 = 2 * fq_, k1 = 2 * fq_ + 1;
        const float2 sa = ln1_row_stats(stats, trow0 + (k0 >> 2) * 128 + (k0 & 3) * 16), sb = ln1_row_stats(stats, trow0 + (k1 >> 2) * 128 + (k1 & 3) * 16);
        float mean[8], rstd[8];
#pragma unroll
        for (int k = 0; k < 8; ++k) { const int src = fr + 16 * (k >> 1); mean[k] = __shfl((k & 1) ? sb.x : sa.x, src); rstd[k] = __shfl((k & 1) ? sb.y : sa.y, src); }
        (void)lane;
#pragma unroll
        for (int bj = 0; bj < 2; ++bj) {
            const int col0 = u.pn * 256 + bj * 128 + wc * 32 + 8 * fq_;
            const f32x4 g0 = *(const GAS f32x4*)(gw + col0), g1 = *(const GAS f32x4*)(gw + col0 + 4), b0 = *(const GAS f32x4*)(bw + col0), b1 = *(const GAS f32x4*)(bw + col0 + 4);
#pragma unroll
            for (int ai = 0; ai < 2; ++ai)
#pragma unroll
                for (int m = 0; m < 4; ++m) {
                    const int t = trow0 + ai * 128 + m * 16; const float mu = mean[4 * ai + m], rs = rstd[4 * ai + m];
                    const f32x4 v0 = (acc[ai][bj][m][0] - g0 * mu) * rs + b0, v1 = (acc[ai][bj][m][1] - g1 * mu) * rs + b1;
                    v4u w; w.x = pg8::cvt_pk_bf16(v0[0], v0[1]); w.y = pg8::cvt_pk_bf16(v0[2], v0[3]); w.z = pg8::cvt_pk_bf16(v1[0], v1[1]); w.w = pg8::cvt_pk_bf16(v1[2], v1[3]);
                    *(GAS v4u*)(q + ((size_t)(t >> 5) * 8192 + (size_t)(col0 >> 3) * 32 + (t & 31)) * 8) = w;
                }
        }
    }
};
#define TOPK_SORT128(v) do { \
  CE(v[0],v[1]);CE(v[3],v[2]);CE(v[4],v[5]);CE(v[7],v[6]);CE(v[8],v[9]);CE(v[11],v[10]);CE(v[12],v[13]);CE(v[15],v[14]);CE(v[0],v[2]);CE(v[1],v[3]);CE(v[6],v[4]);CE(v[7],v[5]);CE(v[8],v[10]);CE(v[9],v[11]);CE(v[14],v[12]);CE(v[15],v[13]);CE(v[0],v[1]);CE(v[2],v[3]);CE(v[5],v[4]);CE(v[7],v[6]);CE(v[8],v[9]);CE(v[10],v[11]);CE(v[13],v[12]);CE(v[15],v[14]);CE(v[0],v[4]);CE(v[1],v[5]);CE(v[2],v[6]);CE(v[3],v[7]);CE(v[12],v[8]);CE(v[13],v[9]);CE(v[14],v[10]);CE(v[15],v[11]);CE(v[0],v[2]);CE(v[1],v[3]);CE(v[4],v[6]);CE(v[5],v[7]);CE(v[10],v[8]);CE(v[11],v[9]);CE(v[14],v[12]);CE(v[15],v[13]);CE(v[0],v[1]);CE(v[2],v[3]);CE(v[4],v[5]);CE(v[6],v[7]);CE(v[9],v[8]);CE(v[11],v[10]);CE(v[13],v[12]);CE(v[15],v[14]);CE(v[0],v[8]);CE(v[1],v[9]);CE(v[2],v[10]);CE(v[3],v[11]);CE(v[4],v[12]);CE(v[5],v[13]);CE(v[6],v[14]);CE(v[7],v[15]);CE(v[0],v[4]);CE(v[1],v[5]);CE(v[2],v[6]);CE(v[3],v[7]);CE(v[8],v[12]);CE(v[9],v[13]);CE(v[10],v[14]);CE(v[11],v[15]);CE(v[0],v[2]);CE(v[1],v[3]);CE(v[4],v[6]);CE(v[5],v[7]);CE(v[8],v[10]);CE(v[9],v[11]);CE(v[12],v[14]);CE(v[13],v[15]);CE(v[0],v[1]);CE(v[2],v[3]);CE(v[4],v[5]);CE(v[6],v[7]);CE(v[8],v[9]);CE(v[10],v[11]);CE(v[12],v[13]);CE(v[14],v[15]); \
  CE(v[16],v[17]);CE(v[19],v[18]);CE(v[20],v[21]);CE(v[23],v[22]);CE(v[24],v[25]);CE(v[27],v[26]);CE(v[28],v[29]);CE(v[31],v[30]);CE(v[16],v[18]);CE(v[17],v[19]);CE(v[22],v[20]);CE(v[23],v[21]);CE(v[24],v[26]);CE(v[25],v[27]);CE(v[30],v[28]);CE(v[31],v[29]);CE(v[16],v[17]);CE(v[18],v[19]);CE(v[21],v[20]);CE(v[23],v[22]);CE(v[24],v[25]);CE(v[26],v[27]);CE(v[29],v[28]);CE(v[31],v[30]);CE(v[16],v[20]);CE(v[17],v[21]);CE(v[18],v[22]);CE(v[19],v[23]);CE(v[28],v[24]);CE(v[29],v[25]);CE(v[30],v[26]);CE(v[31],v[27]);CE(v[16],v[18]);CE(v[17],v[19]);CE(v[20],v[22]);CE(v[21],v[23]);CE(v[26],v[24]);CE(v[27],v[25]);CE(v[30],v[28]);CE(v[31],v[29]);CE(v[16],v[17]);CE(v[18],v[19]);CE(v[20],v[21]);CE(v[22],v[23]);CE(v[25],v[24]);CE(v[27],v[26]);CE(v[29],v[28]);CE(v[31],v[30]);CE(v[16],v[24]);CE(v[17],v[25]);CE(v[18],v[26]);CE(v[19],v[27]);CE(v[20],v[28]);CE(v[21],v[29]);CE(v[22],v[30]);CE(v[23],v[31]);CE(v[16],v[20]);CE(v[17],v[21]);CE(v[18],v[22]);CE(v[19],v[23]);CE(v[24],v[28]);CE(v[25],v[29]);CE(v[26],v[30]);CE(v[27],v[31]);CE(v[16],v[18]);CE(v[17],v[19]);CE(v[20],v[22]);CE(v[21],v[23]);CE(v[24],v[26]);CE(v[25],v[27]);CE(v[28],v[30]);CE(v[29],v[31]);CE(v[16],v[17]);CE(v[18],v[19]);CE(v[20],v[21]);CE(v[22],v[23]);CE(v[24],v[25]);CE(v[26],v[27]);CE(v[28],v[29]);CE(v[30],v[31]); \
  CE(v[32],v[33]);CE(v[35],v[34]);CE(v[36],v[37]);CE(v[39],v[38]);CE(v[40],v[41]);CE(v[43],v[42]);CE(v[44],v[45]);CE(v[47],v[46]);CE(v[32],v[34]);CE(v[33],v[35]);CE(v[38],v[36]);CE(v[39],v[37]);CE(v[40],v[42]);CE(v[41],v[43]);CE(v[46],v[44]);CE(v[47],v[45]);CE(v[32],v[33]);CE(v[34],v[35]);CE(v[37],v[36]);CE(v[39],v[38]);CE(v[40],v[41]);CE(v[42],v[43]);CE(v[45],v[44]);CE(v[47],v[46]);CE(v[32],v[36]);CE(v[33],v[37]);CE(v[34],v[38]);CE(v[35],v[39]);CE(v[44],v[40]);CE(v[45],v[41]);CE(v[46],v[42]);CE(v[47],v[43]);CE(v[32],v[34]);CE(v[33],v[35]);CE(v[36],v[38]);CE(v[37],v[39]);CE(v[42],v[40]);CE(v[43],v[41]);CE(v[46],v[44]);CE(v[47],v[45]);CE(v[32],v[33]);CE(v[34],v[35]);CE(v[36],v[37]);CE(v[38],v[39]);CE(v[41],v[40]);CE(v[43],v[42]);CE(v[45],v[44]);CE(v[47],v[46]);CE(v[32],v[40]);CE(v[33],v[41]);CE(v[34],v[42]);CE(v[35],v[43]);CE(v[36],v[44]);CE(v[37],v[45]);CE(v[38],v[46]);CE(v[39],v[47]);CE(v[32],v[36]);CE(v[33],v[37]);CE(v[34],v[38]);CE(v[35],v[39]);CE(v[40],v[44]);CE(v[41],v[45]);CE(v[42],v[46]);CE(v[43],v[47]);CE(v[32],v[34]);CE(v[33],v[35]);CE(v[36],v[38]);CE(v[37],v[39]);CE(v[40],v[42]);CE(v[41],v[43]);CE(v[44],v[46]);CE(v[45],v[47]);CE(v[32],v[33]);CE(v[34],v[35]);CE(v[36],v[37]);CE(v[38],v[39]);CE(v[40],v[41]);CE(v[42],v[43]);CE(v[44],v[45]);CE(v[46],v[47]); \
  CE(v[48],v[49]);CE(v[51],v[50]);CE(v[52],v[53]);CE(v[55],v[54]);CE(v[56],v[57]);CE(v[59],v[58]);CE(v[60],v[61]);CE(v[63],v[62]);CE(v[48],v[50]);CE(v[49],v[51]);CE(v[54],v[52]);CE(v[55],v[53]);CE(v[56],v[58]);CE(v[57],v[59]);CE(v[62],v[60]);CE(v[63],v[61]);CE(v[48],v[49]);CE(v[50],v[51]);CE(v[53],v[52]);CE(v[55],v[54]);CE(v[56],v[57]);CE(v[58],v[59]);CE(v[61],v[60]);CE(v[63],v[62]);CE(v[48],v[52]);CE(v[49],v[53]);CE(v[50],v[54]);CE(v[51],v[55]);CE(v[60],v[56]);CE(v[61],v[57]);CE(v[62],v[58]);CE(v[63],v[59]);CE(v[48],v[50]);CE(v[49],v[51]);CE(v[52],v[54]);CE(v[53],v[55]);CE(v[58],v[56]);CE(v[59],v[57]);CE(v[62],v[60]);CE(v[63],v[61]);CE(v[48],v[49]);CE(v[50],v[51]);CE(v[52],v[53]);CE(v[54],v[55]);CE(v[57],v[56]);CE(v[59],v[58]);CE(v[61],v[60]);CE(v[63],v[62]);CE(v[48],v[56]);CE(v[49],v[57]);CE(v[50],v[58]);CE(v[51],v[59]);CE(v[52],v[60]);CE(v[53],v[61]);CE(v[54],v[62]);CE(v[55],v[63]);CE(v[48],v[52]);CE(v[49],v[53]);CE(v[50],v[54]);CE(v[51],v[55]);CE(v[56],v[60]);CE(v[57],v[61]);CE(v[58],v[62]);CE(v[59],v[63]);CE(v[48],v[50]);CE(v[49],v[51]);CE(v[52],v[54]);CE(v[53],v[55]);CE(v[56],v[58]);CE(v[57],v[59]);CE(v[60],v[62]);CE(v[61],v[63]);CE(v[48],v[49]);CE(v[50],v[51]);CE(v[52],v[53]);CE(v[54],v[55]);CE(v[56],v[57]);CE(v[58],v[59]);CE(v[60],v[61]);CE(v[62],v[63]); \
  CE(v[64],v[65]);CE(v[67],v[66]);CE(v[68],v[69]);CE(v[71],v[70]);CE(v[72],v[73]);CE(v[75],v[74]);CE(v[76],v[77]);CE(v[79],v[78]);CE(v[64],v[66]);CE(v[65],v[67]);CE(v[70],v[68]);CE(v[71],v[69]);CE(v[72],v[74]);CE(v[73],v[75]);CE(v[78],v[76]);CE(v[79],v[77]);CE(v[64],v[65]);CE(v[66],v[67]);CE(v[69],v[68]);CE(v[71],v[70]);CE(v[72],v[73]);CE(v[74],v[75]);CE(v[77],v[76]);CE(v[79],v[78]);CE(v[64],v[68]);CE(v[65],v[69]);CE(v[66],v[70]);CE(v[67],v[71]);CE(v[76],v[72]);CE(v[77],v[73]);CE(v[78],v[74]);CE(v[79],v[75]);CE(v[64],v[66]);CE(v[65],v[67]);CE(v[68],v[70]);CE(v[69],v[71]);CE(v[74],v[72]);CE(v[75],v[73]);CE(v[78],v[76]);CE(v[79],v[77]);CE(v[64],v[65]);CE(v[66],v[67]);CE(v[68],v[69]);CE(v[70],v[71]);CE(v[73],v[72]);CE(v[75],v[74]);CE(v[77],v[76]);CE(v[79],v[78]);CE(v[64],v[72]);CE(v[65],v[73]);CE(v[66],v[74]);CE(v[67],v[75]);CE(v[68],v[76]);CE(v[69],v[77]);CE(v[70],v[78]);CE(v[71],v[79]);CE(v[64],v[68]);CE(v[65],v[69]);CE(v[66],v[70]);CE(v[67],v[71]);CE(v[72],v[76]);CE(v[73],v[77]);CE(v[74],v[78]);CE(v[75],v[79]);CE(v[64],v[66]);CE(v[65],v[67]);CE(v[68],v[70]);CE(v[69],v[71]);CE(v[72],v[74]);CE(v[73],v[75]);CE(v[76],v[78]);CE(v[77],v[79]);CE(v[64],v[65]);CE(v[66],v[67]);CE(v[68],v[69]);CE(v[70],v[71]);CE(v[72],v[73]);CE(v[74],v[75]);CE(v[76],v[77]);CE(v[78],v[79]); \
  CE(v[80],v[81]);CE(v[83],v[82]);CE(v[84],v[85]);CE(v[87],v[86]);CE(v[88],v[89]);CE(v[91],v[90]);CE(v[92],v[93]);CE(v[95],v[94]);CE(v[80],v[82]);CE(v[81],v[83]);CE(v[86],v[84]);CE(v[87],v[85]);CE(v[88],v[90]);CE(v[89],v[91]);CE(v[94],v[92]);CE(v[95],v[93]);CE(v[80],v[81]);CE(v[82],v[83]);CE(v[85],v[84]);CE(v[87],v[86]);CE(v[88],v[89]);CE(v[90],v[91]);CE(v[93],v[92]);CE(v[95],v[94]);CE(v[80],v[84]);CE(v[81],v[85]);CE(v[82],v[86]);CE(v[83],v[87]);CE(v[92],v[88]);CE(v[93],v[89]);CE(v[94],v[90]);CE(v[95],v[91]);CE(v[80],v[82]);CE(v[81],v[83]);CE(v[84],v[86]);CE(v[85],v[87]);CE(v[90],v[88]);CE(v[91],v[89]);CE(v[94],v[92]);CE(v[95],v[93]);CE(v[80],v[81]);CE(v[82],v[83]);CE(v[84],v[85]);CE(v[86],v[87]);CE(v[89],v[88]);CE(v[91],v[90]);CE(v[93],v[92]);CE(v[95],v[94]);CE(v[80],v[88]);CE(v[81],v[89]);CE(v[82],v[90]);CE(v[83],v[91]);CE(v[84],v[92]);CE(v[85],v[93]);CE(v[86],v[94]);CE(v[87],v[95]);CE(v[80],v[84]);CE(v[81],v[85]);CE(v[82],v[86]);CE(v[83],v[87]);CE(v[88],v[92]);CE(v[89],v[93]);CE(v[90],v[94]);CE(v[91],v[95]);CE(v[80],v[82]);CE(v[81],v[83]);CE(v[84],v[86]);CE(v[85],v[87]);CE(v[88],v[90]);CE(v[89],v[91]);CE(v[92],v[94]);CE(v[93],v[95]);CE(v[80],v[81]);CE(v[82],v[83]);CE(v[84],v[85]);CE(v[86],v[87]);CE(v[88],v[89]);CE(v[90],v[91]);CE(v[92],v[93]);CE(v[94],v[95]); \
  CE(v[96],v[97]);CE(v[99],v[98]);CE(v[100],v[101]);CE(v[103],v[102]);CE(v[104],v[105]);CE(v[107],v[106]);CE(v[108],v[109]);CE(v[111],v[110]);CE(v[96],v[98]);CE(v[97],v[99]);CE(v[102],v[100]);CE(v[103],v[101]);CE(v[104],v[106]);CE(v[105],v[107]);CE(v[110],v[108]);CE(v[111],v[109]);CE(v[96],v[97]);CE(v[98],v[99]);CE(v[101],v[100]);CE(v[103],v[102]);CE(v[104],v[105]);CE(v[106],v[107]);CE(v[109],v[108]);CE(v[111],v[110]);CE(v[96],v[100]);CE(v[97],v[101]);CE(v[98],v[102]);CE(v[99],v[103]);CE(v[108],v[104]);CE(v[109],v[105]);CE(v[110],v[106]);CE(v[111],v[107]);CE(v[96],v[98]);CE(v[97],v[99]);CE(v[100],v[102]);CE(v[101],v[103]);CE(v[106],v[104]);CE(v[107],v[105]);CE(v[110],v[108]);CE(v[111],v[109]);CE(v[96],v[97]);CE(v[98],v[99]);CE(v[100],v[101]);CE(v[102],v[103]);CE(v[105],v[104]);CE(v[107],v[106]);CE(v[109],v[108]);CE(v[111],v[110]);CE(v[96],v[104]);CE(v[97],v[105]);CE(v[98],v[106]);CE(v[99],v[107]);CE(v[100],v[108]);CE(v[101],v[109]);CE(v[102],v[110]);CE(v[103],v[111]);CE(v[96],v[100]);CE(v[97],v[101]);CE(v[98],v[102]);CE(v[99],v[103]);CE(v[104],v[108]);CE(v[105],v[109]);CE(v[106],v[110]);CE(v[107],v[111]);CE(v[96],v[98]);CE(v[97],v[99]);CE(v[100],v[102]);CE(v[101],v[103]);CE(v[104],v[106]);CE(v[105],v[107]);CE(v[108],v[110]);CE(v[109],v[111]);CE(v[96],v[97]);CE(v[98],v[99]);CE(v[100],v[101]);CE(v[102],v[103]);CE(v[104],v[105]);CE(v[106],v[107]);CE(v[108],v[109]);CE(v[110],v[111]); \
  CE(v[112],v[113]);CE(v[115],v[114]);CE(v[116],v[117]);CE(v[119],v[118]);CE(v[120],v[121]);CE(v[123],v[122]);CE(v[124],v[125]);CE(v[127],v[126]);CE(v[112],v[114]);CE(v[113],v[115]);CE(v[118],v[116]);CE(v[119],v[117]);CE(v[120],v[122]);CE(v[121],v[123]);CE(v[126],v[124]);CE(v[127],v[125]);CE(v[112],v[113]);CE(v[114],v[115]);CE(v[117],v[116]);CE(v[119],v[118]);CE(v[120],v[121]);CE(v[122],v[123]);CE(v[125],v[124]);CE(v[127],v[126]);CE(v[112],v[116]);CE(v[113],v[117]);CE(v[114],v[118]);CE(v[115],v[119]);CE(v[124],v[120]);CE(v[125],v[121]);CE(v[126],v[122]);CE(v[127],v[123]);CE(v[112],v[114]);CE(v[113],v[115]);CE(v[116],v[118]);CE(v[117],v[119]);CE(v[122],v[120]);CE(v[123],v[121]);CE(v[126],v[124]);CE(v[127],v[125]);CE(v[112],v[113]);CE(v[114],v[115]);CE(v[116],v[117]);CE(v[118],v[119]);CE(v[121],v[120]);CE(v[123],v[122]);CE(v[125],v[124]);CE(v[127],v[126]);CE(v[112],v[120]);CE(v[113],v[121]);CE(v[114],v[122]);CE(v[115],v[123]);CE(v[116],v[124]);CE(v[117],v[125]);CE(v[118],v[126]);CE(v[119],v[127]);CE(v[112],v[116]);CE(v[113],v[117]);CE(v[114],v[118]);CE(v[115],v[119]);CE(v[120],v[124]);CE(v[121],v[125]);CE(v[122],v[126]);CE(v[123],v[127]);CE(v[112],v[114]);CE(v[113],v[115]);CE(v[116],v[118]);CE(v[117],v[119]);CE(v[120],v[122]);CE(v[121],v[123]);CE(v[124],v[126]);CE(v[125],v[127]);CE(v[112],v[113]);CE(v[114],v[115]);CE(v[116],v[117]);CE(v[118],v[119]);CE(v[120],v[121]);CE(v[122],v[123]);CE(v[124],v[125]);CE(v[126],v[127]); \
  v[0]=vmaxf(v[0],v[31]);v[1]=vmaxf(v[1],v[30]);v[2]=vmaxf(v[2],v[29]);v[3]=vmaxf(v[3],v[28]);v[4]=vmaxf(v[4],v[27]);v[5]=vmaxf(v[5],v[26]);v[6]=vmaxf(v[6],v[25]);v[7]=vmaxf(v[7],v[24]);v[8]=vmaxf(v[8],v[23]);v[9]=vmaxf(v[9],v[22]);v[10]=vmaxf(v[10],v[21]);v[11]=vmaxf(v[11],v[20]);v[12]=vmaxf(v[12],v[19]);v[13]=vmaxf(v[13],v[18]);v[14]=vmaxf(v[14],v[17]);v[15]=vmaxf(v[15],v[16]);CE(v[0],v[8]);CE(v[1],v[9]);CE(v[2],v[10]);CE(v[3],v[11]);CE(v[4],v[12]);CE(v[5],v[13]);CE(v[6],v[14]);CE(v[7],v[15]);CE(v[0],v[4]);CE(v[1],v[5]);CE(v[2],v[6]);CE(v[3],v[7]);CE(v[8],v[12]);CE(v[9],v[13]);CE(v[10],v[14]);CE(v[11],v[15]);CE(v[0],v[2]);CE(v[1],v[3]);CE(v[4],v[6]);CE(v[5],v[7]);CE(v[8],v[10]);CE(v[9],v[11]);CE(v[12],v[14]);CE(v[13],v[15]);CE(v[0],v[1]);CE(v[2],v[3]);CE(v[4],v[5]);CE(v[6],v[7]);CE(v[8],v[9]);CE(v[10],v[11]);CE(v[12],v[13]);CE(v[14],v[15]); \
  v[32]=vmaxf(v[32],v[63]);v[33]=vmaxf(v[33],v[62]);v[34]=vmaxf(v[34],v[61]);v[35]=vmaxf(v[35],v[60]);v[36]=vmaxf(v[36],v[59]);v[37]=vmaxf(v[37],v[58]);v[38]=vmaxf(v[38],v[57]);v[39]=vmaxf(v[39],v[56]);v[40]=vmaxf(v[40],v[55]);v[41]=vmaxf(v[41],v[54]);v[42]=vmaxf(v[42],v[53]);v[43]=vmaxf(v[43],v[52]);v[44]=vmaxf(v[44],v[51]);v[45]=vmaxf(v[45],v[50]);v[46]=vmaxf(v[46],v[49]);v[47]=vmaxf(v[47],v[48]);CE(v[32],v[40]);CE(v[33],v[41]);CE(v[34],v[42]);CE(v[35],v[43]);CE(v[36],v[44]);CE(v[37],v[45]);CE(v[38],v[46]);CE(v[39],v[47]);CE(v[32],v[36]);CE(v[33],v[37]);CE(v[34],v[38]);CE(v[35],v[39]);CE(v[40],v[44]);CE(v[41],v[45]);CE(v[42],v[46]);CE(v[43],v[47]);CE(v[32],v[34]);CE(v[33],v[35]);CE(v[36],v[38]);CE(v[37],v[39]);CE(v[40],v[42]);CE(v[41],v[43]);CE(v[44],v[46]);CE(v[45],v[47]);CE(v[32],v[33]);CE(v[34],v[35]);CE(v[36],v[37]);CE(v[38],v[39]);CE(v[40],v[41]);CE(v[42],v[43]);CE(v[44],v[45]);CE(v[46],v[47]); \
  v[64]=vmaxf(v[64],v[95]);v[65]=vmaxf(v[65],v[94]);v[66]=vmaxf(v[66],v[93]);v[67]=vmaxf(v[67],v[92]);v[68]=vmaxf(v[68],v[91]);v[69]=vmaxf(v[69],v[90]);v[70]=vmaxf(v[70],v[89]);v[71]=vmaxf(v[71],v[88]);v[72]=vmaxf(v[72],v[87]);v[73]=vmaxf(v[73],v[86]);v[74]=vmaxf(v[74],v[85]);v[75]=vmaxf(v[75],v[84]);v[76]=vmaxf(v[76],v[83]);v[77]=vmaxf(v[77],v[82]);v[78]=vmaxf(v[78],v[81]);v[79]=vmaxf(v[79],v[80]);CE(v[64],v[72]);CE(v[65],v[73]);CE(v[66],v[74]);CE(v[67],v[75]);CE(v[68],v[76]);CE(v[69],v[77]);CE(v[70],v[78]);CE(v[71],v[79]);CE(v[64],v[68]);CE(v[65],v[69]);CE(v[66],v[70]);CE(v[67],v[71]);CE(v[72],v[76]);CE(v[73],v[77]);CE(v[74],v[78]);CE(v[75],v[79]);CE(v[64],v[66]);CE(v[65],v[67]);CE(v[68],v[70]);CE(v[69],v[71]);CE(v[72],v[74]);CE(v[73],v[75]);CE(v[76],v[78]);CE(v[77],v[79]);CE(v[64],v[65]);CE(v[66],v[67]);CE(v[68],v[69]);CE(v[70],v[71]);CE(v[72],v[73]);CE(v[74],v[75]);CE(v[76],v[77]);CE(v[78],v[79]); \
  v[96]=vmaxf(v[96],v[127]);v[97]=vmaxf(v[97],v[126]);v[98]=vmaxf(v[98],v[125]);v[99]=vmaxf(v[99],v[124]);v[100]=vmaxf(v[100],v[123]);v[101]=vmaxf(v[101],v[122]);v[102]=vmaxf(v[102],v[121]);v[103]=vmaxf(v[103],v[120]);v[104]=vmaxf(v[104],v[119]);v[105]=vmaxf(v[105],v[118]);v[106]=vmaxf(v[106],v[117]);v[107]=vmaxf(v[107],v[116]);v[108]=vmaxf(v[108],v[115]);v[109]=vmaxf(v[109],v[114]);v[110]=vmaxf(v[110],v[113]);v[111]=vmaxf(v[111],v[112]);CE(v[96],v[104]);CE(v[97],v[105]);CE(v[98],v[106]);CE(v[99],v[107]);CE(v[100],v[108]);CE(v[101],v[109]);CE(v[102],v[110]);CE(v[103],v[111]);CE(v[96],v[100]);CE(v[97],v[101]);CE(v[98],v[102]);CE(v[99],v[103]);CE(v[104],v[108]);CE(v[105],v[109]);CE(v[106],v[110]);CE(v[107],v[111]);CE(v[96],v[98]);CE(v[97],v[99]);CE(v[100],v[102]);CE(v[101],v[103]);CE(v[104],v[106]);CE(v[105],v[107]);CE(v[108],v[110]);CE(v[109],v[111]);CE(v[96],v[97]);CE(v[98],v[99]);CE(v[100],v[101]);CE(v[102],v[103]);CE(v[104],v[105]);CE(v[106],v[107]);CE(v[108],v[109]);CE(v[110],v[111]); \
  v[0]=vmaxf(v[0],v[47]);v[1]=vmaxf(v[1],v[46]);v[2]=vmaxf(v[2],v[45]);v[3]=vmaxf(v[3],v[44]);v[4]=vmaxf(v[4],v[43]);v[5]=vmaxf(v[5],v[42]);v[6]=vmaxf(v[6],v[41]);v[7]=vmaxf(v[7],v[40]);v[8]=vmaxf(v[8],v[39]);v[9]=vmaxf(v[9],v[38]);v[10]=vmaxf(v[10],v[37]);v[11]=vmaxf(v[11],v[36]);v[12]=vmaxf(v[12],v[35]);v[13]=vmaxf(v[13],v[34]);v[14]=vmaxf(v[14],v[33]);v[15]=vmaxf(v[15],v[32]);CE(v[0],v[8]);CE(v[1],v[9]);CE(v[2],v[10]);CE(v[3],v[11]);CE(v[4],v[12]);CE(v[5],v[13]);CE(v[6],v[14]);CE(v[7],v[15]);CE(v[0],v[4]);CE(v[1],v[5]);CE(v[2],v[6]);CE(v[3],v[7]);CE(v[8],v[12]);CE(v[9],v[13]);CE(v[10],v[14]);CE(v[11],v[15]);CE(v[0],v[2]);CE(v[1],v[3]);CE(v[4],v[6]);CE(v[5],v[7]);CE(v[8],v[10]);CE(v[9],v[11]);CE(v[12],v[14]);CE(v[13],v[15]);CE(v[0],v[1]);CE(v[2],v[3]);CE(v[4],v[5]);CE(v[6],v[7]);CE(v[8],v[9]);CE(v[10],v[11]);CE(v[12],v[13]);CE(v[14],v[15]); \
  v[64]=vmaxf(v[64],v[111]);v[65]=vmaxf(v[65],v[110]);v[66]=vmaxf(v[66],v[109]);v[67]=vmaxf(v[67],v[108]);v[68]=vmaxf(v[68],v[107]);v[69]=vmaxf(v[69],v[106]);v[70]=vmaxf(v[70],v[105]);v[71]=vmaxf(v[71],v[104]);v[72]=vmaxf(v[72],v[103]);v[73]=vmaxf(v[73],v[102]);v[74]=vmaxf(v[74],v[101]);v[75]=vmaxf(v[75],v[100]);v[76]=vmaxf(v[76],v[99]);v[77]=vmaxf(v[77],v[98]);v[78]=vmaxf(v[78],v[97]);v[79]=vmaxf(v[79],v[96]);CE(v[64],v[72]);CE(v[65],v[73]);CE(v[66],v[74]);CE(v[67],v[75]);CE(v[68],v[76]);CE(v[69],v[77]);CE(v[70],v[78]);CE(v[71],v[79]);CE(v[64],v[68]);CE(v[65],v[69]);CE(v[66],v[70]);CE(v[67],v[71]);CE(v[72],v[76]);CE(v[73],v[77]);CE(v[74],v[78]);CE(v[75],v[79]);CE(v[64],v[66]);CE(v[65],v[67]);CE(v[68],v[70]);CE(v[69],v[71]);CE(v[72],v[74]);CE(v[73],v[75]);CE(v[76],v[78]);CE(v[77],v[79]);CE(v[64],v[65]);CE(v[66],v[67]);CE(v[68],v[69]);CE(v[70],v[71]);CE(v[72],v[73]);CE(v[74],v[75]);CE(v[76],v[77]);CE(v[78],v[79]); \
  v[0]=vmaxf(v[0],v[79]);v[1]=vmaxf(v[1],v[78]);v[2]=vmaxf(v[2],v[77]);v[3]=vmaxf(v[3],v[76]);v[4]=vmaxf(v[4],v[75]);v[5]=vmaxf(v[5],v[74]);v[6]=vmaxf(v[6],v[73]);v[7]=vmaxf(v[7],v[72]);v[8]=vmaxf(v[8],v[71]);v[9]=vmaxf(v[9],v[70]);v[10]=vmaxf(v[10],v[69]);v[11]=vmaxf(v[11],v[68]);v[12]=vmaxf(v[12],v[67]);v[13]=vmaxf(v[13],v[66]);v[14]=vmaxf(v[14],v[65]);v[15]=vmaxf(v[15],v[64]);CE(v[0],v[8]);CE(v[1],v[9]);CE(v[2],v[10]);CE(v[3],v[11]);CE(v[4],v[12]);CE(v[5],v[13]);CE(v[6],v[14]);CE(v[7],v[15]);CE(v[0],v[4]);CE(v[1],v[5]);CE(v[2],v[6]);CE(v[3],v[7]);CE(v[8],v[12]);CE(v[9],v[13]);CE(v[10],v[14]);CE(v[11],v[15]);CE(v[0],v[2]);CE(v[1],v[3]);CE(v[4],v[6]);CE(v[5],v[7]);CE(v[8],v[10]);CE(v[9],v[11]);CE(v[12],v[14]);CE(v[13],v[15]);CE(v[0],v[1]);CE(v[2],v[3]);CE(v[4],v[5]);CE(v[6],v[7]);CE(v[8],v[9]);CE(v[10],v[11]);CE(v[12],v[13]);CE(v[14],v[15]); \
} while (0)
#define TOPK_SORT32(v) do { \
  CE(v[0],v[1]);CE(v[3],v[2]);CE(v[4],v[5]);CE(v[7],v[6]);CE(v[8],v[9]);CE(v[11],v[10]);CE(v[12],v[13]);CE(v[15],v[14]);CE(v[0],v[2]);CE(v[1],v[3]);CE(v[6],v[4]);CE(v[7],v[5]);CE(v[8],v[10]);CE(v[9],v[11]);CE(v[14],v[12]);CE(v[15],v[13]);CE(v[0],v[1]);CE(v[2],v[3]);CE(v[5],v[4]);CE(v[7],v[6]);CE(v[8],v[9]);CE(v[10],v[11]);CE(v[13],v[12]);CE(v[15],v[14]);CE(v[0],v[4]);CE(v[1],v[5]);CE(v[2],v[6]);CE(v[3],v[7]);CE(v[12],v[8]);CE(v[13],v[9]);CE(v[14],v[10]);CE(v[15],v[11]);CE(v[0],v[2]);CE(v[1],v[3]);CE(v[4],v[6]);CE(v[5],v[7]);CE(v[10],v[8]);CE(v[11],v[9]);CE(v[14],v[12]);CE(v[15],v[13]);CE(v[0],v[1]);CE(v[2],v[3]);CE(v[4],v[5]);CE(v[6],v[7]);CE(v[9],v[8]);CE(v[11],v[10]);CE(v[13],v[12]);CE(v[15],v[14]);CE(v[0],v[8]);CE(v[1],v[9]);CE(v[2],v[10]);CE(v[3],v[11]);CE(v[4],v[12]);CE(v[5],v[13]);CE(v[6],v[14]);CE(v[7],v[15]);CE(v[0],v[4]);CE(v[1],v[5]);CE(v[2],v[6]);CE(v[3],v[7]);CE(v[8],v[12]);CE(v[9],v[13]);CE(v[10],v[14]);CE(v[11],v[15]);CE(v[0],v[2]);CE(v[1],v[3]);CE(v[4],v[6]);CE(v[5],v[7]);CE(v[8],v[10]);CE(v[9],v[11]);CE(v[12],v[14]);CE(v[13],v[15]);CE(v[0],v[1]);CE(v[2],v[3]);CE(v[4],v[5]);CE(v[6],v[7]);CE(v[8],v[9]);CE(v[10],v[11]);CE(v[12],v[13]);CE(v[14],v[15]); \
  CE(v[16],v[17]);CE(v[19],v[18]);CE(v[20],v[21]);CE(v[23],v[22]);CE(v[24],v[25]);CE(v[27],v[26]);CE(v[28],v[29]);CE(v[31],v[30]);CE(v[16],v[18]);CE(v[17],v[19]);CE(v[22],v[20]);CE(v[23],v[21]);CE(v[24],v[26]);CE(v[25],v[27]);CE(v[30],v[28]);CE(v[31],v[29]);CE(v[16],v[17]);CE(v[18],v[19]);CE(v[21],v[20]);CE(v[23],v[22]);CE(v[24],v[25]);CE(v[26],v[27]);CE(v[29],v[28]);CE(v[31],v[30]);CE(v[16],v[20]);CE(v[17],v[21]);CE(v[18],v[22]);CE(v[19],v[23]);CE(v[28],v[24]);CE(v[29],v[25]);CE(v[30],v[26]);CE(v[31],v[27]);CE(v[16],v[18]);CE(v[17],v[19]);CE(v[20],v[22]);CE(v[21],v[23]);CE(v[26],v[24]);CE(v[27],v[25]);CE(v[30],v[28]);CE(v[31],v[29]);CE(v[16],v[17]);CE(v[18],v[19]);CE(v[20],v[21]);CE(v[22],v[23]);CE(v[25],v[24]);CE(v[27],v[26]);CE(v[29],v[28]);CE(v[31],v[30]);CE(v[16],v[24]);CE(v[17],v[25]);CE(v[18],v[26]);CE(v[19],v[27]);CE(v[20],v[28]);CE(v[21],v[29]);CE(v[22],v[30]);CE(v[23],v[31]);CE(v[16],v[20]);CE(v[17],v[21]);CE(v[18],v[22]);CE(v[19],v[23]);CE(v[24],v[28]);CE(v[25],v[29]);CE(v[26],v[30]);CE(v[27],v[31]);CE(v[16],v[18]);CE(v[17],v[19]);CE(v[20],v[22]);CE(v[21],v[23]);CE(v[24],v[26]);CE(v[25],v[27]);CE(v[28],v[30]);CE(v[29],v[31]);CE(v[16],v[17]);CE(v[18],v[19]);CE(v[20],v[21]);CE(v[22],v[23]);CE(v[24],v[25]);CE(v[26],v[27]);CE(v[28],v[29]);CE(v[30],v[31]); \
  v[0]=vmaxf(v[0],v[31]);v[1]=vmaxf(v[1],v[30]);v[2]=vmaxf(v[2],v[29]);v[3]=vmaxf(v[3],v[28]);v[4]=vmaxf(v[4],v[27]);v[5]=vmaxf(v[5],v[26]);v[6]=vmaxf(v[6],v[25]);v[7]=vmaxf(v[7],v[24]);v[8]=vmaxf(v[8],v[23]);v[9]=vmaxf(v[9],v[22]);v[10]=vmaxf(v[10],v[21]);v[11]=vmaxf(v[11],v[20]);v[12]=vmaxf(v[12],v[19]);v[13]=vmaxf(v[13],v[18]);v[14]=vmaxf(v[14],v[17]);v[15]=vmaxf(v[15],v[16]);CE(v[0],v[8]);CE(v[1],v[9]);CE(v[2],v[10]);CE(v[3],v[11]);CE(v[4],v[12]);CE(v[5],v[13]);CE(v[6],v[14]);CE(v[7],v[15]);CE(v[0],v[4]);CE(v[1],v[5]);CE(v[2],v[6]);CE(v[3],v[7]);CE(v[8],v[12]);CE(v[9],v[13]);CE(v[10],v[14]);CE(v[11],v[15]);CE(v[0],v[2]);CE(v[1],v[3]);CE(v[4],v[6]);CE(v[5],v[7]);CE(v[8],v[10]);CE(v[9],v[11]);CE(v[12],v[14]);CE(v[13],v[15]);CE(v[0],v[1]);CE(v[2],v[3]);CE(v[4],v[5]);CE(v[6],v[7]);CE(v[8],v[9]);CE(v[10],v[11]);CE(v[12],v[13]);CE(v[14],v[15]); \
} while (0)
#define TOPK_MERGE_BITONIC16(v) do { \
  CE(v[0],v[8]);CE(v[1],v[9]);CE(v[2],v[10]);CE(v[3],v[11]);CE(v[4],v[12]);CE(v[5],v[13]);CE(v[6],v[14]);CE(v[7],v[15]);CE(v[0],v[4]);CE(v[1],v[5]);CE(v[2],v[6]);CE(v[3],v[7]);CE(v[8],v[12]);CE(v[9],v[13]);CE(v[10],v[14]);CE(v[11],v[15]);CE(v[0],v[2]);CE(v[1],v[3]);CE(v[4],v[6]);CE(v[5],v[7]);CE(v[8],v[10]);CE(v[9],v[11]);CE(v[12],v[14]);CE(v[13],v[15]);CE(v[0],v[1]);CE(v[2],v[3]);CE(v[4],v[5]);CE(v[6],v[7]);CE(v[8],v[9]);CE(v[10],v[11]);CE(v[12],v[13]);CE(v[14],v[15]); \
} while (0)
#define TOPK_PAIRS(X) \
  X(0,0,0) X(1,0,1) X(2,0,2) X(3,0,3) X(4,0,4) X(5,0,5) X(6,0,6) X(7,0,7) X(8,0,8) X(9,0,9) X(10,0,10) X(11,0,11) X(12,0,12) X(13,0,13) X(14,0,14) X(15,0,15) X(16,1,1) X(17,1,2) X(18,1,3) X(19,1,4) X(20,1,5) X(21,1,6) X(22,1,7) X(23,2,2) X(24,2,3) X(25,2,4) X(26,3,3)

namespace tk {
typedef float f32x16 __attribute__((ext_vector_type(16)));
__device__ __forceinline__ float vmaxf(float a, float b) { float r; asm("v_max_f32 %0, %1, %2" : "=v"(r) : "v"(a), "v"(b)); return r; }
__device__ __forceinline__ float vminf(float a, float b) { float r; asm("v_min_f32 %0, %1, %2" : "=v"(r) : "v"(a), "v"(b)); return r; }
#define CE(x, y) do { const float h_ = vmaxf(x, y); y = vminf(x, y); x = h_; } while (0)
__device__ __forceinline__ unsigned fbits(float f) { return __float_as_uint(f); }
__device__ __forceinline__ float bitsf(unsigned u) { return __uint_as_float(u); }
__device__ __forceinline__ unsigned byte_lookup(const unsigned (&pk)[4], unsigned i) {
    const unsigned long long lo = (unsigned long long)pk[0] | ((unsigned long long)pk[1] << 32), hi_ = (unsigned long long)pk[2] | ((unsigned long long)pk[3] << 32);
    const unsigned long long s = (i & 8u) ? hi_ : lo;
    return (unsigned)(s >> ((i & 7u) * 8u)) & 0x7Fu;
}
constexpr float PADV = -3.0e38f;

template <int VAR>
__device__ __forceinline__ void topk_phase(Frame& F) {
    const int lane = F.lane, r32 = lane & 31, hi = lane >> 5, wid = F.wave, tid = F.tid;
    LAS unsigned char* lds = F.lds;
    const unsigned char* SUBK = F.ws + WS_SUBK; const bf16* Q = (const bf16*)(F.ws + WS_Q);
    int* IDX = (int*)(F.ws + (VAR ? 360 * MiB : WS_IDX)); float* G = (float*)(F.ws + (VAR ? 376 * MiB : WS_G));
    int cur_h = -1;
    for (int it = (int)blockIdx.x; it < 8 * (T / 256); it += F.G) {
        const int h = it & 7, chunk = it >> 3;
        if (h != cur_h) {
            __syncthreads();
            for (int i = tid; i < 4096; i += NWAVES * 64) { const int ch = i & 15, pn = i >> 4;
                *(LAS v4u*)(lds + (pn >> 7) * 32768 + ch * 2048 + (pn & 127) * 16) = *(const GAS v4u*)(SUBK + (size_t)h * 65536 + (size_t)pn * 256 + ch * 16); }
            __syncthreads();
            cur_h = h;
        }
        asm volatile("; TOPK_BEGIN");
        const int t = chunk * 256 + wid * 32 + r32;
        if (VAR == 0 || VAR == 1 || VAR == 4)
        {
            const float2 st = ln1_row_stats((const float2*)(F.ws + WS_STATS), t);
            const int dcol = 128 * h + 4 * r32;
            const f32x4 g1 = *(const GAS f32x4*)(F.in[5] + dcol), b1 = *(const GAS f32x4*)(F.in[6] + dcol);
            bf16* X1B = (bf16*)(F.ws + WS_X1B);
#pragma unroll
            for (int i = 0; i < 16; ++i) {
                const float m0_ = __uint_as_float(__builtin_amdgcn_readlane(__float_as_uint(st.x), 2 * i)), m1_ = __uint_as_float(__builtin_amdgcn_readlane(__float_as_uint(st.x), 2 * i + 1));
                const float r0_ = __uint_as_float(__builtin_amdgcn_readlane(__float_as_uint(st.y), 2 * i)), r1_ = __uint_as_float(__builtin_amdgcn_readlane(__float_as_uint(st.y), 2 * i + 1));
                const float mu = hi ? m1_ : m0_, rs = hi ? r1_ : r0_;
                const size_t off = (size_t)(chunk * 256 + wid * 32 + 2 * i + hi) * D_MODEL + dcol;
                const u32x2 yw = *(const GAS u32x2*)(X1B + off);
                const f32x4 y4 = {__uint_as_float(yw.x << 16), __uint_as_float(yw.x & 0xffff0000u), __uint_as_float(yw.y << 16), __uint_as_float(yw.y & 0xffff0000u)};
                const f32x4 x4 = (y4 - mu) * rs * g1 + b1;
                u32x2 w; w.x = pk2(x4.x, x4.y); w.y = pk2(x4.z, x4.w);
                const unsigned wq = q8x4(x4.x * X_QS, x4.y * X_QS, x4.z * X_QS, x4.w * X_QS);
                if (VAR == 0) { *(GAS u32x2*)(X1B + off) = w; *(GAS unsigned*)(F.ws + WS_X1Q + off) = wq; } else asm volatile("" :: "v"(w.x), "v"(w.y), "v"(wq));
            }
        }
        float v[128];
        {
            f32x16 acc[2][4];
#pragma unroll
            for (int p = 0; p < 2; ++p)
#pragma unroll
                for (int nt = 0; nt < 4; ++nt)
#pragma unroll
                    for (int r = 0; r < 16; ++r) acc[p][nt][r] = 0.f;
#pragma unroll
            for (int p = 0; p < 2; ++p) {
                bf16x8 bq[8];
#pragma unroll
                for (int ks = 0; ks < 8; ++ks) bq[ks] = *(const GAS bf16x8*)(Q + ((size_t)(t >> 5) * 8192 + (size_t)(h * 32 + p * 16 + ks * 2 + hi) * 32 + r32) * 8);
#pragma unroll
                for (int ks = 0; ks < 8; ++ks)
#pragma unroll
                    for (int nt = 0; nt < 4; ++nt) {
                        const bf16x8 a = *(const LAS bf16x8*)(lds + p * 32768 + (2 * ks + hi) * 2048 + (nt * 32 + r32) * 16);
                        acc[p][nt] = __builtin_amdgcn_mfma_f32_32x32x16_bf16(a, bq[ks], acc[p][nt], 0, 0, 0);
                    }
            }
#pragma unroll
            for (int nt = 0; nt < 4; ++nt)
#pragma unroll
                for (int r = 0; r < 16; ++r) {
                    auto rr = __builtin_amdgcn_permlane32_swap(fbits(acc[0][nt][r]), fbits(acc[1][nt][r]), false, false);
                    const unsigned n0 = 32 * nt + (r & 3) + 8 * (r >> 2);
                    v[nt * 32 + r] = bitsf((rr[0] & 0xFFFFFF80u) | n0);
                    v[nt * 32 + 16 + r] = bitsf((rr[1] & 0xFFFFFF80u) | (n0 + 4u));
                }
        }
        unsigned pf0 = 0, pf1 = 0, pf2 = 0, pf3 = 0;
        if (it + F.G < 8 * (T / 256)) {
            const int hn = (it + F.G) & 7, chn = (it + F.G) >> 3, tgn = chn * 8 + wid;
            const unsigned char* qn_ = (const unsigned char*)Q + ((size_t)tgn * 8192 + (size_t)hn * 1024) * 16;
            pf0 = *(const GAS unsigned*)(qn_ + lane * 128); pf1 = *(const GAS unsigned*)(qn_ + (64 + lane) * 128);
            pf2 = *(const GAS unsigned*)((const unsigned char*)(F.ws + WS_X1B) + ((size_t)(tgn * 32 + (lane >> 1)) * D_MODEL + 128 * hn) * 2 + (lane & 1) * 128);
            pf3 = *(const GAS unsigned*)((const unsigned char*)(F.ws + WS_STATS) + (size_t)(tgn * 32 + (lane & 31)) * 128);
        }
        if (VAR == 2 || VAR == 4 || VAR == 5) { _Pragma("unroll") for (int i_ = 16; i_ < 128; ++i_) asm volatile("" :: "v"(v[i_])); } else
        TOPK_SORT128(v);
        unsigned ak[16], bk[16]; float uval[16], wval[16];
#pragma unroll
        for (int i = 0; i < 16; ++i) {
            auto rr = __builtin_amdgcn_permlane32_swap(fbits(v[i]), fbits(v[i]), false, false);
            ak[i] = rr[0]; bk[i] = rr[1];
            const unsigned oth = hi ? rr[0] : rr[1];
            uval[i] = bitsf(fbits(v[i]) & 0xFFFFFF80u); wval[i] = bitsf(oth & 0xFFFFFF80u);
        }
        unsigned na_pack[4], nb_pack[4];
#pragma unroll
        for (int q = 0; q < 4; ++q) {
            na_pack[q] = (ak[4 * q] & 0x7Fu) | ((ak[4 * q + 1] & 0x7Fu) << 8) | ((ak[4 * q + 2] & 0x7Fu) << 16) | ((ak[4 * q + 3] & 0x7Fu) << 24);
            nb_pack[q] = (bk[4 * q] & 0x7Fu) | ((bk[4 * q + 1] & 0x7Fu) << 8) | ((bk[4 * q + 2] & 0x7Fu) << 16) | ((bk[4 * q + 3] & 0x7Fu) << 24);
        }
        float cand[32];
        const unsigned hb = (unsigned)hi << 8;
#define TK_X(k, i, j) { const float s_ = uval[i] + wval[j]; unsigned kb_ = (fbits(s_) & 0xFFFFFE00u) | hb | (unsigned)((i) * 16 + (j)); if ((i) == (j)) kb_ = hi ? fbits(PADV) : kb_; cand[k] = bitsf(kb_); }
        TOPK_PAIRS(TK_X)
#undef TK_X
#pragma unroll
        for (int k = 27; k < 32; ++k) cand[k] = PADV;
        if (VAR == 3 || VAR == 4 || VAR == 5) { _Pragma("unroll") for (int i_ = 16; i_ < 32; ++i_) asm volatile("" :: "v"(cand[i_])); } else
        TOPK_SORT32(cand);
        float fin[16];
        {
            unsigned oc[16];
#pragma unroll
            for (int i = 0; i < 16; ++i) { auto rr = __builtin_amdgcn_permlane32_swap(fbits(cand[i]), fbits(cand[i]), false, false); oc[i] = hi ? rr[0] : rr[1]; }
#pragma unroll
            for (int i = 0; i < 16; ++i) fin[i] = vmaxf(cand[i], bitsf(oc[15 - i]));
        }
        TOPK_MERGE_BITONIC16(fin);
        float e[16]; float esum = 0.f; const float m0 = bitsf(fbits(fin[0]) & 0xFFFFFE00u);
#pragma unroll
        for (int k = 0; k < 16; ++k) { e[k] = __builtin_amdgcn_exp2f((bitsf(fbits(fin[k]) & 0xFFFFFE00u) - m0) * LOG2E); esum += e[k]; }
        const float inv = 1.f / esum;
        int oi[8]; float og[8];
#pragma unroll
        for (int kk = 0; kk < 8; ++kk) {
            const unsigned key = hi ? fbits(fin[8 + kk]) : fbits(fin[kk]); og[kk] = (hi ? e[8 + kk] : e[kk]) * inv;
            const unsigned code = key & 0x1FFu, f = code >> 8, ci = (code >> 4) & 15u, cj = code & 15u;
            const unsigned ia = f ? cj : ci, jb = f ? ci : cj;
            oi[kk] = (int)(byte_lookup(na_pack, ia) * 128u + byte_lookup(nb_pack, jb));
        }
        int* ip = IDX + ((size_t)t * PEER_H + h) * TOPK + 8 * hi; float* gp = G + ((size_t)t * PEER_H + h) * TOPK + 8 * hi;
        *(GAS v4u*)ip = (v4u){(unsigned)oi[0], (unsigned)oi[1], (unsigned)oi[2], (unsigned)oi[3]}; *(GAS v4u*)(ip + 4) = (v4u){(unsigned)oi[4], (unsigned)oi[5], (unsigned)oi[6], (unsigned)oi[7]};
        *(GAS f32x4*)gp = (f32x4){og[0], og[1], og[2], og[3]}; *(GAS f32x4*)(gp + 4) = (f32x4){og[4], og[5], og[6], og[7]};
        asm volatile("" :: "v"(pf0), "v"(pf1), "v"(pf2), "v"(pf3));
        asm volatile("; TOPK_END");
    }
}
#undef CE
}


namespace ex {
typedef float f32x2 __attribute__((ext_vector_type(2)));
typedef _Float16 h16x2 __attribute__((ext_vector_type(2)));
__device__ __forceinline__ float gelu_erf(float v) {
    const float av = fabsf(v), t = __builtin_amdgcn_rcpf(fmaf(av, 0.2316418882f, 1.0f));
    float q = fmaf(t, 0.5307027145f, -0.7265760135f); q = fmaf(q, t, 0.7107068705f); q = fmaf(q, t, -0.142248368f); q = fmaf(q, t, 0.127414796f); q = q * t;
    const float ee = __builtin_amdgcn_exp2f(v * v * -0.72134752044f);
    const float mm = v * (q * ee);
    return v < 0.f ? mm : v - mm;
}
__device__ __forceinline__ f32x2 bf2_to_f2(unsigned w) { return (f32x2){__uint_as_float(w << 16), __uint_as_float(w & 0xffff0000u)}; }

template <int PH> struct Aux;
template <> struct Aux<0> { v4u xq; };
template <> struct Aux<1> { v4u wv; unsigned x2; };

template <int PH>
__device__ __forceinline__ void gather_issue(Frame& F, v4u (&rw)[16], Aux<PH>& ax, const LAS unsigned* ixl, const unsigned char* tab, unsigned loff, int t, int i, int g, int dl) {
    v4u ix[4];
#pragma unroll
    for (int jj = 0; jj < 4; ++jj) ix[jj] = *(const LAS v4u*)(ixl + i * 128 + 16 * g + 4 * jj);
#pragma unroll
    for (int j = 0; j < 16; ++j) rw[j] = *(const GAS v4u*)(tab + (unsigned)(ix[j >> 2][j & 3] * 128u + loff));
    if constexpr (PH == 0) {
        ax.xq = *(const GAS v4u*)(F.ws + WS_X1Q + (size_t)t * D_MODEL + dl);
    } else {
        ax.wv = *(const GAS v4u*)(F.ws + WS_W16 + (size_t)t * 128 + 16 * g);
        ax.x2 = *(const GAS unsigned*)((const bf16*)(F.ws + WS_X1B) + (size_t)t * D_MODEL + dl + 2 * g);
    }
}
template <int PH, int VAR>
__device__ __forceinline__ void gather_compute(Frame& F, const v4u (&rw)[16], const Aux<PH>& ax, int slice, int t, int lane, int g, int sub, int dl) {
    if constexpr (PH == 0) {
        int p[16];
#pragma unroll
        for (int j = 0; j < 16; ++j) {
            int a_ = __builtin_amdgcn_sdot4((int)rw[j][0], (int)ax.xq[0], 0, false);
#pragma unroll
            for (int c = 1; c < 4; ++c) a_ = __builtin_amdgcn_sdot4((int)rw[j][c], (int)ax.xq[c], a_, false);
            p[j] = a_;
        }
        const bool b2 = (lane & 4) != 0, b1 = (lane & 2) != 0, b0 = (lane & 1) != 0;
#pragma unroll
        for (int k = 0; k < 8; ++k) { const int send = b2 ? p[k] : p[k + 8], keep = b2 ? p[k + 8] : p[k]; p[k] = keep + __builtin_amdgcn_update_dpp(0, send, 0x141, 0xF, 0xF, false); }
#pragma unroll
        for (int k = 0; k < 4; ++k) { const int send = b1 ? p[k] : p[k + 4], keep = b1 ? p[k + 4] : p[k]; p[k] = keep + __builtin_amdgcn_update_dpp(0, send, 0x4E, 0xF, 0xF, false); }
#pragma unroll
        for (int k = 0; k < 2; ++k) { const int send = b0 ? p[k] : p[k + 2], keep = b0 ? p[k + 2] : p[k]; p[k] = keep + __builtin_amdgcn_update_dpp(0, send, 0xB1, 0xF, 0xF, false); }
        const float pf0 = (float)p[0] * (1.f / (U_QS * X_QS)), pf1 = (float)p[1] * (1.f / (U_QS * X_QS));
        const h16x2 ph = {(_Float16)pf0, (_Float16)pf1};
        if (VAR == 0) *(GAS unsigned*)((_Float16*)(F.ws + WS_HP) + ((size_t)slice * T + t) * 128 + 16 * g + 2 * sub) = __builtin_bit_cast(unsigned, ph); else asm volatile("" :: "v"(pf0), "v"(pf1));
    } else {
        const f32x2 x2 = bf2_to_f2(ax.x2);
        const float wsc = ((const float*)(F.ws + WS_MR))[t];
        int acc[16];
#pragma unroll
        for (int c = 0; c < 16; ++c) acc[c] = 0;
#pragma unroll
        for (int q4 = 0; q4 < 4; ++q4) {
            const int w4 = (int)ax.wv[q4];
#pragma unroll
            for (int c = 0; c < 4; ++c) {
                const unsigned r0 = rw[4 * q4][c], r1 = rw[4 * q4 + 1][c], r2 = rw[4 * q4 + 2][c], r3 = rw[4 * q4 + 3][c];
                const unsigned lo01 = __builtin_amdgcn_perm(r1, r0, 0x05010400u), hi01 = __builtin_amdgcn_perm(r1, r0, 0x07030602u);
                const unsigned lo23 = __builtin_amdgcn_perm(r3, r2, 0x05010400u), hi23 = __builtin_amdgcn_perm(r3, r2, 0x07030602u);
                const unsigned d0 = __builtin_amdgcn_perm(lo23, lo01, 0x05040100u), d1 = __builtin_amdgcn_perm(lo23, lo01, 0x07060302u);
                const unsigned d2 = __builtin_amdgcn_perm(hi23, hi01, 0x05040100u), d3 = __builtin_amdgcn_perm(hi23, hi01, 0x07060302u);
                acc[4 * c] = __builtin_amdgcn_sdot4((int)d0, w4, acc[4 * c], false); acc[4 * c + 1] = __builtin_amdgcn_sdot4((int)d1, w4, acc[4 * c + 1], false);
                acc[4 * c + 2] = __builtin_amdgcn_sdot4((int)d2, w4, acc[4 * c + 2], false); acc[4 * c + 3] = __builtin_amdgcn_sdot4((int)d3, w4, acc[4 * c + 3], false);
            }
        }
#pragma unroll
        for (int k = 0; k < 8; ++k) { auto rr = __builtin_amdgcn_permlane32_swap((unsigned)acc[k], (unsigned)acc[k + 8], false, false); acc[k] = (int)rr[0] + (int)rr[1]; }
#pragma unroll
        for (int k = 0; k < 4; ++k) { auto rr = __builtin_amdgcn_permlane16_swap((unsigned)acc[k], (unsigned)acc[k + 4], false, false); acc[k] = (int)rr[0] + (int)rr[1]; }
        const bool b3 = (lane & 8) != 0;
#pragma unroll
        for (int k = 0; k < 2; ++k) { const int send = b3 ? acc[k] : acc[k + 2], keep = b3 ? acc[k + 2] : acc[k]; acc[k] = keep + __builtin_amdgcn_update_dpp(0, send, 0x128, 0xF, 0xF, false); }
        float a[2];
        a[0] = (float)acc[0] * wsc; a[1] = (float)acc[1] * wsc;
        f32x2 v2;
        v2.x = fmaf(ALPHA, x2.x, a[0]);
        v2.y = fmaf(ALPHA, x2.y, a[1]);
        if (VAR == 0) *(GAS unsigned*)((bf16*)(F.ws + WS_V2) + (size_t)t * D_MODEL + dl + 2 * g) = pk2(v2.x, v2.y);
    }
}

constexpr int GTW = 32;
template <int PH, int VAR>
__device__ __forceinline__ void gather_item(Frame& F, int slice_, int chunk_) {
    const int lane = F.lane, g = lane >> 3, sub = lane & 7;
    const int slice = __builtin_amdgcn_readfirstlane(slice_), chunk = __builtin_amdgcn_readfirstlane(chunk_);
    const unsigned char* tab = F.ws + (PH == 0 ? WS_EU : WS_EV) + (size_t)slice * EXP_SLICE_BYTES;
    const unsigned loff = 16u * (unsigned)sub;
    const int tbase = chunk * (8 * GTW) + F.wave * GTW;
    const int dl = 128 * slice + 16 * sub;
    LAS unsigned* ixl = (LAS unsigned*)(F.lds + F.wave * 16384);
    {
        const v4u* src = (const v4u*)((const int*)(F.ws + WS_IDX) + (size_t)tbase * 128);
        v4u tmp[GTW / 2];
#pragma unroll
        for (int k = 0; k < GTW / 2; ++k) tmp[k] = *(const GAS v4u*)(src + k * 64 + lane);
#pragma unroll
        for (int k = 0; k < GTW / 2; ++k) *(LAS v4u*)(ixl + (k * 64 + lane) * 4) = tmp[k];
    }
    v4u rwA[16], rwB[16]; Aux<PH> axA, axB;
    gather_issue<PH>(F, rwA, axA, ixl, tab, loff, tbase, 0, g, dl);
    if (VAR == 2) gather_issue<PH>(F, rwB, axB, ixl, tab, loff, tbase + 1, 1, g, dl);
#pragma unroll 4
    for (int i = 0; i < GTW; i += 2) {
        if (VAR != 2) gather_issue<PH>(F, rwB, axB, ixl, tab, loff, tbase + i + 1, i + 1, g, dl);
        if (VAR != 1) gather_compute<PH, VAR>(F, rwA, axA, slice, tbase + i, lane, g, sub, dl);
        else { _Pragma("unroll") for (int j = 0; j < 16; ++j) asm volatile("" :: "v"(rwA[j])); }
        const int in = (i + 2 < GTW) ? i + 2 : GTW - 1;
        if (VAR != 2) gather_issue<PH>(F, rwA, axA, ixl, tab, loff, tbase + in, in, g, dl);
        if (VAR != 1) gather_compute<PH, VAR>(F, rwB, axB, slice, tbase + i + 1, lane, g, sub, dl);
        else { _Pragma("unroll") for (int j = 0; j < 16; ++j) asm volatile("" :: "v"(rwB[j])); }
        if (VAR == 2) { _Pragma("unroll") for (int j = 0; j < 16; ++j) asm volatile("" : "+v"(rwA[j]), "+v"(rwB[j])); }
    }
}

template <int PH, int VAR = 0>
__device__ __forceinline__ void gather_phase(Frame& F) {
    LAS int* sh = (LAS int*)(F.lds + RING_BYTES + 1024);
    const unsigned xcc = xb_xcc_id() & 7u;
    gu32* qbase = F.ctl + (VAR ? CW_QV + 1024 : (PH == 0 ? CW_QU : CW_QV));
    for (int r = 0; r < 8; ++r) {
        const int qi = (int)((xcc + (unsigned)r) & 7u);
        for (;;) {
            if (F.tid == 0) sh[0] = (int)__hip_atomic_fetch_add(qbase + 64 * qi, 1u, __ATOMIC_RELAXED, __HIP_MEMORY_SCOPE_AGENT);
            __syncthreads();
            const int n = sh[0];
            __syncthreads();
            if (n >= T / (8 * GTW)) break;
            gather_item<PH, VAR>(F, qi, n);
        }
    }
}

__device__ __forceinline__ void combine_phase(Frame& F) {
    const _Float16* HP = (const _Float16*)(F.ws + WS_HP); const float* W = (const float*)(F.ws + WS_G);
    const int nthr = F.G * NWAVES * 64;
    for (int i = F.vcu * NWAVES * 64 + F.tid; i < T * 128 / 4; i += nthr) {
        f32x4 s = {0.f, 0.f, 0.f, 0.f};
#pragma unroll
        for (int sl = 0; sl < 8; ++sl) {
            const u32x2 hw = *(const GAS u32x2*)(HP + (size_t)sl * T * 128 + (size_t)i * 4);
            s[0] += (float)__builtin_bit_cast(_Float16, (unsigned short)(hw.x & 0xFFFFu)); s[1] += (float)__builtin_bit_cast(_Float16, (unsigned short)(hw.x >> 16));
            s[2] += (float)__builtin_bit_cast(_Float16, (unsigned short)(hw.y & 0xFFFFu)); s[3] += (float)__builtin_bit_cast(_Float16, (unsigned short)(hw.y >> 16));
        }
        const f32x4 gv = *(const GAS f32x4*)(W + (size_t)i * 4);
        float wv_[4]; float mx = 0.f;
#pragma unroll
        for (int e = 0; e < 4; ++e) { wv_[e] = gv[e] * gelu_erf(s[e]); mx = fmaxf(mx, fabsf(wv_[e])); }
#pragma unroll
        for (int o = 1; o < 32; o <<= 1) mx = fmaxf(mx, __shfl_xor(mx, o));
        const float sc = 127.f / fmaxf(mx, 1e-30f);
        *(GAS unsigned*)(F.ws + WS_W16 + (size_t)i * 4) = q8x4(wv_[0] * sc, wv_[1] * sc, wv_[2] * sc, wv_[3] * sc);
        if ((i & 31) == 0) ((float*)(F.ws + WS_MR))[i >> 5] = 1.f / (sc * SQ_V);
    }
}

__device__ __forceinline__ void ln2_phase(Frame& F) {
    const int lane = F.lane, gw = F.vcu * NWAVES + F.wave, NGW = F.G * NWAVES;
    const float* ln2_g = F.in[11]; const float* ln2_b = F.in[12];
    f32x4 gg[4], bb[4];
#pragma unroll
    for (int j = 0; j < 2; ++j) { gg[2 * j] = *(const GAS f32x4*)(ln2_g + 512 * j + 8 * lane); gg[2 * j + 1] = *(const GAS f32x4*)(ln2_g + 512 * j + 8 * lane + 4);
                                  bb[2 * j] = *(const GAS f32x4*)(ln2_b + 512 * j + 8 * lane); bb[2 * j + 1] = *(const GAS f32x4*)(ln2_b + 512 * j + 8 * lane + 4); }
    for (int t = gw; t < T; t += NGW) {
        const bf16* vrow = (const bf16*)(F.ws + WS_V2) + (size_t)t * D_MODEL;
        f32x4 v[4]; float s = 0.f;
#pragma unroll
        for (int j = 0; j < 2; ++j) { const v4u w = *(const GAS v4u*)(vrow + 512 * j + 8 * lane);
            v[2 * j] = (f32x4){__uint_as_float(w[0] << 16), __uint_as_float(w[0] & 0xffff0000u), __uint_as_float(w[1] << 16), __uint_as_float(w[1] & 0xffff0000u)};
            v[2 * j + 1] = (f32x4){__uint_as_float(w[2] << 16), __uint_as_float(w[2] & 0xffff0000u), __uint_as_float(w[3] << 16), __uint_as_float(w[3] & 0xffff0000u)}; }
#pragma unroll
        for (int j = 0; j < 4; ++j) s += (v[j].x + v[j].y) + (v[j].z + v[j].w);
        const float mean = wave_sum(s) * (1.f / D_MODEL); float s2 = 0.f;
#pragma unroll
        for (int j = 0; j < 4; ++j) { v[j] = v[j] - mean; s2 += (v[j].x * v[j].x + v[j].y * v[j].y) + (v[j].z * v[j].z + v[j].w * v[j].w); }
        const float rstd = 1.f / sqrtf(wave_sum(s2) * (1.f / D_MODEL) + LN_EPS);
        float* row = F.out + (size_t)t * D_MODEL;
#pragma unroll
        for (int j = 0; j < 2; ++j) { *(GAS f32x4*)(row + 512 * j + 8 * lane) = v[2 * j] * rstd * gg[2 * j] + bb[2 * j]; *(GAS f32x4*)(row + 512 * j + 8 * lane + 4) = v[2 * j + 1] * rstd * gg[2 * j + 1] + bb[2 * j + 1]; }
    }
}
}

struct Args { const float* in[13]; float* out; unsigned char* ws; int ph_lo, ph_hi; };
static_assert(sizeof(Args) == 13 * 8 + 8 + 8 + 8, "Args has no padding");
constexpr int N_PHASES = 10;

__global__ void __launch_bounds__(NWAVES * 64, 2) mk_fwd(Args args) {
    extern __shared__ __attribute__((aligned(16))) unsigned char lds[];
    Frame F;
    F.lds = (LAS unsigned char*)lds;
    F.MISC = (volatile LAS unsigned*)(F.lds + MISC_OFF);
    F.tid = threadIdx.x; F.lane = F.tid & 63; F.wave = __builtin_amdgcn_readfirstlane(F.tid >> 6);
    F.G = gridDim.x; { const int bx = blockIdx.x; F.vcu = (F.G % 8 == 0) ? (bx % 8) * (F.G / 8) + bx / 8 : bx; }
    F.ws = args.ws; F.out = args.out; F.ctl = (gu32*)(args.ws + WS_CTL);
#pragma unroll
    for (int i = 0; i < 13; ++i) F.in[i] = args.in[i];
    for (int u = F.tid; u < (LDS_BYTES - RING_BYTES) / 4; u += NWAVES * 64) ((LAS unsigned*)(F.lds + RING_BYTES))[u] = 0u;
    __syncthreads();
    XcdBarrier bar = xcd_barrier_post((unsigned*)(F.ctl + CW_BAR), F.MISC + 8);
    const int lo = args.ph_lo, hi = args.ph_hi;
#define IN(k) (lo <= (k) && (k) < hi)
#define SEAM(k) do { if (IN(k) && IN((k) + 1)) xcd_barrier(bar); } while (0)

    if (IN(0)) { p0_prologue(F); }
    SEAM(0);
    if (IN(1)) {
        pg8::Gemm g{(const pg8::bf16_t*)(F.ws + WS_XQ), (const pg8::bf16_t*)(F.ws + WS_WIN), T, NPHYS, D_MODEL / 2};
        pg8::StaticOrder S; S.init(T, NPHYS, F.G, (int)blockIdx.x);
        EpiInProj E{(bf16*)(F.ws + WS_FQ), (bf16*)(F.ws + WS_FKT), (bf16*)(F.ws + WS_FVT), (bf16*)(F.ws + WS_SQ), (bf16*)(F.ws + WS_SKT), (bf16*)(F.ws + WS_SVT),
                    (const float2*)(F.ws + WS_ROPE), (float*)(F.ws + WS_QN2), (float*)(F.ws + WS_KN2)};
        pg8::gemm_phase<EpiInProj, pg8::StaticOrder, true, true, true>(F.lds, g, S, E);
        if ((int)blockIdx.x >= F.G / 2) p1_slack_jobs(F, (int)blockIdx.x - F.G / 2, F.G - F.G / 2);
        else convert_experts(F, (int)blockIdx.x * NWAVES + F.wave, (F.G / 2) * NWAVES, EXP_SPLIT, 2 * NEXP);
    }
    SEAM(1);
    if (IN(2)) { att::attn_phase(F); }
    SEAM(2);
    if (IN(3)) {
        pg8::Gemm g{(const pg8::bf16_t*)(F.ws + WS_ATTN), (const pg8::bf16_t*)(F.ws + WS_WOUT), T, D_MODEL, D_MODEL / 2};
        pg8::StaticOrder S; S.init(T, D_MODEL, F.G, (int)blockIdx.x);
        EpiOutProj E{(bf16*)(F.ws + WS_XB), (float2*)(F.ws + WS_STATS)};
        pg8::gemm_phase<EpiOutProj, pg8::StaticOrder, true, true, true>(F.lds, g, S, E);
    }
    SEAM(3);
    if (IN(4)) {
        pg8::Gemm g{(const pg8::bf16_t*)(F.ws + WS_XB), (const pg8::bf16_t*)(F.ws + WS_WQ), T, QCOLS, D_MODEL};
        pg8::StaticOrder S; S.init(T, QCOLS, F.G, (int)blockIdx.x);
        EpiQuery E{(const float2*)(F.ws + WS_STATS), (const float*)(F.ws + WS_GW), (const float*)(F.ws + WS_GW) + QCOLS, (bf16*)(F.ws + WS_Q)};
        pg8::gemm_phase<EpiQuery, pg8::StaticOrder, true, true>(F.lds, g, S, E);
    }
    SEAM(4);
    if (IN(5)) { tk::topk_phase<0>(F); }
#ifdef P5_PROBE
    if (IN(5)) { xcd_barrier(bar); tk::topk_phase<P5_PROBE>(F); }
#endif
    SEAM(5);
    if (IN(6)) { ex::gather_phase<0>(F); }
    SEAM(6);
    if (IN(7)) { ex::combine_phase(F); }
    SEAM(7);
    if (IN(8)) { ex::gather_phase<1>(F); }
    SEAM(8);
#ifdef G_PROBE_PH
    if (IN(8)) { ex::gather_phase<G_PROBE_PH, G_PROBE_VAR>(F); xcd_barrier(bar); }
#endif
#ifdef EXTRA_BAR
    for (int eb = 0; eb < EXTRA_BAR; ++eb) xcd_barrier(bar);
#endif
    if (IN(9)) { ex::ln2_phase(F); }
#undef IN
#undef SEAM
}

#if DBG_STAGE > 0
constexpr int DBG_B = 5;
constexpr size_t DBG_BASE = 360 * MiB;
constexpr size_t DBG_ACC = 511 * MiB;
__device__ __forceinline__ float bf2f(bf16 v) { return __uint_as_float((unsigned)v << 16); }
__device__ __forceinline__ void dbg_acc(double* acc, int slot, float opt, float ref) {
    float d2 = (opt - ref) * (opt - ref), r2 = ref * ref;
    if (!(d2 == d2)) d2 = 1e30f;
    d2 = wave_sum(d2); r2 = wave_sum(r2);
    if ((threadIdx.x & 63) == 0) { atomicAdd(acc + 2 * slot, (double)d2); atomicAdd(acc + 2 * slot + 1, (double)r2); }
}
__global__ void __launch_bounds__(256) dbg_check_inproj(const float* __restrict__ proj, const unsigned char* __restrict__ ws, const float* __restrict__ cn, double* acc) {
    const int s = blockIdx.x, t = DBG_B * SEQ + s;
    const float* pr = proj + (size_t)s * IN_COLS;
    for (int j = threadIdx.x; j < 2304; j += 256) {
        float ref, opt; int slot;
        if (j < 1536) {
            const int which = j >> 9, hd = (j >> 6) & 7, d = j & 63;
            ref = pr[j];
            if (which == 0) { opt = bf2f(((const bf16*)(ws + WS_FQ))[(size_t)t * 512 + hd * 64 + d]) / C2; slot = 0; }
            else if (which == 1) { opt = bf2f(*(const bf16*)(ws + WS_FKT + EpiInProj::tile_off(8, t, hd) + (size_t)((d >> 3) * 64 + (t & 63)) * 16 + (d & 7) * 2)); slot = 1; }
            else { opt = bf2f(*(const bf16*)(ws + WS_FVT + EpiInProj::tile_off(8, t, hd) + (size_t)((d >> 5) * 4 + ((t & 63) >> 4)) * 1024 + (t & 15) * 64 + (d & 31) * 2)); slot = 2; }
        } else if (j < 2176) {
            const bool isq = j < 2048; const int r = isq ? j - 1536 : j - 2048, hd = r >> 6, d = r & 63, base = (isq ? OFF_SQ : OFF_SK) + hd * 64;
            float cs, sn; rope_cs(s, d & 31, cs, sn);
            ref = (d < 32) ? pr[base + d] * cs - pr[base + d + 32] * sn : pr[base + d] * cs + pr[base + d - 32] * sn;
            if (isq) { opt = bf2f(((const bf16*)(ws + WS_SQ))[(size_t)t * 512 + hd * 64 + d]) / C2; slot = 3; }
            else { opt = bf2f(*(const bf16*)(ws + WS_SKT + EpiInProj::tile_off(2, t, hd) + (size_t)((d >> 3) * 64 + (t & 63)) * 16 + (d & 7) * 2)); slot = 4; }
        } else {
            const int r = j - 2176, hd = r >> 6, d = r & 63;
            ref = pr[OFF_SV + r];
            opt = bf2f(*(const bf16*)(ws + WS_SVT + EpiInProj::tile_off(2, t, hd) + (size_t)((d >> 5) * 4 + ((t & 63) >> 4)) * 1024 + (t & 15) * 64 + (d & 31) * 2)); slot = 5;
        }
#pragma unroll
        for (int sl = 0; sl < 6; ++sl) dbg_acc(acc, sl, slot == sl ? opt : 0.f, slot == sl ? ref : 0.f);
    }
    if (threadIdx.x < 64) {
        const int h = threadIdx.x & 7;
        const float opt = (threadIdx.x < 8) ? ((const float*)(ws + WS_C))[(size_t)(DBG_B * 8 + h) * SEQ + s] : 0.f, ref = (threadIdx.x < 8) ? cn[(size_t)h * SEQ + s] : 0.f;
        dbg_acc(acc, 6, opt, ref);
    }
}
__global__ void __launch_bounds__(256) dbg_check_attn(const float* __restrict__ attn_n, const unsigned char* __restrict__ ws, double* acc) {
    const int s = blockIdx.x, t = DBG_B * SEQ + s;
    for (int j = threadIdx.x; j < 1024; j += 256) {
        const float ref = attn_n[(size_t)s * 1024 + j], opt = bf2f(((const bf16*)(ws + WS_ATTN))[(size_t)t * 1024 + j]);
        dbg_acc(acc, j >> 9, opt, ref);
    }
}
__global__ void __launch_bounds__(256) dbg_check_q(const float* __restrict__ qn, const float* __restrict__ x1n, const float* __restrict__ y, const float* __restrict__ g1, const float* __restrict__ b1, const unsigned char* __restrict__ ws, double* acc) {
    const int s = blockIdx.x, t = DBG_B * SEQ + s;
    for (int j = threadIdx.x; j < 2048; j += 256) dbg_acc(acc, 0, bf2f(((const bf16*)(ws + WS_Q))[(size_t)t * QCOLS + j]), qn[(size_t)s * QCOLS + j]);
    const float2 st = ln1_row_stats((const float2*)(ws + WS_STATS), t);
    for (int j = threadIdx.x; j < 1024; j += 256) dbg_acc(acc, 1, (y[(size_t)t * 1024 + j] - st.x) * st.y * g1[j] + b1[j], x1n[(size_t)s * 1024 + j]);
}
__global__ void __launch_bounds__(256) dbg_check_picks(const int* __restrict__ idxn, const float* __restrict__ gn, const unsigned char* __restrict__ ws, double* acc) {
    const int i = blockIdx.x * 256 + threadIdx.x;
    const int s = i >> 3, h = i & 7, t = DBG_B * SEQ + s;
    const int* io = (const int*)(ws + WS_IDX) + ((size_t)t * 8 + h) * 16; const float* go = (const float*)(ws + WS_G) + ((size_t)t * 8 + h) * 16;
    const int* in_ = idxn + ((size_t)s * 8 + h) * 16; const float* gn_ = gn + ((size_t)s * 8 + h) * 16;
    float miss = 0.f, d2 = 0.f, r2 = 0.f;
    for (int a = 0; a < 16; ++a) { const int e = in_[a]; bool found = false;
        for (int b = 0; b < 16; ++b) if (io[b] == e) { found = true; d2 += (go[b] - gn_[a]) * (go[b] - gn_[a]); r2 += gn_[a] * gn_[a]; }
        if (!found) miss += 1.f; }
    miss = wave_sum(miss); d2 = wave_sum(d2); r2 = wave_sum(r2);
    if ((threadIdx.x & 63) == 0) { atomicAdd(acc + 0, (double)miss); atomicAdd(acc + 1, 16.0 * 64.0); atomicAdd(acc + 2, (double)d2); atomicAdd(acc + 3, (double)r2); }
}
__global__ void dbg_code_picks(const double* acc, float* code) {
    if (threadIdx.x != 0 || blockIdx.x != 0) return;
    const float frac = (float)(acc[0] / acc[1]), gerr = (float)sqrt(acc[2] / acc[3]);
    *code = 10.f * frac + (gerr > 0.05f ? 100.f : 0.f) + (frac != frac ? 1000.f : 0.f);
}
__global__ void dbg_code(const double* acc, float* code, int nslots) {
    if (threadIdx.x != 0 || blockIdx.x != 0) return;
    float worst = 0.f; int mask = 0;
    for (int i = 0; i < nslots; ++i) { const double r = acc[2 * i + 1] > 0 ? sqrt(acc[2 * i] / acc[2 * i + 1]) : 99.0; if (r > 0.02) mask |= 1 << i; if ((float)r > worst) worst = (float)r; }
    *code = mask ? (float)mask : worst * 10.f;
}
__global__ void dbg_scale(float* out, const float* code, int n) { const int i = blockIdx.x * blockDim.x + threadIdx.x; if (i < n) out[i] *= (1.f + *code); }

static void launch_naive(const float* const* in, float* out, char* ws, int b0, int nb, hipStream_t stream, float** proj_o, float** c_o, float** x1_o, int** idx_o, float** g_o, float* attn_tmp) {
    const int Tn = nb * SEQ;
    float* proj = (float*)ws; size_t off = (size_t)Tn * IN_COLS * 4; off = (off + 255) & ~(size_t)255;
    float* cbuf = (float*)(ws + off); off += (size_t)nb * FOX_H * SEQ * 4;
    float* x1 = (float*)(ws + off); off += (size_t)Tn * D_MODEL * 4;
    int* idx = (int*)(ws + off); off += (size_t)Tn * 128 * 4;
    float* gbuf = (float*)(ws + off); off += (size_t)Tn * 128 * 4;
    const float* x = in[0] + (size_t)b0 * SEQ * D_MODEL;
    float* attn = attn_tmp ? attn_tmp : out + (size_t)b0 * SEQ * D_MODEL;
    nv_gemm<<<dim3((IN_COLS + 127) / 128, Tn / 128), 256, 0, stream>>>(x, D_MODEL, in[1], IN_COLS, proj, IN_COLS, Tn, IN_COLS, D_MODEL);
    nv_forget_cumsum<<<1, 64, 0, stream>>>(proj, in[2], cbuf, nb);
    nv_fox<<<dim3(SEQ / 64, FOX_H, nb), 64, 0, stream>>>(proj, cbuf, attn);
    nv_swa<<<dim3(SEQ / 64, SWA_H, nb), 64, 0, stream>>>(proj, in[3], attn);
    nv_gemm<<<dim3(D_MODEL / 128, Tn / 128), 256, 0, stream>>>(attn, D_MODEL, in[4], D_MODEL, x1, D_MODEL, Tn, D_MODEL, D_MODEL);
    nv_ln_res<<<Tn / 4, 256, 0, stream>>>(x, x1, in[5], in[6], x1, Tn);
    float* q = proj;
    if (proj_o) {
        *proj_o = proj; *c_o = cbuf; *x1_o = x1; *idx_o = idx; *g_o = gbuf;
        q = attn_tmp + (size_t)Tn * D_MODEL + (1u << 18);
        nv_gemm<<<dim3(QCOLS / 128, Tn / 128), 256, 0, stream>>>(x1, D_MODEL, in[7], QCOLS, q, QCOLS, Tn, QCOLS, D_MODEL);
        nv_peer_topk<<<dim3(Tn / 64, PEER_H), 64, 0, stream>>>(q, in[8], idx, gbuf);
        return;
    }
    nv_gemm<<<dim3(QCOLS / 128, Tn / 128), 256, 0, stream>>>(x1, D_MODEL, in[7], QCOLS, q, QCOLS, Tn, QCOLS, D_MODEL);
    nv_peer_topk<<<dim3(Tn / 64, PEER_H), 64, 0, stream>>>(q, in[8], idx, gbuf);
    nv_peer_expert<<<Tn / 4, 256, 0, stream>>>(x1, idx, gbuf, in[9], in[10], in[11], in[12], out + (size_t)b0 * SEQ * D_MODEL, Tn);
}
#endif

extern "C" void kernel_launch(void* const* d_in, const int* in_sizes, int n_in, void* d_out, int out_size, void* d_ws, size_t ws_size, hipStream_t stream) {
    static int grid = 0;
    if (grid == 0) {
        if (n_in != 13 || out_size != T * D_MODEL || ws_size < 512 * MiB) { fprintf(stderr, "kernel_launch: unexpected shapes / workspace (%d inputs, out %d, ws %zu)\n", n_in, out_size, ws_size); grid = -1; return; }
        int dev = 0, cus = 0, per_cu = 0;
        if (hipGetDevice(&dev) != hipSuccess || hipDeviceGetAttribute(&cus, hipDeviceAttributeMultiprocessorCount, dev) != hipSuccess) { grid = -1; return; }
        if (hipFuncSetAttribute((const void*)mk_fwd, hipFuncAttributeMaxDynamicSharedMemorySize, LDS_BYTES) != hipSuccess) { fprintf(stderr, "kernel_launch: hipFuncSetAttribute failed\n"); grid = -1; return; }
        if (hipOccupancyMaxActiveBlocksPerMultiprocessor(&per_cu, (const void*)mk_fwd, NWAVES * 64, LDS_BYTES) != hipSuccess || per_cu < 1) { fprintf(stderr, "kernel_launch: occupancy query says %d blocks per CU\n", per_cu); (void)hipGetLastError(); grid = -1; return; }
        grid = cus;
    }
    if (grid < 0) return;
    const float* in[13]; for (int i = 0; i < 13; ++i) in[i] = (const float*)d_in[i];
    (void)hipMemsetAsync((char*)d_ws + WS_CTL, 0, CTL_ZERO_BYTES, stream);
    Args a{};
    for (int i = 0; i < 13; ++i) a.in[i] = in[i];
    a.out = (float*)d_out; a.ws = (unsigned char*)d_ws;
#if DBG_STAGE == 0 && defined(TIME_LO)
    a.ph_lo = 0; a.ph_hi = TIME_HI;
    { void* k1[] = {&a}; (void)hipLaunchCooperativeKernel((const void*)mk_fwd, dim3(grid), dim3(NWAVES * 64), k1, LDS_BYTES, stream); }
    (void)hipMemsetAsync((char*)d_ws + WS_CTL, 0, CTL_ZERO_BYTES, stream);
    a.ph_lo = TIME_LO; a.ph_hi = N_PHASES;
#elif DBG_STAGE == 0
    a.ph_lo = 0; a.ph_hi = N_PHASES;
#else
    a.ph_lo = 0; a.ph_hi = DBG_STAGE + 1;
#endif
    void* kargs[] = {&a};
    hipError_t le = hipLaunchCooperativeKernel((const void*)mk_fwd, dim3(grid), dim3(NWAVES * 64), kargs, LDS_BYTES, stream);
    if (le != hipSuccess) fprintf(stderr, "kernel_launch: cooperative launch failed: %s (grid %d)\n", hipGetErrorName(le), grid);
#if DBG_STAGE > 0
    char* ws = (char*)d_ws;
    double* acc = (double*)(ws + DBG_ACC); float* code = (float*)(ws + DBG_ACC + 512);
    (void)hipMemsetAsync(acc, 0, 1024, stream);
    float *proj, *cn, *x1n, *gn; int* idxn;
    launch_naive(in, (float*)d_out, ws + DBG_BASE, DBG_B, 1, stream, &proj, &cn, &x1n, &idxn, &gn, (float*)(ws + DBG_BASE + 100 * MiB));
#if DBG_STAGE == 1
    dbg_check_inproj<<<SEQ, 256, 0, stream>>>(proj, (const unsigned char*)d_ws, cn, acc);
    dbg_code<<<1, 1, 0, stream>>>(acc, code, 7);
#elif DBG_STAGE == 4
    dbg_check_q<<<SEQ, 256, 0, stream>>>((const float*)(ws + DBG_BASE + 100 * MiB) + (size_t)SEQ * D_MODEL + (1u << 18), x1n, (const float*)d_out, in[5], in[6], (const unsigned char*)d_ws, acc);
    dbg_code<<<1, 1, 0, stream>>>(acc, code, 2);
#elif DBG_STAGE == 5
    dbg_check_picks<<<SEQ * 8 / 256, 256, 0, stream>>>(idxn, gn, (const unsigned char*)d_ws, acc);
    dbg_code_picks<<<1, 1, 0, stream>>>(acc, code);
#elif DBG_STAGE == 2
    dbg_check_attn<<<SEQ, 256, 0, stream>>>((const float*)(ws + DBG_BASE + 100 * MiB), (const unsigned char*)d_ws, acc);
    dbg_code<<<1, 1, 0, stream>>>(acc, code, 2);
#endif
    launch_naive(in, (float*)d_out, ws, 0, BATCH, stream, nullptr, nullptr, nullptr, nullptr, nullptr, nullptr);
    dbg_scale<<<(T * D_MODEL + 255) / 256, 256, 0, stream>>>((float*)d_out, code, T * D_MODEL);
#endif
}
```

```cpp
#include <hip/hip_runtime.h>
#include <hip/hip_bf16.h>
#include <hip/hip_cooperative_groups.h>
#include <cstdint>
#include <cstdio>
#include <cmath>

#ifndef DBG_STAGE
#define DBG_STAGE 0
#endif

namespace cfg {
constexpr int D_MODEL = 1024, BATCH = 8, SEQ = 4096, T = BATCH * SEQ;
constexpr int HD = 64, FOX_H = 8, SWA_H = 8, SWA_KVH = 2;
constexpr int OFF_FQ = 0, OFF_FK = 512, OFF_FV = 1024, OFF_FF = 1536, OFF_SQ = 1544, OFF_SK = 2056, OFF_SV = 2184, IN_COLS = 2312;
constexpr int NPHYS = 2304;
constexpr int WINDOW = 128;
constexpr int PEER_H = 8, NKEYS = 128, PEER_HALF = 128, TOPK = 16, QCOLS = 2048, NEXP = 16384;
constexpr float LN_EPS = 1e-5f;
constexpr float ALPHA = 1.189207115002721f;
constexpr float LOG2E = 1.4426950408889634f;
constexpr float C2 = 0.125f * LOG2E;
}
using namespace cfg;

namespace pg8 {
#define PG8_LAS __attribute__((address_space(3)))
typedef unsigned short bf16_t;
typedef short bf16x8 __attribute__((ext_vector_type(8)));
typedef float f32x4 __attribute__((ext_vector_type(4)));
typedef unsigned u32x4 __attribute__((ext_vector_type(4)));
constexpr int BM = 256, BK = 64, HALF = 128, HTB = HALF * BK * 2  , STAGE_BYTES = 8 * HTB, NXCD = 8, WGM = 8;

__host__ __device__ __forceinline__ int lds_byte(int r, int c) { const int st = (r >> 4) * 2 + (c >> 5), rr = r & 15, cc = c & 31, ob = rr * 64 + cc * 2; return st * 1024 + (ob ^ (((ob >> 9) & 1) << 5)); }
__host__ __device__ __forceinline__ void stage_rc(int b, int& R, int& C) { const int st = b / 1024, sb = b % 1024, swz = sb ^ (((sb >> 9) & 1) << 5); R = (st >> 1) * 16 + swz / 64; C = (st & 1) * 32 + (swz % 64) / 2; }
__host__ __device__ __forceinline__ int perm32(int rho) { const int n = rho >> 4, i = rho & 15; return 8 * (i >> 2) + 4 * n + (i & 3); }

struct Unit { int pm, pn; };
struct Gemm { const bf16_t* A; const bf16_t* Bt; int M, N, K; };

struct StaticOrder {
    int nM, nN, nwg, G, c;
    __host__ __device__ void init(int M, int N, int G_, int c_) { nM = M / BM; nN = N / BM; nwg = nM * nN; G = G_; c = c_; }
    __host__ __device__ bool next(int i, Unit& u) const {
        const long L = (long)i * G + c; if (L >= nwg) return false;
        int wgid = (int)L; { const int q = nwg / NXCD, r = nwg % NXCD, xcd = wgid % NXCD, off = wgid / NXCD; wgid = (xcd < r ? xcd * (q + 1) : r * (q + 1) + (xcd - r) * q) + off; }
        const int nig = WGM * nN, gid = wgid / nig, fm = gid * WGM, gsz = (nM - fm) < WGM ? (nM - fm) : WGM;
        u.pm = fm + ((wgid % nig) % gsz); u.pn = (wgid % nig) / gsz; return true;
    }
    __device__ __forceinline__ void a_ready(const Unit&) const {}
    __device__ __forceinline__ void done(const Unit&) const {}
};
__device__ __forceinline__ unsigned cvt_pk_bf16(float lo, float hi) { unsigned r; asm volatile("v_cvt_pk_bf16_f32 %0, %1, %2" : "=v"(r) : "v"(lo), "v"(hi)); return r; }
typedef float f32x2 __attribute__((ext_vector_type(2)));
template <bool I8> __device__ __forceinline__ f32x4 pg8_mma(bf16x8 a, bf16x8 b, f32x4 c) {
    if constexpr (I8) { typedef int v4i_ __attribute__((ext_vector_type(4)));
        return __builtin_bit_cast(f32x4, __builtin_amdgcn_mfma_i32_16x16x64_i8(__builtin_bit_cast(v4i_, a), __builtin_bit_cast(v4i_, b), __builtin_bit_cast(v4i_, c), 0, 0, 0)); }
    else return __builtin_amdgcn_mfma_f32_16x16x32_bf16(a, b, c, 0, 0, 0);
}
template <class Epi, class Sched, bool ALIGN_EPI = false, bool SP2 = false, bool I8 = false>
__device__ __forceinline__ void gemm_phase(PG8_LAS unsigned char* lds, const Gemm g, const Sched& S, const Epi& E) {
    const int tid = threadIdx.x, wid = __builtin_amdgcn_readfirstlane(tid >> 6), lane = tid & 63, wr = wid >> 2, wc = wid & 3, fr = lane & 15, fq = lane >> 4;
    const int K = g.K, nt = K / BK;
    unsigned voffA[2], voffB[2];
#pragma unroll
    for (int i = 0; i < 2; ++i) { int R, C; stage_rc(tid * 16 + i * 8192, R, C); const int Rb = Epi::PERM ? ((R & ~31) + perm32(R & 31)) : R;
        voffA[i] = (unsigned)(R * K + C) * 2u; voffB[i] = (unsigned)(Rb * K + C) * 2u; }
    const size_t kstep = (size_t)(BK * 2);
    const size_t hstep = (size_t)HALF * K * 2;
    const size_t tstep = 2 * hstep;
    const unsigned ldsw = (unsigned)wid * 1024u;
    const int aoff = lds_byte(wr * 64 + fr, fq * 8), boff = lds_byte(wc * 32 + fr, fq * 8);
#define PG8_SA(b, h) (((b) * 2 + (h)) * HTB)
#define PG8_SB(b, h) ((4 + (b) * 2 + (h)) * HTB)
#define PG8_STAGE(bufoff, gbase, voff) do { _Pragma("unroll") for (int _i = 0; _i < 2; ++_i) \
        __builtin_amdgcn_global_load_lds((const unsigned*)((const char*)(gbase) + (voff)[_i]), (PG8_LAS unsigned*)(lds + (bufoff) + ldsw + _i * 8192), 16, 0, 0); } while (0)
#define PG8_LDA(dst, b, h) do { _Pragma("unroll") for (int m = 0; m < 4; ++m) _Pragma("unroll") for (int k = 0; k < 2; ++k) dst[m][k] = *(const PG8_LAS bf16x8*)(lds + PG8_SA(b, h) + aoff + m * 2048 + k * 1024); } while (0)
#define PG8_LDB(dst, b, h) do { _Pragma("unroll") for (int n = 0; n < 2; ++n) _Pragma("unroll") for (int k = 0; k < 2; ++k) dst[n][k] = *(const PG8_LAS bf16x8*)(lds + PG8_SB(b, h) + boff + n * 2048 + k * 1024); } while (0)
#define PG8_MMA(ai, bj, At, Bt) do { __builtin_amdgcn_s_setprio(1); _Pragma("unroll") for (int m = 0; m < 4; ++m) _Pragma("unroll") for (int n = 0; n < 2; ++n) _Pragma("unroll") for (int k = 0; k < 2; ++k) \
        acc[ai][bj][m][n] = pg8_mma<I8>(Bt[n][k], At[m][k], acc[ai][bj][m][n]); __builtin_amdgcn_s_setprio(0); } while (0)
#define PG8_WAIT_V(n) asm volatile("s_waitcnt vmcnt(" #n ")" ::: "memory")
#define PG8_WAIT_L(n) asm volatile("s_waitcnt lgkmcnt(" #n ")" ::: "memory")
#define PG8_BAR __builtin_amdgcn_s_barrier()
#define PG8_SCHED __builtin_amdgcn_sched_barrier(0)
    Unit cur, nxt; int ui = 0;
    if (!S.next(0, cur)) return;
    f32x4 acc[2][2][4][2];
#pragma unroll
    for (int a = 0; a < 2; ++a)
#pragma unroll
        for (int b = 0; b < 2; ++b)
#pragma unroll
            for (int m = 0; m < 4; ++m)
#pragma unroll
                for (int n = 0; n < 2; ++n) acc[a][b][m][n] = (f32x4){0.f, 0.f, 0.f, 0.f};
    bf16x8 At[4][2], B0[2][2], B1[2][2];
    const char* cA = (const char*)g.A + (size_t)cur.pm * tstep; const char* cB = (const char*)g.Bt + (size_t)cur.pn * tstep;
    S.a_ready(cur);
    if constexpr (SP2) {
        PG8_STAGE(PG8_SB(0, 0), cB, voffB); PG8_STAGE(PG8_SB(0, 1), cB + hstep, voffB); PG8_STAGE(PG8_SA(0, 0), cA, voffA); PG8_STAGE(PG8_SA(0, 1), cA + hstep, voffA);
        if (wr == 1) PG8_BAR;
        PG8_WAIT_V(2); PG8_BAR;
        PG8_STAGE(PG8_SB(1, 0), cB + kstep, voffB); PG8_STAGE(PG8_SA(1, 0), cA + kstep, voffA); PG8_STAGE(PG8_SB(1, 1), cB + hstep + kstep, voffB);
        PG8_WAIT_V(6); PG8_BAR;
    } else {
        PG8_STAGE(PG8_SB(0, 0), cB, voffB); PG8_STAGE(PG8_SA(0, 0), cA, voffA); PG8_STAGE(PG8_SB(0, 1), cB + hstep, voffB); PG8_STAGE(PG8_SA(0, 1), cA + hstep, voffA);
        if (wr == 1) PG8_BAR;
        PG8_WAIT_V(4); PG8_BAR;
        PG8_STAGE(PG8_SB(1, 0), cB + kstep, voffB); PG8_STAGE(PG8_SA(1, 0), cA + kstep, voffA); PG8_STAGE(PG8_SB(1, 1), cB + hstep + kstep, voffB);
        PG8_WAIT_V(6); PG8_BAR;
    }
    for (;;) {
        const bool has_next = S.next(ui + 1, nxt);
        const char* nA = has_next ? (const char*)g.A + (size_t)nxt.pm * tstep : cA; const char* nB = has_next ? (const char*)g.Bt + (size_t)nxt.pn * tstep : cB;
        for (int t = 0; t < nt; t += 2) {
            const bool last = (t == nt - 2);
            const char* a1 = cA + (size_t)(t + 1) * kstep;
            const char* a2 = last ? nA : cA + (size_t)(t + 2) * kstep; const char* b2 = last ? nB : cB + (size_t)(t + 2) * kstep;
            const char* a3 = a2 + kstep; const char* b3 = b2 + kstep;
            if (last && has_next) S.a_ready(nxt);
            if constexpr (SP2) {
            PG8_LDB(B0, 0, 0); PG8_LDB(B1, 0, 1); PG8_SCHED; PG8_LDA(At, 0, 0); PG8_STAGE(PG8_SA(1, 1), a1 + hstep, voffA);
            PG8_WAIT_V(8); PG8_WAIT_L(0); PG8_BAR; PG8_MMA(0, 0, At, B0); PG8_MMA(0, 1, At, B1); PG8_BAR; PG8_SCHED;
            PG8_LDA(At, 0, 1); PG8_STAGE(PG8_SB(0, 0), b2, voffB); PG8_STAGE(PG8_SB(0, 1), b2 + hstep, voffB); PG8_STAGE(PG8_SA(0, 0), a2, voffA);
            PG8_WAIT_V(8); PG8_WAIT_L(0); PG8_BAR; PG8_MMA(1, 0, At, B0); PG8_MMA(1, 1, At, B1); PG8_BAR; PG8_SCHED;
            PG8_LDB(B0, 1, 0); PG8_LDB(B1, 1, 1); PG8_SCHED; PG8_LDA(At, 1, 0); PG8_STAGE(PG8_SA(0, 1), a2 + hstep, voffA);
            PG8_WAIT_V(8); PG8_WAIT_L(0); PG8_BAR; PG8_MMA(0, 0, At, B0); PG8_MMA(0, 1, At, B1); PG8_BAR; PG8_SCHED;
            PG8_LDA(At, 1, 1); PG8_STAGE(PG8_SB(1, 0), b3, voffB); PG8_STAGE(PG8_SB(1, 1), b3 + hstep, voffB); PG8_STAGE(PG8_SA(1, 0), a3, voffA);
            PG8_WAIT_V(8); PG8_WAIT_L(0); PG8_BAR; PG8_MMA(1, 0, At, B0); PG8_MMA(1, 1, At, B1); PG8_BAR; PG8_SCHED;
            } else {
            PG8_LDB(B0, 0, 0); PG8_SCHED; PG8_LDA(At, 0, 0); PG8_STAGE(PG8_SA(1, 1), a1 + hstep, voffA);
            PG8_WAIT_L(8); PG8_BAR; PG8_WAIT_L(0); PG8_MMA(0, 0, At, B0); PG8_BAR; PG8_SCHED;
            PG8_LDB(B1, 0, 1); PG8_STAGE(PG8_SB(0, 0), b2, voffB);
            PG8_BAR; PG8_WAIT_L(0); PG8_MMA(0, 1, At, B1); PG8_BAR;
            PG8_LDA(At, 0, 1); PG8_STAGE(PG8_SA(0, 0), a2, voffA);
            PG8_BAR; PG8_WAIT_L(0); PG8_MMA(1, 0, At, B0); PG8_BAR; PG8_SCHED;
            PG8_STAGE(PG8_SB(0, 1), b2 + hstep, voffB);
            PG8_WAIT_V(6); PG8_BAR; PG8_MMA(1, 1, At, B1); PG8_BAR;
            PG8_LDB(B0, 1, 0); PG8_SCHED; PG8_LDA(At, 1, 0); PG8_STAGE(PG8_SA(0, 1), a2 + hstep, voffA);
            PG8_WAIT_L(8); PG8_BAR; PG8_WAIT_L(0); PG8_MMA(0, 0, At, B0); PG8_BAR; PG8_SCHED;
            PG8_LDB(B1, 1, 1); PG8_STAGE(PG8_SB(1, 0), b3, voffB);
            PG8_BAR; PG8_WAIT_L(0); PG8_MMA(0, 1, At, B1); PG8_BAR;
            PG8_LDA(At, 1, 1); PG8_STAGE(PG8_SA(1, 0), a3, voffA);
            PG8_BAR; PG8_WAIT_L(0); PG8_MMA(1, 0, At, B0); PG8_BAR; PG8_SCHED;
            PG8_STAGE(PG8_SB(1, 1), b3 + hstep, voffB);
            PG8_WAIT_V(6); PG8_BAR; PG8_MMA(1, 1, At, B1); PG8_BAR;
            }
        }
        if constexpr (ALIGN_EPI) { if (wr == 0) PG8_BAR; }
        if constexpr (!Epi::AFTER_DRAIN) { E(acc, cur, wr, wc, fr, fq); S.done(cur); }
        if (!has_next) break;
#pragma unroll
        for (int a = 0; a < 2; ++a)
#pragma unroll
            for (int b = 0; b < 2; ++b)
#pragma unroll
                for (int m = 0; m < 4; ++m)
#pragma unroll
                    for (int n = 0; n < 2; ++n) acc[a][b][m][n] = (f32x4){0.f, 0.f, 0.f, 0.f};
        cur = nxt; cA = nA; cB = nB; ++ui;
        if constexpr (ALIGN_EPI) { if (wr == 1) PG8_BAR; }
    }
    PG8_WAIT_V(0);
    if constexpr (!ALIGN_EPI) { if (wr == 0) PG8_BAR; }
    PG8_BAR;
    if constexpr (Epi::AFTER_DRAIN) { E.fused(acc, cur, wr, wc, fr, fq, lds, wid, lane); S.done(cur); }
#undef PG8_SA
#undef PG8_SB
#undef PG8_STAGE
#undef PG8_LDA
#undef PG8_LDB
#undef PG8_MMA
#undef PG8_WAIT_V
#undef PG8_WAIT_L
#undef PG8_BAR
#undef PG8_SCHED
}
}
#define GAS __attribute__((address_space(1)))
#define LAS __attribute__((address_space(3)))
typedef unsigned short bf16;
typedef unsigned v4u __attribute__((ext_vector_type(4)));
typedef float f32x4 __attribute__((ext_vector_type(4)));
typedef short bf16x8 __attribute__((ext_vector_type(8)));
typedef GAS unsigned gu32;
typedef GAS unsigned long long gu64;
#define RLX_AGENT __ATOMIC_RELAXED, __HIP_MEMORY_SCOPE_AGENT
#define LDS_WAIT() asm volatile("s_waitcnt lgkmcnt(0)" ::: "memory")
#define VM_WAIT() asm volatile("s_waitcnt vmcnt(0)" ::: "memory")
__device__ __forceinline__ unsigned long long rt() { return __builtin_amdgcn_s_memrealtime(); }
__device__ __forceinline__ unsigned f2bf(float f) { unsigned u = __builtin_bit_cast(unsigned, f); return (u + 0x7fffu + ((u >> 16) & 1u)) >> 16; }
__device__ __forceinline__ unsigned pk2(float lo, float hi) { return f2bf(lo) | (f2bf(hi) << 16); }
#define XB_TMO      128
#define XB_XCNT(j)  (256  + 64 * (j))
#define XB_XSUB(j)  (1280 + 64 * (j))
#define XB_XGEN(j)  (2304 + 64 * (j))
#define XB_TOP      3328
#define XB_TOPGEN   3392
#define XCD_BAR_WORDS 3456
#define XB_SPIN_CAP (1u << 18)

__device__ __forceinline__ unsigned xb_ld(unsigned* p)              { return __hip_atomic_load(p, __ATOMIC_RELAXED, __HIP_MEMORY_SCOPE_AGENT); }
__device__ __forceinline__ unsigned xb_add(unsigned* p, unsigned v) { return __hip_atomic_fetch_add(p, v, __ATOMIC_RELAXED, __HIP_MEMORY_SCOPE_AGENT); }
__device__ __forceinline__ unsigned xb_xcc_id() { return (unsigned)__builtin_amdgcn_s_getreg((3 << 11) | 20) & 0xFu; }
#define XB_SPIN(cond, bar) do { unsigned _sp = 0; while (cond) { __builtin_amdgcn_s_sleep(1); \
    if ((++_sp & 255u) == 0u) { if (xb_ld(&(bar)[XB_TMO])) break; if (_sp > XB_SPIN_CAP) { atomicAdd(&(bar)[XB_TMO], 1u); break; } } } } while (0)

struct XcdBarrier {
    unsigned* bar; unsigned x;
    volatile LAS unsigned* st;
};

__device__ __forceinline__ XcdBarrier xcd_barrier_post(unsigned* bar, volatile LAS unsigned* st) {
    XcdBarrier b; b.bar = bar; b.x = xb_xcc_id(); b.st = st;
    if (threadIdx.x == 0) (void)xb_add(&bar[XB_XCNT(b.x)], 1u);
    return b;
}
__device__ __forceinline__ void xcd_barrier_complete(unsigned* bar, unsigned x, unsigned& nloc, unsigned& nx) {
    const unsigned G = gridDim.x * gridDim.y * gridDim.z;
    unsigned sum, cnt, mine, sp = 0u;
    for (;;) {
        sum = 0u; cnt = 0u; mine = 0u;
#pragma unroll
        for (unsigned j = 0; j < 16; ++j) { const unsigned c = xb_ld(&bar[XB_XCNT(j)]); sum += c; cnt += (c > 0u) ? 1u : 0u; mine = (j == x) ? c : mine; }
        if (sum == G) break;
        __builtin_amdgcn_s_sleep(1);
        if ((++sp & 255u) == 0u) { if (xb_ld(&bar[XB_TMO])) break; if (sp > XB_SPIN_CAP) { atomicAdd(&bar[XB_TMO], 1u); break; } }
    }
    nloc = mine > 0u ? mine : 1u; nx = cnt > 0u ? cnt : 1u;
}

__device__ __forceinline__ void xcd_barrier(const XcdBarrier& b) {
    asm volatile("s_waitcnt vmcnt(0)" ::: "memory");
    __syncthreads();
    if (threadIdx.x == 0) {
        unsigned* bar = b.bar;
        __builtin_amdgcn_s_waitcnt(0);
        unsigned nloc = b.st[0], nx = b.st[1];
        if (nloc == 0u) { xcd_barrier_complete(bar, b.x, nloc, nx); b.st[0] = nloc; b.st[1] = nx; }
        const unsigned old = xb_add(&bar[XB_XSUB(b.x)], 1u);
        const unsigned gen = old / nloc;
        if (old + 1u == (gen + 1u) * nloc) {
            __builtin_amdgcn_fence(__ATOMIC_RELEASE, "agent");
            asm volatile("s_waitcnt vmcnt(0)" ::: "memory");
            const unsigned og = xb_add(&bar[XB_TOP], 1u);
            const unsigned tg = og / nx;
            if (og + 1u == (tg + 1u) * nx) xb_add(&bar[XB_TOPGEN], 1u);
            else XB_SPIN(xb_ld(&bar[XB_TOPGEN]) == tg, bar);
            __builtin_amdgcn_fence(__ATOMIC_ACQUIRE, "agent");
            xb_add(&bar[XB_XGEN(b.x)], 1u);
            asm volatile("s_waitcnt vmcnt(0)" ::: "memory");
        } else {
            XB_SPIN(xb_ld(&bar[XB_XGEN(b.x)]) == gen, bar);
            __builtin_amdgcn_fence(__ATOMIC_ACQUIRE, "agent");
            asm volatile("s_waitcnt vmcnt(0)" ::: "memory");
        }
    }
    __syncthreads();
}

constexpr size_t MiB = 1u << 20;
constexpr size_t WS_CTL = 0, CTL_ZERO_BYTES = 64 * 1024;
constexpr size_t WS_GW = 1 * MiB;
constexpr size_t WS_ROPE = 2 * MiB;
constexpr size_t WS_LF = 3 * MiB;
constexpr size_t WS_C = 4 * MiB;
constexpr size_t WS_QN2 = 5 * MiB, WS_KN2 = 5 * MiB + 64 * 1024;
constexpr size_t WS_STATS = 6 * MiB;
constexpr size_t WS_WIN = 10 * MiB;
constexpr size_t WS_WOUT = 15 * MiB;
constexpr size_t WS_WQ = 17 * MiB;
constexpr size_t WS_SUBK = 21 * MiB;
constexpr size_t WS_EU = 22 * MiB, WS_EV = 54 * MiB;
constexpr size_t WS_XB = 86 * MiB;
constexpr size_t WS_FQ = 150 * MiB, WS_FKT = 182 * MiB, WS_FVT = 214 * MiB, WS_SQ = 246 * MiB, WS_SKT = 278 * MiB, WS_SVT = 286 * MiB;
constexpr size_t WS_Q = 150 * MiB;
constexpr size_t WS_ATTN = 294 * MiB;
constexpr size_t WS_IDX = 294 * MiB, WS_G = 310 * MiB;
constexpr size_t WS_END = 358 * MiB;
constexpr size_t WS_MR = 5 * MiB + 128 * 1024;
constexpr size_t WS_STATS2 = 10 * MiB;
constexpr size_t WS_X1B = 86 * MiB;
constexpr size_t WS_HP = 150 * MiB;
constexpr size_t WS_V2 = 214 * MiB;
constexpr size_t EXP_SLICE_BYTES = (size_t)NEXP * 128;
constexpr float U_QS = 768.f, X_QS = 20.f, SQ_V = 40.f;
constexpr size_t WS_XQ = 326 * MiB;
constexpr float SQ_X = 24.f, SQ_A = 24.f, SQ_WIN = 768.f, SQ_WOUT = 1280.f;
constexpr size_t WS_W16 = 358 * MiB;
constexpr size_t WS_X1Q = 326 * MiB;
constexpr int CW_QU = 8192, CW_QV = 8192 + 1024;
constexpr int EXP_SPLIT = 16384;
constexpr int CW_BAR = 1024;
static_assert((CW_BAR + XCD_BAR_WORDS) * 4 <= (int)CTL_ZERO_BYTES, "ctl");

constexpr int NWAVES = 8;
constexpr int RING_BYTES = 131072, MISC_OFF = RING_BYTES + 320, LDS_BYTES = 147456;

struct Frame {
    LAS unsigned char* lds;
    volatile LAS unsigned* MISC;
    gu32* ctl;
    int tid, lane, wave, vcu, G;
    const float* in[13]; float* out; unsigned char* ws;
};

__device__ __forceinline__ float wave_sum(float v) {
#pragma unroll
    for (int o = 1; o < 64; o <<= 1) v += __shfl_xor(v, o);
    return v;
}
__device__ __forceinline__ float wave_max(float v) {
#pragma unroll
    for (int o = 1; o < 64; o <<= 1) v = fmaxf(v, __shfl_xor(v, o));
    return v;
}

typedef unsigned u32x2 __attribute__((ext_vector_type(2)));
__device__ __forceinline__ unsigned q8x4(float a, float b, float c, float d_) {
    const int ia = (int)fminf(fmaxf(rintf(a), -127.f), 127.f), ib = (int)fminf(fmaxf(rintf(b), -127.f), 127.f), ic = (int)fminf(fmaxf(rintf(c), -127.f), 127.f), id = (int)fminf(fmaxf(rintf(d_), -127.f), 127.f);
    return ((unsigned)ia & 0xFFu) | (((unsigned)ib & 0xFFu) << 8) | (((unsigned)ic & 0xFFu) << 16) | ((unsigned)id << 24);
}
__device__ __forceinline__ int win_src_col(int pc) {
    if (pc < 1536) return pc;
    int r, base;
    if (pc < 2048) { r = pc - 1536; base = OFF_SQ; }
    else if (pc < 2176) { r = pc - 2048; base = OFF_SK; }
    else return OFF_SV + (pc - 2176);
    const int hd = r >> 6, p = r & 63;
    const int g = p >> 5, fq = (p >> 3) & 3, n = (p >> 2) & 1, e = p & 3;
    return base + hd * 64 + 16 * g + 4 * fq + e + 32 * n;
}
template <bool I8, class SrcCol, class Scale>
__device__ __forceinline__ void p0_transpose_item(const float* W, int ldw, int K, bf16* WT, LAS float* scr, int nblk, int item, int lane, SrcCol sc, Scale sk) {
    const int kb = item / nblk, nb = item % nblk, k0 = 64 * kb, n0 = 32 * nb;
    const int scol = sc(n0 + (lane & 31));
#pragma unroll 8
    for (int i = 0; i < 32; ++i) { const int kk = 2 * i + (lane >> 5); scr[kk * 33 + (lane & 31)] = W[(size_t)(k0 + kk) * ldw + scol] * sk(k0 + kk); }
    LDS_WAIT(); asm volatile("" ::: "memory");
    const int c = lane & 7;
#pragma unroll
    for (int j = 0; j < 4; ++j) { const int n = (lane >> 3) + 8 * j; const LAS float* s = scr + (8 * c) * 33 + n;
        if constexpr (I8) { u32x2 o; o.x = q8x4(s[0 * 33], s[1 * 33], s[2 * 33], s[3 * 33]); o.y = q8x4(s[4 * 33], s[5 * 33], s[6 * 33], s[7 * 33]);
            *(GAS u32x2*)((unsigned char*)WT + (size_t)(n0 + n) * K + k0 + 8 * c) = o; }
        else { v4u o; o.x = pk2(s[0 * 33], s[1 * 33]); o.y = pk2(s[2 * 33], s[3 * 33]); o.z = pk2(s[4 * 33], s[5 * 33]); o.w = pk2(s[6 * 33], s[7 * 33]);
            *(GAS v4u*)(WT + (size_t)(n0 + n) * K + k0 + 8 * c) = o; } }
    LDS_WAIT(); asm volatile("" ::: "memory");
}
__device__ __forceinline__ float log_sigmoid(float z) { return fminf(z, 0.f) - log1pf(__expf(-fabsf(z))); }

__device__ __forceinline__ void p0_prologue(Frame& F) {
    LAS float* scr = (LAS float*)(F.lds + F.wave * 16384);
    const int gw = F.vcu * NWAVES + F.wave, NGW = F.G * NWAVES, lane = F.lane;
    const float* x = F.in[0]; const float* w_in = F.in[1]; const float* b_forget = F.in[2]; const float* w_out = F.in[4]; const float* ln1_g = F.in[5];
    const float* w_query = F.in[7]; const float* sub_keys = F.in[8];
    bf16* WIN = (bf16*)(F.ws + WS_WIN); bf16* WOUT = (bf16*)(F.ws + WS_WOUT); bf16* WQ = (bf16*)(F.ws + WS_WQ); bf16* SUBK = (bf16*)(F.ws + WS_SUBK);
    bf16* XB = (bf16*)(F.ws + WS_XB);
    float2* ROPE = (float2*)(F.ws + WS_ROPE); float* LF = (float*)(F.ws + WS_LF);
    constexpr int I_IN = 16 * (NPHYS / 32), I_OUT = 16 * 32, I_Q = 16 * 64;
    for (int it = gw; it < I_IN + I_OUT + I_Q; it += NGW) {
        if (it < I_IN) p0_transpose_item<true>(w_in, IN_COLS, 1024, WIN, scr, NPHYS / 32, it, lane, [](int pc) { return win_src_col(pc); }, [](int) { return SQ_WIN; });
        else if (it < I_IN + I_OUT) p0_transpose_item<true>(w_out, 1024, 1024, WOUT, scr, 32, it - I_IN, lane, [](int pc) { return pc; }, [](int) { return SQ_WOUT; });
        else p0_transpose_item<false>(w_query, QCOLS, 1024, WQ, scr, 64, it - I_IN - I_OUT, lane, [](int pc) { return pc; }, [=](int k) { return ln1_g[k]; });
    }
    for (int it = gw; it < (PEER_H * 2 * NKEYS * PEER_HALF) / 512; it += NGW) {
        const size_t o = (size_t)it * 512 + lane * 8; const f32x4 a = *(const GAS f32x4*)(sub_keys + o), b = *(const GAS f32x4*)(sub_keys + o + 4);
        v4u w; w.x = pk2(a.x, a.y); w.y = pk2(a.z, a.w); w.z = pk2(b.x, b.y); w.w = pk2(b.z, b.w); *(GAS v4u*)(SUBK + o) = w;
    }
    for (int it = gw; it < (SEQ * 32) / 64; it += NGW) {
        const int e = it * 64 + lane, pos = e >> 5, i = e & 31;
        const float inv = powf(10000.0f, -(float)i / 32.0f), ang = (float)pos * inv;
        double rev = (double)ang * 0.15915494309189535; rev -= floor(rev);
        const float r = (float)rev;
        ROPE[e] = make_float2(__builtin_amdgcn_cosf(r), __builtin_amdgcn_sinf(r));
    }
    {
        float wff[16][8];
#pragma unroll
        for (int j = 0; j < 2; ++j)
#pragma unroll
            for (int e = 0; e < 8; ++e) { const float* wr_ = w_in + (size_t)(512 * j + 8 * lane + e) * IN_COLS + OFF_FF; const f32x4 a = *(const GAS f32x4*)wr_, b = *(const GAS f32x4*)(wr_ + 4);
                wff[j * 8 + e][0] = a.x; wff[j * 8 + e][1] = a.y; wff[j * 8 + e][2] = a.z; wff[j * 8 + e][3] = a.w; wff[j * 8 + e][4] = b.x; wff[j * 8 + e][5] = b.y; wff[j * 8 + e][6] = b.z; wff[j * 8 + e][7] = b.w; }
        const float bfl = b_forget[lane & 7];
        for (int m = gw; m < T; m += NGW) {
            const float* src = x + (size_t)m * D_MODEL; bf16* dst = XB + (size_t)m * D_MODEL;
            float xv[16];
#pragma unroll
            for (int j = 0; j < 2; ++j) { const f32x4 a = *(const GAS f32x4*)(src + 512 * j + 8 * lane), b = *(const GAS f32x4*)(src + 512 * j + 8 * lane + 4);
                xv[8 * j + 0] = a.x; xv[8 * j + 1] = a.y; xv[8 * j + 2] = a.z; xv[8 * j + 3] = a.w; xv[8 * j + 4] = b.x; xv[8 * j + 5] = b.y; xv[8 * j + 6] = b.z; xv[8 * j + 7] = b.w;
                v4u w; w.x = pk2(a.x, a.y); w.y = pk2(a.z, a.w); w.z = pk2(b.x, b.y); w.w = pk2(b.z, b.w); *(GAS v4u*)(dst + 512 * j + 8 * lane) = w;
                u32x2 wq; wq.x = q8x4(a.x * SQ_X, a.y * SQ_X, a.z * SQ_X, a.w * SQ_X); wq.y = q8x4(b.x * SQ_X, b.y * SQ_X, b.z * SQ_X, b.w * SQ_X);
                *(GAS u32x2*)(F.ws + WS_XQ + (size_t)m * D_MODEL + 512 * j + 8 * lane) = wq; }
            float acc[8];
#pragma unroll
            for (int h = 0; h < 8; ++h) { float s = 0.f;
#pragma unroll
                for (int d = 0; d < 16; ++d) s = fmaf(xv[d], wff[d][h], s);
                acc[h] = wave_sum(s); }
            float mine = acc[0];
#pragma unroll
            for (int h = 1; h < 8; ++h) mine = ((lane & 7) == h) ? acc[h] : mine;
            if (lane < 8) LF[(size_t)m * 8 + lane] = log_sigmoid(mine + bfl);
        }
    }
}

__device__ __forceinline__ pg8::f32x4 iacc(pg8::f32x4 a, float s) { typedef int v4i_ __attribute__((ext_vector_type(4))); const v4i_ i = __builtin_bit_cast(v4i_, a); return (pg8::f32x4){(float)i[0] * s, (float)i[1] * s, (float)i[2] * s, (float)i[3] * s}; }
struct EpiInProj {
    static constexpr bool PERM = true, AFTER_DRAIN = false;
    static constexpr float SI = 1.f / (SQ_X * SQ_WIN);
    bf16 *fq, *fkt, *fvt, *sq, *skt, *svt; const float2* rope; float *qn2, *kn2;
    static __device__ __forceinline__ size_t tile_off(int nh, int t, int head) { const int b = t >> 12, s = t & 4095; return ((size_t)(b * nh + head) * 64 + (s >> 6)) * 8192; }
    __device__ __forceinline__ void operator()(const pg8::f32x4 (&acc)[2][2][4][2], const pg8::Unit& u, int wr, int wc, int fr, int fq_) const {
        const int pn = u.pn, g = wc & 1, hsub = wc >> 1;
        const int trow0 = u.pm * 256 + wr * 64 + fr;
        const bool lane0 = (fr == 0) && (fq_ == 0);
#pragma unroll
        for (int ai = 0; ai < 2; ++ai)
#pragma unroll
            for (int bj = 0; bj < 2; ++bj) {
                const int blk64 = (u.pm * 256 + ai * 128 + wr * 64) >> 6;
                if (pn < 6) {
                    const int head = 4 * (pn & 1) + 2 * bj + hsub;
                    float nrm = 0.f;
#pragma unroll
                    for (int m = 0; m < 4; ++m) {
                        const int t = trow0 + ai * 128 + m * 16;
                        pg8::f32x4 v0 = iacc(acc[ai][bj][m][0], SI), v1 = iacc(acc[ai][bj][m][1], SI);
                        if (pn < 2) { v0 = v0 * C2; v1 = v1 * C2; }
                        v4u w; w.x = pg8::cvt_pk_bf16(v0[0], v0[1]); w.y = pg8::cvt_pk_bf16(v0[2], v0[3]); w.z = pg8::cvt_pk_bf16(v1[0], v1[1]); w.w = pg8::cvt_pk_bf16(v1[2], v1[3]);
                        if (pn < 4) { float ss = (v0[0] * v0[0] + v0[1] * v0[1]) + (v0[2] * v0[2] + v0[3] * v0[3]) + (v1[0] * v1[0] + v1[1] * v1[1]) + (v1[2] * v1[2] + v1[3] * v1[3]);
                            ss += __shfl_xor(ss, 16); ss += __shfl_xor(ss, 32); nrm = fmaxf(nrm, ss); }
                        if (pn < 2) *(GAS v4u*)(fq + (size_t)t * 512 + head * 64 + 32 * g + 8 * fq_) = w;
                        else if (pn < 4) *(GAS v4u*)((GAS unsigned char*)fkt + tile_off(8, t, head) + (size_t)((4 * g + fq_) * 64 + (t & 63)) * 16) = w;
                        else *(GAS v4u*)((GAS unsigned char*)fvt + tile_off(8, t, head) + (size_t)(g * 4 + ((t & 63) >> 4)) * 1024 + (t & 15) * 64 + fq_ * 16) = w;
                    }
                    if (pn < 4) {
                        nrm = fmaxf(nrm, __shfl_xor(nrm, 1)); nrm = fmaxf(nrm, __shfl_xor(nrm, 2)); nrm = fmaxf(nrm, __shfl_xor(nrm, 4)); nrm = fmaxf(nrm, __shfl_xor(nrm, 8));
                        if (lane0) (pn < 2 ? qn2 : kn2)[(blk64 * 8 + head) * 2 + g] = nrm;
                    }
                } else if (pn < 8 || bj == 0) {
                    const int head = (pn < 8) ? 4 * (pn & 1) + 2 * bj + hsub : hsub;
                    const int i0 = 16 * g + 4 * fq_;
#pragma unroll
                    for (int m = 0; m < 4; ++m) {
                        const int t = trow0 + ai * 128 + m * 16, pos = t & 4095;
                        const pg8::f32x4 x1 = iacc(acc[ai][bj][m][0], SI), x2 = iacc(acc[ai][bj][m][1], SI);
                        const f32x4 cs01 = *(const GAS f32x4*)(rope + pos * 32 + i0), cs23 = *(const GAS f32x4*)(rope + pos * 32 + i0 + 2);
                        float o1[4], o2[4];
                        o1[0] = x1[0] * cs01.x - x2[0] * cs01.y; o2[0] = x2[0] * cs01.x + x1[0] * cs01.y;
                        o1[1] = x1[1] * cs01.z - x2[1] * cs01.w; o2[1] = x2[1] * cs01.z + x1[1] * cs01.w;
                        o1[2] = x1[2] * cs23.x - x2[2] * cs23.y; o2[2] = x2[2] * cs23.x + x1[2] * cs23.y;
                        o1[3] = x1[3] * cs23.z - x2[3] * cs23.w; o2[3] = x2[3] * cs23.z + x1[3] * cs23.w;
                        if (pn < 8) {
#pragma unroll
                            for (int e = 0; e < 4; ++e) { o1[e] *= C2; o2[e] *= C2; }
                        }
                        u32x2 w1, w2; w1.x = pg8::cvt_pk_bf16(o1[0], o1[1]); w1.y = pg8::cvt_pk_bf16(o1[2], o1[3]); w2.x = pg8::cvt_pk_bf16(o2[0], o2[1]); w2.y = pg8::cvt_pk_bf16(o2[2], o2[3]);
                        if (pn < 8) { bf16* p = sq + (size_t)t * 512 + head * 64 + i0; *(GAS u32x2*)p = w1; *(GAS u32x2*)(p + 32) = w2; }
                        else { GAS unsigned char* p = (GAS unsigned char*)skt + tile_off(2, t, head) + (size_t)((2 * g + (fq_ >> 1)) * 64 + (t & 63)) * 16 + (fq_ & 1) * 8;
                            *(GAS u32x2*)p = w1; *(GAS u32x2*)(p + 4 * 1024) = w2; }
                    }
                } else {
                    const int head = hsub;
#pragma unroll
                    for (int m = 0; m < 4; ++m) {
                        const int t = trow0 + ai * 128 + m * 16;
                        const pg8::f32x4 v0 = iacc(acc[ai][bj][m][0], SI), v1 = iacc(acc[ai][bj][m][1], SI);
                        v4u w; w.x = pg8::cvt_pk_bf16(v0[0], v0[1]); w.y = pg8::cvt_pk_bf16(v0[2], v0[3]); w.z = pg8::cvt_pk_bf16(v1[0], v1[1]); w.w = pg8::cvt_pk_bf16(v1[2], v1[3]);
                        *(GAS v4u*)((GAS unsigned char*)svt + tile_off(2, t, head) + (size_t)(g * 4 + ((t & 63) >> 4)) * 1024 + (t & 15) * 64 + fq_ * 16) = w;
                    }
                }
            }
    }
};

__device__ __forceinline__ void convert_experts(Frame& F, int w, int nw, int r0, int r1) {
    const float* eu = F.in[9]; const float* ev = F.in[10]; const int lane = F.lane;
    for (int m0 = r0 + 4 * w; m0 < r1; m0 += 4 * nw) {
        const bool isu = m0 < NEXP; const int e0 = m0 % NEXP;
        const float* src = (isu ? eu : ev) + (size_t)e0 * D_MODEL; unsigned char* dst = F.ws + (isu ? WS_EU : WS_EV); const float sc = isu ? U_QS : SQ_V;
        f32x4 va[4][2], vb[4][2];
#pragma unroll
        for (int r = 0; r < 4; ++r)
#pragma unroll
            for (int j = 0; j < 2; ++j) { va[r][j] = *(const GAS f32x4*)(src + r * D_MODEL + 512 * j + 8 * lane); vb[r][j] = *(const GAS f32x4*)(src + r * D_MODEL + 512 * j + 8 * lane + 4); }
#pragma unroll
        for (int r = 0; r < 4; ++r)
#pragma unroll
            for (int j = 0; j < 2; ++j) { const f32x4 a = va[r][j] * sc, b = vb[r][j] * sc;
                const int w0 = (int)q8x4(a.x, a.y, a.z, a.w), w1 = (int)q8x4(b.x, b.y, b.z, b.w);
                u32x2 wd; wd.x = (unsigned)w0; wd.y = (unsigned)w1;
                *(GAS u32x2*)(dst + (size_t)(4 * j + (lane >> 4)) * EXP_SLICE_BYTES + (size_t)(e0 + r) * 128 + 8 * (lane & 15)) = wd; }
    }
}
__device__ __forceinline__ void p1_slack_jobs(Frame& F, int sb, int nsb) {
    const float* LF = (const float*)(F.ws + WS_LF); float* C = (float*)(F.ws + WS_C);
    LAS float* red = (LAS float*)F.lds;
    const int lane = F.lane;
    for (int job = sb; job < BATCH * FOX_H; job += nsb) {
        const int b = job >> 3, h = job & 7;
        float v[8]; float run = 0.f;
#pragma unroll
        for (int i = 0; i < 8; ++i) { run += LF[(size_t)(b * SEQ + F.tid * 8 + i) * 8 + h]; v[i] = run; }
        float inc = run;
#pragma unroll
        for (int o = 1; o < 64; o <<= 1) { const float n = __shfl_up(inc, o); if (lane >= o) inc += n; }
        __syncthreads();
        if (lane == 63) red[F.wave] = inc;
        __syncthreads();
        float base = inc - run;
        for (int w = 0; w < F.wave; ++w) base += red[w];
#pragma unroll
        for (int i = 0; i < 8; ++i) C[(size_t)job * SEQ + F.tid * 8 + i] = (base + v[i]) * LOG2E;
    }
    const int w = sb * NWAVES + F.wave, nw = nsb * NWAVES;
    {
        const bf16* WQ = (const bf16*)(F.ws + WS_WQ); const float* w_query = F.in[7]; const float* ln1_b = F.in[6];
        float* GW = (float*)(F.ws + WS_GW); float* BW = GW + QCOLS;
        for (int n = w; n < QCOLS; n += nw) {
            const v4u a = *(const GAS v4u*)(WQ + (size_t)n * 1024 + 8 * lane), b = *(const GAS v4u*)(WQ + (size_t)n * 1024 + 512 + 8 * lane);
            float s = 0.f;
#pragma unroll
            for (int i = 0; i < 4; ++i) { s += __uint_as_float(a[i] << 16) + __uint_as_float(a[i] & 0xffff0000u); s += __uint_as_float(b[i] << 16) + __uint_as_float(b[i] & 0xffff0000u); }
            s = wave_sum(s);
            if (lane == 0) GW[n] = s;
        }
    }
    for (int c64 = sb; c64 < QCOLS / 64; c64 += nsb) {
        const float* w_query = F.in[7]; const float* ln1_b = F.in[6]; float* BW = (float*)(F.ws + WS_GW) + QCOLS;
        const int n = c64 * 64 + lane; float s = 0.f;
        for (int k0 = F.wave * 128; k0 < F.wave * 128 + 128; k0 += 16) {
            float wv_[16];
#pragma unroll
            for (int i = 0; i < 16; ++i) wv_[i] = w_query[(size_t)(k0 + i) * QCOLS + n];
#pragma unroll
            for (int i = 0; i < 16; ++i) s = fmaf(ln1_b[k0 + i], wv_[i], s);
        }
        __syncthreads();
        red[F.wave * 64 + lane] = s;
        __syncthreads();
        if (F.wave == 0) { float t_ = 0.f;
#pragma unroll
            for (int w8 = 0; w8 < 8; ++w8) t_ += red[w8 * 64 + lane];
            BW[n] = t_; }
    }
    convert_experts(F, w, nw, 0, EXP_SPLIT);
}

namespace att {
typedef float f32x16 __attribute__((ext_vector_type(16)));
typedef short s16x4 __attribute__((ext_vector_type(4)));
constexpr int LDS_K = 0, LDS_V = 16384, LDS_WS = 32768, LDS_OST = LDS_WS + 8 * 256, LDS_TOTAL = LDS_OST + 8 * 4096;
__device__ __forceinline__ int crow(int r, int hi) { return (r & 3) + 8 * (r >> 2) + 4 * hi; }
__device__ __forceinline__ float max3f(float a, float b, float c) { float r; asm("v_max3_f32 %0, %1, %2, %3" : "=v"(r) : "v"(a), "v"(b), "v"(c)); return r; }
__device__ __forceinline__ unsigned cvtpk(float lo, float hi) { unsigned r; asm("v_cvt_pk_bf16_f32 %0, %1, %2" : "=v"(r) : "v"(lo), "v"(hi)); return r; }
__device__ __forceinline__ float rowmax(const f32x16& p0, const f32x16& p1) {
    float a = max3f(p0[0], p0[1], p1[0]), b = max3f(p0[2], p0[3], p1[1]); a = max3f(a, p1[2], p1[3]);
#pragma unroll
    for (int r = 4; r < 16; r += 4) { a = max3f(a, p0[r], p0[r + 1]); b = max3f(b, p0[r + 2], p0[r + 3]); a = max3f(a, p1[r], p1[r + 1]); b = max3f(b, p1[r + 2], p1[r + 3]); }
    const float m = fmaxf(a, b);
    auto rr = __builtin_amdgcn_permlane32_swap(__float_as_uint(m), __float_as_uint(m), false, false);
    return fmaxf(__uint_as_float(rr[0]), __uint_as_float(rr[1]));
}
__device__ __forceinline__ void qkt(f32x16& p0, f32x16& p1, const LAS unsigned char* Kslot, const bf16x8* qr, int r32, int hi) {
    const LAS unsigned char* kb = Kslot + hi * 1024 + r32 * 16;
#pragma unroll
    for (int d0 = 0; d0 < 4; ++d0) {
        const bf16x8 b0 = *(const LAS bf16x8*)(kb + d0 * 2048), b1 = *(const LAS bf16x8*)(kb + d0 * 2048 + 512);
        p0 = __builtin_amdgcn_mfma_f32_32x32x16_bf16(b0, qr[d0], p0, 0, 0, 0);
        p1 = __builtin_amdgcn_mfma_f32_32x32x16_bf16(b1, qr[d0], p1, 0, 0, 0);
    }
}
__device__ __forceinline__ void pv(f32x16* o, int vb, bf16x8 pa0, bf16x8 pa1, bf16x8 pa2, bf16x8 pa3) {
#pragma unroll
    for (int d0 = 0; d0 < 2; ++d0) {
        s16x4 lo[4], hi[4];
#pragma unroll
        for (int ks = 0; ks < 4; ++ks) {
            asm volatile("ds_read_b64_tr_b16 %0,%1 offset:%c2" : "=&v"(lo[ks]) : "v"(vb), "i"(d0 * 4096 + ks * 1024) : "memory");
            asm volatile("ds_read_b64_tr_b16 %0,%1 offset:%c2" : "=&v"(hi[ks]) : "v"(vb), "i"(d0 * 4096 + ks * 1024 + 512) : "memory");
        }
        asm volatile("s_waitcnt lgkmcnt(0)" ::: "memory"); __builtin_amdgcn_sched_barrier(0);
#define ATT_PK(k) (bf16x8){lo[k][0], lo[k][1], lo[k][2], lo[k][3], hi[k][0], hi[k][1], hi[k][2], hi[k][3]}
        o[d0] = __builtin_amdgcn_mfma_f32_32x32x16_bf16(pa0, ATT_PK(0), o[d0], 0, 0, 0);
        o[d0] = __builtin_amdgcn_mfma_f32_32x32x16_bf16(pa1, ATT_PK(1), o[d0], 0, 0, 0);
        o[d0] = __builtin_amdgcn_mfma_f32_32x32x16_bf16(pa2, ATT_PK(2), o[d0], 0, 0, 0);
        o[d0] = __builtin_amdgcn_mfma_f32_32x32x16_bf16(pa3, ATT_PK(3), o[d0], 0, 0, 0);
#undef ATT_PK
    }
}

template <int KIND>
__device__ __forceinline__ void attn_unit(Frame& F, int b, int h, int qb) {
    const int tid = F.tid, lane = F.lane, r32 = lane & 31, hi = lane >> 5, wid = F.wave;
    const int q0 = qb * 256, w0 = q0 + wid * 32, myq = w0 + r32;
    const bf16* Qg = (const bf16*)(F.ws + (KIND == 0 ? WS_FQ : WS_SQ)) + (size_t)(b * SEQ + myq) * 512 + h * 64;
    const int kvh = (KIND == 0) ? h : (h >> 2), nkv = (KIND == 0) ? 8 : 2;
    const unsigned char* KT = F.ws + (KIND == 0 ? WS_FKT : WS_SKT) + (size_t)(b * nkv + kvh) * 64 * 8192;
    const unsigned char* VT = F.ws + (KIND == 0 ? WS_FVT : WS_SVT) + (size_t)(b * nkv + kvh) * 64 * 8192;
    const float* Cg = (const float*)(F.ws + WS_C) + (size_t)(b * 8 + h) * SEQ;
    LAS unsigned char* lds = F.lds;
    LAS float* wsf = (LAS float*)(lds + LDS_WS) + wid * 64;
#define ATT_LOAD(j, buf) do { \
        __builtin_amdgcn_global_load_lds((const unsigned*)(KT + (size_t)(j) * 8192 + tid * 16), (LAS unsigned*)(lds + LDS_K + (buf) * 8192 + wid * 1024), 16, 0, 0); \
        __builtin_amdgcn_global_load_lds((const unsigned*)(VT + (size_t)(j) * 8192 + tid * 16), (LAS unsigned*)(lds + LDS_V + (buf) * 8192 + wid * 1024), 16, 0, 0); } while (0)
    const int jhi = qb * 4 + 3; int jlo; float cref = 0.f, cw0 = 0.f, TH = 0.f;
    ATT_LOAD(jhi, 0);
    bf16x8 qr[4];
#pragma unroll
    for (int d0 = 0; d0 < 4; ++d0) qr[d0] = *(const GAS bf16x8*)(Qg + d0 * 16 + hi * 8);
    if (KIND == 0) {
        const float* QN2 = (const float*)(F.ws + WS_QN2); const float* KN2 = (const float*)(F.ws + WS_KN2);
        const int kblk = b * 64 + lane; const float knl = KN2[(kblk * 8 + h) * 2] + KN2[(kblk * 8 + h) * 2 + 1];
        const int qblk = (b * SEQ + q0) / 64 + (lane & 3); const float qnl = QN2[(qblk * 8 + h) * 2] + QN2[(qblk * 8 + h) * 2 + 1];
        const int jt = qb * 4 - 1 - lane; const float cl = Cg[jt >= 0 ? 64 * jt + 63 : 0];
        cref = Cg[q0]; cw0 = Cg[w0];
        const float kn = wave_max(knl), qn = wave_max(qnl);
        TH = 160.f + 2.05f * sqrtf(qn * kn);
        const unsigned long long keep = __ballot(lane < 16 && jt >= 0 && (cref - cl) >= -TH);
        const int nkeep = __builtin_ctzll(~keep);
        jlo = qb * 4 - nkeep;
        if (nkeep == 16) { while (jlo > 0 && (cref - Cg[64 * (jlo - 1) + 63]) >= -TH) --jlo; }
        jlo = __builtin_amdgcn_readfirstlane(jlo);
    } else {
        jlo = (q0 - 127) < 0 ? 0 : ((q0 - 127) >> 6);
    }
    float m_run, l_run;
    if (KIND == 0) { m_run = -INFINITY; l_run = 0.f; }
    else { m_run = F.in[3][h] * LOG2E; l_run = (hi == 0) ? 1.f : 0.f; }
    f32x16 o[2];
#pragma unroll
    for (int r = 0; r < 16; ++r) { o[0][r] = 0.f; o[1][r] = 0.f; }
    const int vb0 = (int)(unsigned)(uintptr_t)(lds + LDS_V) + ((lane >> 4) & 1) * 32 + (lane & 3) * 8 + (4 * hi + ((lane & 15) >> 2)) * 64;
    int cur = 0;
    for (int j = jhi; j >= jlo; --j, cur ^= 1) {
        asm volatile("s_waitcnt vmcnt(0)" ::: "memory");
        __syncthreads();
        if (j > jlo) ATT_LOAD(j - 1, cur ^ 1);
        const int k0 = 64 * j;
        bool active = k0 <= w0 + 31;
        if (KIND == 1) active = active && (k0 + 63 >= w0 - 127);
        if (KIND == 0 && k0 + 63 < w0) active = active && ((cw0 - Cg[k0 + 63]) >= -TH);
        if (active) {
            f32x16 p0, p1;
            if (KIND == 0) {
#pragma unroll
                for (int g = 0; g < 4; ++g) {
                    const f32x4 c0 = *(const GAS f32x4*)(Cg + k0 + 8 * g + 4 * hi), c1 = *(const GAS f32x4*)(Cg + k0 + 32 + 8 * g + 4 * hi);
#pragma unroll
                    for (int e = 0; e < 4; ++e) { p0[4 * g + e] = cref - c0[e]; p1[4 * g + e] = cref - c1[e]; }
                }
            } else {
#pragma unroll
                for (int r = 0; r < 16; ++r) { p0[r] = 0.f; p1[r] = 0.f; }
            }
            qkt(p0, p1, lds + LDS_K + cur * 8192, qr, r32, hi);
            if (k0 + 63 > w0) {
#pragma unroll
                for (int r = 0; r < 16; ++r) { const int kv = k0 + crow(r, hi); if (kv > myq) p0[r] = -INFINITY; if (kv + 32 > myq) p1[r] = -INFINITY; }
            }
            if (KIND == 1 && k0 < w0 + 31 - 127) {
#pragma unroll
                for (int r = 0; r < 16; ++r) { const int kv = k0 + crow(r, hi); if (kv < myq - 127) p0[r] = -INFINITY; if (kv + 32 < myq - 127) p1[r] = -INFINITY; }
            }
            const float rm = rowmax(p0, p1);
            const float m_new = fmaxf(m_run, rm);
            const bool resc = __any(m_new > m_run);
            const float alpha = __builtin_amdgcn_exp2f(m_run - m_new);
            m_run = m_new;
            float ps = 0.f;
#pragma unroll
            for (int r = 0; r < 16; ++r) { p0[r] = __builtin_amdgcn_exp2f(p0[r] - m_new); p1[r] = __builtin_amdgcn_exp2f(p1[r] - m_new); ps += p0[r] + p1[r]; }
            l_run = l_run * alpha + ps;
            v4u pw0, pw1, pw2, pw3;
#pragma unroll
            for (int i = 0; i < 4; ++i) { pw0[i] = cvtpk(p0[2 * i], p0[2 * i + 1]); pw1[i] = cvtpk(p0[8 + 2 * i], p0[9 + 2 * i]); pw2[i] = cvtpk(p1[2 * i], p1[2 * i + 1]); pw3[i] = cvtpk(p1[8 + 2 * i], p1[9 + 2 * i]); }
            if (resc) {
                if (hi == 0) wsf[r32] = alpha;
#pragma unroll
                for (int r = 0; r < 16; ++r) { const float a = wsf[crow(r, hi)]; o[0][r] *= a; o[1][r] *= a; }
            }
            pv(o, vb0 + cur * 8192, __builtin_bit_cast(bf16x8, pw0), __builtin_bit_cast(bf16x8, pw1), __builtin_bit_cast(bf16x8, pw2), __builtin_bit_cast(bf16x8, pw3));
        }
    }
#undef ATT_LOAD
    { auto rr = __builtin_amdgcn_permlane32_swap(__float_as_uint(l_run), __float_as_uint(l_run), false, false); l_run = __uint_as_float(rr[0]) + __uint_as_float(rr[1]); }
    if (hi == 0) wsf[32 + r32] = l_run;
    float rli[16];
#pragma unroll
    for (int r = 0; r < 16; ++r) rli[r] = __builtin_amdgcn_rcpf(wsf[32 + crow(r, hi)]);
    LAS unsigned char* stg = lds + LDS_OST + wid * 2048;
#pragma unroll
    for (int r = 0; r < 16; ++r) { const int orow = crow(r, hi);
#pragma unroll
        for (int d0 = 0; d0 < 2; ++d0) { const float qv = fminf(fmaxf(rintf(o[d0][r] * rli[r] * SQ_A), -127.f), 127.f); stg[orow * 64 + d0 * 32 + r32] = (unsigned char)(int)qv; } }
    unsigned char* Ow = F.ws + WS_ATTN + (size_t)(b * SEQ + w0) * 1024 + (KIND == 0 ? 0 : 512) + h * 64;
#pragma unroll
    for (int i = 0; i < 2; ++i) { const int row = i * 16 + (lane >> 2), ch = lane & 3; const v4u v = *(const LAS v4u*)(stg + row * 64 + ch * 16); *(GAS v4u*)(Ow + (size_t)row * 1024 + ch * 16) = v; }
    __syncthreads();
}

__device__ __forceinline__ void attn_phase(Frame& F, int kmask = 3) {
    for (int u = (int)blockIdx.x; u < 2048; u += F.G) {
        const int kind = u >> 10; if (!((kmask >> kind) & 1)) continue;
        const int rem = u & 1023, b = rem >> 7, h = (rem >> 4) & 7, qb = ((rem & 15) + (rem >> 8)) & 15;
        if (kind == 0) attn_unit<0>(F, b, h, qb); else attn_unit<1>(F, b, h, qb);
    }
}
}

struct EpiOutProj {
    static constexpr bool PERM = true, AFTER_DRAIN = false;
    bf16* yb; float2* stats;
    __device__ __forceinline__ void operator()(const pg8::f32x4 (&acc)[2][2][4][2], const pg8::Unit& u, int wr, int wc, int fr, int fq_) const {
        const int trow0 = u.pm * 256 + wr * 64 + fr;
#pragma unroll
        for (int ai = 0; ai < 2; ++ai)
#pragma unroll
            for (int m = 0; m < 4; ++m) {
                const int t = trow0 + ai * 128 + m * 16;
                float s = 0.f, ss = 0.f;
#pragma unroll
                for (int bj = 0; bj < 2; ++bj) {
                    const size_t off = (size_t)t * D_MODEL + u.pn * 256 + bj * 128 + wc * 32 + 8 * fq_;
                    const v4u xw = *(const GAS v4u*)(yb + off);
                    f32x4 x0, x1;
                    x0[0] = __uint_as_float(xw[0] << 16); x0[1] = __uint_as_float(xw[0] & 0xffff0000u); x0[2] = __uint_as_float(xw[1] << 16); x0[3] = __uint_as_float(xw[1] & 0xffff0000u);
                    x1[0] = __uint_as_float(xw[2] << 16); x1[1] = __uint_as_float(xw[2] & 0xffff0000u); x1[2] = __uint_as_float(xw[3] << 16); x1[3] = __uint_as_float(xw[3] & 0xffff0000u);
                    const f32x4 v0 = x0 * ALPHA + iacc(acc[ai][bj][m][0], 1.f / (SQ_A * SQ_WOUT)), v1 = x1 * ALPHA + iacc(acc[ai][bj][m][1], 1.f / (SQ_A * SQ_WOUT));
                    v4u w; w.x = pg8::cvt_pk_bf16(v0[0], v0[1]); w.y = pg8::cvt_pk_bf16(v0[2], v0[3]); w.z = pg8::cvt_pk_bf16(v1[0], v1[1]); w.w = pg8::cvt_pk_bf16(v1[2], v1[3]);
                    *(GAS v4u*)(yb + off) = w;
                    s += (v0[0] + v0[1]) + (v0[2] + v0[3]) + (v1[0] + v1[1]) + (v1[2] + v1[3]);
                    ss += (v0[0] * v0[0] + v0[1] * v0[1]) + (v0[2] * v0[2] + v0[3] * v0[3]) + (v1[0] * v1[0] + v1[1] * v1[1]) + (v1[2] * v1[2] + v1[3] * v1[3]);
                }
                s += __shfl_xor(s, 16); s += __shfl_xor(s, 32); ss += __shfl_xor(ss, 16); ss += __shfl_xor(ss, 32);
                if (fq_ == 0) stats[(size_t)t * 16 + u.pn * 4 + wc] = make_float2(s, ss);
            }
    }
};
__device__ __forceinline__ float2 ln1_row_stats(const float2* stats, int t) {
    float s = 0.f, ss = 0.f;
#pragma unroll
    for (int i = 0; i < 16; i += 2) { const f32x4 a = *(const GAS f32x4*)(stats + (size_t)t * 16 + i); s += a.x + a.z; ss += a.y + a.w; }
    const float mean = s * (1.f / D_MODEL), var = fmaxf(ss * (1.f / D_MODEL) - mean * mean, 0.f);
    return make_float2(mean, 1.f / sqrtf(var + LN_EPS));
}
struct EpiQuery {
    static constexpr bool PERM = true, AFTER_DRAIN = false;
    const float2* stats; const float* gw; const float* bw; bf16* q;
    __device__ __forceinline__ void operator()(const pg8::f32x4 (&acc)[2][2][4][2], const pg8::Unit& u, int wr, int wc, int fr, int fq_) const {
        const int trow0 = u.pm * 256 + wr * 64 + fr, lane = fr + 16 * fq_;
        const int k0 = 2 * fq_, k1 = 2 * fq_ + 1;
        const float2 sa = ln1_row_stats(stats, trow0 + (k0 >> 2) * 128 + (k0 & 3) * 16), sb = ln1_row_stats(stats, trow0 + (k1 >> 2) * 128 + (k1 & 3) * 16);
        float mean[8], rstd[8];
#pragma unroll
        for (int k = 0; k < 8; ++k) { const int src = fr + 16 * (k >> 1); mean[k] = __shfl((k & 1) ? sb.x : sa.x, src); rstd[k] = __shfl((k & 1) ? sb.y : sa.y, src); }
        (void)lane;
#pragma unroll
        for (int bj = 0; bj < 2; ++bj) {
            const int col0 = u.pn * 256 + bj * 128 + wc * 32 + 8 * fq_;
            const f32x4 g0 = *(const GAS f32x4*)(gw + col0), g1 = *(const GAS f32x4*)(gw + col0 + 4), b0 = *(const GAS f32x4*)(bw + col0), b1 = *(const GAS f32x4*)(bw + col0 + 4);
#pragma unroll
            for (int ai = 0; ai < 2; ++ai)
#pragma unroll
                for (int m = 0; m < 4; ++m) {
                    const int t = trow0 + ai * 128 + m * 16; const float mu = mean[4 * ai + m], rs = rstd[4 * ai + m];
                    const f32x4 v0 = (acc[ai][bj][m][0] - g0 * mu) * rs + b0, v1 = (acc[ai][bj][m][1] - g1 * mu) * rs + b1;
                    v4u w; w.x = pg8::cvt_pk_bf16(v0[0], v0[1]); w.y = pg8::cvt_pk_bf16(v0[2], v0[3]); w.z = pg8::cvt_pk_bf16(v1[0], v1[1]); w.w = pg8::cvt_pk_bf16(v1[2], v1[3]);
                    *(GAS v4u*)(q + ((size_t)(t >> 5) * 8192 + (size_t)(col0 >> 3) * 32 + (t & 31)) * 8) = w;
                }
        }
    }
};
#define TOPK_SORT128(v) do { \
  CE(v[0],v[1]);CE(v[3],v[2]);CE(v[4],v[5]);CE(v[7],v[6]);CE(v[8],v[9]);CE(v[11],v[10]);CE(v[12],v[13]);CE(v[15],v[14]);CE(v[0],v[2]);CE(v[1],v[3]);CE(v[6],v[4]);CE(v[7],v[5]);CE(v[8],v[10]);CE(v[9],v[11]);CE(v[14],v[12]);CE(v[15],v[13]);CE(v[0],v[1]);CE(v[2],v[3]);CE(v[5],v[4]);CE(v[7],v[6]);CE(v[8],v[9]);CE(v[10],v[11]);CE(v[13],v[12]);CE(v[15],v[14]);CE(v[0],v[4]);CE(v[1],v[5]);CE(v[2],v[6]);CE(v[3],v[7]);CE(v[12],v[8]);CE(v[13],v[9]);CE(v[14],v[10]);CE(v[15],v[11]);CE(v[0],v[2]);CE(v[1],v[3]);CE(v[4],v[6]);CE(v[5],v[7]);CE(v[10],v[8]);CE(v[11],v[9]);CE(v[14],v[12]);CE(v[15],v[13]);CE(v[0],v[1]);CE(v[2],v[3]);CE(v[4],v[5]);CE(v[6],v[7]);CE(v[9],v[8]);CE(v[11],v[10]);CE(v[13],v[12]);CE(v[15],v[14]);CE(v[0],v[8]);CE(v[1],v[9]);CE(v[2],v[10]);CE(v[3],v[11]);CE(v[4],v[12]);CE(v[5],v[13]);CE(v[6],v[14]);CE(v[7],v[15]);CE(v[0],v[4]);CE(v[1],v[5]);CE(v[2],v[6]);CE(v[3],v[7]);CE(v[8],v[12]);CE(v[9],v[13]);CE(v[10],v[14]);CE(v[11],v[15]);CE(v[0],v[2]);CE(v[1],v[3]);CE(v[4],v[6]);CE(v[5],v[7]);CE(v[8],v[10]);CE(v[9],v[11]);CE(v[12],v[14]);CE(v[13],v[15]);CE(v[0],v[1]);CE(v[2],v[3]);CE(v[4],v[5]);CE(v[6],v[7]);CE(v[8],v[9]);CE(v[10],v[11]);CE(v[12],v[13]);CE(v[14],v[15]); \
  CE(v[16],v[17]);CE(v[19],v[18]);CE(v[20],v[21]);CE(v[23],v[22]);CE(v[24],v[25]);CE(v[27],v[26]);CE(v[28],v[29]);CE(v[31],v[30]);CE(v[16],v[18]);CE(v[17],v[19]);CE(v[22],v[20]);CE(v[23],v[21]);CE(v[24],v[26]);CE(v[25],v[27]);CE(v[30],v[28]);CE(v[31],v[29]);CE(v[16],v[17]);CE(v[18],v[19]);CE(v[21],v[20]);CE(v[23],v[22]);CE(v[24],v[25]);CE(v[26],v[27]);CE(v[29],v[28]);CE(v[31],v[30]);CE(v[16],v[20]);CE(v[17],v[21]);CE(v[18],v[22]);CE(v[19],v[23]);CE(v[28],v[24]);CE(v[29],v[25]);CE(v[30],v[26]);CE(v[31],v[27]);CE(v[16],v[18]);CE(v[17],v[19]);CE(v[20],v[22]);CE(v[21],v[23]);CE(v[26],v[24]);CE(v[27],v[25]);CE(v[30],v[28]);CE(v[31],v[29]);CE(v[16],v[17]);CE(v[18],v[19]);CE(v[20],v[21]);CE(v[22],v[23]);CE(v[25],v[24]);CE(v[27],v[26]);CE(v[29],v[28]);CE(v[31],v[30]);CE(v[16],v[24]);CE(v[17],v[25]);CE(v[18],v[26]);CE(v[19],v[27]);CE(v[20],v[28]);CE(v[21],v[29]);CE(v[22],v[30]);CE(v[23],v[31]);CE(v[16],v[20]);CE(v[17],v[21]);CE(v[18],v[22]);CE(v[19],v[23]);CE(v[24],v[28]);CE(v[25],v[29]);CE(v[26],v[30]);CE(v[27],v[31]);CE(v[16],v[18]);CE(v[17],v[19]);CE(v[20],v[22]);CE(v[21],v[23]);CE(v[24],v[26]);CE(v[25],v[27]);CE(v[28],v[30]);CE(v[29],v[31]);CE(v[16],v[17]);CE(v[18],v[19]);CE(v[20],v[21]);CE(v[22],v[23]);CE(v[24],v[25]);CE(v[26],v[27]);CE(v[28],v[29]);CE(v[30],v[31]); \
  CE(v[32],v[33]);CE(v[35],v[34]);CE(v[36],v[37]);CE(v[39],v[38]);CE(v[40],v[41]);CE(v[43],v[42]);CE(v[44],v[45]);CE(v[47],v[46]);CE(v[32],v[34]);CE(v[33],v[35]);CE(v[38],v[36]);CE(v[39],v[37]);CE(v[40],v[42]);CE(v[41],v[43]);CE(v[46],v[44]);CE(v[47],v[45]);CE(v[32],v[33]);CE(v[34],v[35]);CE(v[37],v[36]);CE(v[39],v[38]);CE(v[40],v[41]);CE(v[42],v[43]);CE(v[45],v[44]);CE(v[47],v[46]);CE(v[32],v[36]);CE(v[33],v[37]);CE(v[34],v[38]);CE(v[35],v[39]);CE(v[44],v[40]);CE(v[45],v[41]);CE(v[46],v[42]);CE(v[47],v[43]);CE(v[32],v[34]);CE(v[33],v[35]);CE(v[36],v[38]);CE(v[37],v[39]);CE(v[42],v[40]);CE(v[43],v[41]);CE(v[46],v[44]);CE(v[47],v[45]);CE(v[32],v[33]);CE(v[34],v[35]);CE(v[36],v[37]);CE(v[38],v[39]);CE(v[41],v[40]);CE(v[43],v[42]);CE(v[45],v[44]);CE(v[47],v[46]);CE(v[32],v[40]);CE(v[33],v[41]);CE(v[34],v[42]);CE(v[35],v[43]);CE(v[36],v[44]);CE(v[37],v[45]);CE(v[38],v[46]);CE(v[39],v[47]);CE(v[32],v[36]);CE(v[33],v[37]);CE(v[34],v[38]);CE(v[35],v[39]);CE(v[40],v[44]);CE(v[41],v[45]);CE(v[42],v[46]);CE(v[43],v[47]);CE(v[32],v[34]);CE(v[33],v[35]);CE(v[36],v[38]);CE(v[37],v[39]);CE(v[40],v[42]);CE(v[41],v[43]);CE(v[44],v[46]);CE(v[45],v[47]);CE(v[32],v[33]);CE(v[34],v[35]);CE(v[36],v[37]);CE(v[38],v[39]);CE(v[40],v[41]);CE(v[42],v[43]);CE(v[44],v[45]);CE(v[46],v[47]); \
  CE(v[48],v[49]);CE(v[51],v[50]);CE(v[52],v[53]);CE(v[55],v[54]);CE(v[56],v[57]);CE(v[59],v[58]);CE(v[60],v[61]);CE(v[63],v[62]);CE(v[48],v[50]);CE(v[49],v[51]);CE(v[54],v[52]);CE(v[55],v[53]);CE(v[56],v[58]);CE(v[57],v[59]);CE(v[62],v[60]);CE(v[63],v[61]);CE(v[48],v[49]);CE(v[50],v[51]);CE(v[53],v[52]);CE(v[55],v[54]);CE(v[56],v[57]);CE(v[58],v[59]);CE(v[61],v[60]);CE(v[63],v[62]);CE(v[48],v[52]);CE(v[49],v[53]);CE(v[50],v[54]);CE(v[51],v[55]);CE(v[60],v[56]);CE(v[61],v[57]);CE(v[62],v[58]);CE(v[63],v[59]);CE(v[48],v[50]);CE(v[49],v[51]);CE(v[52],v[54]);CE(v[53],v[55]);CE(v[58],v[56]);CE(v[59],v[57]);CE(v[62],v[60]);CE(v[63],v[61]);CE(v[48],v[49]);CE(v[50],v[51]);CE(v[52],v[53]);CE(v[54],v[55]);CE(v[57],v[56]);CE(v[59],v[58]);CE(v[61],v[60]);CE(v[63],v[62]);CE(v[48],v[56]);CE(v[49],v[57]);CE(v[50],v[58]);CE(v[51],v[59]);CE(v[52],v[60]);CE(v[53],v[61]);CE(v[54],v[62]);CE(v[55],v[63]);CE(v[48],v[52]);CE(v[49],v[53]);CE(v[50],v[54]);CE(v[51],v[55]);CE(v[56],v[60]);CE(v[57],v[61]);CE(v[58],v[62]);CE(v[59],v[63]);CE(v[48],v[50]);CE(v[49],v[51]);CE(v[52],v[54]);CE(v[53],v[55]);CE(v[56],v[58]);CE(v[57],v[59]);CE(v[60],v[62]);CE(v[61],v[63]);CE(v[48],v[49]);CE(v[50],v[51]);CE(v[52],v[53]);CE(v[54],v[55]);CE(v[56],v[57]);CE(v[58],v[59]);CE(v[60],v[61]);CE(v[62],v[63]); \
  CE(v[64],v[65]);CE(v[67],v[66]);CE(v[68],v[69]);CE(v[71],v[70]);CE(v[72],v[73]);CE(v[75],v[74]);CE(v[76],v[77]);CE(v[79],v[78]);CE(v[64],v[66]);CE(v[65],v[67]);CE(v[70],v[68]);CE(v[71],v[69]);CE(v[72],v[74]);CE(v[73],v[75]);CE(v[78],v[76]);CE(v[79],v[77]);CE(v[64],v[65]);CE(v[66],v[67]);CE(v[69],v[68]);CE(v[71],v[70]);CE(v[72],v[73]);CE(v[74],v[75]);CE(v[77],v[76]);CE(v[79],v[78]);CE(v[64],v[68]);CE(v[65],v[69]);CE(v[66],v[70]);CE(v[67],v[71]);CE(v[76],v[72]);CE(v[77],v[73]);CE(v[78],v[74]);CE(v[79],v[75]);CE(v[64],v[66]);CE(v[65],v[67]);CE(v[68],v[70]);CE(v[69],v[71]);CE(v[74],v[72]);CE(v[75],v[73]);CE(v[78],v[76]);CE(v[79],v[77]);CE(v[64],v[65]);CE(v[66],v[67]);CE(v[68],v[69]);CE(v[70],v[71]);CE(v[73],v[72]);CE(v[75],v[74]);CE(v[77],v[76]);CE(v[79],v[78]);CE(v[64],v[72]);CE(v[65],v[73]);CE(v[66],v[74]);CE(v[67],v[75]);CE(v[68],v[76]);CE(v[69],v[77]);CE(v[70],v[78]);CE(v[71],v[79]);CE(v[64],v[68]);CE(v[65],v[69]);CE(v[66],v[70]);CE(v[67],v[71]);CE(v[72],v[76]);CE(v[73],v[77]);CE(v[74],v[78]);CE(v[75],v[79]);CE(v[64],v[66]);CE(v[65],v[67]);CE(v[68],v[70]);CE(v[69],v[71]);CE(v[72],v[74]);CE(v[73],v[75]);CE(v[76],v[78]);CE(v[77],v[79]);CE(v[64],v[65]);CE(v[66],v[67]);CE(v[68],v[69]);CE(v[70],v[71]);CE(v[72],v[73]);CE(v[74],v[75]);CE(v[76],v[77]);CE(v[78],v[79]); \
  CE(v[80],v[81]);CE(v[83],v[82]);CE(v[84],v[85]);CE(v[87],v[86]);CE(v[88],v[89]);CE(v[91],v[90]);CE(v[92],v[93]);CE(v[95],v[94]);CE(v[80],v[82]);CE(v[81],v[83]);CE(v[86],v[84]);CE(v[87],v[85]);CE(v[88],v[90]);CE(v[89],v[91]);CE(v[94],v[92]);CE(v[95],v[93]);CE(v[80],v[81]);CE(v[82],v[83]);CE(v[85],v[84]);CE(v[87],v[86]);CE(v[88],v[89]);CE(v[90],v[91]);CE(v[93],v[92]);CE(v[95],v[94]);CE(v[80],v[84]);CE(v[81],v[85]);CE(v[82],v[86]);CE(v[83],v[87]);CE(v[92],v[88]);CE(v[93],v[89]);CE(v[94],v[90]);CE(v[95],v[91]);CE(v[80],v[82]);CE(v[81],v[83]);CE(v[84],v[86]);CE(v[85],v[87]);CE(v[90],v[88]);CE(v[91],v[89]);CE(v[94],v[92]);CE(v[95],v[93]);CE(v[80],v[81]);CE(v[82],v[83]);CE(v[84],v[85]);CE(v[86],v[87]);CE(v[89],v[88]);CE(v[91],v[90]);CE(v[93],v[92]);CE(v[95],v[94]);CE(v[80],v[88]);CE(v[81],v[89]);CE(v[82],v[90]);CE(v[83],v[91]);CE(v[84],v[92]);CE(v[85],v[93]);CE(v[86],v[94]);CE(v[87],v[95]);CE(v[80],v[84]);CE(v[81],v[85]);CE(v[82],v[86]);CE(v[83],v[87]);CE(v[88],v[92]);CE(v[89],v[93]);CE(v[90],v[94]);CE(v[91],v[95]);CE(v[80],v[82]);CE(v[81],v[83]);CE(v[84],v[86]);CE(v[85],v[87]);CE(v[88],v[90]);CE(v[89],v[91]);CE(v[92],v[94]);CE(v[93],v[95]);CE(v[80],v[81]);CE(v[82],v[83]);CE(v[84],v[85]);CE(v[86],v[87]);CE(v[88],v[89]);CE(v[90],v[91]);CE(v[92],v[93]);CE(v[94],v[95]); \
  CE(v[96],v[97]);CE(v[99],v[98]);CE(v[100],v[101]);CE(v[103],v[102]);CE(v[104],v[105]);CE(v[107],v[106]);CE(v[108],v[109]);CE(v[111],v[110]);CE(v[96],v[98]);CE(v[97],v[99]);CE(v[102],v[100]);CE(v[103],v[101]);CE(v[104],v[106]);CE(v[105],v[107]);CE(v[110],v[108]);CE(v[111],v[109]);CE(v[96],v[97]);CE(v[98],v[99]);CE(v[101],v[100]);CE(v[103],v[102]);CE(v[104],v[105]);CE(v[106],v[107]);CE(v[109],v[108]);CE(v[111],v[110]);CE(v[96],v[100]);CE(v[97],v[101]);CE(v[98],v[102]);CE(v[99],v[103]);CE(v[108],v[104]);CE(v[109],v[105]);CE(v[110],v[106]);CE(v[111],v[107]);CE(v[96],v[98]);CE(v[97],v[99]);CE(v[100],v[102]);CE(v[101],v[103]);CE(v[106],v[104]);CE(v[107],v[105]);CE(v[110],v[108]);CE(v[111],v[109]);CE(v[96],v[97]);CE(v[98],v[99]);CE(v[100],v[101]);CE(v[102],v[103]);CE(v[105],v[104]);CE(v[107],v[106]);CE(v[109],v[108]);CE(v[111],v[110]);CE(v[96],v[104]);CE(v[97],v[105]);CE(v[98],v[106]);CE(v[99],v[107]);CE(v[100],v[108]);CE(v[101],v[109]);CE(v[102],v[110]);CE(v[103],v[111]);CE(v[96],v[100]);CE(v[97],v[101]);CE(v[98],v[102]);CE(v[99],v[103]);CE(v[104],v[108]);CE(v[105],v[109]);CE(v[106],v[110]);CE(v[107],v[111]);CE(v[96],v[98]);CE(v[97],v[99]);CE(v[100],v[102]);CE(v[101],v[103]);CE(v[104],v[106]);CE(v[105],v[107]);CE(v[108],v[110]);CE(v[109],v[111]);CE(v[96],v[97]);CE(v[98],v[99]);CE(v[100],v[101]);CE(v[102],v[103]);CE(v[104],v[105]);CE(v[106],v[107]);CE(v[108],v[109]);CE(v[110],v[111]); \
  CE(v[112],v[113]);CE(v[115],v[114]);CE(v[116],v[117]);CE(v[119],v[118]);CE(v[120],v[121]);CE(v[123],v[122]);CE(v[124],v[125]);CE(v[127],v[126]);CE(v[112],v[114]);CE(v[113],v[115]);CE(v[118],v[116]);CE(v[119],v[117]);CE(v[120],v[122]);CE(v[121],v[123]);CE(v[126],v[124]);CE(v[127],v[125]);CE(v[112],v[113]);CE(v[114],v[115]);CE(v[117],v[116]);CE(v[119],v[118]);CE(v[120],v[121]);CE(v[122],v[123]);CE(v[125],v[124]);CE(v[127],v[126]);CE(v[112],v[116]);CE(v[113],v[117]);CE(v[114],v[118]);CE(v[115],v[119]);CE(v[124],v[120]);CE(v[125],v[121]);CE(v[126],v[122]);CE(v[127],v[123]);CE(v[112],v[114]);CE(v[113],v[115]);CE(v[116],v[118]);CE(v[117],v[119]);CE(v[122],v[120]);CE(v[123],v[121]);CE(v[126],v[124]);CE(v[127],v[125]);CE(v[112],v[113]);CE(v[114],v[115]);CE(v[116],v[117]);CE(v[118],v[119]);CE(v[121],v[120]);CE(v[123],v[122]);CE(v[125],v[124]);CE(v[127],v[126]);CE(v[112],v[120]);CE(v[113],v[121]);CE(v[114],v[122]);CE(v[115],v[123]);CE(v[116],v[124]);CE(v[117],v[125]);CE(v[118],v[126]);CE(v[119],v[127]);CE(v[112],v[116]);CE(v[113],v[117]);CE(v[114],v[118]);CE(v[115],v[119]);CE(v[120],v[124]);CE(v[121],v[125]);CE(v[122],v[126]);CE(v[123],v[127]);CE(v[112],v[114]);CE(v[113],v[115]);CE(v[116],v[118]);CE(v[117],v[119]);CE(v[120],v[122]);CE(v[121],v[123]);CE(v[124],v[126]);CE(v[125],v[127]);CE(v[112],v[113]);CE(v[114],v[115]);CE(v[116],v[117]);CE(v[118],v[119]);CE(v[120],v[121]);CE(v[122],v[123]);CE(v[124],v[125]);CE(v[126],v[127]); \
  v[0]=vmaxf(v[0],v[31]);v[1]=vmaxf(v[1],v[30]);v[2]=vmaxf(v[2],v[29]);v[3]=vmaxf(v[3],v[28]);v[4]=vmaxf(v[4],v[27]);v[5]=vmaxf(v[5],v[26]);v[6]=vmaxf(v[6],v[25]);v[7]=vmaxf(v[7],v[24]);v[8]=vmaxf(v[8],v[23]);v[9]=vmaxf(v[9],v[22]);v[10]=vmaxf(v[10],v[21]);v[11]=vmaxf(v[11],v[20]);v[12]=vmaxf(v[12],v[19]);v[13]=vmaxf(v[13],v[18]);v[14]=vmaxf(v[14],v[17]);v[15]=vmaxf(v[15],v[16]);CE(v[0],v[8]);CE(v[1],v[9]);CE(v[2],v[10]);CE(v[3],v[11]);CE(v[4],v[12]);CE(v[5],v[13]);CE(v[6],v[14]);CE(v[7],v[15]);CE(v[0],v[4]);CE(v[1],v[5]);CE(v[2],v[6]);CE(v[3],v[7]);CE(v[8],v[12]);CE(v[9],v[13]);CE(v[10],v[14]);CE(v[11],v[15]);CE(v[0],v[2]);CE(v[1],v[3]);CE(v[4],v[6]);CE(v[5],v[7]);CE(v[8],v[10]);CE(v[9],v[11]);CE(v[12],v[14]);CE(v[13],v[15]);CE(v[0],v[1]);CE(v[2],v[3]);CE(v[4],v[5]);CE(v[6],v[7]);CE(v[8],v[9]);CE(v[10],v[11]);CE(v[12],v[13]);CE(v[14],v[15]); \
  v[32]=vmaxf(v[32],v[63]);v[33]=vmaxf(v[33],v[62]);v[34]=vmaxf(v[34],v[61]);v[35]=vmaxf(v[35],v[60]);v[36]=vmaxf(v[36],v[59]);v[37]=vmaxf(v[37],v[58]);v[38]=vmaxf(v[38],v[57]);v[39]=vmaxf(v[39],v[56]);v[40]=vmaxf(v[40],v[55]);v[41]=vmaxf(v[41],v[54]);v[42]=vmaxf(v[42],v[53]);v[43]=vmaxf(v[43],v[52]);v[44]=vmaxf(v[44],v[51]);v[45]=vmaxf(v[45],v[50]);v[46]=vmaxf(v[46],v[49]);v[47]=vmaxf(v[47],v[48]);CE(v[32],v[40]);CE(v[33],v[41]);CE(v[34],v[42]);CE(v[35],v[43]);CE(v[36],v[44]);CE(v[37],v[45]);CE(v[38],v[46]);CE(v[39],v[47]);CE(v[32],v[36]);CE(v[33],v[37]);CE(v[34],v[38]);CE(v[35],v[39]);CE(v[40],v[44]);CE(v[41],v[45]);CE(v[42],v[46]);CE(v[43],v[47]);CE(v[32],v[34]);CE(v[33],v[35]);CE(v[36],v[38]);CE(v[37],v[39]);CE(v[40],v[42]);CE(v[41],v[43]);CE(v[44],v[46]);CE(v[45],v[47]);CE(v[32],v[33]);CE(v[34],v[35]);CE(v[36],v[37]);CE(v[38],v[39]);CE(v[40],v[41]);CE(v[42],v[43]);CE(v[44],v[45]);CE(v[46],v[47]); \
  v[64]=vmaxf(v[64],v[95]);v[65]=vmaxf(v[65],v[94]);v[66]=vmaxf(v[66],v[93]);v[67]=vmaxf(v[67],v[92]);v[68]=vmaxf(v[68],v[91]);v[69]=vmaxf(v[69],v[90]);v[70]=vmaxf(v[70],v[89]);v[71]=vmaxf(v[71],v[88]);v[72]=vmaxf(v[72],v[87]);v[73]=vmaxf(v[73],v[86]);v[74]=vmaxf(v[74],v[85]);v[75]=vmaxf(v[75],v[84]);v[76]=vmaxf(v[76],v[83]);v[77]=vmaxf(v[77],v[82]);v[78]=vmaxf(v[78],v[81]);v[79]=vmaxf(v[79],v[80]);CE(v[64],v[72]);CE(v[65],v[73]);CE(v[66],v[74]);CE(v[67],v[75]);CE(v[68],v[76]);CE(v[69],v[77]);CE(v[70],v[78]);CE(v[71],v[79]);CE(v[64],v[68]);CE(v[65],v[69]);CE(v[66],v[70]);CE(v[67],v[71]);CE(v[72],v[76]);CE(v[73],v[77]);CE(v[74],v[78]);CE(v[75],v[79]);CE(v[64],v[66]);CE(v[65],v[67]);CE(v[68],v[70]);CE(v[69],v[71]);CE(v[72],v[74]);CE(v[73],v[75]);CE(v[76],v[78]);CE(v[77],v[79]);CE(v[64],v[65]);CE(v[66],v[67]);CE(v[68],v[69]);CE(v[70],v[71]);CE(v[72],v[73]);CE(v[74],v[75]);CE(v[76],v[77]);CE(v[78],v[79]); \
  v[96]=vmaxf(v[96],v[127]);v[97]=vmaxf(v[97],v[126]);v[98]=vmaxf(v[98],v[125]);v[99]=vmaxf(v[99],v[124]);v[100]=vmaxf(v[100],v[123]);v[101]=vmaxf(v[101],v[122]);v[102]=vmaxf(v[102],v[121]);v[103]=vmaxf(v[103],v[120]);v[104]=vmaxf(v[104],v[119]);v[105]=vmaxf(v[105],v[118]);v[106]=vmaxf(v[106],v[117]);v[107]=vmaxf(v[107],v[116]);v[108]=vmaxf(v[108],v[115]);v[109]=vmaxf(v[109],v[114]);v[110]=vmaxf(v[110],v[113]);v[111]=vmaxf(v[111],v[112]);CE(v[96],v[104]);CE(v[97],v[105]);CE(v[98],v[106]);CE(v[99],v[107]);CE(v[100],v[108]);CE(v[101],v[109]);CE(v[102],v[110]);CE(v[103],v[111]);CE(v[96],v[100]);CE(v[97],v[101]);CE(v[98],v[102]);CE(v[99],v[103]);CE(v[104],v[108]);CE(v[105],v[109]);CE(v[106],v[110]);CE(v[107],v[111]);CE(v[96],v[98]);CE(v[97],v[99]);CE(v[100],v[102]);CE(v[101],v[103]);CE(v[104],v[106]);CE(v[105],v[107]);CE(v[108],v[110]);CE(v[109],v[111]);CE(v[96],v[97]);CE(v[98],v[99]);CE(v[100],v[101]);CE(v[102],v[103]);CE(v[104],v[105]);CE(v[106],v[107]);CE(v[108],v[109]);CE(v[110],v[111]); \
  v[0]=vmaxf(v[0],v[47]);v[1]=vmaxf(v[1],v[46]);v[2]=vmaxf(v[2],v[45]);v[3]=vmaxf(v[3],v[44]);v[4]=vmaxf(v[4],v[43]);v[5]=vmaxf(v[5],v[42]);v[6]=vmaxf(v[6],v[41]);v[7]=vmaxf(v[7],v[40]);v[8]=vmaxf(v[8],v[39]);v[9]=vmaxf(v[9],v[38]);v[10]=vmaxf(v[10],v[37]);v[11]=vmaxf(v[11],v[36]);v[12]=vmaxf(v[12],v[35]);v[13]=vmaxf(v[13],v[34]);v[14]=vmaxf(v[14],v[33]);v[15]=vmaxf(v[15],v[32]);CE(v[0],v[8]);CE(v[1],v[9]);CE(v[2],v[10]);CE(v[3],v[11]);CE(v[4],v[12]);CE(v[5],v[13]);CE(v[6],v[14]);CE(v[7],v[15]);CE(v[0],v[4]);CE(v[1],v[5]);CE(v[2],v[6]);CE(v[3],v[7]);CE(v[8],v[12]);CE(v[9],v[13]);CE(v[10],v[14]);CE(v[11],v[15]);CE(v[0],v[2]);CE(v[1],v[3]);CE(v[4],v[6]);CE(v[5],v[7]);CE(v[8],v[10]);CE(v[9],v[11]);CE(v[12],v[14]);CE(v[13],v[15]);CE(v[0],v[1]);CE(v[2],v[3]);CE(v[4],v[5]);CE(v[6],v[7]);CE(v[8],v[9]);CE(v[10],v[11]);CE(v[12],v[13]);CE(v[14],v[15]); \
  v[64]=vmaxf(v[64],v[111]);v[65]=vmaxf(v[65],v[110]);v[66]=vmaxf(v[66],v[109]);v[67]=vmaxf(v[67],v[108]);v[68]=vmaxf(v[68],v[107]);v[69]=vmaxf(v[69],v[106]);v[70]=vmaxf(v[70],v[105]);v[71]=vmaxf(v[71],v[104]);v[72]=vmaxf(v[72],v[103]);v[73]=vmaxf(v[73],v[102]);v[74]=vmaxf(v[74],v[101]);v[75]=vmaxf(v[75],v[100]);v[76]=vmaxf(v[76],v[99]);v[77]=vmaxf(v[77],v[98]);v[78]=vmaxf(v[78],v[97]);v[79]=vmaxf(v[79],v[96]);CE(v[64],v[72]);CE(v[65],v[73]);CE(v[66],v[74]);CE(v[67],v[75]);CE(v[68],v[76]);CE(v[69],v[77]);CE(v[70],v[78]);CE(v[71],v[79]);CE(v[64],v[68]);CE(v[65],v[69]);CE(v[66],v[70]);CE(v[67],v[71]);CE(v[72],v[76]);CE(v[73],v[77]);CE(v[74],v[78]);CE(v[75],v[79]);CE(v[64],v[66]);CE(v[65],v[67]);CE(v[68],v[70]);CE(v[69],v[71]);CE(v[72],v[74]);CE(v[73],v[75]);CE(v[76],v[78]);CE(v[77],v[79]);CE(v[64],v[65]);CE(v[66],v[67]);CE(v[68],v[69]);CE(v[70],v[71]);CE(v[72],v[73]);CE(v[74],v[75]);CE(v[76],v[77]);CE(v[78],v[79]); \
  v[0]=vmaxf(v[0],v[79]);v[1]=vmaxf(v[1],v[78]);v[2]=vmaxf(v[2],v[77]);v[3]=vmaxf(v[3],v[76]);v[4]=vmaxf(v[4],v[75]);v[5]=vmaxf(v[5],v[74]);v[6]=vmaxf(v[6],v[73]);v[7]=vmaxf(v[7],v[72]);v[8]=vmaxf(v[8],v[71]);v[9]=vmaxf(v[9],v[70]);v[10]=vmaxf(v[10],v[69]);v[11]=vmaxf(v[11],v[68]);v[12]=vmaxf(v[12],v[67]);v[13]=vmaxf(v[13],v[66]);v[14]=vmaxf(v[14],v[65]);v[15]=vmaxf(v[15],v[64]);CE(v[0],v[8]);CE(v[1],v[9]);CE(v[2],v[10]);CE(v[3],v[11]);CE(v[4],v[12]);CE(v[5],v[13]);CE(v[6],v[14]);CE(v[7],v[15]);CE(v[0],v[4]);CE(v[1],v[5]);CE(v[2],v[6]);CE(v[3],v[7]);CE(v[8],v[12]);CE(v[9],v[13]);CE(v[10],v[14]);CE(v[11],v[15]);CE(v[0],v[2]);CE(v[1],v[3]);CE(v[4],v[6]);CE(v[5],v[7]);CE(v[8],v[10]);CE(v[9],v[11]);CE(v[12],v[14]);CE(v[13],v[15]);CE(v[0],v[1]);CE(v[2],v[3]);CE(v[4],v[5]);CE(v[6],v[7]);CE(v[8],v[9]);CE(v[10],v[11]);CE(v[12],v[13]);CE(v[14],v[15]); \
} while (0)
#define TOPK_SORT32(v) do { \
  CE(v[0],v[1]);CE(v[3],v[2]);CE(v[4],v[5]);CE(v[7],v[6]);CE(v[8],v[9]);CE(v[11],v[10]);CE(v[12],v[13]);CE(v[15],v[14]);CE(v[0],v[2]);CE(v[1],v[3]);CE(v[6],v[4]);CE(v[7],v[5]);CE(v[8],v[10]);CE(v[9],v[11]);CE(v[14],v[12]);CE(v[15],v[13]);CE(v[0],v[1]);CE(v[2],v[3]);CE(v[5],v[4]);CE(v[7],v[6]);CE(v[8],v[9]);CE(v[10],v[11]);CE(v[13],v[12]);CE(v[15],v[14]);CE(v[0],v[4]);CE(v[1],v[5]);CE(v[2],v[6]);CE(v[3],v[7]);CE(v[12],v[8]);CE(v[13],v[9]);CE(v[14],v[10]);CE(v[15],v[11]);CE(v[0],v[2]);CE(v[1],v[3]);CE(v[4],v[6]);CE(v[5],v[7]);CE(v[10],v[8]);CE(v[11],v[9]);CE(v[14],v[12]);CE(v[15],v[13]);CE(v[0],v[1]);CE(v[2],v[3]);CE(v[4],v[5]);CE(v[6],v[7]);CE(v[9],v[8]);CE(v[11],v[10]);CE(v[13],v[12]);CE(v[15],v[14]);CE(v[0],v[8]);CE(v[1],v[9]);CE(v[2],v[10]);CE(v[3],v[11]);CE(v[4],v[12]);CE(v[5],v[13]);CE(v[6],v[14]);CE(v[7],v[15]);CE(v[0],v[4]);CE(v[1],v[5]);CE(v[2],v[6]);CE(v[3],v[7]);CE(v[8],v[12]);CE(v[9],v[13]);CE(v[10],v[14]);CE(v[11],v[15]);CE(v[0],v[2]);CE(v[1],v[3]);CE(v[4],v[6]);CE(v[5],v[7]);CE(v[8],v[10]);CE(v[9],v[11]);CE(v[12],v[14]);CE(v[13],v[15]);CE(v[0],v[1]);CE(v[2],v[3]);CE(v[4],v[5]);CE(v[6],v[7]);CE(v[8],v[9]);CE(v[10],v[11]);CE(v[12],v[13]);CE(v[14],v[15]); \
  CE(v[16],v[17]);CE(v[19],v[18]);CE(v[20],v[21]);CE(v[23],v[22]);CE(v[24],v[25]);CE(v[27],v[26]);CE(v[28],v[29]);CE(v[31],v[30]);CE(v[16],v[18]);CE(v[17],v[19]);CE(v[22],v[20]);CE(v[23],v[21]);CE(v[24],v[26]);CE(v[25],v[27]);CE(v[30],v[28]);CE(v[31],v[29]);CE(v[16],v[17]);CE(v[18],v[19]);CE(v[21],v[20]);CE(v[23],v[22]);CE(v[24],v[25]);CE(v[26],v[27]);CE(v[29],v[28]);CE(v[31],v[30]);CE(v[16],v[20]);CE(v[17],v[21]);CE(v[18],v[22]);CE(v[19],v[23]);CE(v[28],v[24]);CE(v[29],v[25]);CE(v[30],v[26]);CE(v[31],v[27]);CE(v[16],v[18]);CE(v[17],v[19]);CE(v[20],v[22]);CE(v[21],v[23]);CE(v[26],v[24]);CE(v[27],v[25]);CE(v[30],v[28]);CE(v[31],v[29]);CE(v[16],v[17]);CE(v[18],v[19]);CE(v[20],v[21]);CE(v[22],v[23]);CE(v[25],v[24]);CE(v[27],v[26]);CE(v[29],v[28]);CE(v[31],v[30]);CE(v[16],v[24]);CE(v[17],v[25]);CE(v[18],v[26]);CE(v[19],v[27]);CE(v[20],v[28]);CE(v[21],v[29]);CE(v[22],v[30]);CE(v[23],v[31]);CE(v[16],v[20]);CE(v[17],v[21]);CE(v[18],v[22]);CE(v[19],v[23]);CE(v[24],v[28]);CE(v[25],v[29]);CE(v[26],v[30]);CE(v[27],v[31]);CE(v[16],v[18]);CE(v[17],v[19]);CE(v[20],v[22]);CE(v[21],v[23]);CE(v[24],v[26]);CE(v[25],v[27]);CE(v[28],v[30]);CE(v[29],v[31]);CE(v[16],v[17]);CE(v[18],v[19]);CE(v[20],v[21]);CE(v[22],v[23]);CE(v[24],v[25]);CE(v[26],v[27]);CE(v[28],v[29]);CE(v[30],v[31]); \
  v[0]=vmaxf(v[0],v[31]);v[1]=vmaxf(v[1],v[30]);v[2]=vmaxf(v[2],v[29]);v[3]=vmaxf(v[3],v[28]);v[4]=vmaxf(v[4],v[27]);v[5]=vmaxf(v[5],v[26]);v[6]=vmaxf(v[6],v[25]);v[7]=vmaxf(v[7],v[24]);v[8]=vmaxf(v[8],v[23]);v[9]=vmaxf(v[9],v[22]);v[10]=vmaxf(v[10],v[21]);v[11]=vmaxf(v[11],v[20]);v[12]=vmaxf(v[12],v[19]);v[13]=vmaxf(v[13],v[18]);v[14]=vmaxf(v[14],v[17]);v[15]=vmaxf(v[15],v[16]);CE(v[0],v[8]);CE(v[1],v[9]);CE(v[2],v[10]);CE(v[3],v[11]);CE(v[4],v[12]);CE(v[5],v[13]);CE(v[6],v[14]);CE(v[7],v[15]);CE(v[0],v[4]);CE(v[1],v[5]);CE(v[2],v[6]);CE(v[3],v[7]);CE(v[8],v[12]);CE(v[9],v[13]);CE(v[10],v[14]);CE(v[11],v[15]);CE(v[0],v[2]);CE(v[1],v[3]);CE(v[4],v[6]);CE(v[5],v[7]);CE(v[8],v[10]);CE(v[9],v[11]);CE(v[12],v[14]);CE(v[13],v[15]);CE(v[0],v[1]);CE(v[2],v[3]);CE(v[4],v[5]);CE(v[6],v[7]);CE(v[8],v[9]);CE(v[10],v[11]);CE(v[12],v[13]);CE(v[14],v[15]); \
} while (0)
#define TOPK_MERGE_BITONIC16(v) do { \
  CE(v[0],v[8]);CE(v[1],v[9]);CE(v[2],v[10]);CE(v[3],v[11]);CE(v[4],v[12]);CE(v[5],v[13]);CE(v[6],v[14]);CE(v[7],v[15]);CE(v[0],v[4]);CE(v[1],v[5]);CE(v[2],v[6]);CE(v[3],v[7]);CE(v[8],v[12]);CE(v[9],v[13]);CE(v[10],v[14]);CE(v[11],v[15]);CE(v[0],v[2]);CE(v[1],v[3]);CE(v[4],v[6]);CE(v[5],v[7]);CE(v[8],v[10]);CE(v[9],v[11]);CE(v[12],v[14]);CE(v[13],v[15]);CE(v[0],v[1]);CE(v[2],v[3]);CE(v[4],v[5]);CE(v[6],v[7]);CE(v[8],v[9]);CE(v[10],v[11]);CE(v[12],v[13]);CE(v[14],v[15]); \
} while (0)
#define TOPK_PAIRS(X) \
  X(0,0,0) X(1,0,1) X(2,0,2) X(3,0,3) X(4,0,4) X(5,0,5) X(6,0,6) X(7,0,7) X(8,0,8) X(9,0,9) X(10,0,10) X(11,0,11) X(12,0,12) X(13,0,13) X(14,0,14) X(15,0,15) X(16,1,1) X(17,1,2) X(18,1,3) X(19,1,4) X(20,1,5) X(21,1,6) X(22,1,7) X(23,2,2) X(24,2,3) X(25,2,4) X(26,3,3)

namespace tk {
typedef float f32x16 __attribute__((ext_vector_type(16)));
__device__ __forceinline__ float vmaxf(float a, float b) { float r; asm("v_max_f32 %0, %1, %2" : "=v"(r) : "v"(a), "v"(b)); return r; }
__device__ __forceinline__ float vminf(float a, float b) { float r; asm("v_min_f32 %0, %1, %2" : "=v"(r) : "v"(a), "v"(b)); return r; }
#define CE(x, y) do { const float h_ = vmaxf(x, y); y = vminf(x, y); x = h_; } while (0)
__device__ __forceinline__ unsigned fbits(float f) { return __float_as_uint(f); }
__device__ __forceinline__ float bitsf(unsigned u) { return __uint_as_float(u); }
__device__ __forceinline__ unsigned byte_lookup(const unsigned (&pk)[4], unsigned i) {
    const unsigned long long lo = (unsigned long long)pk[0] | ((unsigned long long)pk[1] << 32), hi_ = (unsigned long long)pk[2] | ((unsigned long long)pk[3] << 32);
    const unsigned long long s = (i & 8u) ? hi_ : lo;
    return (unsigned)(s >> ((i & 7u) * 8u)) & 0x7Fu;
}
constexpr float PADV = -3.0e38f;

template <int VAR>
__device__ __forceinline__ void topk_phase(Frame& F) {
    const int lane = F.lane, r32 = lane & 31, hi = lane >> 5, wid = F.wave, tid = F.tid;
    LAS unsigned char* lds = F.lds;
    const unsigned char* SUBK = F.ws + WS_SUBK; const bf16* Q = (const bf16*)(F.ws + WS_Q);
    int* IDX = (int*)(F.ws + (VAR ? 360 * MiB : WS_IDX)); float* G = (float*)(F.ws + (VAR ? 376 * MiB : WS_G));
    int cur_h = -1;
    for (int it = (int)blockIdx.x; it < 8 * (T / 256); it += F.G) {
        const int h = it & 7, chunk = it >> 3;
        if (h != cur_h) {
            __syncthreads();
            for (int i = tid; i < 4096; i += NWAVES * 64) { const int ch = i & 15, pn = i >> 4;
                *(LAS v4u*)(lds + (pn >> 7) * 32768 + ch * 2048 + (pn & 127) * 16) = *(const GAS v4u*)(SUBK + (size_t)h * 65536 + (size_t)pn * 256 + ch * 16); }
            __syncthreads();
            cur_h = h;
        }
        asm volatile("; TOPK_BEGIN");
        const int t = chunk * 256 + wid * 32 + r32;
        if (VAR == 0 || VAR == 1 || VAR == 4)
        {
            const float2 st = ln1_row_stats((const float2*)(F.ws + WS_STATS), t);
            const int dcol = 128 * h + 4 * r32;
            const f32x4 g1 = *(const GAS f32x4*)(F.in[5] + dcol), b1 = *(const GAS f32x4*)(F.in[6] + dcol);
            bf16* X1B = (bf16*)(F.ws + WS_X1B);
#pragma unroll
            for (int i = 0; i < 16; ++i) {
                const float m0_ = __uint_as_float(__builtin_amdgcn_readlane(__float_as_uint(st.x), 2 * i)), m1_ = __uint_as_float(__builtin_amdgcn_readlane(__float_as_uint(st.x), 2 * i + 1));
                const float r0_ = __uint_as_float(__builtin_amdgcn_readlane(__float_as_uint(st.y), 2 * i)), r1_ = __uint_as_float(__builtin_amdgcn_readlane(__float_as_uint(st.y), 2 * i + 1));
                const float mu = hi ? m1_ : m0_, rs = hi ? r1_ : r0_;
                const size_t off = (size_t)(chunk * 256 + wid * 32 + 2 * i + hi) * D_MODEL + dcol;
                const u32x2 yw = *(const GAS u32x2*)(X1B + off);
                const f32x4 y4 = {__uint_as_float(yw.x << 16), __uint_as_float(yw.x & 0xffff0000u), __uint_as_float(yw.y << 16), __uint_as_float(yw.y & 0xffff0000u)};
                const f32x4 x4 = (y4 - mu) * rs * g1 + b1;
                u32x2 w; w.x = pk2(x4.x, x4.y); w.y = pk2(x4.z, x4.w);
                const unsigned wq = q8x4(x4.x * X_QS, x4.y * X_QS, x4.z * X_QS, x4.w * X_QS);
                if (VAR == 0) { *(GAS u32x2*)(X1B + off) = w; *(GAS unsigned*)(F.ws + WS_X1Q + off) = wq; } else asm volatile("" :: "v"(w.x), "v"(w.y), "v"(wq));
            }
        }
        float v[128];
        {
            f32x16 acc[2][4];
#pragma unroll
            for (int p = 0; p < 2; ++p)
#pragma unroll
                for (int nt = 0; nt < 4; ++nt)
#pragma unroll
                    for (int r = 0; r < 16; ++r) acc[p][nt][r] = 0.f;
#pragma unroll
            for (int p = 0; p < 2; ++p) {
                bf16x8 bq[8];
#pragma unroll
                for (int ks = 0; ks < 8; ++ks) bq[ks] = *(const GAS bf16x8*)(Q + ((size_t)(t >> 5) * 8192 + (size_t)(h * 32 + p * 16 + ks * 2 + hi) * 32 + r32) * 8);
#pragma unroll
                for (int ks = 0; ks < 8; ++ks)
#pragma unroll
                    for (int nt = 0; nt < 4; ++nt) {
                        const bf16x8 a = *(const LAS bf16x8*)(lds + p * 32768 + (2 * ks + hi) * 2048 + (nt * 32 + r32) * 16);
                        acc[p][nt] = __builtin_amdgcn_mfma_f32_32x32x16_bf16(a, bq[ks], acc[p][nt], 0, 0, 0);
                    }
            }
#pragma unroll
            for (int nt = 0; nt < 4; ++nt)
#pragma unroll
                for (int r = 0; r < 16; ++r) {
                    auto rr = __builtin_amdgcn_permlane32_swap(fbits(acc[0][nt][r]), fbits(acc[1][nt][r]), false, false);
                    const unsigned n0 = 32 * nt + (r & 3) + 8 * (r >> 2);
                    v[nt * 32 + r] = bitsf((rr[0] & 0xFFFFFF80u) | n0);
                    v[nt * 32 + 16 + r] = bitsf((rr[1] & 0xFFFFFF80u) | (n0 + 4u));
                }
        }
        unsigned pf0 = 0, pf1 = 0, pf2 = 0, pf3 = 0;
        if (it + F.G < 8 * (T / 256)) {
            const int hn = (it + F.G) & 7, chn = (it + F.G) >> 3, tgn = chn * 8 + wid;
            const unsigned char* qn_ = (const unsigned char*)Q + ((size_t)tgn * 8192 + (size_t)hn * 1024) * 16;
            pf0 = *(const GAS unsigned*)(qn_ + lane * 128); pf1 = *(const GAS unsigned*)(qn_ + (64 + lane) * 128);
            pf2 = *(const GAS unsigned*)((const unsigned char*)(F.ws + WS_X1B) + ((size_t)(tgn * 32 + (lane >> 1)) * D_MODEL + 128 * hn) * 2 + (lane & 1) * 128);
            pf3 = *(const GAS unsigned*)((const unsigned char*)(F.ws + WS_STATS) + (size_t)(tgn * 32 + (lane & 31)) * 128);
        }
        if (VAR == 2 || VAR == 4 || VAR == 5) { _Pragma("unroll") for (int i_ = 16; i_ < 128; ++i_) asm volatile("" :: "v"(v[i_])); } else
        TOPK_SORT128(v);
        unsigned ak[16], bk[16]; float uval[16], wval[16];
#pragma unroll
        for (int i = 0; i < 16; ++i) {
            auto rr = __builtin_amdgcn_permlane32_swap(fbits(v[i]), fbits(v[i]), false, false);
            ak[i] = rr[0]; bk[i] = rr[1];
            const unsigned oth = hi ? rr[0] : rr[1];
            uval[i] = bitsf(fbits(v[i]) & 0xFFFFFF80u); wval[i] = bitsf(oth & 0xFFFFFF80u);
        }
        unsigned na_pack[4], nb_pack[4];
#pragma unroll
        for (int q = 0; q < 4; ++q) {
            na_pack[q] = (ak[4 * q] & 0x7Fu) | ((ak[4 * q + 1] & 0x7Fu) << 8) | ((ak[4 * q + 2] & 0x7Fu) << 16) | ((ak[4 * q + 3] & 0x7Fu) << 24);
            nb_pack[q] = (bk[4 * q] & 0x7Fu) | ((bk[4 * q + 1] & 0x7Fu) << 8) | ((bk[4 * q + 2] & 0x7Fu) << 16) | ((bk[4 * q + 3] & 0x7Fu) << 24);
        }
        float cand[32];
        const unsigned hb = (unsigned)hi << 8;
#define TK_X(k, i, j) { const float s_ = uval[i] + wval[j]; unsigned kb_ = (fbits(s_) & 0xFFFFFE00u) | hb | (unsigned)((i) * 16 + (j)); if ((i) == (j)) kb_ = hi ? fbits(PADV) : kb_; cand[k] = bitsf(kb_); }
        TOPK_PAIRS(TK_X)
#undef TK_X
#pragma unroll
        for (int k = 27; k < 32; ++k) cand[k] = PADV;
        if (VAR == 3 || VAR == 4 || VAR == 5) { _Pragma("unroll") for (int i_ = 16; i_ < 32; ++i_) asm volatile("" :: "v"(cand[i_])); } else
        TOPK_SORT32(cand);
        float fin[16];
        {
            unsigned oc[16];
#pragma unroll
            for (int i = 0; i < 16; ++i) { auto rr = __builtin_amdgcn_permlane32_swap(fbits(cand[i]), fbits(cand[i]), false, false); oc[i] = hi ? rr[0] : rr[1]; }
#pragma unroll
            for (int i = 0; i < 16; ++i) fin[i] = vmaxf(cand[i], bitsf(oc[15 - i]));
        }
        TOPK_MERGE_BITONIC16(fin);
        float e[16]; float esum = 0.f; const float m0 = bitsf(fbits(fin[0]) & 0xFFFFFE00u);
#pragma unroll
        for (int k = 0; k < 16; ++k) { e[k] = __builtin_amdgcn_exp2f((bitsf(fbits(fin[k]) & 0xFFFFFE00u) - m0) * LOG2E); esum += e[k]; }
        const float inv = 1.f / esum;
        int oi[8]; float og[8];
#pragma unroll
        for (int kk = 0; kk < 8; ++kk) {
            const unsigned key = hi ? fbits(fin[8 + kk]) : fbits(fin[kk]); og[kk] = (hi ? e[8 + kk] : e[kk]) * inv;
            const unsigned code = key & 0x1FFu, f = code >> 8, ci = (code >> 4) & 15u, cj = code & 15u;
            const unsigned ia = f ? cj : ci, jb = f ? ci : cj;
            oi[kk] = (int)(byte_lookup(na_pack, ia) * 128u + byte_lookup(nb_pack, jb));
        }
        int* ip = IDX + ((size_t)t * PEER_H + h) * TOPK + 8 * hi; float* gp = G + ((size_t)t * PEER_H + h) * TOPK + 8 * hi;
        *(GAS v4u*)ip = (v4u){(unsigned)oi[0], (unsigned)oi[1], (unsigned)oi[2], (unsigned)oi[3]}; *(GAS v4u*)(ip + 4) = (v4u){(unsigned)oi[4], (unsigned)oi[5], (unsigned)oi[6], (unsigned)oi[7]};
        *(GAS f32x4*)gp = (f32x4){og[0], og[1], og[2], og[3]}; *(GAS f32x4*)(gp + 4) = (f32x4){og[4], og[5], og[6], og[7]};
        asm volatile("" :: "v"(pf0), "v"(pf1), "v"(pf2), "v"(pf3));
        asm volatile("; TOPK_END");
    }
}
#undef CE
}


namespace ex {
typedef float f32x2 __attribute__((ext_vector_type(2)));
typedef _Float16 h16x2 __attribute__((ext_vector_type(2)));
__device__ __forceinline__ float gelu_erf(float v) {
    const float av = fabsf(v), t = __builtin_amdgcn_rcpf(fmaf(av, 0.2316418882f, 1.0f));
    float q = fmaf(t, 0.5307027145f, -0.7265760135f); q = fmaf(q, t, 0.7107068705f); q = fmaf(q, t, -0.142248368f); q = fmaf(q, t, 0.127414796f); q = q * t;
    const float ee = __builtin_amdgcn_exp2f(v * v * -0.72134752044f);
    const float mm = v * (q * ee);
    return v < 0.f ? mm : v - mm;
}
__device__ __forceinline__ f32x2 bf2_to_f2(unsigned w) { return (f32x2){__uint_as_float(w << 16), __uint_as_float(w & 0xffff0000u)}; }

template <int PH> struct Aux;
template <> struct Aux<0> { v4u xq; };
template <> struct Aux<1> { v4u wv; unsigned x2; };

template <int PH>
__device__ __forceinline__ void gather_issue(Frame& F, v4u (&rw)[16], Aux<PH>& ax, const LAS unsigned* ixl, const unsigned char* tab, unsigned loff, int t, int i, int g, int dl) {
    v4u ix[4];
#pragma unroll
    for (int jj = 0; jj < 4; ++jj) ix[jj] = *(const LAS v4u*)(ixl + i * 128 + 16 * g + 4 * jj);
#pragma unroll
    for (int j = 0; j < 16; ++j) rw[j] = *(const GAS v4u*)(tab + (unsigned)(ix[j >> 2][j & 3] * 128u + loff));
    if constexpr (PH == 0) {
        ax.xq = *(const GAS v4u*)(F.ws + WS_X1Q + (size_t)t * D_MODEL + dl);
    } else {
        ax.wv = *(const GAS v4u*)(F.ws + WS_W16 + (size_t)t * 128 + 16 * g);
        ax.x2 = *(const GAS unsigned*)((const bf16*)(F.ws + WS_X1B) + (size_t)t * D_MODEL + dl + 2 * g);
    }
}
template <int PH, int VAR>
__device__ __forceinline__ void gather_compute(Frame& F, const v4u (&rw)[16], const Aux<PH>& ax, int slice, int t, int lane, int g, int sub, int dl) {
    if constexpr (PH == 0) {
        int p[16];
#pragma unroll
        for (int j = 0; j < 16; ++j) {
            int a_ = __builtin_amdgcn_sdot4((int)rw[j][0], (int)ax.xq[0], 0, false);
#pragma unroll
            for (int c = 1; c < 4; ++c) a_ = __builtin_amdgcn_sdot4((int)rw[j][c], (int)ax.xq[c], a_, false);
            p[j] = a_;
        }
        const bool b2 = (lane & 4) != 0, b1 = (lane & 2) != 0, b0 = (lane & 1) != 0;
#pragma unroll
        for (int k = 0; k < 8; ++k) { const int send = b2 ? p[k] : p[k + 8], keep = b2 ? p[k + 8] : p[k]; p[k] = keep + __builtin_amdgcn_update_dpp(0, send, 0x141, 0xF, 0xF, false); }
#pragma unroll
        for (int k = 0; k < 4; ++k) { const int send = b1 ? p[k] : p[k + 4], keep = b1 ? p[k + 4] : p[k]; p[k] = keep + __builtin_amdgcn_update_dpp(0, send, 0x4E, 0xF, 0xF, false); }
#pragma unroll
        for (int k = 0; k < 2; ++k) { const int send = b0 ? p[k] : p[k + 2], keep = b0 ? p[k + 2] : p[k]; p[k] = keep + __builtin_amdgcn_update_dpp(0, send, 0xB1, 0xF, 0xF, false); }
        const float pf0 = (float)p[0] * (1.f / (U_QS * X_QS)), pf1 = (float)p[1] * (1.f / (U_QS * X_QS));
        const h16x2 ph = {(_Float16)pf0, (_Float16)pf1};
        if (VAR == 0) *(GAS unsigned*)((_Float16*)(F.ws + WS_HP) + ((size_t)slice * T + t) * 128 + 16 * g + 2 * sub) = __builtin_bit_cast(unsigned, ph); else asm volatile("" :: "v"(pf0), "v"(pf1));
    } else {
        const f32x2 x2 = bf2_to_f2(ax.x2);
        const float wsc = ((const float*)(F.ws + WS_MR))[t];
        int acc[16];
#pragma unroll
        for (int c = 0; c < 16; ++c) acc[c] = 0;
#pragma unroll
        for (int q4 = 0; q4 < 4; ++q4) {
            const int w4 = (int)ax.wv[q4];
#pragma unroll
            for (int c = 0; c < 4; ++c) {
                const unsigned r0 = rw[4 * q4][c], r1 = rw[4 * q4 + 1][c], r2 = rw[4 * q4 + 2][c], r3 = rw[4 * q4 + 3][c];
                const unsigned lo01 = __builtin_amdgcn_perm(r1, r0, 0x05010400u), hi01 = __builtin_amdgcn_perm(r1, r0, 0x07030602u);
                const unsigned lo23 = __builtin_amdgcn_perm(r3, r2, 0x05010400u), hi23 = __builtin_amdgcn_perm(r3, r2, 0x07030602u);
                const unsigned d0 = __builtin_amdgcn_perm(lo23, lo01, 0x05040100u), d1 = __builtin_amdgcn_perm(lo23, lo01, 0x07060302u);
                const unsigned d2 = __builtin_amdgcn_perm(hi23, hi01, 0x05040100u), d3 = __builtin_amdgcn_perm(hi23, hi01, 0x07060302u);
                acc[4 * c] = __builtin_amdgcn_sdot4((int)d0, w4, acc[4 * c], false); acc[4 * c + 1] = __builtin_amdgcn_sdot4((int)d1, w4, acc[4 * c + 1], false);
                acc[4 * c + 2] = __builtin_amdgcn_sdot4((int)d2, w4, acc[4 * c + 2], false); acc[4 * c + 3] = __builtin_amdgcn_sdot4((int)d3, w4, acc[4 * c + 3], false);
            }
        }
#pragma unroll
        for (int k = 0; k < 8; ++k) { auto rr = __builtin_amdgcn_permlane32_swap((unsigned)acc[k], (unsigned)acc[k + 8], false, false); acc[k] = (int)rr[0] + (int)rr[1]; }
#pragma unroll
        for (int k = 0; k < 4; ++k) { auto rr = __builtin_amdgcn_permlane16_swap((unsigned)acc[k], (unsigned)acc[k + 4], false, false); acc[k] = (int)rr[0] + (int)rr[1]; }
        const bool b3 = (lane & 8) != 0;
#pragma unroll
        for (int k = 0; k < 2; ++k) { const int send = b3 ? acc[k] : acc[k + 2], keep = b3 ? acc[k + 2] : acc[k]; acc[k] = keep + __builtin_amdgcn_update_dpp(0, send, 0x128, 0xF, 0xF, false); }
        float a[2];
        a[0] = (float)acc[0] * wsc; a[1] = (float)acc[1] * wsc;
        f32x2 v2;
        v2.x = fmaf(ALPHA, x2.x, a[0]);
        v2.y = fmaf(ALPHA, x2.y, a[1]);
        if (VAR == 0) *(GAS unsigned*)((bf16*)(F.ws + WS_V2) + (size_t)t * D_MODEL + dl + 2 * g) = pk2(v2.x, v2.y);
    }
}

constexpr int GTW = 32;
template <int PH, int VAR>
__device__ __forceinline__ void gather_item(Frame& F, int slice_, int chunk_) {
    const int lane = F.lane, g = lane >> 3, sub = lane & 7;
    const int slice = __builtin_amdgcn_readfirstlane(slice_), chunk = __builtin_amdgcn_readfirstlane(chunk_);
    const unsigned char* tab = F.ws + (PH == 0 ? WS_EU : WS_EV) + (size_t)slice * EXP_SLICE_BYTES;
    const unsigned loff = 16u * (unsigned)sub;
    const int tbase = chunk * (8 * GTW) + F.wave * GTW;
    const int dl = 128 * slice + 16 * sub;
    LAS unsigned* ixl = (LAS unsigned*)(F.lds + F.wave * 16384);
    {
        const v4u* src = (const v4u*)((const int*)(F.ws + WS_IDX) + (size_t)tbase * 128);
        v4u tmp[GTW / 2];
#pragma unroll
        for (int k = 0; k < GTW / 2; ++k) tmp[k] = *(const GAS v4u*)(src + k * 64 + lane);
#pragma unroll
        for (int k = 0; k < GTW / 2; ++k) *(LAS v4u*)(ixl + (k * 64 + lane) * 4) = tmp[k];
    }
    v4u rwA[16], rwB[16]; Aux<PH> axA, axB;
    gather_issue<PH>(F, rwA, axA, ixl, tab, loff, tbase, 0, g, dl);
    if (VAR == 2) gather_issue<PH>(F, rwB, axB, ixl, tab, loff, tbase + 1, 1, g, dl);
#pragma unroll 4
    for (int i = 0; i < GTW; i += 2) {
        if (VAR != 2) gather_issue<PH>(F, rwB, axB, ixl, tab, loff, tbase + i + 1, i + 1, g, dl);
        if (VAR != 1) gather_compute<PH, VAR>(F, rwA, axA, slice, tbase + i, lane, g, sub, dl);
        else { _Pragma("unroll") for (int j = 0; j < 16; ++j) asm volatile("" :: "v"(rwA[j])); }
        const int in = (i + 2 < GTW) ? i + 2 : GTW - 1;
        if (VAR != 2) gather_issue<PH>(F, rwA, axA, ixl, tab, loff, tbase + in, in, g, dl);
        if (VAR != 1) gather_compute<PH, VAR>(F, rwB, axB, slice, tbase + i + 1, lane, g, sub, dl);
        else { _Pragma("unroll") for (int j = 0; j < 16; ++j) asm volatile("" :: "v"(rwB[j])); }
        if (VAR == 2) { _Pragma("unroll") for (int j = 0; j < 16; ++j) asm volatile("" : "+v"(rwA[j]), "+v"(rwB[j])); }
    }
}

template <int PH, int VAR = 0>
__device__ __forceinline__ void gather_phase(Frame& F) {
    LAS int* sh = (LAS int*)(F.lds + RING_BYTES + 1024);
    const unsigned xcc = xb_xcc_id() & 7u;
    gu32* qbase = F.ctl + (VAR ? CW_QV + 1024 : (PH == 0 ? CW_QU : CW_QV));
    for (int r = 0; r < 8; ++r) {
        const int qi = (int)((xcc + (unsigned)r) & 7u);
        for (;;) {
            if (F.tid == 0) sh[0] = (int)__hip_atomic_fetch_add(qbase + 64 * qi, 1u, __ATOMIC_RELAXED, __HIP_MEMORY_SCOPE_AGENT);
            __syncthreads();
            const int n = sh[0];
            __syncthreads();
            if (n >= T / (8 * GTW)) break;
            gather_item<PH, VAR>(F, qi, n);
        }
    }
}

__device__ __forceinline__ void combine_phase(Frame& F) {
    const _Float16* HP = (const _Float16*)(F.ws + WS_HP); const float* W = (const float*)(F.ws + WS_G);
    const int nthr = F.G * NWAVES * 64;
    for (int i = F.vcu * NWAVES * 64 + F.tid; i < T * 128 / 4; i += nthr) {
        f32x4 s = {0.f, 0.f, 0.f, 0.f};
#pragma unroll
        for (int sl = 0; sl < 8; ++sl) {
            const u32x2 hw = *(const GAS u32x2*)(HP + (size_t)sl * T * 128 + (size_t)i * 4);
            s[0] += (float)__builtin_bit_cast(_Float16, (unsigned short)(hw.x & 0xFFFFu)); s[1] += (float)__builtin_bit_cast(_Float16, (unsigned short)(hw.x >> 16));
            s[2] += (float)__builtin_bit_cast(_Float16, (unsigned short)(hw.y & 0xFFFFu)); s[3] += (float)__builtin_bit_cast(_Float16, (unsigned short)(hw.y >> 16));
        }
        const f32x4 gv = *(const GAS f32x4*)(W + (size_t)i * 4);
        float wv_[4]; float mx = 0.f;
#pragma unroll
        for (int e = 0; e < 4; ++e) { wv_[e] = gv[e] * gelu_erf(s[e]); mx = fmaxf(mx, fabsf(wv_[e])); }
#pragma unroll
        for (int o = 1; o < 32; o <<= 1) mx = fmaxf(mx, __shfl_xor(mx, o));
        const float sc = 127.f / fmaxf(mx, 1e-30f);
        *(GAS unsigned*)(F.ws + WS_W16 + (size_t)i * 4) = q8x4(wv_[0] * sc, wv_[1] * sc, wv_[2] * sc, wv_[3] * sc);
        if ((i & 31) == 0) ((float*)(F.ws + WS_MR))[i >> 5] = 1.f / (sc * SQ_V);
    }
}

__device__ __forceinline__ void ln2_phase(Frame& F) {
    const int lane = F.lane, gw = F.vcu * NWAVES + F.wave, NGW = F.G * NWAVES;
    const float* ln2_g = F.in[11]; const float* ln2_b = F.in[12];
    f32x4 gg[4], bb[4];
#pragma unroll
    for (int j = 0; j < 2; ++j) { gg[2 * j] = *(const GAS f32x4*)(ln2_g + 512 * j + 8 * lane); gg[2 * j + 1] = *(const GAS f32x4*)(ln2_g + 512 * j + 8 * lane + 4);
                                  bb[2 * j] = *(const GAS f32x4*)(ln2_b + 512 * j + 8 * lane); bb[2 * j + 1] = *(const GAS f32x4*)(ln2_b + 512 * j + 8 * lane + 4); }
    for (int t = gw; t < T; t += NGW) {
        const bf16* vrow = (const bf16*)(F.ws + WS_V2) + (size_t)t * D_MODEL;
        f32x4 v[4]; float s = 0.f;
#pragma unroll
        for (int j = 0; j < 2; ++j) { const v4u w = *(const GAS v4u*)(vrow + 512 * j + 8 * lane);
            v[2 * j] = (f32x4){__uint_as_float(w[0] << 16), __uint_as_float(w[0] & 0xffff0000u), __uint_as_float(w[1] << 16), __uint_as_float(w[1] & 0xffff0000u)};
            v[2 * j + 1] = (f32x4){__uint_as_float(w[2] << 16), __uint_as_float(w[2] & 0xffff0000u), __uint_as_float(w[3] << 16), __uint_as_float(w[3] & 0xffff0000u)}; }
#pragma unroll
        for (int j = 0; j < 4; ++j) s += (v[j].x + v[j].y) + (v[j].z + v[j].w);
        const float mean = wave_sum(s) * (1.f / D_MODEL); float s2 = 0.f;
#pragma unroll
        for (int j = 0; j < 4; ++j) { v[j] = v[j] - mean; s2 += (v[j].x * v[j].x + v[j].y * v[j].y) + (v[j].z * v[j].z + v[j].w * v[j].w); }
        const float rstd = 1.f / sqrtf(wave_sum(s2) * (1.f / D_MODEL) + LN_EPS);
        float* row = F.out + (size_t)t * D_MODEL;
#pragma unroll
        for (int j = 0; j < 2; ++j) { *(GAS f32x4*)(row + 512 * j + 8 * lane) = v[2 * j] * rstd * gg[2 * j] + bb[2 * j]; *(GAS f32x4*)(row + 512 * j + 8 * lane + 4) = v[2 * j + 1] * rstd * gg[2 * j + 1] + bb[2 * j + 1]; }
    }
}
}

struct Args { const float* in[13]; float* out; unsigned char* ws; int ph_lo, ph_hi; };
static_assert(sizeof(Args) == 13 * 8 + 8 + 8 + 8, "Args has no padding");
constexpr int N_PHASES = 10;
template <class Epi> struct EpiNull {
    static constexpr bool PERM = Epi::PERM, AFTER_DRAIN = Epi::AFTER_DRAIN;
    __device__ __forceinline__ void operator()(const pg8::f32x4 (&acc)[2][2][4][2], const pg8::Unit&, int, int, int, int) const {
#pragma unroll
        for (int a = 0; a < 2; ++a)
#pragma unroll
            for (int b = 0; b < 2; ++b)
#pragma unroll
                for (int m = 0; m < 4; ++m) { asm volatile("" :: "v"(acc[a][b][m][0]), "v"(acc[a][b][m][1])); }
    }
};

__global__ void __launch_bounds__(NWAVES * 64, 2) mk_fwd(Args args) {
    extern __shared__ __attribute__((aligned(16))) unsigned char lds[];
    Frame F;
    F.lds = (LAS unsigned char*)lds;
    F.MISC = (volatile LAS unsigned*)(F.lds + MISC_OFF);
    F.tid = threadIdx.x; F.lane = F.tid & 63; F.wave = __builtin_amdgcn_readfirstlane(F.tid >> 6);
    F.G = gridDim.x; { const int bx = blockIdx.x; F.vcu = (F.G % 8 == 0) ? (bx % 8) * (F.G / 8) + bx / 8 : bx; }
    F.ws = args.ws; F.out = args.out; F.ctl = (gu32*)(args.ws + WS_CTL);
#pragma unroll
    for (int i = 0; i < 13; ++i) F.in[i] = args.in[i];
    for (int u = F.tid; u < (LDS_BYTES - RING_BYTES) / 4; u += NWAVES * 64) ((LAS unsigned*)(F.lds + RING_BYTES))[u] = 0u;
    __syncthreads();
    XcdBarrier bar = xcd_barrier_post((unsigned*)(F.ctl + CW_BAR), F.MISC + 8);
    const int lo = args.ph_lo, hi = args.ph_hi;
#ifndef ATT_KMASK
#define ATT_KMASK 3
#endif
#define IN(k) (lo <= (k) && (k) < hi)
#define SEAM(k) do { if (IN(k) && IN((k) + 1)) xcd_barrier(bar); } while (0)

    if (IN(0)) { p0_prologue(F); }
    SEAM(0);
    if (IN(1)) {
        pg8::Gemm g{(const pg8::bf16_t*)(F.ws + WS_XQ), (const pg8::bf16_t*)(F.ws + WS_WIN), T, NPHYS, D_MODEL / 2};
        pg8::StaticOrder S; S.init(T, NPHYS, F.G, (int)blockIdx.x);
        EpiInProj E{(bf16*)(F.ws + WS_FQ), (bf16*)(F.ws + WS_FKT), (bf16*)(F.ws + WS_FVT), (bf16*)(F.ws + WS_SQ), (bf16*)(F.ws + WS_SKT), (bf16*)(F.ws + WS_SVT),
                    (const float2*)(F.ws + WS_ROPE), (float*)(F.ws + WS_QN2), (float*)(F.ws + WS_KN2)};
        const bool upper = (int)blockIdx.x >= F.G / 2;
        if (upper) { p1_slack_jobs(F, (int)blockIdx.x - F.G / 2, F.G - F.G / 2); __syncthreads(); }
#ifdef GEMM_NULL
        if (lo == 1) pg8::gemm_phase<EpiNull<EpiInProj>, pg8::StaticOrder, true, true, true>(F.lds, g, S, EpiNull<EpiInProj>{}); else
#endif
        pg8::gemm_phase<EpiInProj, pg8::StaticOrder, true, true, true>(F.lds, g, S, E);
        if (!upper) convert_experts(F, (int)blockIdx.x * NWAVES + F.wave, (F.G / 2) * NWAVES, EXP_SPLIT, 2 * NEXP);
    }
    SEAM(1);
    if (IN(2)) { att::attn_phase(F); }
    SEAM(2);
    if (IN(3)) {
        pg8::Gemm g{(const pg8::bf16_t*)(F.ws + WS_ATTN), (const pg8::bf16_t*)(F.ws + WS_WOUT), T, D_MODEL, D_MODEL / 2};
        pg8::StaticOrder S; S.init(T, D_MODEL, F.G, (int)blockIdx.x);
        EpiOutProj E{(bf16*)(F.ws + WS_XB), (float2*)(F.ws + WS_STATS)};
#ifdef GEMM_NULL
        if (lo == 3) pg8::gemm_phase<EpiNull<EpiOutProj>, pg8::StaticOrder, true, true, true>(F.lds, g, S, EpiNull<EpiOutProj>{}); else
#endif
        pg8::gemm_phase<EpiOutProj, pg8::StaticOrder, true, true, true>(F.lds, g, S, E);
    }
    SEAM(3);
    if (IN(4)) {
        pg8::Gemm g{(const pg8::bf16_t*)(F.ws + WS_XB), (const pg8::bf16_t*)(F.ws + WS_WQ), T, QCOLS, D_MODEL};
        pg8::StaticOrder S; S.init(T, QCOLS, F.G, (int)blockIdx.x);
        EpiQuery E{(const float2*)(F.ws + WS_STATS), (const float*)(F.ws + WS_GW), (const float*)(F.ws + WS_GW) + QCOLS, (bf16*)(F.ws + WS_Q)};
#ifdef GEMM_NULL
        if (lo == 4) pg8::gemm_phase<EpiNull<EpiQuery>, pg8::StaticOrder, true, true>(F.lds, g, S, EpiNull<EpiQuery>{}); else
#endif
        pg8::gemm_phase<EpiQuery, pg8::StaticOrder, true, true>(F.lds, g, S, E);
    }
    SEAM(4);
    if (IN(5)) { tk::topk_phase<0>(F); }
#ifdef P5_PROBE
    if (IN(5)) { xcd_barrier(bar); tk::topk_phase<P5_PROBE>(F); }
#endif
    SEAM(5);
    if (IN(6)) { ex::gather_phase<0>(F); }
    SEAM(6);
    if (IN(7)) { ex::combine_phase(F); }
    SEAM(7);
    if (IN(8)) { ex::gather_phase<1>(F); }
    SEAM(8);
#ifdef G_PROBE_PH
    if (IN(8)) { ex::gather_phase<G_PROBE_PH, G_PROBE_VAR>(F); xcd_barrier(bar); }
#endif
#ifdef EXTRA_BAR
    for (int eb = 0; eb < EXTRA_BAR; ++eb) xcd_barrier(bar);
#endif
    if (IN(9)) { ex::ln2_phase(F); }
#undef IN
#undef SEAM
}

#if DBG_STAGE > 0
constexpr int DBG_B = 5;
constexpr size_t DBG_BASE = 360 * MiB;
constexpr size_t DBG_ACC = 511 * MiB;
__device__ __forceinline__ float bf2f(bf16 v) { return __uint_as_float((unsigned)v << 16); }
__device__ __forceinline__ void dbg_acc(double* acc, int slot, float opt, float ref) {
    float d2 = (opt - ref) * (opt - ref), r2 = ref * ref;
    if (!(d2 == d2)) d2 = 1e30f;
    d2 = wave_sum(d2); r2 = wave_sum(r2);
    if ((threadIdx.x & 63) == 0) { atomicAdd(acc + 2 * slot, (double)d2); atomicAdd(acc + 2 * slot + 1, (double)r2); }
}
__global__ void __launch_bounds__(256) dbg_check_inproj(const float* __restrict__ proj, const unsigned char* __restrict__ ws, const float* __restrict__ cn, double* acc) {
    const int s = blockIdx.x, t = DBG_B * SEQ + s;
    const float* pr = proj + (size_t)s * IN_COLS;
    for (int j = threadIdx.x; j < 2304; j += 256) {
        float ref, opt; int slot;
        if (j < 1536) {
            const int which = j >> 9, hd = (j >> 6) & 7, d = j & 63;
            ref = pr[j];
            if (which == 0) { opt = bf2f(((const bf16*)(ws + WS_FQ))[(size_t)t * 512 + hd * 64 + d]) / C2; slot = 0; }
            else if (which == 1) { opt = bf2f(*(const bf16*)(ws + WS_FKT + EpiInProj::tile_off(8, t, hd) + (size_t)((d >> 3) * 64 + (t & 63)) * 16 + (d & 7) * 2)); slot = 1; }
            else { opt = bf2f(*(const bf16*)(ws + WS_FVT + EpiInProj::tile_off(8, t, hd) + (size_t)((d >> 5) * 4 + ((t & 63) >> 4)) * 1024 + (t & 15) * 64 + (d & 31) * 2)); slot = 2; }
        } else if (j < 2176) {
            const bool isq = j < 2048; const int r = isq ? j - 1536 : j - 2048, hd = r >> 6, d = r & 63, base = (isq ? OFF_SQ : OFF_SK) + hd * 64;
            float cs, sn; rope_cs(s, d & 31, cs, sn);
            ref = (d < 32) ? pr[base + d] * cs - pr[base + d + 32] * sn : pr[base + d] * cs + pr[base + d - 32] * sn;
            if (isq) { opt = bf2f(((const bf16*)(ws + WS_SQ))[(size_t)t * 512 + hd * 64 + d]) / C2; slot = 3; }
            else { opt = bf2f(*(const bf16*)(ws + WS_SKT + EpiInProj::tile_off(2, t, hd) + (size_t)((d >> 3) * 64 + (t & 63)) * 16 + (d & 7) * 2)); slot = 4; }
        } else {
            const int r = j - 2176, hd = r >> 6, d = r & 63;
            ref = pr[OFF_SV + r];
            opt = bf2f(*(const bf16*)(ws + WS_SVT + EpiInProj::tile_off(2, t, hd) + (size_t)((d >> 5) * 4 + ((t & 63) >> 4)) * 1024 + (t & 15) * 64 + (d & 31) * 2)); slot = 5;
        }
#pragma unroll
        for (int sl = 0; sl < 6; ++sl) dbg_acc(acc, sl, slot == sl ? opt : 0.f, slot == sl ? ref : 0.f);
    }
    if (threadIdx.x < 64) {
        const int h = threadIdx.x & 7;
        const float opt = (threadIdx.x < 8) ? ((const float*)(ws + WS_C))[(size_t)(DBG_B * 8 + h) * SEQ + s] : 0.f, ref = (threadIdx.x < 8) ? cn[(size_t)h * SEQ + s] : 0.f;
        dbg_acc(acc, 6, opt, ref);
    }
}
__global__ void __launch_bounds__(256) dbg_check_attn(const float* __restrict__ attn_n, const unsigned char* __restrict__ ws, double* acc) {
    const int s = blockIdx.x, t = DBG_B * SEQ + s;
    for (int j = threadIdx.x; j < 1024; j += 256) {
        const float ref = attn_n[(size_t)s * 1024 + j], opt = bf2f(((const bf16*)(ws + WS_ATTN))[(size_t)t * 1024 + j]);
        dbg_acc(acc, j >> 9, opt, ref);
    }
}
__global__ void __launch_bounds__(256) dbg_check_q(const float* __restrict__ qn, const float* __restrict__ x1n, const float* __restrict__ y, const float* __restrict__ g1, const float* __restrict__ b1, const unsigned char* __restrict__ ws, double* acc) {
    const int s = blockIdx.x, t = DBG_B * SEQ + s;
    for (int j = threadIdx.x; j < 2048; j += 256) dbg_acc(acc, 0, bf2f(((const bf16*)(ws + WS_Q))[(size_t)t * QCOLS + j]), qn[(size_t)s * QCOLS + j]);
    const float2 st = ln1_row_stats((const float2*)(ws + WS_STATS), t);
    for (int j = threadIdx.x; j < 1024; j += 256) dbg_acc(acc, 1, (y[(size_t)t * 1024 + j] - st.x) * st.y * g1[j] + b1[j], x1n[(size_t)s * 1024 + j]);
}
__global__ void __launch_bounds__(256) dbg_check_picks(const int* __restrict__ idxn, const float* __restrict__ gn, const unsigned char* __restrict__ ws, double* acc) {
    const int i = blockIdx.x * 256 + threadIdx.x;
    const int s = i >> 3, h = i & 7, t = DBG_B * SEQ + s;
    const int* io = (const int*)(ws + WS_IDX) + ((size_t)t * 8 + h) * 16; const float* go = (const float*)(ws + WS_G) + ((size_t)t * 8 + h) * 16;
    const int* in_ = idxn + ((size_t)s * 8 + h) * 16; const float* gn_ = gn + ((size_t)s * 8 + h) * 16;
    float miss = 0.f, d2 = 0.f, r2 = 0.f;
    for (int a = 0; a < 16; ++a) { const int e = in_[a]; bool found = false;
        for (int b = 0; b < 16; ++b) if (io[b] == e) { found = true; d2 += (go[b] - gn_[a]) * (go[b] - gn_[a]); r2 += gn_[a] * gn_[a]; }
        if (!found) miss += 1.f; }
    miss = wave_sum(miss); d2 = wave_sum(d2); r2 = wave_sum(r2);
    if ((threadIdx.x & 63) == 0) { atomicAdd(acc + 0, (double)miss); atomicAdd(acc + 1, 16.0 * 64.0); atomicAdd(acc + 2, (double)d2); atomicAdd(acc + 3, (double)r2); }
}
__global__ void dbg_code_picks(const double* acc, float* code) {
    if (threadIdx.x != 0 || blockIdx.x != 0) return;
    const float frac = (float)(acc[0] / acc[1]), gerr = (float)sqrt(acc[2] / acc[3]);
    *code = 10.f * frac + (gerr > 0.05f ? 100.f : 0.f) + (frac != frac ? 1000.f : 0.f);
}
__global__ void dbg_code(const double* acc, float* code, int nslots) {
    if (threadIdx.x != 0 || blockIdx.x != 0) return;
    float worst = 0.f; int mask = 0;
    for (int i = 0; i < nslots; ++i) { const double r = acc[2 * i + 1] > 0 ? sqrt(acc[2 * i] / acc[2 * i + 1]) : 99.0; if (r > 0.02) mask |= 1 << i; if ((float)r > worst) worst = (float)r; }
    *code = mask ? (float)mask : worst * 10.f;
}
__global__ void dbg_scale(float* out, const float* code, int n) { const int i = blockIdx.x * blockDim.x + threadIdx.x; if (i < n) out[i] *= (1.f + *code); }

static void launch_naive(const float* const* in, float* out, char* ws, int b0, int nb, hipStream_t stream, float** proj_o, float** c_o, float** x1_o, int** idx_o, float** g_o, float* attn_tmp) {
    const int Tn = nb * SEQ;
    float* proj = (float*)ws; size_t off = (size_t)Tn * IN_COLS * 4; off = (off + 255) & ~(size_t)255;
    float* cbuf = (float*)(ws + off); off += (size_t)nb * FOX_H * SEQ * 4;
    float* x1 = (float*)(ws + off); off += (size_t)Tn * D_MODEL * 4;
    int* idx = (int*)(ws + off); off += (size_t)Tn * 128 * 4;
    float* gbuf = (float*)(ws + off); off += (size_t)Tn * 128 * 4;
    const float* x = in[0] + (size_t)b0 * SEQ * D_MODEL;
    float* attn = attn_tmp ? attn_tmp : out + (size_t)b0 * SEQ * D_MODEL;
    nv_gemm<<<dim3((IN_COLS + 127) / 128, Tn / 128), 256, 0, stream>>>(x, D_MODEL, in[1], IN_COLS, proj, IN_COLS, Tn, IN_COLS, D_MODEL);
    nv_forget_cumsum<<<1, 64, 0, stream>>>(proj, in[2], cbuf, nb);
    nv_fox<<<dim3(SEQ / 64, FOX_H, nb), 64, 0, stream>>>(proj, cbuf, attn);
    nv_swa<<<dim3(SEQ / 64, SWA_H, nb), 64, 0, stream>>>(proj, in[3], attn);
    nv_gemm<<<dim3(D_MODEL / 128, Tn / 128), 256, 0, stream>>>(attn, D_MODEL, in[4], D_MODEL, x1, D_MODEL, Tn, D_MODEL, D_MODEL);
    nv_ln_res<<<Tn / 4, 256, 0, stream>>>(x, x1, in[5], in[6], x1, Tn);
    float* q = proj;
    if (proj_o) {
        *proj_o = proj; *c_o = cbuf; *x1_o = x1; *idx_o = idx; *g_o = gbuf;
        q = attn_tmp + (size_t)Tn * D_MODEL + (1u << 18);
        nv_gemm<<<dim3(QCOLS / 128, Tn / 128), 256, 0, stream>>>(x1, D_MODEL, in[7], QCOLS, q, QCOLS, Tn, QCOLS, D_MODEL);
        nv_peer_topk<<<dim3(Tn / 64, PEER_H), 64, 0, stream>>>(q, in[8], idx, gbuf);
        return;
    }
    nv_gemm<<<dim3(QCOLS / 128, Tn / 128), 256, 0, stream>>>(x1, D_MODEL, in[7], QCOLS, q, QCOLS, Tn, QCOLS, D_MODEL);
    nv_peer_topk<<<dim3(Tn / 64, PEER_H), 64, 0, stream>>>(q, in[8], idx, gbuf);
    nv_peer_expert<<<Tn / 4, 256, 0, stream>>>(x1, idx, gbuf, in[9], in[10], in[11], in[12], out + (size_t)b0 * SEQ * D_MODEL, Tn);
}
#endif

extern "C" void kernel_launch(void* const* d_in, const int* in_sizes, int n_in, void* d_out, int out_size, void* d_ws, size_t ws_size, hipStream_t stream) {
    static int grid = 0;
    if (grid == 0) {
        if (n_in != 13 || out_size != T * D_MODEL || ws_size < 512 * MiB) { fprintf(stderr, "kernel_launch: unexpected shapes / workspace (%d inputs, out %d, ws %zu)\n", n_in, out_size, ws_size); grid = -1; return; }
        int dev = 0, cus = 0, per_cu = 0;
        if (hipGetDevice(&dev) != hipSuccess || hipDeviceGetAttribute(&cus, hipDeviceAttributeMultiprocessorCount, dev) != hipSuccess) { grid = -1; return; }
        if (hipFuncSetAttribute((const void*)mk_fwd, hipFuncAttributeMaxDynamicSharedMemorySize, LDS_BYTES) != hipSuccess) { fprintf(stderr, "kernel_launch: hipFuncSetAttribute failed\n"); grid = -1; return; }
        if (hipOccupancyMaxActiveBlocksPerMultiprocessor(&per_cu, (const void*)mk_fwd, NWAVES * 64, LDS_BYTES) != hipSuccess || per_cu < 1) { fprintf(stderr, "kernel_launch: occupancy query says %d blocks per CU\n", per_cu); (void)hipGetLastError(); grid = -1; return; }
        grid = cus;
    }
    if (grid < 0) return;
    const float* in[13]; for (int i = 0; i < 13; ++i) in[i] = (const float*)d_in[i];
    (void)hipMemsetAsync((char*)d_ws + WS_CTL, 0, CTL_ZERO_BYTES, stream);
    Args a{};
    for (int i = 0; i < 13; ++i) a.in[i] = in[i];
    a.out = (float*)d_out; a.ws = (unsigned char*)d_ws;
#if DBG_STAGE == 0 && defined(TIME_LO)
    a.ph_lo = 0; a.ph_hi = TIME_HI;
    { void* k1[] = {&a}; (void)hipLaunchCooperativeKernel((const void*)mk_fwd, dim3(grid), dim3(NWAVES * 64), k1, LDS_BYTES, stream); }
    (void)hipMemsetAsync((char*)d_ws + WS_CTL, 0, CTL_ZERO_BYTES, stream);
    a.ph_lo = TIME_LO; a.ph_hi = N_PHASES;
#elif DBG_STAGE == 0
    a.ph_lo = 0; a.ph_hi = N_PHASES;
#else
    a.ph_lo = 0; a.ph_hi = DBG_STAGE + 1;
#endif
    void* kargs[] = {&a};
    hipError_t le = hipLaunchCooperativeKernel((const void*)mk_fwd, dim3(grid), dim3(NWAVES * 64), kargs, LDS_BYTES, stream);
    if (le != hipSuccess) fprintf(stderr, "kernel_launch: cooperative launch failed: %s (grid %d)\n", hipGetErrorName(le), grid);
#if DBG_STAGE > 0
    char* ws = (char*)d_ws;
    double* acc = (double*)(ws + DBG_ACC); float* code = (float*)(ws + DBG_ACC + 512);
    (void)hipMemsetAsync(acc, 0, 1024, stream);
    float *proj, *cn, *x1n, *gn; int* idxn;
    launch_naive(in, (float*)d_out, ws + DBG_BASE, DBG_B, 1, stream, &proj, &cn, &x1n, &idxn, &gn, (float*)(ws + DBG_BASE + 100 * MiB));
#if DBG_STAGE == 1
    dbg_check_inproj<<<SEQ, 256, 0, stream>>>(proj, (const unsigned char*)d_ws, cn, acc);
    dbg_code<<<1, 1, 0, stream>>>(acc, code, 7);
#elif DBG_STAGE == 4
    dbg_check_q<<<SEQ, 256, 0, stream>>>((const float*)(ws + DBG_BASE + 100 * MiB) + (size_t)SEQ * D_MODEL + (1u << 18), x1n, (const float*)d_out, in[5], in[6], (const unsigned char*)d_ws, acc);
    dbg_code<<<1, 1, 0, stream>>>(acc, code, 2);
#elif DBG_STAGE == 5
    dbg_check_picks<<<SEQ * 8 / 256, 256, 0, stream>>>(idxn, gn, (const unsigned char*)d_ws, acc);
    dbg_code_picks<<<1, 1, 0, stream>>>(acc, code);
#elif DBG_STAGE == 2
    dbg_check_attn<<<SEQ, 256, 0, stream>>>((const float*)(ws + DBG_BASE + 100 * MiB), (const unsigned char*)d_ws, acc);
    dbg_code<<<1, 1, 0, stream>>>(acc, code, 2);
#endif
    launch_naive(in, (float*)d_out, ws, 0, BATCH, stream, nullptr, nullptr, nullptr, nullptr, nullptr, nullptr);
    dbg_scale<<<(T * D_MODEL + 255) / 256, 256, 0, stream>>>((float*)d_out, code, T * D_MODEL);
#endif
}
```

```cpp
#include <hip/hip_runtime.h>
#include <hip/hip_bf16.h>
#include <hip/hip_cooperative_groups.h>
#include <cstdint>
#include <cstdio>
#include <cmath>

#ifndef DBG_STAGE
#define DBG_STAGE 0
#endif

namespace cfg {
constexpr int D_MODEL = 1024, BATCH = 8, SEQ = 4096, T = BATCH * SEQ;
constexpr int HD = 64, FOX_H = 8, SWA_H = 8, SWA_KVH = 2;
constexpr int OFF_FQ = 0, OFF_FK = 512, OFF_FV = 1024, OFF_FF = 1536, OFF_SQ = 1544, OFF_SK = 2056, OFF_SV = 2184, IN_COLS = 2312;
constexpr int NPHYS = 2304;
constexpr int WINDOW = 128;
constexpr int PEER_H = 8, NKEYS = 128, PEER_HALF = 128, TOPK = 16, QCOLS = 2048, NEXP = 16384;
constexpr float LN_EPS = 1e-5f;
constexpr float ALPHA = 1.189207115002721f;
constexpr float LOG2E = 1.4426950408889634f;
constexpr float C2 = 0.125f * LOG2E;
}
using namespace cfg;

namespace pg8 {
#define PG8_LAS __attribute__((address_space(3)))
typedef unsigned short bf16_t;
typedef short bf16x8 __attribute__((ext_vector_type(8)));
typedef float f32x4 __attribute__((ext_vector_type(4)));
typedef unsigned u32x4 __attribute__((ext_vector_type(4)));
constexpr int BM = 256, BK = 64, HALF = 128, HTB = HALF * BK * 2  , STAGE_BYTES = 8 * HTB, NXCD = 8, WGM = 8;

__host__ __device__ __forceinline__ int lds_byte(int r, int c) { const int st = (r >> 4) * 2 + (c >> 5), rr = r & 15, cc = c & 31, ob = rr * 64 + cc * 2; return st * 1024 + (ob ^ (((ob >> 9) & 1) << 5)); }
__host__ __device__ __forceinline__ void stage_rc(int b, int& R, int& C) { const int st = b / 1024, sb = b % 1024, swz = sb ^ (((sb >> 9) & 1) << 5); R = (st >> 1) * 16 + swz / 64; C = (st & 1) * 32 + (swz % 64) / 2; }
__host__ __device__ __forceinline__ int perm32(int rho) { const int n = rho >> 4, i = rho & 15; return 8 * (i >> 2) + 4 * n + (i & 3); }

struct Unit { int pm, pn; };
struct Gemm { const bf16_t* A; const bf16_t* Bt; int M, N, K; };

struct StaticOrder {
    int nM, nN, nwg, G, c;
    __host__ __device__ void init(int M, int N, int G_, int c_) { nM = M / BM; nN = N / BM; nwg = nM * nN; G = G_; c = c_; }
    __host__ __device__ bool next(int i, Unit& u) const {
        const long L = (long)i * G + c; if (L >= nwg) return false;
        int wgid = (int)L; { const int q = nwg / NXCD, r = nwg % NXCD, xcd = wgid % NXCD, off = wgid / NXCD; wgid = (xcd < r ? xcd * (q + 1) : r * (q + 1) + (xcd - r) * q) + off; }
        const int nig = WGM * nN, gid = wgid / nig, fm = gid * WGM, gsz = (nM - fm) < WGM ? (nM - fm) : WGM;
        u.pm = fm + ((wgid % nig) % gsz); u.pn = (wgid % nig) / gsz; return true;
    }
    __device__ __forceinline__ void a_ready(const Unit&) const {}
    __device__ __forceinline__ void done(const Unit&) const {}
};
__device__ __forceinline__ unsigned cvt_pk_bf16(float lo, float hi) { unsigned r; asm volatile("v_cvt_pk_bf16_f32 %0, %1, %2" : "=v"(r) : "v"(lo), "v"(hi)); return r; }
typedef float f32x2 __attribute__((ext_vector_type(2)));
template <bool I8> __device__ __forceinline__ f32x4 pg8_mma(bf16x8 a, bf16x8 b, f32x4 c) {
    if constexpr (I8) { typedef int v4i_ __attribute__((ext_vector_type(4)));
        return __builtin_bit_cast(f32x4, __builtin_amdgcn_mfma_i32_16x16x64_i8(__builtin_bit_cast(v4i_, a), __builtin_bit_cast(v4i_, b), __builtin_bit_cast(v4i_, c), 0, 0, 0)); }
    else return __builtin_amdgcn_mfma_f32_16x16x32_bf16(a, b, c, 0, 0, 0);
}
template <class Epi, class Sched, bool ALIGN_EPI = false, bool SP2 = false, bool I8 = false>
__device__ __forceinline__ void gemm_phase(PG8_LAS unsigned char* lds, const Gemm g, const Sched& S, const Epi& E) {
    const int tid = threadIdx.x, wid = __builtin_amdgcn_readfirstlane(tid >> 6), lane = tid & 63, wr = wid >> 2, wc = wid & 3, fr = lane & 15, fq = lane >> 4;
    const int K = g.K, nt = K / BK;
    unsigned voffA[2], voffB[2];
#pragma unroll
    for (int i = 0; i < 2; ++i) { int R, C; stage_rc(tid * 16 + i * 8192, R, C); const int Rb = Epi::PERM ? ((R & ~31) + perm32(R & 31)) : R;
        voffA[i] = (unsigned)(R * K + C) * 2u; voffB[i] = (unsigned)(Rb * K + C) * 2u; }
    const size_t kstep = (size_t)(BK * 2);
    const size_t hstep = (size_t)HALF * K * 2;
    const size_t tstep = 2 * hstep;
    const unsigned ldsw = (unsigned)wid * 1024u;
    const int aoff = lds_byte(wr * 64 + fr, fq * 8), boff = lds_byte(wc * 32 + fr, fq * 8);
#define PG8_SA(b, h) (((b) * 2 + (h)) * HTB)
#define PG8_SB(b, h) ((4 + (b) * 2 + (h)) * HTB)
#define PG8_STAGE(bufoff, gbase, voff) do { _Pragma("unroll") for (int _i = 0; _i < 2; ++_i) \
        __builtin_amdgcn_global_load_lds((const unsigned*)((const char*)(gbase) + (voff)[_i]), (PG8_LAS unsigned*)(lds + (bufoff) + ldsw + _i * 8192), 16, 0, 0); } while (0)
#define PG8_LDA(dst, b, h) do { _Pragma("unroll") for (int m = 0; m < 4; ++m) _Pragma("unroll") for (int k = 0; k < 2; ++k) dst[m][k] = *(const PG8_LAS bf16x8*)(lds + PG8_SA(b, h) + aoff + m * 2048 + k * 1024); } while (0)
#define PG8_LDB(dst, b, h) do { _Pragma("unroll") for (int n = 0; n < 2; ++n) _Pragma("unroll") for (int k = 0; k < 2; ++k) dst[n][k] = *(const PG8_LAS bf16x8*)(lds + PG8_SB(b, h) + boff + n * 2048 + k * 1024); } while (0)
#define PG8_MMA(ai, bj, At, Bt) do { __builtin_amdgcn_s_setprio(1); _Pragma("unroll") for (int m = 0; m < 4; ++m) _Pragma("unroll") for (int n = 0; n < 2; ++n) _Pragma("unroll") for (int k = 0; k < 2; ++k) \
        acc[ai][bj][m][n] = pg8_mma<I8>(Bt[n][k], At[m][k], acc[ai][bj][m][n]); __builtin_amdgcn_s_setprio(0); } while (0)
#define PG8_WAIT_V(n) asm volatile("s_waitcnt vmcnt(" #n ")" ::: "memory")
#define PG8_WAIT_L(n) asm volatile("s_waitcnt lgkmcnt(" #n ")" ::: "memory")
#define PG8_BAR __builtin_amdgcn_s_barrier()
#define PG8_SCHED __builtin_amdgcn_sched_barrier(0)
    Unit cur, nxt; int ui = 0;
    if (!S.next(0, cur)) return;
    f32x4 acc[2][2][4][2];
#pragma unroll
    for (int a = 0; a < 2; ++a)
#pragma unroll
        for (int b = 0; b < 2; ++b)
#pragma unroll
            for (int m = 0; m < 4; ++m)
#pragma unroll
                for (int n = 0; n < 2; ++n) acc[a][b][m][n] = (f32x4){0.f, 0.f, 0.f, 0.f};
    bf16x8 At[4][2], B0[2][2], B1[2][2];
    const char* cA = (const char*)g.A + (size_t)cur.pm * tstep; const char* cB = (const char*)g.Bt + (size_t)cur.pn * tstep;
    S.a_ready(cur);
    if constexpr (SP2) {
        PG8_STAGE(PG8_SB(0, 0), cB, voffB); PG8_STAGE(PG8_SB(0, 1), cB + hstep, voffB); PG8_STAGE(PG8_SA(0, 0), cA, voffA); PG8_STAGE(PG8_SA(0, 1), cA + hstep, voffA);
        if (wr == 1) PG8_BAR;
        PG8_WAIT_V(2); PG8_BAR;
        PG8_STAGE(PG8_SB(1, 0), cB + kstep, voffB); PG8_STAGE(PG8_SA(1, 0), cA + kstep, voffA); PG8_STAGE(PG8_SB(1, 1), cB + hstep + kstep, voffB);
        PG8_WAIT_V(6); PG8_BAR;
    } else {
        PG8_STAGE(PG8_SB(0, 0), cB, voffB); PG8_STAGE(PG8_SA(0, 0), cA, voffA); PG8_STAGE(PG8_SB(0, 1), cB + hstep, voffB); PG8_STAGE(PG8_SA(0, 1), cA + hstep, voffA);
        if (wr == 1) PG8_BAR;
        PG8_WAIT_V(4); PG8_BAR;
        PG8_STAGE(PG8_SB(1, 0), cB + kstep, voffB); PG8_STAGE(PG8_SA(1, 0), cA + kstep, voffA); PG8_STAGE(PG8_SB(1, 1), cB + hstep + kstep, voffB);
        PG8_WAIT_V(6); PG8_BAR;
    }
    for (;;) {
        const bool has_next = S.next(ui + 1, nxt);
        const char* nA = has_next ? (const char*)g.A + (size_t)nxt.pm * tstep : cA; const char* nB = has_next ? (const char*)g.Bt + (size_t)nxt.pn * tstep : cB;
        for (int t = 0; t < nt; t += 2) {
            const bool last = (t == nt - 2);
            const char* a1 = cA + (size_t)(t + 1) * kstep;
            const char* a2 = last ? nA : cA + (size_t)(t + 2) * kstep; const char* b2 = last ? nB : cB + (size_t)(t + 2) * kstep;
            const char* a3 = a2 + kstep; const char* b3 = b2 + kstep;
            if (last && has_next) S.a_ready(nxt);
            if constexpr (SP2) {
            PG8_LDB(B0, 0, 0); PG8_LDB(B1, 0, 1); PG8_SCHED; PG8_LDA(At, 0, 0); PG8_STAGE(PG8_SA(1, 1), a1 + hstep, voffA);
            PG8_WAIT_V(8); PG8_WAIT_L(0); PG8_BAR; PG8_MMA(0, 0, At, B0); PG8_MMA(0, 1, At, B1); PG8_BAR; PG8_SCHED;
            PG8_LDA(At, 0, 1); PG8_STAGE(PG8_SB(0, 0), b2, voffB); PG8_STAGE(PG8_SB(0, 1), b2 + hstep, voffB); PG8_STAGE(PG8_SA(0, 0), a2, voffA);
            PG8_WAIT_V(8); PG8_WAIT_L(0); PG8_BAR; PG8_MMA(1, 0, At, B0); PG8_MMA(1, 1, At, B1); PG8_BAR; PG8_SCHED;
            PG8_LDB(B0, 1, 0); PG8_LDB(B1, 1, 1); PG8_SCHED; PG8_LDA(At, 1, 0); PG8_STAGE(PG8_SA(0, 1), a2 + hstep, voffA);
            PG8_WAIT_V(8); PG8_WAIT_L(0); PG8_BAR; PG8_MMA(0, 0, At, B0); PG8_MMA(0, 1, At, B1); PG8_BAR; PG8_SCHED;
            PG8_LDA(At, 1, 1); PG8_STAGE(PG8_SB(1, 0), b3, voffB); PG8_STAGE(PG8_SB(1, 1), b3 + hstep, voffB); PG8_STAGE(PG8_SA(1, 0), a3, voffA);
            PG8_WAIT_V(8); PG8_WAIT_L(0); PG8_BAR; PG8_MMA(1, 0, At, B0); PG8_MMA(1, 1, At, B1); PG8_BAR; PG8_SCHED;
            } else {
            PG8_LDB(B0, 0, 0); PG8_SCHED; PG8_LDA(At, 0, 0); PG8_STAGE(PG8_SA(1, 1), a1 + hstep, voffA);
            PG8_WAIT_L(8); PG8_BAR; PG8_WAIT_L(0); PG8_MMA(0, 0, At, B0); PG8_BAR; PG8_SCHED;
            PG8_LDB(B1, 0, 1); PG8_STAGE(PG8_SB(0, 0), b2, voffB);
            PG8_BAR; PG8_WAIT_L(0); PG8_MMA(0, 1, At, B1); PG8_BAR;
            PG8_LDA(At, 0, 1); PG8_STAGE(PG8_SA(0, 0), a2, voffA);
            PG8_BAR; PG8_WAIT_L(0); PG8_MMA(1, 0, At, B0); PG8_BAR; PG8_SCHED;
            PG8_STAGE(PG8_SB(0, 1), b2 + hstep, voffB);
            PG8_WAIT_V(6); PG8_BAR; PG8_MMA(1, 1, At, B1); PG8_BAR;
            PG8_LDB(B0, 1, 0); PG8_SCHED; PG8_LDA(At, 1, 0); PG8_STAGE(PG8_SA(0, 1), a2 + hstep, voffA);
            PG8_WAIT_L(8); PG8_BAR; PG8_WAIT_L(0); PG8_MMA(0, 0, At, B0); PG8_BAR; PG8_SCHED;
            PG8_LDB(B1, 1, 1); PG8_STAGE(PG8_SB(1, 0), b3, voffB);
            PG8_BAR; PG8_WAIT_L(0); PG8_MMA(0, 1, At, B1); PG8_BAR;
            PG8_LDA(At, 1, 1); PG8_STAGE(PG8_SA(1, 0), a3, voffA);
            PG8_BAR; PG8_WAIT_L(0); PG8_MMA(1, 0, At, B0); PG8_BAR; PG8_SCHED;
            PG8_STAGE(PG8_SB(1, 1), b3 + hstep, voffB);
            PG8_WAIT_V(6); PG8_BAR; PG8_MMA(1, 1, At, B1); PG8_BAR;
            }
        }
        if constexpr (ALIGN_EPI) { if (wr == 0) PG8_BAR; }
        if constexpr (!Epi::AFTER_DRAIN) { E(acc, cur, wr, wc, fr, fq); S.done(cur); }
        if (!has_next) break;
#pragma unroll
        for (int a = 0; a < 2; ++a)
#pragma unroll
            for (int b = 0; b < 2; ++b)
#pragma unroll
                for (int m = 0; m < 4; ++m)
#pragma unroll
                    for (int n = 0; n < 2; ++n) acc[a][b][m][n] = (f32x4){0.f, 0.f, 0.f, 0.f};
        cur = nxt; cA = nA; cB = nB; ++ui;
        if constexpr (ALIGN_EPI) { if (wr == 1) PG8_BAR; }
    }
    PG8_WAIT_V(0);
    if constexpr (!ALIGN_EPI) { if (wr == 0) PG8_BAR; }
    PG8_BAR;
    if constexpr (Epi::AFTER_DRAIN) { E.fused(acc, cur, wr, wc, fr, fq, lds, wid, lane); S.done(cur); }
#undef PG8_SA
#undef PG8_SB
#undef PG8_STAGE
#undef PG8_LDA
#undef PG8_LDB
#undef PG8_MMA
#undef PG8_WAIT_V
#undef PG8_WAIT_L
#undef PG8_BAR
#undef PG8_SCHED
}
}
#define GAS __attribute__((address_space(1)))
#define LAS __attribute__((address_space(3)))
typedef unsigned short bf16;
typedef unsigned v4u __attribute__((ext_vector_type(4)));
typedef float f32x4 __attribute__((ext_vector_type(4)));
typedef short bf16x8 __attribute__((ext_vector_type(8)));
typedef GAS unsigned gu32;
typedef GAS unsigned long long gu64;
#define RLX_AGENT __ATOMIC_RELAXED, __HIP_MEMORY_SCOPE_AGENT
#define LDS_WAIT() asm volatile("s_waitcnt lgkmcnt(0)" ::: "memory")
#define VM_WAIT() asm volatile("s_waitcnt vmcnt(0)" ::: "memory")
__device__ __forceinline__ unsigned long long rt() { return __builtin_amdgcn_s_memrealtime(); }
__device__ __forceinline__ unsigned f2bf(float f) { unsigned u = __builtin_bit_cast(unsigned, f); return (u + 0x7fffu + ((u >> 16) & 1u)) >> 16; }
__device__ __forceinline__ unsigned pk2(float lo, float hi) { return f2bf(lo) | (f2bf(hi) << 16); }
#define XB_TMO      128
#define XB_XCNT(j)  (256  + 64 * (j))
#define XB_XSUB(j)  (1280 + 64 * (j))
#define XB_XGEN(j)  (2304 + 64 * (j))
#define XB_TOP      3328
#define XB_TOPGEN   3392
#define XCD_BAR_WORDS 3456
#define XB_SPIN_CAP (1u << 18)

__device__ __forceinline__ unsigned xb_ld(unsigned* p)              { return __hip_atomic_load(p, __ATOMIC_RELAXED, __HIP_MEMORY_SCOPE_AGENT); }
__device__ __forceinline__ unsigned xb_add(unsigned* p, unsigned v) { return __hip_atomic_fetch_add(p, v, __ATOMIC_RELAXED, __HIP_MEMORY_SCOPE_AGENT); }
__device__ __forceinline__ unsigned xb_xcc_id() { return (unsigned)__builtin_amdgcn_s_getreg((3 << 11) | 20) & 0xFu; }
#define XB_SPIN(cond, bar) do { unsigned _sp = 0; while (cond) { __builtin_amdgcn_s_sleep(1); \
    if ((++_sp & 255u) == 0u) { if (xb_ld(&(bar)[XB_TMO])) break; if (_sp > XB_SPIN_CAP) { atomicAdd(&(bar)[XB_TMO], 1u); break; } } } } while (0)

struct XcdBarrier {
    unsigned* bar; unsigned x;
    volatile LAS unsigned* st;
};

__device__ __forceinline__ XcdBarrier xcd_barrier_post(unsigned* bar, volatile LAS unsigned* st) {
    XcdBarrier b; b.bar = bar; b.x = xb_xcc_id(); b.st = st;
    if (threadIdx.x == 0) (void)xb_add(&bar[XB_XCNT(b.x)], 1u);
    return b;
}
__device__ __forceinline__ void xcd_barrier_complete(unsigned* bar, unsigned x, unsigned& nloc, unsigned& nx) {
    const unsigned G = gridDim.x * gridDim.y * gridDim.z;
    unsigned sum, cnt, mine, sp = 0u;
    for (;;) {
        sum = 0u; cnt = 0u; mine = 0u;
#pragma unroll
        for (unsigned j = 0; j < 16; ++j) { const unsigned c = xb_ld(&bar[XB_XCNT(j)]); sum += c; cnt += (c > 0u) ? 1u : 0u; mine = (j == x) ? c : mine; }
        if (sum == G) break;
        __builtin_amdgcn_s_sleep(1);
        if ((++sp & 255u) == 0u) { if (xb_ld(&bar[XB_TMO])) break; if (sp > XB_SPIN_CAP) { atomicAdd(&bar[XB_TMO], 1u); break; } }
    }
    nloc = mine > 0u ? mine : 1u; nx = cnt > 0u ? cnt : 1u;
}

__device__ __forceinline__ void xcd_barrier(const XcdBarrier& b) {
    asm volatile("s_waitcnt vmcnt(0)" ::: "memory");
    __syncthreads();
    if (threadIdx.x == 0) {
        unsigned* bar = b.bar;
        __builtin_amdgcn_s_waitcnt(0);
        unsigned nloc = b.st[0], nx = b.st[1];
        if (nloc == 0u) { xcd_barrier_complete(bar, b.x, nloc, nx); b.st[0] = nloc; b.st[1] = nx; }
        const unsigned old = xb_add(&bar[XB_XSUB(b.x)], 1u);
        const unsigned gen = old / nloc;
        if (old + 1u == (gen + 1u) * nloc) {
            __builtin_amdgcn_fence(__ATOMIC_RELEASE, "agent");
            asm volatile("s_waitcnt vmcnt(0)" ::: "memory");
            const unsigned og = xb_add(&bar[XB_TOP], 1u);
            const unsigned tg = og / nx;
            if (og + 1u == (tg + 1u) * nx) xb_add(&bar[XB_TOPGEN], 1u);
            else XB_SPIN(xb_ld(&bar[XB_TOPGEN]) == tg, bar);
            __builtin_amdgcn_fence(__ATOMIC_ACQUIRE, "agent");
            xb_add(&bar[XB_XGEN(b.x)], 1u);
            asm volatile("s_waitcnt vmcnt(0)" ::: "memory");
        } else {
            XB_SPIN(xb_ld(&bar[XB_XGEN(b.x)]) == gen, bar);
            __builtin_amdgcn_fence(__ATOMIC_ACQUIRE, "agent");
            asm volatile("s_waitcnt vmcnt(0)" ::: "memory");
        }
    }
    __syncthreads();
}

constexpr size_t MiB = 1u << 20;
constexpr size_t WS_CTL = 0, CTL_ZERO_BYTES = 64 * 1024;
constexpr size_t WS_GW = 1 * MiB;
constexpr size_t WS_ROPE = 2 * MiB;
constexpr size_t WS_LF = 3 * MiB;
constexpr size_t WS_C = 4 * MiB;
constexpr size_t WS_QN2 = 5 * MiB, WS_KN2 = 5 * MiB + 64 * 1024;
constexpr size_t WS_STATS = 6 * MiB;
constexpr size_t WS_WIN = 10 * MiB;
constexpr size_t WS_WOUT = 15 * MiB;
constexpr size_t WS_WQ = 17 * MiB;
constexpr size_t WS_SUBK = 21 * MiB;
constexpr size_t WS_EU = 22 * MiB, WS_EV = 54 * MiB;
constexpr size_t WS_XB = 86 * MiB;
constexpr size_t WS_FQ = 150 * MiB, WS_FKT = 182 * MiB, WS_FVT = 214 * MiB, WS_SQ = 246 * MiB, WS_SKT = 278 * MiB, WS_SVT = 286 * MiB;
constexpr size_t WS_Q = 150 * MiB;
constexpr size_t WS_ATTN = 294 * MiB;
constexpr size_t WS_IDX = 294 * MiB, WS_G = 310 * MiB;
constexpr size_t WS_END = 358 * MiB;
constexpr size_t WS_MR = 5 * MiB + 128 * 1024;
constexpr size_t WS_STATS2 = 10 * MiB;
constexpr size_t WS_X1B = 86 * MiB;
constexpr size_t WS_HP = 150 * MiB;
constexpr size_t WS_V2 = 214 * MiB;
constexpr size_t EXP_SLICE_BYTES = (size_t)NEXP * 128;
constexpr float U_QS = 768.f, X_QS = 20.f, SQ_V = 40.f;
constexpr size_t WS_XQ = 326 * MiB;
constexpr float SQ_X = 24.f, SQ_A = 24.f, SQ_WIN = 768.f, SQ_WOUT = 1280.f;
constexpr size_t WS_W16 = 358 * MiB;
constexpr size_t WS_X1Q = 326 * MiB;
constexpr int CW_QU = 8192, CW_QV = 8192 + 1024;
#ifndef EXP_PRE_ROWS
#define EXP_PRE_ROWS 16384
#endif
constexpr int EXP_PRE = EXP_PRE_ROWS;
#ifndef V_PRE_ROWS
#define V_PRE_ROWS 6144
#endif
constexpr int V_PRE = V_PRE_ROWS;
#ifndef V_P4_ROWS
#define V_P4_ROWS 8192
#endif
constexpr int V_P4 = V_P4_ROWS;
constexpr int EXP_SPLIT = 16384;
constexpr int CW_BAR = 1024;
static_assert((CW_BAR + XCD_BAR_WORDS) * 4 <= (int)CTL_ZERO_BYTES, "ctl");

constexpr int NWAVES = 8;
constexpr int RING_BYTES = 131072, MISC_OFF = RING_BYTES + 320, LDS_BYTES = 147456;

struct Frame {
    LAS unsigned char* lds;
    volatile LAS unsigned* MISC;
    gu32* ctl;
    int tid, lane, wave, vcu, G;
    const float* in[13]; float* out; unsigned char* ws;
};

__device__ __forceinline__ float wave_sum(float v) {
#pragma unroll
    for (int o = 1; o < 64; o <<= 1) v += __shfl_xor(v, o);
    return v;
}
__device__ __forceinline__ float wave_max(float v) {
#pragma unroll
    for (int o = 1; o < 64; o <<= 1) v = fmaxf(v, __shfl_xor(v, o));
    return v;
}

typedef unsigned u32x2 __attribute__((ext_vector_type(2)));
__device__ __forceinline__ unsigned q8x4(float a, float b, float c, float d_) {
    const int ia = (int)fminf(fmaxf(rintf(a), -127.f), 127.f), ib = (int)fminf(fmaxf(rintf(b), -127.f), 127.f), ic = (int)fminf(fmaxf(rintf(c), -127.f), 127.f), id = (int)fminf(fmaxf(rintf(d_), -127.f), 127.f);
    return ((unsigned)ia & 0xFFu) | (((unsigned)ib & 0xFFu) << 8) | (((unsigned)ic & 0xFFu) << 16) | ((unsigned)id << 24);
}
__device__ __forceinline__ int win_src_col(int pc) {
    if (pc < 1536) return pc;
    int r, base;
    if (pc < 2048) { r = pc - 1536; base = OFF_SQ; }
    else if (pc < 2176) { r = pc - 2048; base = OFF_SK; }
    else return OFF_SV + (pc - 2176);
    const int hd = r >> 6, p = r & 63;
    const int g = p >> 5, fq = (p >> 3) & 3, n = (p >> 2) & 1, e = p & 3;
    return base + hd * 64 + 16 * g + 4 * fq + e + 32 * n;
}
template <bool I8, class SrcCol, class Scale>
__device__ __forceinline__ void p0_transpose_item(const float* W, int ldw, int K, bf16* WT, LAS float* scr, int nblk, int item, int lane, SrcCol sc, Scale sk) {
    const int kb = item / nblk, nb = item % nblk, k0 = 64 * kb, n0 = 32 * nb;
    const int scol = sc(n0 + (lane & 31));
#pragma unroll 8
    for (int i = 0; i < 32; ++i) { const int kk = 2 * i + (lane >> 5); scr[kk * 33 + (lane & 31)] = W[(size_t)(k0 + kk) * ldw + scol] * sk(k0 + kk); }
    LDS_WAIT(); asm volatile("" ::: "memory");
    const int c = lane & 7;
#pragma unroll
    for (int j = 0; j < 4; ++j) { const int n = (lane >> 3) + 8 * j; const LAS float* s = scr + (8 * c) * 33 + n;
        if constexpr (I8) { u32x2 o; o.x = q8x4(s[0 * 33], s[1 * 33], s[2 * 33], s[3 * 33]); o.y = q8x4(s[4 * 33], s[5 * 33], s[6 * 33], s[7 * 33]);
            *(GAS u32x2*)((unsigned char*)WT + (size_t)(n0 + n) * K + k0 + 8 * c) = o; }
        else { v4u o; o.x = pk2(s[0 * 33], s[1 * 33]); o.y = pk2(s[2 * 33], s[3 * 33]); o.z = pk2(s[4 * 33], s[5 * 33]); o.w = pk2(s[6 * 33], s[7 * 33]);
            *(GAS v4u*)(WT + (size_t)(n0 + n) * K + k0 + 8 * c) = o; } }
    LDS_WAIT(); asm volatile("" ::: "memory");
}
__device__ __forceinline__ float log_sigmoid(float z) { return fminf(z, 0.f) - log1pf(__expf(-fabsf(z))); }

__device__ __forceinline__ void p0_prologue(Frame& F) {
    LAS float* scr = (LAS float*)(F.lds + F.wave * 16384);
    const int gw = F.vcu * NWAVES + F.wave, NGW = F.G * NWAVES, lane = F.lane;
    const float* x = F.in[0]; const float* w_in = F.in[1]; const float* b_forget = F.in[2]; const float* w_out = F.in[4]; const float* ln1_g = F.in[5];
    const float* w_query = F.in[7]; const float* sub_keys = F.in[8];
    bf16* WIN = (bf16*)(F.ws + WS_WIN); bf16* WOUT = (bf16*)(F.ws + WS_WOUT); bf16* WQ = (bf16*)(F.ws + WS_WQ); bf16* SUBK = (bf16*)(F.ws + WS_SUBK);
    bf16* XB = (bf16*)(F.ws + WS_XB);
    float2* ROPE = (float2*)(F.ws + WS_ROPE); float* LF = (float*)(F.ws + WS_LF);
    constexpr int I_IN = 16 * (NPHYS / 32), I_OUT = 16 * 32, I_Q = 16 * 64;
    for (int it = gw; it < I_IN + I_OUT + I_Q; it += NGW) {
        if (it < I_IN) p0_transpose_item<true>(w_in, IN_COLS, 1024, WIN, scr, NPHYS / 32, it, lane, [](int pc) { return win_src_col(pc); }, [](int) { return SQ_WIN; });
        else if (it < I_IN + I_OUT) p0_transpose_item<true>(w_out, 1024, 1024, WOUT, scr, 32, it - I_IN, lane, [](int pc) { return pc; }, [](int) { return SQ_WOUT; });
        else p0_transpose_item<false>(w_query, QCOLS, 1024, WQ, scr, 64, it - I_IN - I_OUT, lane, [](int pc) { return pc; }, [=](int k) { return ln1_g[k]; });
    }
    for (int it = gw; it < (PEER_H * 2 * NKEYS * PEER_HALF) / 512; it += NGW) {
        const size_t o = (size_t)it * 512 + lane * 8; const f32x4 a = *(const GAS f32x4*)(sub_keys + o), b = *(const GAS f32x4*)(sub_keys + o + 4);
        v4u w; w.x = pk2(a.x, a.y); w.y = pk2(a.z, a.w); w.z = pk2(b.x, b.y); w.w = pk2(b.z, b.w); *(GAS v4u*)(SUBK + o) = w;
    }
    for (int it = gw; it < (SEQ * 32) / 64; it += NGW) {
        const int e = it * 64 + lane, pos = e >> 5, i = e & 31;
        const float inv = powf(10000.0f, -(float)i / 32.0f), ang = (float)pos * inv;
        double rev = (double)ang * 0.15915494309189535; rev -= floor(rev);
        const float r = (float)rev;
        ROPE[e] = make_float2(__builtin_amdgcn_cosf(r), __builtin_amdgcn_sinf(r));
    }
    {
        float wff[16][8];
#pragma unroll
        for (int j = 0; j < 2; ++j)
#pragma unroll
            for (int e = 0; e < 8; ++e) { const float* wr_ = w_in + (size_t)(512 * j + 8 * lane + e) * IN_COLS + OFF_FF; const f32x4 a = *(const GAS f32x4*)wr_, b = *(const GAS f32x4*)(wr_ + 4);
                wff[j * 8 + e][0] = a.x; wff[j * 8 + e][1] = a.y; wff[j * 8 + e][2] = a.z; wff[j * 8 + e][3] = a.w; wff[j * 8 + e][4] = b.x; wff[j * 8 + e][5] = b.y; wff[j * 8 + e][6] = b.z; wff[j * 8 + e][7] = b.w; }
        const float bfl = b_forget[lane & 7];
        for (int m = gw; m < T; m += NGW) {
            const float* src = x + (size_t)m * D_MODEL; bf16* dst = XB + (size_t)m * D_MODEL;
            float xv[16];
#pragma unroll
            for (int j = 0; j < 2; ++j) { const f32x4 a = *(const GAS f32x4*)(src + 512 * j + 8 * lane), b = *(const GAS f32x4*)(src + 512 * j + 8 * lane + 4);
                xv[8 * j + 0] = a.x; xv[8 * j + 1] = a.y; xv[8 * j + 2] = a.z; xv[8 * j + 3] = a.w; xv[8 * j + 4] = b.x; xv[8 * j + 5] = b.y; xv[8 * j + 6] = b.z; xv[8 * j + 7] = b.w;
                v4u w; w.x = pk2(a.x, a.y); w.y = pk2(a.z, a.w); w.z = pk2(b.x, b.y); w.w = pk2(b.z, b.w); *(GAS v4u*)(dst + 512 * j + 8 * lane) = w;
                u32x2 wq; wq.x = q8x4(a.x * SQ_X, a.y * SQ_X, a.z * SQ_X, a.w * SQ_X); wq.y = q8x4(b.x * SQ_X, b.y * SQ_X, b.z * SQ_X, b.w * SQ_X);
                *(GAS u32x2*)(F.ws + WS_XQ + (size_t)m * D_MODEL + 512 * j + 8 * lane) = wq; }
            float acc[8];
#pragma unroll
            for (int h = 0; h < 8; ++h) { float s = 0.f;
#pragma unroll
                for (int d = 0; d < 16; ++d) s = fmaf(xv[d], wff[d][h], s);
                acc[h] = wave_sum(s); }
            float mine = acc[0];
#pragma unroll
            for (int h = 1; h < 8; ++h) mine = ((lane & 7) == h) ? acc[h] : mine;
            if (lane < 8) LF[(size_t)m * 8 + lane] = log_sigmoid(mine + bfl);
        }
    }
}

__device__ __forceinline__ pg8::f32x4 iacc(pg8::f32x4 a, float s) { typedef int v4i_ __attribute__((ext_vector_type(4))); const v4i_ i = __builtin_bit_cast(v4i_, a); return (pg8::f32x4){(float)i[0] * s, (float)i[1] * s, (float)i[2] * s, (float)i[3] * s}; }
struct EpiInProj {
    static constexpr bool PERM = true, AFTER_DRAIN = false;
    static constexpr float SI = 1.f / (SQ_X * SQ_WIN);
    bf16 *fq, *fkt, *fvt, *sq, *skt, *svt; const float2* rope; float *qn2, *kn2;
    static __device__ __forceinline__ size_t tile_off(int nh, int t, int head) { const int b = t >> 12, s = t & 4095; return ((size_t)(b * nh + head) * 64 + (s >> 6)) * 8192; }
    __device__ __forceinline__ void operator()(const pg8::f32x4 (&acc)[2][2][4][2], const pg8::Unit& u, int wr, int wc, int fr, int fq_) const {
        const int pn = u.pn, g = wc & 1, hsub = wc >> 1;
        const int trow0 = u.pm * 256 + wr * 64 + fr;
        const bool lane0 = (fr == 0) && (fq_ == 0);
#pragma unroll
        for (int ai = 0; ai < 2; ++ai)
#pragma unroll
            for (int bj = 0; bj < 2; ++bj) {
                const int blk64 = (u.pm * 256 + ai * 128 + wr * 64) >> 6;
                if (pn < 6) {
                    const int head = 4 * (pn & 1) + 2 * bj + hsub;
                    float nrm = 0.f;
#pragma unroll
                    for (int m = 0; m < 4; ++m) {
                        const int t = trow0 + ai * 128 + m * 16;
                        pg8::f32x4 v0 = iacc(acc[ai][bj][m][0], SI), v1 = iacc(acc[ai][bj][m][1], SI);
                        if (pn < 2) { v0 = v0 * C2; v1 = v1 * C2; }
                        v4u w; w.x = pg8::cvt_pk_bf16(v0[0], v0[1]); w.y = pg8::cvt_pk_bf16(v0[2], v0[3]); w.z = pg8::cvt_pk_bf16(v1[0], v1[1]); w.w = pg8::cvt_pk_bf16(v1[2], v1[3]);
                        if (pn < 4) { float ss = (v0[0] * v0[0] + v0[1] * v0[1]) + (v0[2] * v0[2] + v0[3] * v0[3]) + (v1[0] * v1[0] + v1[1] * v1[1]) + (v1[2] * v1[2] + v1[3] * v1[3]);
                            ss += __shfl_xor(ss, 16); ss += __shfl_xor(ss, 32); nrm = fmaxf(nrm, ss); }
                        if (pn < 2) *(GAS v4u*)(fq + (size_t)t * 512 + head * 64 + 32 * g + 8 * fq_) = w;
                        else if (pn < 4) *(GAS v4u*)((GAS unsigned char*)fkt + tile_off(8, t, head) + (size_t)((4 * g + fq_) * 64 + (t & 63)) * 16) = w;
                        else *(GAS v4u*)((GAS unsigned char*)fvt + tile_off(8, t, head) + (size_t)(g * 4 + ((t & 63) >> 4)) * 1024 + (t & 15) * 64 + fq_ * 16) = w;
                    }
                    if (pn < 4) {
                        nrm = fmaxf(nrm, __shfl_xor(nrm, 1)); nrm = fmaxf(nrm, __shfl_xor(nrm, 2)); nrm = fmaxf(nrm, __shfl_xor(nrm, 4)); nrm = fmaxf(nrm, __shfl_xor(nrm, 8));
                        if (lane0) (pn < 2 ? qn2 : kn2)[(blk64 * 8 + head) * 2 + g] = nrm;
                    }
                } else if (pn < 8 || bj == 0) {
                    const int head = (pn < 8) ? 4 * (pn & 1) + 2 * bj + hsub : hsub;
                    const int i0 = 16 * g + 4 * fq_;
#pragma unroll
                    for (int m = 0; m < 4; ++m) {
                        const int t = trow0 + ai * 128 + m * 16, pos = t & 4095;
                        const pg8::f32x4 x1 = iacc(acc[ai][bj][m][0], SI), x2 = iacc(acc[ai][bj][m][1], SI);
                        const f32x4 cs01 = *(const GAS f32x4*)(rope + pos * 32 + i0), cs23 = *(const GAS f32x4*)(rope + pos * 32 + i0 + 2);
                        float o1[4], o2[4];
                        o1[0] = x1[0] * cs01.x - x2[0] * cs01.y; o2[0] = x2[0] * cs01.x + x1[0] * cs01.y;
                        o1[1] = x1[1] * cs01.z - x2[1] * cs01.w; o2[1] = x2[1] * cs01.z + x1[1] * cs01.w;
                        o1[2] = x1[2] * cs23.x - x2[2] * cs23.y; o2[2] = x2[2] * cs23.x + x1[2] * cs23.y;
                        o1[3] = x1[3] * cs23.z - x2[3] * cs23.w; o2[3] = x2[3] * cs23.z + x1[3] * cs23.w;
                        if (pn < 8) {
#pragma unroll
                            for (int e = 0; e < 4; ++e) { o1[e] *= C2; o2[e] *= C2; }
                        }
                        u32x2 w1, w2; w1.x = pg8::cvt_pk_bf16(o1[0], o1[1]); w1.y = pg8::cvt_pk_bf16(o1[2], o1[3]); w2.x = pg8::cvt_pk_bf16(o2[0], o2[1]); w2.y = pg8::cvt_pk_bf16(o2[2], o2[3]);
                        if (pn < 8) { bf16* p = sq + (size_t)t * 512 + head * 64 + i0; *(GAS u32x2*)p = w1; *(GAS u32x2*)(p + 32) = w2; }
                        else { GAS unsigned char* p = (GAS unsigned char*)skt + tile_off(2, t, head) + (size_t)((2 * g + (fq_ >> 1)) * 64 + (t & 63)) * 16 + (fq_ & 1) * 8;
                            *(GAS u32x2*)p = w1; *(GAS u32x2*)(p + 4 * 1024) = w2; }
                    }
                } else {
                    const int head = hsub;
#pragma unroll
                    for (int m = 0; m < 4; ++m) {
                        const int t = trow0 + ai * 128 + m * 16;
                        const pg8::f32x4 v0 = iacc(acc[ai][bj][m][0], SI), v1 = iacc(acc[ai][bj][m][1], SI);
                        v4u w; w.x = pg8::cvt_pk_bf16(v0[0], v0[1]); w.y = pg8::cvt_pk_bf16(v0[2], v0[3]); w.z = pg8::cvt_pk_bf16(v1[0], v1[1]); w.w = pg8::cvt_pk_bf16(v1[2], v1[3]);
                        *(GAS v4u*)((GAS unsigned char*)svt + tile_off(2, t, head) + (size_t)(g * 4 + ((t & 63) >> 4)) * 1024 + (t & 15) * 64 + fq_ * 16) = w;
                    }
                }
            }
    }
};

__device__ __forceinline__ void convert_experts(Frame& F, int w, int nw, int r0, int r1) {
    const float* eu = F.in[9]; const float* ev = F.in[10]; const int lane = F.lane;
    for (int m0 = r0 + 4 * w; m0 < r1; m0 += 4 * nw) {
        const bool isu = m0 < NEXP; const int e0 = m0 % NEXP;
        const float* src = (isu ? eu : ev) + (size_t)e0 * D_MODEL; unsigned char* dst = F.ws + (isu ? WS_EU : WS_EV); const float sc = isu ? U_QS : SQ_V;
        f32x4 va[4][2], vb[4][2];
#pragma unroll
        for (int r = 0; r < 4; ++r)
#pragma unroll
            for (int j = 0; j < 2; ++j) { va[r][j] = *(const GAS f32x4*)(src + r * D_MODEL + 512 * j + 8 * lane); vb[r][j] = *(const GAS f32x4*)(src + r * D_MODEL + 512 * j + 8 * lane + 4); }
#pragma unroll
        for (int r = 0; r < 4; ++r)
#pragma unroll
            for (int j = 0; j < 2; ++j) { const f32x4 a = va[r][j] * sc, b = vb[r][j] * sc;
                const int w0 = (int)q8x4(a.x, a.y, a.z, a.w), w1 = (int)q8x4(b.x, b.y, b.z, b.w);
                u32x2 wd; wd.x = (unsigned)w0; wd.y = (unsigned)w1;
                *(GAS u32x2*)(dst + (size_t)(4 * j + (lane >> 4)) * EXP_SLICE_BYTES + (size_t)(e0 + r) * 128 + 8 * (lane & 15)) = wd; }
    }
}
__device__ __forceinline__ void p1_slack_jobs(Frame& F, int sb, int nsb) {
    const float* LF = (const float*)(F.ws + WS_LF); float* C = (float*)(F.ws + WS_C);
    LAS float* red = (LAS float*)F.lds;
    const int lane = F.lane;
    for (int job = sb; job < BATCH * FOX_H; job += nsb) {
        const int b = job >> 3, h = job & 7;
        float v[8]; float run = 0.f;
#pragma unroll
        for (int i = 0; i < 8; ++i) { run += LF[(size_t)(b * SEQ + F.tid * 8 + i) * 8 + h]; v[i] = run; }
        float inc = run;
#pragma unroll
        for (int o = 1; o < 64; o <<= 1) { const float n = __shfl_up(inc, o); if (lane >= o) inc += n; }
        __syncthreads();
        if (lane == 63) red[F.wave] = inc;
        __syncthreads();
        float base = inc - run;
        for (int w = 0; w < F.wave; ++w) base += red[w];
#pragma unroll
        for (int i = 0; i < 8; ++i) C[(size_t)job * SEQ + F.tid * 8 + i] = (base + v[i]) * LOG2E;
    }
    const int w = sb * NWAVES + F.wave, nw = nsb * NWAVES;
    {
        const bf16* WQ = (const bf16*)(F.ws + WS_WQ); const float* w_query = F.in[7]; const float* ln1_b = F.in[6];
        float* GW = (float*)(F.ws + WS_GW); float* BW = GW + QCOLS;
        for (int n = w; n < QCOLS; n += nw) {
            const v4u a = *(const GAS v4u*)(WQ + (size_t)n * 1024 + 8 * lane), b = *(const GAS v4u*)(WQ + (size_t)n * 1024 + 512 + 8 * lane);
            float s = 0.f;
#pragma unroll
            for (int i = 0; i < 4; ++i) { s += __uint_as_float(a[i] << 16) + __uint_as_float(a[i] & 0xffff0000u); s += __uint_as_float(b[i] << 16) + __uint_as_float(b[i] & 0xffff0000u); }
            s = wave_sum(s);
            if (lane == 0) GW[n] = s;
        }
    }
    for (int c64 = sb; c64 < QCOLS / 64; c64 += nsb) {
        const float* w_query = F.in[7]; const float* ln1_b = F.in[6]; float* BW = (float*)(F.ws + WS_GW) + QCOLS;
        const int n = c64 * 64 + lane; float s = 0.f;
        for (int k0 = F.wave * 128; k0 < F.wave * 128 + 128; k0 += 16) {
            float wv_[16];
#pragma unroll
            for (int i = 0; i < 16; ++i) wv_[i] = w_query[(size_t)(k0 + i) * QCOLS + n];
#pragma unroll
            for (int i = 0; i < 16; ++i) s = fmaf(ln1_b[k0 + i], wv_[i], s);
        }
        __syncthreads();
        red[F.wave * 64 + lane] = s;
        __syncthreads();
        if (F.wave == 0) { float t_ = 0.f;
#pragma unroll
            for (int w8 = 0; w8 < 8; ++w8) t_ += red[w8 * 64 + lane];
            BW[n] = t_; }
    }
    convert_experts(F, w, nw, 0, EXP_PRE);
}

namespace att {
typedef float f32x16 __attribute__((ext_vector_type(16)));
typedef short s16x4 __attribute__((ext_vector_type(4)));
constexpr int LDS_K = 0, LDS_V = 16384, LDS_WS = 32768, LDS_OST = LDS_WS + 8 * 256, LDS_TOTAL = LDS_OST + 8 * 4096;
__device__ __forceinline__ int crow(int r, int hi) { return (r & 3) + 8 * (r >> 2) + 4 * hi; }
__device__ __forceinline__ float max3f(float a, float b, float c) { float r; asm("v_max3_f32 %0, %1, %2, %3" : "=v"(r) : "v"(a), "v"(b), "v"(c)); return r; }
__device__ __forceinline__ unsigned cvtpk(float lo, float hi) { unsigned r; asm("v_cvt_pk_bf16_f32 %0, %1, %2" : "=v"(r) : "v"(lo), "v"(hi)); return r; }
__device__ __forceinline__ float rowmax(const f32x16& p0, const f32x16& p1) {
    float a = max3f(p0[0], p0[1], p1[0]), b = max3f(p0[2], p0[3], p1[1]); a = max3f(a, p1[2], p1[3]);
#pragma unroll
    for (int r = 4; r < 16; r += 4) { a = max3f(a, p0[r], p0[r + 1]); b = max3f(b, p0[r + 2], p0[r + 3]); a = max3f(a, p1[r], p1[r + 1]); b = max3f(b, p1[r + 2], p1[r + 3]); }
    const float m = fmaxf(a, b);
    auto rr = __builtin_amdgcn_permlane32_swap(__float_as_uint(m), __float_as_uint(m), false, false);
    return fmaxf(__uint_as_float(rr[0]), __uint_as_float(rr[1]));
}
__device__ __forceinline__ void qkt(f32x16& p0, f32x16& p1, const LAS unsigned char* Kslot, const bf16x8* qr, int r32, int hi) {
    const LAS unsigned char* kb = Kslot + hi * 1024 + r32 * 16;
#pragma unroll
    for (int d0 = 0; d0 < 4; ++d0) {
        const bf16x8 b0 = *(const LAS bf16x8*)(kb + d0 * 2048), b1 = *(const LAS bf16x8*)(kb + d0 * 2048 + 512);
        p0 = __builtin_amdgcn_mfma_f32_32x32x16_bf16(b0, qr[d0], p0, 0, 0, 0);
        p1 = __builtin_amdgcn_mfma_f32_32x32x16_bf16(b1, qr[d0], p1, 0, 0, 0);
    }
}
__device__ __forceinline__ void pv(f32x16* o, int vb, bf16x8 pa0, bf16x8 pa1, bf16x8 pa2, bf16x8 pa3) {
#pragma unroll
    for (int d0 = 0; d0 < 2; ++d0) {
        s16x4 lo[4], hi[4];
#pragma unroll
        for (int ks = 0; ks < 4; ++ks) {
            asm volatile("ds_read_b64_tr_b16 %0,%1 offset:%c2" : "=&v"(lo[ks]) : "v"(vb), "i"(d0 * 4096 + ks * 1024) : "memory");
            asm volatile("ds_read_b64_tr_b16 %0,%1 offset:%c2" : "=&v"(hi[ks]) : "v"(vb), "i"(d0 * 4096 + ks * 1024 + 512) : "memory");
        }
        asm volatile("s_waitcnt lgkmcnt(0)" ::: "memory"); __builtin_amdgcn_sched_barrier(0);
#define ATT_PK(k) (bf16x8){lo[k][0], lo[k][1], lo[k][2], lo[k][3], hi[k][0], hi[k][1], hi[k][2], hi[k][3]}
        o[d0] = __builtin_amdgcn_mfma_f32_32x32x16_bf16(pa0, ATT_PK(0), o[d0], 0, 0, 0);
        o[d0] = __builtin_amdgcn_mfma_f32_32x32x16_bf16(pa1, ATT_PK(1), o[d0], 0, 0, 0);
        o[d0] = __builtin_amdgcn_mfma_f32_32x32x16_bf16(pa2, ATT_PK(2), o[d0], 0, 0, 0);
        o[d0] = __builtin_amdgcn_mfma_f32_32x32x16_bf16(pa3, ATT_PK(3), o[d0], 0, 0, 0);
#undef ATT_PK
    }
}

template <int KIND>
__device__ __forceinline__ void attn_unit(Frame& F, int b, int h, int qb) {
    const int tid = F.tid, lane = F.lane, r32 = lane & 31, hi = lane >> 5, wid = F.wave;
    const int q0 = qb * 256, w0 = q0 + wid * 32, myq = w0 + r32;
    const bf16* Qg = (const bf16*)(F.ws + (KIND == 0 ? WS_FQ : WS_SQ)) + (size_t)(b * SEQ + myq) * 512 + h * 64;
    const int kvh = (KIND == 0) ? h : (h >> 2), nkv = (KIND == 0) ? 8 : 2;
    const unsigned char* KT = F.ws + (KIND == 0 ? WS_FKT : WS_SKT) + (size_t)(b * nkv + kvh) * 64 * 8192;
    const unsigned char* VT = F.ws + (KIND == 0 ? WS_FVT : WS_SVT) + (size_t)(b * nkv + kvh) * 64 * 8192;
    const float* Cg = (const float*)(F.ws + WS_C) + (size_t)(b * 8 + h) * SEQ;
    LAS unsigned char* lds = F.lds;
    LAS float* wsf = (LAS float*)(lds + LDS_WS) + wid * 64;
#define ATT_LOAD(j, buf) do { \
        __builtin_amdgcn_global_load_lds((const unsigned*)(KT + (size_t)(j) * 8192 + tid * 16), (LAS unsigned*)(lds + LDS_K + (buf) * 8192 + wid * 1024), 16, 0, 0); \
        __builtin_amdgcn_global_load_lds((const unsigned*)(VT + (size_t)(j) * 8192 + tid * 16), (LAS unsigned*)(lds + LDS_V + (buf) * 8192 + wid * 1024), 16, 0, 0); } while (0)
    const int jhi = qb * 4 + 3; int jlo; float cref = 0.f, cw0 = 0.f, TH = 0.f;
    ATT_LOAD(jhi, 0);
    bf16x8 qr[4];
#pragma unroll
    for (int d0 = 0; d0 < 4; ++d0) qr[d0] = *(const GAS bf16x8*)(Qg + d0 * 16 + hi * 8);
    if (KIND == 0) {
        const float* QN2 = (const float*)(F.ws + WS_QN2); const float* KN2 = (const float*)(F.ws + WS_KN2);
        const int kblk = b * 64 + lane; const float knl = KN2[(kblk * 8 + h) * 2] + KN2[(kblk * 8 + h) * 2 + 1];
        const int qblk = (b * SEQ + q0) / 64 + (lane & 3); const float qnl = QN2[(qblk * 8 + h) * 2] + QN2[(qblk * 8 + h) * 2 + 1];
        const int jt = qb * 4 - 1 - lane; const float cl = Cg[jt >= 0 ? 64 * jt + 63 : 0];
        cref = Cg[q0]; cw0 = Cg[w0];
        const float kn = wave_max(knl), qn = wave_max(qnl);
        TH = 160.f + 2.05f * sqrtf(qn * kn);
        const unsigned long long keep = __ballot(lane < 16 && jt >= 0 && (cref - cl) >= -TH);
        const int nkeep = __builtin_ctzll(~keep);
        jlo = qb * 4 - nkeep;
        if (nkeep == 16) { while (jlo > 0 && (cref - Cg[64 * (jlo - 1) + 63]) >= -TH) --jlo; }
        jlo = __builtin_amdgcn_readfirstlane(jlo);
    } else {
        jlo = (q0 - 127) < 0 ? 0 : ((q0 - 127) >> 6);
    }
    float m_run, l_run;
    if (KIND == 0) { m_run = -INFINITY; l_run = 0.f; }
    else { m_run = F.in[3][h] * LOG2E; l_run = (hi == 0) ? 1.f : 0.f; }
    f32x16 o[2];
#pragma unroll
    for (int r = 0; r < 16; ++r) { o[0][r] = 0.f; o[1][r] = 0.f; }
    const int vb0 = (int)(unsigned)(uintptr_t)(lds + LDS_V) + ((lane >> 4) & 1) * 32 + (lane & 3) * 8 + (4 * hi + ((lane & 15) >> 2)) * 64;
    int cur = 0;
    for (int j = jhi; j >= jlo; --j, cur ^= 1) {
        asm volatile("s_waitcnt vmcnt(0)" ::: "memory");
        __syncthreads();
        if (j > jlo) ATT_LOAD(j - 1, cur ^ 1);
        const int k0 = 64 * j;
        bool active = k0 <= w0 + 31;
        if (KIND == 1) active = active && (k0 + 63 >= w0 - 127);
        if (KIND == 0 && k0 + 63 < w0) active = active && ((cw0 - Cg[k0 + 63]) >= -TH);
        if (active) {
            f32x16 p0, p1;
            if (KIND == 0) {
#pragma unroll
                for (int g = 0; g < 4; ++g) {
                    const f32x4 c0 = *(const GAS f32x4*)(Cg + k0 + 8 * g + 4 * hi), c1 = *(const GAS f32x4*)(Cg + k0 + 32 + 8 * g + 4 * hi);
#pragma unroll
                    for (int e = 0; e < 4; ++e) { p0[4 * g + e] = cref - c0[e]; p1[4 * g + e] = cref - c1[e]; }
                }
            } else {
#pragma unroll
                for (int r = 0; r < 16; ++r) { p0[r] = 0.f; p1[r] = 0.f; }
            }
            qkt(p0, p1, lds + LDS_K + cur * 8192, qr, r32, hi);
            if (k0 + 63 > w0) {
#pragma unroll
                for (int r = 0; r < 16; ++r) { const int kv = k0 + crow(r, hi); if (kv > myq) p0[r] = -INFINITY; if (kv + 32 > myq) p1[r] = -INFINITY; }
            }
            if (KIND == 1 && k0 < w0 + 31 - 127) {
#pragma unroll
                for (int r = 0; r < 16; ++r) { const int kv = k0 + crow(r, hi); if (kv < myq - 127) p0[r] = -INFINITY; if (kv + 32 < myq - 127) p1[r] = -INFINITY; }
            }
            const float rm = rowmax(p0, p1);
            const float m_new = fmaxf(m_run, rm);
            const bool resc = __any(m_new > m_run);
            const float alpha = __builtin_amdgcn_exp2f(m_run - m_new);
            m_run = m_new;
            float ps = 0.f;
#pragma unroll
            for (int r = 0; r < 16; ++r) { p0[r] = __builtin_amdgcn_exp2f(p0[r] - m_new); p1[r] = __builtin_amdgcn_exp2f(p1[r] - m_new); ps += p0[r] + p1[r]; }
            l_run = l_run * alpha + ps;
            v4u pw0, pw1, pw2, pw3;
#pragma unroll
            for (int i = 0; i < 4; ++i) { pw0[i] = cvtpk(p0[2 * i], p0[2 * i + 1]); pw1[i] = cvtpk(p0[8 + 2 * i], p0[9 + 2 * i]); pw2[i] = cvtpk(p1[2 * i], p1[2 * i + 1]); pw3[i] = cvtpk(p1[8 + 2 * i], p1[9 + 2 * i]); }
            if (resc) {
                if (hi == 0) wsf[r32] = alpha;
#pragma unroll
                for (int r = 0; r < 16; ++r) { const float a = wsf[crow(r, hi)]; o[0][r] *= a; o[1][r] *= a; }
            }
            pv(o, vb0 + cur * 8192, __builtin_bit_cast(bf16x8, pw0), __builtin_bit_cast(bf16x8, pw1), __builtin_bit_cast(bf16x8, pw2), __builtin_bit_cast(bf16x8, pw3));
        }
    }
#undef ATT_LOAD
    { auto rr = __builtin_amdgcn_permlane32_swap(__float_as_uint(l_run), __float_as_uint(l_run), false, false); l_run = __uint_as_float(rr[0]) + __uint_as_float(rr[1]); }
    if (hi == 0) wsf[32 + r32] = l_run;
    float rli[16];
#pragma unroll
    for (int r = 0; r < 16; ++r) rli[r] = __builtin_amdgcn_rcpf(wsf[32 + crow(r, hi)]);
    LAS unsigned char* stg = lds + LDS_OST + wid * 2048;
#pragma unroll
    for (int r = 0; r < 16; ++r) { const int orow = crow(r, hi);
#pragma unroll
        for (int d0 = 0; d0 < 2; ++d0) { const float qv = fminf(fmaxf(rintf(o[d0][r] * rli[r] * SQ_A), -127.f), 127.f); stg[orow * 64 + d0 * 32 + r32] = (unsigned char)(int)qv; } }
    unsigned char* Ow = F.ws + WS_ATTN + (size_t)(b * SEQ + w0) * 1024 + (KIND == 0 ? 0 : 512) + h * 64;
#pragma unroll
    for (int i = 0; i < 2; ++i) { const int row = i * 16 + (lane >> 2), ch = lane & 3; const v4u v = *(const LAS v4u*)(stg + row * 64 + ch * 16); *(GAS v4u*)(Ow + (size_t)row * 1024 + ch * 16) = v; }
    __syncthreads();
}

__device__ __forceinline__ void attn_phase(Frame& F, int kmask = 3) {
    for (int u = (int)blockIdx.x; u < 2048; u += F.G) {
        const int kind = u >> 10; if (!((kmask >> kind) & 1)) continue;
        const int rem = u & 1023, b = rem >> 7, h = (rem >> 4) & 7, qb = ((rem & 15) + (rem >> 8)) & 15;
        if (kind == 0) attn_unit<0>(F, b, h, qb); else attn_unit<1>(F, b, h, qb);
    }
}
}

struct EpiOutProj {
    static constexpr bool PERM = true, AFTER_DRAIN = false;
    bf16* yb; float2* stats;
    __device__ __forceinline__ void operator()(const pg8::f32x4 (&acc)[2][2][4][2], const pg8::Unit& u, int wr, int wc, int fr, int fq_) const {
        const int trow0 = u.pm * 256 + wr * 64 + fr;
        v4u xw[2][4][2];
#pragma unroll
        for (int ai = 0; ai < 2; ++ai)
#pragma unroll
            for (int m = 0; m < 4; ++m)
#pragma unroll
                for (int bj = 0; bj < 2; ++bj)
                    xw[ai][m][bj] = *(const GAS v4u*)(yb + (size_t)(trow0 + ai * 128 + m * 16) * D_MODEL + u.pn * 256 + bj * 128 + wc * 32 + 8 * fq_);
        __builtin_amdgcn_sched_barrier(0);
#pragma unroll
        for (int ai = 0; ai < 2; ++ai)
#pragma unroll
            for (int m = 0; m < 4; ++m) {
                const int t = trow0 + ai * 128 + m * 16;
                float s = 0.f, ss = 0.f;
#pragma unroll
                for (int bj = 0; bj < 2; ++bj) {
                    const size_t off = (size_t)t * D_MODEL + u.pn * 256 + bj * 128 + wc * 32 + 8 * fq_;
                    const v4u xv = xw[ai][m][bj];
                    f32x4 x0, x1;
                    x0[0] = __uint_as_float(xv[0] << 16); x0[1] = __uint_as_float(xv[0] & 0xffff0000u); x0[2] = __uint_as_float(xv[1] << 16); x0[3] = __uint_as_float(xv[1] & 0xffff0000u);
                    x1[0] = __uint_as_float(xv[2] << 16); x1[1] = __uint_as_float(xv[2] & 0xffff0000u); x1[2] = __uint_as_float(xv[3] << 16); x1[3] = __uint_as_float(xv[3] & 0xffff0000u);
                    const f32x4 v0 = x0 * ALPHA + iacc(acc[ai][bj][m][0], 1.f / (SQ_A * SQ_WOUT)), v1 = x1 * ALPHA + iacc(acc[ai][bj][m][1], 1.f / (SQ_A * SQ_WOUT));
                    v4u w; w.x = pg8::cvt_pk_bf16(v0[0], v0[1]); w.y = pg8::cvt_pk_bf16(v0[2], v0[3]); w.z = pg8::cvt_pk_bf16(v1[0], v1[1]); w.w = pg8::cvt_pk_bf16(v1[2], v1[3]);
                    *(GAS v4u*)(yb + off) = w;
                    s += (v0[0] + v0[1]) + (v0[2] + v0[3]) + (v1[0] + v1[1]) + (v1[2] + v1[3]);
                    ss += (v0[0] * v0[0] + v0[1] * v0[1]) + (v0[2] * v0[2] + v0[3] * v0[3]) + (v1[0] * v1[0] + v1[1] * v1[1]) + (v1[2] * v1[2] + v1[3] * v1[3]);
                }
                s += __shfl_xor(s, 16); s += __shfl_xor(s, 32); ss += __shfl_xor(ss, 16); ss += __shfl_xor(ss, 32);
                if (fq_ == 0) stats[(size_t)t * 16 + u.pn * 4 + wc] = make_float2(s, ss);
            }
    }
};
__device__ __forceinline__ float2 ln1_row_stats(const float2* stats, int t) {
    float s = 0.f, ss = 0.f;
#pragma unroll
    for (int i = 0; i < 16; i += 2) { const f32x4 a = *(const GAS f32x4*)(stats + (size_t)t * 16 + i); s += a.x + a.z; ss += a.y + a.w; }
    const float mean = s * (1.f / D_MODEL), var = fmaxf(ss * (1.f / D_MODEL) - mean * mean, 0.f);
    return make_float2(mean, 1.f / sqrtf(var + LN_EPS));
}
struct EpiQuery {
    static constexpr bool PERM = true, AFTER_DRAIN = false;
    const float2* stats; const float* gw; const float* bw; bf16* q;
    __device__ __forceinline__ void operator()(const pg8::f32x4 (&acc)[2][2][4][2], const pg8::Unit& u, int wr, int wc, int fr, int fq_) const {
        const int trow0 = u.pm * 256 + wr * 64 + fr, lane = fr + 16 * fq_;
        const int k0 = 2 * fq_, k1 = 2 * fq_ + 1;
        const float2 sa = ln1_row_stats(stats, trow0 + (k0 >> 2) * 128 + (k0 & 3) * 16), sb = ln1_row_stats(stats, trow0 + (k1 >> 2) * 128 + (k1 & 3) * 16);
        float mean[8], rstd[8];
#pragma unroll
        for (int k = 0; k < 8; ++k) { const int src = fr + 16 * (k >> 1); mean[k] = __shfl((k & 1) ? sb.x : sa.x, src); rstd[k] = __shfl((k & 1) ? sb.y : sa.y, src); }
        (void)lane;
#pragma unroll
        for (int bj = 0; bj < 2; ++bj) {
            const int col0 = u.pn * 256 + bj * 128 + wc * 32 + 8 * fq_;
            const f32x4 g0 = *(const GAS f32x4*)(gw + col0), g1 = *(const GAS f32x4*)(gw + col0 + 4), b0 = *(const GAS f32x4*)(bw + col0), b1 = *(const GAS f32x4*)(bw + col0 + 4);
#pragma unroll
            for (int ai = 0; ai < 2; ++ai)
#pragma unroll
                for (int m = 0; m < 4; ++m) {
                    const int t = trow0 + ai * 128 + m * 16; const float mu = mean[4 * ai + m], rs = rstd[4 * ai + m];
                    const f32x4 v0 = (acc[ai][bj][m][0] - g0 * mu) * rs + b0, v1 = (acc[ai][bj][m][1] - g1 * mu) * rs + b1;
                    v4u w; w.x = pg8::cvt_pk_bf16(v0[0], v0[1]); w.y = pg8::cvt_pk_bf16(v0[2], v0[3]); w.z = pg8::cvt_pk_bf16(v1[0], v1[1]); w.w = pg8::cvt_pk_bf16(v1[2], v1[3]);
                    *(GAS v4u*)(q + ((size_t)(t >> 5) * 8192 + (size_t)(col0 >> 3) * 32 + (t & 31)) * 8) = w;
                }
        }
    }
};
#define TOPK_SORT128(v) do { \
  CE(v[0],v[1]);CE(v[3],v[2]);CE(v[4],v[5]);CE(v[7],v[6]);CE(v[8],v[9]);CE(v[11],v[10]);CE(v[12],v[13]);CE(v[15],v[14]);CE(v[0],v[2]);CE(v[1],v[3]);CE(v[6],v[4]);CE(v[7],v[5]);CE(v[8],v[10]);CE(v[9],v[11]);CE(v[14],v[12]);CE(v[15],v[13]);CE(v[0],v[1]);CE(v[2],v[3]);CE(v[5],v[4]);CE(v[7],v[6]);CE(v[8],v[9]);CE(v[10],v[11]);CE(v[13],v[12]);CE(v[15],v[14]);CE(v[0],v[4]);CE(v[1],v[5]);CE(v[2],v[6]);CE(v[3],v[7]);CE(v[12],v[8]);CE(v[13],v[9]);CE(v[14],v[10]);CE(v[15],v[11]);CE(v[0],v[2]);CE(v[1],v[3]);CE(v[4],v[6]);CE(v[5],v[7]);CE(v[10],v[8]);CE(v[11],v[9]);CE(v[14],v[12]);CE(v[15],v[13]);CE(v[0],v[1]);CE(v[2],v[3]);CE(v[4],v[5]);CE(v[6],v[7]);CE(v[9],v[8]);CE(v[11],v[10]);CE(v[13],v[12]);CE(v[15],v[14]);CE(v[0],v[8]);CE(v[1],v[9]);CE(v[2],v[10]);CE(v[3],v[11]);CE(v[4],v[12]);CE(v[5],v[13]);CE(v[6],v[14]);CE(v[7],v[15]);CE(v[0],v[4]);CE(v[1],v[5]);CE(v[2],v[6]);CE(v[3],v[7]);CE(v[8],v[12]);CE(v[9],v[13]);CE(v[10],v[14]);CE(v[11],v[15]);CE(v[0],v[2]);CE(v[1],v[3]);CE(v[4],v[6]);CE(v[5],v[7]);CE(v[8],v[10]);CE(v[9],v[11]);CE(v[12],v[14]);CE(v[13],v[15]);CE(v[0],v[1]);CE(v[2],v[3]);CE(v[4],v[5]);CE(v[6],v[7]);CE(v[8],v[9]);CE(v[10],v[11]);CE(v[12],v[13]);CE(v[14],v[15]); \
  CE(v[16],v[17]);CE(v[19],v[18]);CE(v[20],v[21]);CE(v[23],v[22]);CE(v[24],v[25]);CE(v[27],v[26]);CE(v[28],v[29]);CE(v[31],v[30]);CE(v[16],v[18]);CE(v[17],v[19]);CE(v[22],v[20]);CE(v[23],v[21]);CE(v[24],v[26]);CE(v[25],v[27]);CE(v[30],v[28]);CE(v[31],v[29]);CE(v[16],v[17]);CE(v[18],v[19]);CE(v[21],v[20]);CE(v[23],v[22]);CE(v[24],v[25]);CE(v[26],v[27]);CE(v[29],v[28]);CE(v[31],v[30]);CE(v[16],v[20]);CE(v[17],v[21]);CE(v[18],v[22]);CE(v[19],v[23]);CE(v[28],v[24]);CE(v[29],v[25]);CE(v[30],v[26]);CE(v[31],v[27]);CE(v[16],v[18]);CE(v[17],v[19]);CE(v[20],v[22]);CE(v[21],v[23]);CE(v[26],v[24]);CE(v[27],v[25]);CE(v[30],v[28]);CE(v[31],v[29]);CE(v[16],v[17]);CE(v[18],v[19]);CE(v[20],v[21]);CE(v[22],v[23]);CE(v[25],v[24]);CE(v[27],v[26]);CE(v[29],v[28]);CE(v[31],v[30]);CE(v[16],v[24]);CE(v[17],v[25]);CE(v[18],v[26]);CE(v[19],v[27]);CE(v[20],v[28]);CE(v[21],v[29]);CE(v[22],v[30]);CE(v[23],v[31]);CE(v[16],v[20]);CE(v[17],v[21]);CE(v[18],v[22]);CE(v[19],v[23]);CE(v[24],v[28]);CE(v[25],v[29]);CE(v[26],v[30]);CE(v[27],v[31]);CE(v[16],v[18]);CE(v[17],v[19]);CE(v[20],v[22]);CE(v[21],v[23]);CE(v[24],v[26]);CE(v[25],v[27]);CE(v[28],v[30]);CE(v[29],v[31]);CE(v[16],v[17]);CE(v[18],v[19]);CE(v[20],v[21]);CE(v[22],v[23]);CE(v[24],v[25]);CE(v[26],v[27]);CE(v[28],v[29]);CE(v[30],v[31]); \
  CE(v[32],v[33]);CE(v[35],v[34]);CE(v[36],v[37]);CE(v[39],v[38]);CE(v[40],v[41]);CE(v[43],v[42]);CE(v[44],v[45]);CE(v[47],v[46]);CE(v[32],v[34]);CE(v[33],v[35]);CE(v[38],v[36]);CE(v[39],v[37]);CE(v[40],v[42]);CE(v[41],v[43]);CE(v[46],v[44]);CE(v[47],v[45]);CE(v[32],v[33]);CE(v[34],v[35]);CE(v[37],v[36]);CE(v[39],v[38]);CE(v[40],v[41]);CE(v[42],v[43]);CE(v[45],v[44]);CE(v[47],v[46]);CE(v[32],v[36]);CE(v[33],v[37]);CE(v[34],v[38]);CE(v[35],v[39]);CE(v[44],v[40]);CE(v[45],v[41]);CE(v[46],v[42]);CE(v[47],v[43]);CE(v[32],v[34]);CE(v[33],v[35]);CE(v[36],v[38]);CE(v[37],v[39]);CE(v[42],v[40]);CE(v[43],v[41]);CE(v[46],v[44]);CE(v[47],v[45]);CE(v[32],v[33]);CE(v[34],v[35]);CE(v[36],v[37]);CE(v[38],v[39]);CE(v[41],v[40]);CE(v[43],v[42]);CE(v[45],v[44]);CE(v[47],v[46]);CE(v[32],v[40]);CE(v[33],v[41]);CE(v[34],v[42]);CE(v[35],v[43]);CE(v[36],v[44]);CE(v[37],v[45]);CE(v[38],v[46]);CE(v[39],v[47]);CE(v[32],v[36]);CE(v[33],v[37]);CE(v[34],v[38]);CE(v[35],v[39]);CE(v[40],v[44]);CE(v[41],v[45]);CE(v[42],v[46]);CE(v[43],v[47]);CE(v[32],v[34]);CE(v[33],v[35]);CE(v[36],v[38]);CE(v[37],v[39]);CE(v[40],v[42]);CE(v[41],v[43]);CE(v[44],v[46]);CE(v[45],v[47]);CE(v[32],v[33]);CE(v[34],v[35]);CE(v[36],v[37]);CE(v[38],v[39]);CE(v[40],v[41]);CE(v[42],v[43]);CE(v[44],v[45]);CE(v[46],v[47]); \
  CE(v[48],v[49]);CE(v[51],v[50]);CE(v[52],v[53]);CE(v[55],v[54]);CE(v[56],v[57]);CE(v[59],v[58]);CE(v[60],v[61]);CE(v[63],v[62]);CE(v[48],v[50]);CE(v[49],v[51]);CE(v[54],v[52]);CE(v[55],v[53]);CE(v[56],v[58]);CE(v[57],v[59]);CE(v[62],v[60]);CE(v[63],v[61]);CE(v[48],v[49]);CE(v[50],v[51]);CE(v[53],v[52]);CE(v[55],v[54]);CE(v[56],v[57]);CE(v[58],v[59]);CE(v[61],v[60]);CE(v[63],v[62]);CE(v[48],v[52]);CE(v[49],v[53]);CE(v[50],v[54]);CE(v[51],v[55]);CE(v[60],v[56]);CE(v[61],v[57]);CE(v[62],v[58]);CE(v[63],v[59]);CE(v[48],v[50]);CE(v[49],v[51]);CE(v[52],v[54]);CE(v[53],v[55]);CE(v[58],v[56]);CE(v[59],v[57]);CE(v[62],v[60]);CE(v[63],v[61]);CE(v[48],v[49]);CE(v[50],v[51]);CE(v[52],v[53]);CE(v[54],v[55]);CE(v[57],v[56]);CE(v[59],v[58]);CE(v[61],v[60]);CE(v[63],v[62]);CE(v[48],v[56]);CE(v[49],v[57]);CE(v[50],v[58]);CE(v[51],v[59]);CE(v[52],v[60]);CE(v[53],v[61]);CE(v[54],v[62]);CE(v[55],v[63]);CE(v[48],v[52]);CE(v[49],v[53]);CE(v[50],v[54]);CE(v[51],v[55]);CE(v[56],v[60]);CE(v[57],v[61]);CE(v[58],v[62]);CE(v[59],v[63]);CE(v[48],v[50]);CE(v[49],v[51]);CE(v[52],v[54]);CE(v[53],v[55]);CE(v[56],v[58]);CE(v[57],v[59]);CE(v[60],v[62]);CE(v[61],v[63]);CE(v[48],v[49]);CE(v[50],v[51]);CE(v[52],v[53]);CE(v[54],v[55]);CE(v[56],v[57]);CE(v[58],v[59]);CE(v[60],v[61]);CE(v[62],v[63]); \
  CE(v[64],v[65]);CE(v[67],v[66]);CE(v[68],v[69]);CE(v[71],v[70]);CE(v[72],v[73]);CE(v[75],v[74]);CE(v[76],v[77]);CE(v[79],v[78]);CE(v[64],v[66]);CE(v[65],v[67]);CE(v[70],v[68]);CE(v[71],v[69]);CE(v[72],v[74]);CE(v[73],v[75]);CE(v[78],v[76]);CE(v[79],v[77]);CE(v[64],v[65]);CE(v[66],v[67]);CE(v[69],v[68]);CE(v[71],v[70]);CE(v[72],v[73]);CE(v[74],v[75]);CE(v[77],v[76]);CE(v[79],v[78]);CE(v[64],v[68]);CE(v[65],v[69]);CE(v[66],v[70]);CE(v[67],v[71]);CE(v[76],v[72]);CE(v[77],v[73]);CE(v[78],v[74]);CE(v[79],v[75]);CE(v[64],v[66]);CE(v[65],v[67]);CE(v[68],v[70]);CE(v[69],v[71]);CE(v[74],v[72]);CE(v[75],v[73]);CE(v[78],v[76]);CE(v[79],v[77]);CE(v[64],v[65]);CE(v[66],v[67]);CE(v[68],v[69]);CE(v[70],v[71]);CE(v[73],v[72]);CE(v[75],v[74]);CE(v[77],v[76]);CE(v[79],v[78]);CE(v[64],v[72]);CE(v[65],v[73]);CE(v[66],v[74]);CE(v[67],v[75]);CE(v[68],v[76]);CE(v[69],v[77]);CE(v[70],v[78]);CE(v[71],v[79]);CE(v[64],v[68]);CE(v[65],v[69]);CE(v[66],v[70]);CE(v[67],v[71]);CE(v[72],v[76]);CE(v[73],v[77]);CE(v[74],v[78]);CE(v[75],v[79]);CE(v[64],v[66]);CE(v[65],v[67]);CE(v[68],v[70]);CE(v[69],v[71]);CE(v[72],v[74]);CE(v[73],v[75]);CE(v[76],v[78]);CE(v[77],v[79]);CE(v[64],v[65]);CE(v[66],v[67]);CE(v[68],v[69]);CE(v[70],v[71]);CE(v[72],v[73]);CE(v[74],v[75]);CE(v[76],v[77]);CE(v[78],v[79]); \
  CE(v[80],v[81]);CE(v[83],v[82]);CE(v[84],v[85]);CE(v[87],v[86]);CE(v[88],v[89]);CE(v[91],v[90]);CE(v[92],v[93]);CE(v[95],v[94]);CE(v[80],v[82]);CE(v[81],v[83]);CE(v[86],v[84]);CE(v[87],v[85]);CE(v[88],v[90]);CE(v[89],v[91]);CE(v[94],v[92]);CE(v[95],v[93]);CE(v[80],v[81]);CE(v[82],v[83]);CE(v[85],v[84]);CE(v[87],v[86]);CE(v[88],v[89]);CE(v[90],v[91]);CE(v[93],v[92]);CE(v[95],v[94]);CE(v[80],v[84]);CE(v[81],v[85]);CE(v[82],v[86]);CE(v[83],v[87]);CE(v[92],v[88]);CE(v[93],v[89]);CE(v[94],v[90]);CE(v[95],v[91]);CE(v[80],v[82]);CE(v[81],v[83]);CE(v[84],v[86]);CE(v[85],v[87]);CE(v[90],v[88]);CE(v[91],v[89]);CE(v[94],v[92]);CE(v[95],v[93]);CE(v[80],v[81]);CE(v[82],v[83]);CE(v[84],v[85]);CE(v[86],v[87]);CE(v[89],v[88]);CE(v[91],v[90]);CE(v[93],v[92]);CE(v[95],v[94]);CE(v[80],v[88]);CE(v[81],v[89]);CE(v[82],v[90]);CE(v[83],v[91]);CE(v[84],v[92]);CE(v[85],v[93]);CE(v[86],v[94]);CE(v[87],v[95]);CE(v[80],v[84]);CE(v[81],v[85]);CE(v[82],v[86]);CE(v[83],v[87]);CE(v[88],v[92]);CE(v[89],v[93]);CE(v[90],v[94]);CE(v[91],v[95]);CE(v[80],v[82]);CE(v[81],v[83]);CE(v[84],v[86]);CE(v[85],v[87]);CE(v[88],v[90]);CE(v[89],v[91]);CE(v[92],v[94]);CE(v[93],v[95]);CE(v[80],v[81]);CE(v[82],v[83]);CE(v[84],v[85]);CE(v[86],v[87]);CE(v[88],v[89]);CE(v[90],v[91]);CE(v[92],v[93]);CE(v[94],v[95]); \
  CE(v[96],v[97]);CE(v[99],v[98]);CE(v[100],v[101]);CE(v[103],v[102]);CE(v[104],v[105]);CE(v[107],v[106]);CE(v[108],v[109]);CE(v[111],v[110]);CE(v[96],v[98]);CE(v[97],v[99]);CE(v[102],v[100]);CE(v[103],v[101]);CE(v[104],v[106]);CE(v[105],v[107]);CE(v[110],v[108]);CE(v[111],v[109]);CE(v[96],v[97]);CE(v[98],v[99]);CE(v[101],v[100]);CE(v[103],v[102]);CE(v[104],v[105]);CE(v[106],v[107]);CE(v[109],v[108]);CE(v[111],v[110]);CE(v[96],v[100]);CE(v[97],v[101]);CE(v[98],v[102]);CE(v[99],v[103]);CE(v[108],v[104]);CE(v[109],v[105]);CE(v[110],v[106]);CE(v[111],v[107]);CE(v[96],v[98]);CE(v[97],v[99]);CE(v[100],v[102]);CE(v[101],v[103]);CE(v[106],v[104]);CE(v[107],v[105]);CE(v[110],v[108]);CE(v[111],v[109]);CE(v[96],v[97]);CE(v[98],v[99]);CE(v[100],v[101]);CE(v[102],v[103]);CE(v[105],v[104]);CE(v[107],v[106]);CE(v[109],v[108]);CE(v[111],v[110]);CE(v[96],v[104]);CE(v[97],v[105]);CE(v[98],v[106]);CE(v[99],v[107]);CE(v[100],v[108]);CE(v[101],v[109]);CE(v[102],v[110]);CE(v[103],v[111]);CE(v[96],v[100]);CE(v[97],v[101]);CE(v[98],v[102]);CE(v[99],v[103]);CE(v[104],v[108]);CE(v[105],v[109]);CE(v[106],v[110]);CE(v[107],v[111]);CE(v[96],v[98]);CE(v[97],v[99]);CE(v[100],v[102]);CE(v[101],v[103]);CE(v[104],v[106]);CE(v[105],v[107]);CE(v[108],v[110]);CE(v[109],v[111]);CE(v[96],v[97]);CE(v[98],v[99]);CE(v[100],v[101]);CE(v[102],v[103]);CE(v[104],v[105]);CE(v[106],v[107]);CE(v[108],v[109]);CE(v[110],v[111]); \
  CE(v[112],v[113]);CE(v[115],v[114]);CE(v[116],v[117]);CE(v[119],v[118]);CE(v[120],v[121]);CE(v[123],v[122]);CE(v[124],v[125]);CE(v[127],v[126]);CE(v[112],v[114]);CE(v[113],v[115]);CE(v[118],v[116]);CE(v[119],v[117]);CE(v[120],v[122]);CE(v[121],v[123]);CE(v[126],v[124]);CE(v[127],v[125]);CE(v[112],v[113]);CE(v[114],v[115]);CE(v[117],v[116]);CE(v[119],v[118]);CE(v[120],v[121]);CE(v[122],v[123]);CE(v[125],v[124]);CE(v[127],v[126]);CE(v[112],v[116]);CE(v[113],v[117]);CE(v[114],v[118]);CE(v[115],v[119]);CE(v[124],v[120]);CE(v[125],v[121]);CE(v[126],v[122]);CE(v[127],v[123]);CE(v[112],v[114]);CE(v[113],v[115]);CE(v[116],v[118]);CE(v[117],v[119]);CE(v[122],v[120]);CE(v[123],v[121]);CE(v[126],v[124]);CE(v[127],v[125]);CE(v[112],v[113]);CE(v[114],v[115]);CE(v[116],v[117]);CE(v[118],v[119]);CE(v[121],v[120]);CE(v[123],v[122]);CE(v[125],v[124]);CE(v[127],v[126]);CE(v[112],v[120]);CE(v[113],v[121]);CE(v[114],v[122]);CE(v[115],v[123]);CE(v[116],v[124]);CE(v[117],v[125]);CE(v[118],v[126]);CE(v[119],v[127]);CE(v[112],v[116]);CE(v[113],v[117]);CE(v[114],v[118]);CE(v[115],v[119]);CE(v[120],v[124]);CE(v[121],v[125]);CE(v[122],v[126]);CE(v[123],v[127]);CE(v[112],v[114]);CE(v[113],v[115]);CE(v[116],v[118]);CE(v[117],v[119]);CE(v[120],v[122]);CE(v[121],v[123]);CE(v[124],v[126]);CE(v[125],v[127]);CE(v[112],v[113]);CE(v[114],v[115]);CE(v[116],v[117]);CE(v[118],v[119]);CE(v[120],v[121]);CE(v[122],v[123]);CE(v[124],v[125]);CE(v[126],v[127]); \
  v[0]=vmaxf(v[0],v[31]);v[1]=vmaxf(v[1],v[30]);v[2]=vmaxf(v[2],v[29]);v[3]=vmaxf(v[3],v[28]);v[4]=vmaxf(v[4],v[27]);v[5]=vmaxf(v[5],v[26]);v[6]=vmaxf(v[6],v[25]);v[7]=vmaxf(v[7],v[24]);v[8]=vmaxf(v[8],v[23]);v[9]=vmaxf(v[9],v[22]);v[10]=vmaxf(v[10],v[21]);v[11]=vmaxf(v[11],v[20]);v[12]=vmaxf(v[12],v[19]);v[13]=vmaxf(v[13],v[18]);v[14]=vmaxf(v[14],v[17]);v[15]=vmaxf(v[15],v[16]);CE(v[0],v[8]);CE(v[1],v[9]);CE(v[2],v[10]);CE(v[3],v[11]);CE(v[4],v[12]);CE(v[5],v[13]);CE(v[6],v[14]);CE(v[7],v[15]);CE(v[0],v[4]);CE(v[1],v[5]);CE(v[2],v[6]);CE(v[3],v[7]);CE(v[8],v[12]);CE(v[9],v[13]);CE(v[10],v[14]);CE(v[11],v[15]);CE(v[0],v[2]);CE(v[1],v[3]);CE(v[4],v[6]);CE(v[5],v[7]);CE(v[8],v[10]);CE(v[9],v[11]);CE(v[12],v[14]);CE(v[13],v[15]);CE(v[0],v[1]);CE(v[2],v[3]);CE(v[4],v[5]);CE(v[6],v[7]);CE(v[8],v[9]);CE(v[10],v[11]);CE(v[12],v[13]);CE(v[14],v[15]); \
  v[32]=vmaxf(v[32],v[63]);v[33]=vmaxf(v[33],v[62]);v[34]=vmaxf(v[34],v[61]);v[35]=vmaxf(v[35],v[60]);v[36]=vmaxf(v[36],v[59]);v[37]=vmaxf(v[37],v[58]);v[38]=vmaxf(v[38],v[57]);v[39]=vmaxf(v[39],v[56]);v[40]=vmaxf(v[40],v[55]);v[41]=vmaxf(v[41],v[54]);v[42]=vmaxf(v[42],v[53]);v[43]=vmaxf(v[43],v[52]);v[44]=vmaxf(v[44],v[51]);v[45]=vmaxf(v[45],v[50]);v[46]=vmaxf(v[46],v[49]);v[47]=vmaxf(v[47],v[48]);CE(v[32],v[40]);CE(v[33],v[41]);CE(v[34],v[42]);CE(v[35],v[43]);CE(v[36],v[44]);CE(v[37],v[45]);CE(v[38],v[46]);CE(v[39],v[47]);CE(v[32],v[36]);CE(v[33],v[37]);CE(v[34],v[38]);CE(v[35],v[39]);CE(v[40],v[44]);CE(v[41],v[45]);CE(v[42],v[46]);CE(v[43],v[47]);CE(v[32],v[34]);CE(v[33],v[35]);CE(v[36],v[38]);CE(v[37],v[39]);CE(v[40],v[42]);CE(v[41],v[43]);CE(v[44],v[46]);CE(v[45],v[47]);CE(v[32],v[33]);CE(v[34],v[35]);CE(v[36],v[37]);CE(v[38],v[39]);CE(v[40],v[41]);CE(v[42],v[43]);CE(v[44],v[45]);CE(v[46],v[47]); \
  v[64]=vmaxf(v[64],v[95]);v[65]=vmaxf(v[65],v[94]);v[66]=vmaxf(v[66],v[93]);v[67]=vmaxf(v[67],v[92]);v[68]=vmaxf(v[68],v[91]);v[69]=vmaxf(v[69],v[90]);v[70]=vmaxf(v[70],v[89]);v[71]=vmaxf(v[71],v[88]);v[72]=vmaxf(v[72],v[87]);v[73]=vmaxf(v[73],v[86]);v[74]=vmaxf(v[74],v[85]);v[75]=vmaxf(v[75],v[84]);v[76]=vmaxf(v[76],v[83]);v[77]=vmaxf(v[77],v[82]);v[78]=vmaxf(v[78],v[81]);v[79]=vmaxf(v[79],v[80]);CE(v[64],v[72]);CE(v[65],v[73]);CE(v[66],v[74]);CE(v[67],v[75]);CE(v[68],v[76]);CE(v[69],v[77]);CE(v[70],v[78]);CE(v[71],v[79]);CE(v[64],v[68]);CE(v[65],v[69]);CE(v[66],v[70]);CE(v[67],v[71]);CE(v[72],v[76]);CE(v[73],v[77]);CE(v[74],v[78]);CE(v[75],v[79]);CE(v[64],v[66]);CE(v[65],v[67]);CE(v[68],v[70]);CE(v[69],v[71]);CE(v[72],v[74]);CE(v[73],v[75]);CE(v[76],v[78]);CE(v[77],v[79]);CE(v[64],v[65]);CE(v[66],v[67]);CE(v[68],v[69]);CE(v[70],v[71]);CE(v[72],v[73]);CE(v[74],v[75]);CE(v[76],v[77]);CE(v[78],v[79]); \
  v[96]=vmaxf(v[96],v[127]);v[97]=vmaxf(v[97],v[126]);v[98]=vmaxf(v[98],v[125]);v[99]=vmaxf(v[99],v[124]);v[100]=vmaxf(v[100],v[123]);v[101]=vmaxf(v[101],v[122]);v[102]=vmaxf(v[102],v[121]);v[103]=vmaxf(v[103],v[120]);v[104]=vmaxf(v[104],v[119]);v[105]=vmaxf(v[105],v[118]);v[106]=vmaxf(v[106],v[117]);v[107]=vmaxf(v[107],v[116]);v[108]=vmaxf(v[108],v[115]);v[109]=vmaxf(v[109],v[114]);v[110]=vmaxf(v[110],v[113]);v[111]=vmaxf(v[111],v[112]);CE(v[96],v[104]);CE(v[97],v[105]);CE(v[98],v[106]);CE(v[99],v[107]);CE(v[100],v[108]);CE(v[101],v[109]);CE(v[102],v[110]);CE(v[103],v[111]);CE(v[96],v[100]);CE(v[97],v[101]);CE(v[98],v[102]);CE(v[99],v[103]);CE(v[104],v[108]);CE(v[105],v[109]);CE(v[106],v[110]);CE(v[107],v[111]);CE(v[96],v[98]);CE(v[97],v[99]);CE(v[100],v[102]);CE(v[101],v[103]);CE(v[104],v[106]);CE(v[105],v[107]);CE(v[108],v[110]);CE(v[109],v[111]);CE(v[96],v[97]);CE(v[98],v[99]);CE(v[100],v[101]);CE(v[102],v[103]);CE(v[104],v[105]);CE(v[106],v[107]);CE(v[108],v[109]);CE(v[110],v[111]); \
  v[0]=vmaxf(v[0],v[47]);v[1]=vmaxf(v[1],v[46]);v[2]=vmaxf(v[2],v[45]);v[3]=vmaxf(v[3],v[44]);v[4]=vmaxf(v[4],v[43]);v[5]=vmaxf(v[5],v[42]);v[6]=vmaxf(v[6],v[41]);v[7]=vmaxf(v[7],v[40]);v[8]=vmaxf(v[8],v[39]);v[9]=vmaxf(v[9],v[38]);v[10]=vmaxf(v[10],v[37]);v[11]=vmaxf(v[11],v[36]);v[12]=vmaxf(v[12],v[35]);v[13]=vmaxf(v[13],v[34]);v[14]=vmaxf(v[14],v[33]);v[15]=vmaxf(v[15],v[32]);CE(v[0],v[8]);CE(v[1],v[9]);CE(v[2],v[10]);CE(v[3],v[11]);CE(v[4],v[12]);CE(v[5],v[13]);CE(v[6],v[14]);CE(v[7],v[15]);CE(v[0],v[4]);CE(v[1],v[5]);CE(v[2],v[6]);CE(v[3],v[7]);CE(v[8],v[12]);CE(v[9],v[13]);CE(v[10],v[14]);CE(v[11],v[15]);CE(v[0],v[2]);CE(v[1],v[3]);CE(v[4],v[6]);CE(v[5],v[7]);CE(v[8],v[10]);CE(v[9],v[11]);CE(v[12],v[14]);CE(v[13],v[15]);CE(v[0],v[1]);CE(v[2],v[3]);CE(v[4],v[5]);CE(v[6],v[7]);CE(v[8],v[9]);CE(v[10],v[11]);CE(v[12],v[13]);CE(v[14],v[15]); \
  v[64]=vmaxf(v[64],v[111]);v[65]=vmaxf(v[65],v[110]);v[66]=vmaxf(v[66],v[109]);v[67]=vmaxf(v[67],v[108]);v[68]=vmaxf(v[68],v[107]);v[69]=vmaxf(v[69],v[106]);v[70]=vmaxf(v[70],v[105]);v[71]=vmaxf(v[71],v[104]);v[72]=vmaxf(v[72],v[103]);v[73]=vmaxf(v[73],v[102]);v[74]=vmaxf(v[74],v[101]);v[75]=vmaxf(v[75],v[100]);v[76]=vmaxf(v[76],v[99]);v[77]=vmaxf(v[77],v[98]);v[78]=vmaxf(v[78],v[97]);v[79]=vmaxf(v[79],v[96]);CE(v[64],v[72]);CE(v[65],v[73]);CE(v[66],v[74]);CE(v[67],v[75]);CE(v[68],v[76]);CE(v[69],v[77]);CE(v[70],v[78]);CE(v[71],v[79]);CE(v[64],v[68]);CE(v[65],v[69]);CE(v[66],v[70]);CE(v[67],v[71]);CE(v[72],v[76]);CE(v[73],v[77]);CE(v[74],v[78]);CE(v[75],v[79]);CE(v[64],v[66]);CE(v[65],v[67]);CE(v[68],v[70]);CE(v[69],v[71]);CE(v[72],v[74]);CE(v[73],v[75]);CE(v[76],v[78]);CE(v[77],v[79]);CE(v[64],v[65]);CE(v[66],v[67]);CE(v[68],v[69]);CE(v[70],v[71]);CE(v[72],v[73]);CE(v[74],v[75]);CE(v[76],v[77]);CE(v[78],v[79]); \
  v[0]=vmaxf(v[0],v[79]);v[1]=vmaxf(v[1],v[78]);v[2]=vmaxf(v[2],v[77]);v[3]=vmaxf(v[3],v[76]);v[4]=vmaxf(v[4],v[75]);v[5]=vmaxf(v[5],v[74]);v[6]=vmaxf(v[6],v[73]);v[7]=vmaxf(v[7],v[72]);v[8]=vmaxf(v[8],v[71]);v[9]=vmaxf(v[9],v[70]);v[10]=vmaxf(v[10],v[69]);v[11]=vmaxf(v[11],v[68]);v[12]=vmaxf(v[12],v[67]);v[13]=vmaxf(v[13],v[66]);v[14]=vmaxf(v[14],v[65]);v[15]=vmaxf(v[15],v[64]);CE(v[0],v[8]);CE(v[1],v[9]);CE(v[2],v[10]);CE(v[3],v[11]);CE(v[4],v[12]);CE(v[5],v[13]);CE(v[6],v[14]);CE(v[7],v[15]);CE(v[0],v[4]);CE(v[1],v[5]);CE(v[2],v[6]);CE(v[3],v[7]);CE(v[8],v[12]);CE(v[9],v[13]);CE(v[10],v[14]);CE(v[11],v[15]);CE(v[0],v[2]);CE(v[1],v[3]);CE(v[4],v[6]);CE(v[5],v[7]);CE(v[8],v[10]);CE(v[9],v[11]);CE(v[12],v[14]);CE(v[13],v[15]);CE(v[0],v[1]);CE(v[2],v[3]);CE(v[4],v[5]);CE(v[6],v[7]);CE(v[8],v[9]);CE(v[10],v[11]);CE(v[12],v[13]);CE(v[14],v[15]); \
} while (0)
#define TOPK_SORT32(v) do { \
  CE(v[0],v[1]);CE(v[3],v[2]);CE(v[4],v[5]);CE(v[7],v[6]);CE(v[8],v[9]);CE(v[11],v[10]);CE(v[12],v[13]);CE(v[15],v[14]);CE(v[0],v[2]);CE(v[1],v[3]);CE(v[6],v[4]);CE(v[7],v[5]);CE(v[8],v[10]);CE(v[9],v[11]);CE(v[14],v[12]);CE(v[15],v[13]);CE(v[0],v[1]);CE(v[2],v[3]);CE(v[5],v[4]);CE(v[7],v[6]);CE(v[8],v[9]);CE(v[10],v[11]);CE(v[13],v[12]);CE(v[15],v[14]);CE(v[0],v[4]);CE(v[1],v[5]);CE(v[2],v[6]);CE(v[3],v[7]);CE(v[12],v[8]);CE(v[13],v[9]);CE(v[14],v[10]);CE(v[15],v[11]);CE(v[0],v[2]);CE(v[1],v[3]);CE(v[4],v[6]);CE(v[5],v[7]);CE(v[10],v[8]);CE(v[11],v[9]);CE(v[14],v[12]);CE(v[15],v[13]);CE(v[0],v[1]);CE(v[2],v[3]);CE(v[4],v[5]);CE(v[6],v[7]);CE(v[9],v[8]);CE(v[11],v[10]);CE(v[13],v[12]);CE(v[15],v[14]);CE(v[0],v[8]);CE(v[1],v[9]);CE(v[2],v[10]);CE(v[3],v[11]);CE(v[4],v[12]);CE(v[5],v[13]);CE(v[6],v[14]);CE(v[7],v[15]);CE(v[0],v[4]);CE(v[1],v[5]);CE(v[2],v[6]);CE(v[3],v[7]);CE(v[8],v[12]);CE(v[9],v[13]);CE(v[10],v[14]);CE(v[11],v[15]);CE(v[0],v[2]);CE(v[1],v[3]);CE(v[4],v[6]);CE(v[5],v[7]);CE(v[8],v[10]);CE(v[9],v[11]);CE(v[12],v[14]);CE(v[13],v[15]);CE(v[0],v[1]);CE(v[2],v[3]);CE(v[4],v[5]);CE(v[6],v[7]);CE(v[8],v[9]);CE(v[10],v[11]);CE(v[12],v[13]);CE(v[14],v[15]); \
  CE(v[16],v[17]);CE(v[19],v[18]);CE(v[20],v[21]);CE(v[23],v[22]);CE(v[24],v[25]);CE(v[27],v[26]);CE(v[28],v[29]);CE(v[31],v[30]);CE(v[16],v[18]);CE(v[17],v[19]);CE(v[22],v[20]);CE(v[23],v[21]);CE(v[24],v[26]);CE(v[25],v[27]);CE(v[30],v[28]);CE(v[31],v[29]);CE(v[16],v[17]);CE(v[18],v[19]);CE(v[21],v[20]);CE(v[23],v[22]);CE(v[24],v[25]);CE(v[26],v[27]);CE(v[29],v[28]);CE(v[31],v[30]);CE(v[16],v[20]);CE(v[17],v[21]);CE(v[18],v[22]);CE(v[19],v[23]);CE(v[28],v[24]);CE(v[29],v[25]);CE(v[30],v[26]);CE(v[31],v[27]);CE(v[16],v[18]);CE(v[17],v[19]);CE(v[20],v[22]);CE(v[21],v[23]);CE(v[26],v[24]);CE(v[27],v[25]);CE(v[30],v[28]);CE(v[31],v[29]);CE(v[16],v[17]);CE(v[18],v[19]);CE(v[20],v[21]);CE(v[22],v[23]);CE(v[25],v[24]);CE(v[27],v[26]);CE(v[29],v[28]);CE(v[31],v[30]);CE(v[16],v[24]);CE(v[17],v[25]);CE(v[18],v[26]);CE(v[19],v[27]);CE(v[20],v[28]);CE(v[21],v[29]);CE(v[22],v[30]);CE(v[23],v[31]);CE(v[16],v[20]);CE(v[17],v[21]);CE(v[18],v[22]);CE(v[19],v[23]);CE(v[24],v[28]);CE(v[25],v[29]);CE(v[26],v[30]);CE(v[27],v[31]);CE(v[16],v[18]);CE(v[17],v[19]);CE(v[20],v[22]);CE(v[21],v[23]);CE(v[24],v[26]);CE(v[25],v[27]);CE(v[28],v[30]);CE(v[29],v[31]);CE(v[16],v[17]);CE(v[18],v[19]);CE(v[20],v[21]);CE(v[22],v[23]);CE(v[24],v[25]);CE(v[26],v[27]);CE(v[28],v[29]);CE(v[30],v[31]); \
  v[0]=vmaxf(v[0],v[31]);v[1]=vmaxf(v[1],v[30]);v[2]=vmaxf(v[2],v[29]);v[3]=vmaxf(v[3],v[28]);v[4]=vmaxf(v[4],v[27]);v[5]=vmaxf(v[5],v[26]);v[6]=vmaxf(v[6],v[25]);v[7]=vmaxf(v[7],v[24]);v[8]=vmaxf(v[8],v[23]);v[9]=vmaxf(v[9],v[22]);v[10]=vmaxf(v[10],v[21]);v[11]=vmaxf(v[11],v[20]);v[12]=vmaxf(v[12],v[19]);v[13]=vmaxf(v[13],v[18]);v[14]=vmaxf(v[14],v[17]);v[15]=vmaxf(v[15],v[16]);CE(v[0],v[8]);CE(v[1],v[9]);CE(v[2],v[10]);CE(v[3],v[11]);CE(v[4],v[12]);CE(v[5],v[13]);CE(v[6],v[14]);CE(v[7],v[15]);CE(v[0],v[4]);CE(v[1],v[5]);CE(v[2],v[6]);CE(v[3],v[7]);CE(v[8],v[12]);CE(v[9],v[13]);CE(v[10],v[14]);CE(v[11],v[15]);CE(v[0],v[2]);CE(v[1],v[3]);CE(v[4],v[6]);CE(v[5],v[7]);CE(v[8],v[10]);CE(v[9],v[11]);CE(v[12],v[14]);CE(v[13],v[15]);CE(v[0],v[1]);CE(v[2],v[3]);CE(v[4],v[5]);CE(v[6],v[7]);CE(v[8],v[9]);CE(v[10],v[11]);CE(v[12],v[13]);CE(v[14],v[15]); \
} while (0)
#define TOPK_MERGE_BITONIC16(v) do { \
  CE(v[0],v[8]);CE(v[1],v[9]);CE(v[2],v[10]);CE(v[3],v[11]);CE(v[4],v[12]);CE(v[5],v[13]);CE(v[6],v[14]);CE(v[7],v[15]);CE(v[0],v[4]);CE(v[1],v[5]);CE(v[2],v[6]);CE(v[3],v[7]);CE(v[8],v[12]);CE(v[9],v[13]);CE(v[10],v[14]);CE(v[11],v[15]);CE(v[0],v[2]);CE(v[1],v[3]);CE(v[4],v[6]);CE(v[5],v[7]);CE(v[8],v[10]);CE(v[9],v[11]);CE(v[12],v[14]);CE(v[13],v[15]);CE(v[0],v[1]);CE(v[2],v[3]);CE(v[4],v[5]);CE(v[6],v[7]);CE(v[8],v[9]);CE(v[10],v[11]);CE(v[12],v[13]);CE(v[14],v[15]); \
} while (0)
#define TOPK_PAIRS(X) \
  X(0,0,0) X(1,0,1) X(2,0,2) X(3,0,3) X(4,0,4) X(5,0,5) X(6,0,6) X(7,0,7) X(8,0,8) X(9,0,9) X(10,0,10) X(11,0,11) X(12,0,12) X(13,0,13) X(14,0,14) X(15,0,15) X(16,1,1) X(17,1,2) X(18,1,3) X(19,1,4) X(20,1,5) X(21,1,6) X(22,1,7) X(23,2,2) X(24,2,3) X(25,2,4) X(26,3,3)

namespace tk {
typedef float f32x16 __attribute__((ext_vector_type(16)));
__device__ __forceinline__ float vmaxf(float a, float b) { float r; asm("v_max_f32 %0, %1, %2" : "=v"(r) : "v"(a), "v"(b)); return r; }
__device__ __forceinline__ float vminf(float a, float b) { float r; asm("v_min_f32 %0, %1, %2" : "=v"(r) : "v"(a), "v"(b)); return r; }
#define CE(x, y) do { const float h_ = vmaxf(x, y); y = vminf(x, y); x = h_; } while (0)
__device__ __forceinline__ unsigned fbits(float f) { return __float_as_uint(f); }
__device__ __forceinline__ float bitsf(unsigned u) { return __uint_as_float(u); }
__device__ __forceinline__ unsigned byte_lookup(const unsigned (&pk)[4], unsigned i) {
    const unsigned long long lo = (unsigned long long)pk[0] | ((unsigned long long)pk[1] << 32), hi_ = (unsigned long long)pk[2] | ((unsigned long long)pk[3] << 32);
    const unsigned long long s = (i & 8u) ? hi_ : lo;
    return (unsigned)(s >> ((i & 7u) * 8u)) & 0x7Fu;
}
constexpr float PADV = -3.0e38f;

template <int VAR>
__device__ __forceinline__ void topk_phase(Frame& F) {
    const int lane = F.lane, r32 = lane & 31, hi = lane >> 5, wid = F.wave, tid = F.tid;
    LAS unsigned char* lds = F.lds;
    const unsigned char* SUBK = F.ws + WS_SUBK; const bf16* Q = (const bf16*)(F.ws + WS_Q);
    int* IDX = (int*)(F.ws + (VAR ? 360 * MiB : WS_IDX)); float* G = (float*)(F.ws + (VAR ? 376 * MiB : WS_G));
    int cur_h = -1;
    for (int it = (int)blockIdx.x; it < 8 * (T / 256); it += F.G) {
        const int h = it & 7, chunk = it >> 3;
        if (h != cur_h) {
            __syncthreads();
            for (int i = tid; i < 4096; i += NWAVES * 64) { const int ch = i & 15, pn = i >> 4;
                *(LAS v4u*)(lds + (pn >> 7) * 32768 + ch * 2048 + (pn & 127) * 16) = *(const GAS v4u*)(SUBK + (size_t)h * 65536 + (size_t)pn * 256 + ch * 16); }
            __syncthreads();
            cur_h = h;
        }
        asm volatile("; TOPK_BEGIN");
        const int t = chunk * 256 + wid * 32 + r32;
        if (VAR == 0 || VAR == 1 || VAR == 4)
        {
            const float2 st = ln1_row_stats((const float2*)(F.ws + WS_STATS), t);
            const int dcol = 128 * h + 4 * r32;
            const f32x4 g1 = *(const GAS f32x4*)(F.in[5] + dcol), b1 = *(const GAS f32x4*)(F.in[6] + dcol);
            bf16* X1B = (bf16*)(F.ws + WS_X1B);
#pragma unroll
            for (int i = 0; i < 16; ++i) {
                const float m0_ = __uint_as_float(__builtin_amdgcn_readlane(__float_as_uint(st.x), 2 * i)), m1_ = __uint_as_float(__builtin_amdgcn_readlane(__float_as_uint(st.x), 2 * i + 1));
                const float r0_ = __uint_as_float(__builtin_amdgcn_readlane(__float_as_uint(st.y), 2 * i)), r1_ = __uint_as_float(__builtin_amdgcn_readlane(__float_as_uint(st.y), 2 * i + 1));
                const float mu = hi ? m1_ : m0_, rs = hi ? r1_ : r0_;
                const size_t off = (size_t)(chunk * 256 + wid * 32 + 2 * i + hi) * D_MODEL + dcol;
                const u32x2 yw = *(const GAS u32x2*)(X1B + off);
                const f32x4 y4 = {__uint_as_float(yw.x << 16), __uint_as_float(yw.x & 0xffff0000u), __uint_as_float(yw.y << 16), __uint_as_float(yw.y & 0xffff0000u)};
                const f32x4 x4 = (y4 - mu) * rs * g1 + b1;
                u32x2 w; w.x = pk2(x4.x, x4.y); w.y = pk2(x4.z, x4.w);
                const unsigned wq = q8x4(x4.x * X_QS, x4.y * X_QS, x4.z * X_QS, x4.w * X_QS);
                if (VAR == 0) { *(GAS u32x2*)(X1B + off) = w; *(GAS unsigned*)(F.ws + WS_X1Q + off) = wq; } else asm volatile("" :: "v"(w.x), "v"(w.y), "v"(wq));
            }
        }
        float v[128];
        {
            f32x16 acc[2][4];
#pragma unroll
            for (int p = 0; p < 2; ++p)
#pragma unroll
                for (int nt = 0; nt < 4; ++nt)
#pragma unroll
                    for (int r = 0; r < 16; ++r) acc[p][nt][r] = 0.f;
#pragma unroll
            for (int p = 0; p < 2; ++p) {
                bf16x8 bq[8];
#pragma unroll
                for (int ks = 0; ks < 8; ++ks) bq[ks] = *(const GAS bf16x8*)(Q + ((size_t)(t >> 5) * 8192 + (size_t)(h * 32 + p * 16 + ks * 2 + hi) * 32 + r32) * 8);
#pragma unroll
                for (int ks = 0; ks < 8; ++ks)
#pragma unroll
                    for (int nt = 0; nt < 4; ++nt) {
                        const bf16x8 a = *(const LAS bf16x8*)(lds + p * 32768 + (2 * ks + hi) * 2048 + (nt * 32 + r32) * 16);
                        acc[p][nt] = __builtin_amdgcn_mfma_f32_32x32x16_bf16(a, bq[ks], acc[p][nt], 0, 0, 0);
                    }
            }
#pragma unroll
            for (int nt = 0; nt < 4; ++nt)
#pragma unroll
                for (int r = 0; r < 16; ++r) {
                    auto rr = __builtin_amdgcn_permlane32_swap(fbits(acc[0][nt][r]), fbits(acc[1][nt][r]), false, false);
                    const unsigned n0 = 32 * nt + (r & 3) + 8 * (r >> 2);
                    v[nt * 32 + r] = bitsf((rr[0] & 0xFFFFFF80u) | n0);
                    v[nt * 32 + 16 + r] = bitsf((rr[1] & 0xFFFFFF80u) | (n0 + 4u));
                }
        }
        unsigned pf0 = 0, pf1 = 0, pf2 = 0, pf3 = 0;
        if (it + F.G < 8 * (T / 256)) {
            const int hn = (it + F.G) & 7, chn = (it + F.G) >> 3, tgn = chn * 8 + wid;
            const unsigned char* qn_ = (const unsigned char*)Q + ((size_t)tgn * 8192 + (size_t)hn * 1024) * 16;
            pf0 = *(const GAS unsigned*)(qn_ + lane * 128); pf1 = *(const GAS unsigned*)(qn_ + (64 + lane) * 128);
            pf2 = *(const GAS unsigned*)((const unsigned char*)(F.ws + WS_X1B) + ((size_t)(tgn * 32 + (lane >> 1)) * D_MODEL + 128 * hn) * 2 + (lane & 1) * 128);
            pf3 = *(const GAS unsigned*)((const unsigned char*)(F.ws + WS_STATS) + (size_t)(tgn * 32 + (lane & 31)) * 128);
        }
        if (VAR == 2 || VAR == 4 || VAR == 5) { _Pragma("unroll") for (int i_ = 16; i_ < 128; ++i_) asm volatile("" :: "v"(v[i_])); } else
        TOPK_SORT128(v);
        unsigned ak[16], bk[16]; float uval[16], wval[16];
#pragma unroll
        for (int i = 0; i < 16; ++i) {
            auto rr = __builtin_amdgcn_permlane32_swap(fbits(v[i]), fbits(v[i]), false, false);
            ak[i] = rr[0]; bk[i] = rr[1];
            const unsigned oth = hi ? rr[0] : rr[1];
            uval[i] = bitsf(fbits(v[i]) & 0xFFFFFF80u); wval[i] = bitsf(oth & 0xFFFFFF80u);
        }
        unsigned na_pack[4], nb_pack[4];
#pragma unroll
        for (int q = 0; q < 4; ++q) {
            na_pack[q] = (ak[4 * q] & 0x7Fu) | ((ak[4 * q + 1] & 0x7Fu) << 8) | ((ak[4 * q + 2] & 0x7Fu) << 16) | ((ak[4 * q + 3] & 0x7Fu) << 24);
            nb_pack[q] = (bk[4 * q] & 0x7Fu) | ((bk[4 * q + 1] & 0x7Fu) << 8) | ((bk[4 * q + 2] & 0x7Fu) << 16) | ((bk[4 * q + 3] & 0x7Fu) << 24);
        }
        float cand[32];
        const unsigned hb = (unsigned)hi << 8;
#define TK_X(k, i, j) { const float s_ = uval[i] + wval[j]; unsigned kb_ = (fbits(s_) & 0xFFFFFE00u) | hb | (unsigned)((i) * 16 + (j)); if ((i) == (j)) kb_ = hi ? fbits(PADV) : kb_; cand[k] = bitsf(kb_); }
        TOPK_PAIRS(TK_X)
#undef TK_X
#pragma unroll
        for (int k = 27; k < 32; ++k) cand[k] = PADV;
        if (VAR == 3 || VAR == 4 || VAR == 5) { _Pragma("unroll") for (int i_ = 16; i_ < 32; ++i_) asm volatile("" :: "v"(cand[i_])); } else
        TOPK_SORT32(cand);
        float fin[16];
        {
            unsigned oc[16];
#pragma unroll
            for (int i = 0; i < 16; ++i) { auto rr = __builtin_amdgcn_permlane32_swap(fbits(cand[i]), fbits(cand[i]), false, false); oc[i] = hi ? rr[0] : rr[1]; }
#pragma unroll
            for (int i = 0; i < 16; ++i) fin[i] = vmaxf(cand[i], bitsf(oc[15 - i]));
        }
        TOPK_MERGE_BITONIC16(fin);
        float e[16]; float esum = 0.f; const float m0 = bitsf(fbits(fin[0]) & 0xFFFFFE00u);
#pragma unroll
        for (int k = 0; k < 16; ++k) { e[k] = __builtin_amdgcn_exp2f((bitsf(fbits(fin[k]) & 0xFFFFFE00u) - m0) * LOG2E); esum += e[k]; }
        const float inv = 1.f / esum;
        int oi[8]; float og[8];
#pragma unroll
        for (int kk = 0; kk < 8; ++kk) {
            const unsigned key = hi ? fbits(fin[8 + kk]) : fbits(fin[kk]); og[kk] = (hi ? e[8 + kk] : e[kk]) * inv;
            const unsigned code = key & 0x1FFu, f = code >> 8, ci = (code >> 4) & 15u, cj = code & 15u;
            const unsigned ia = f ? cj : ci, jb = f ? ci : cj;
            oi[kk] = (int)(byte_lookup(na_pack, ia) * 128u + byte_lookup(nb_pack, jb));
        }
        int* ip = IDX + ((size_t)t * PEER_H + h) * TOPK + 8 * hi; float* gp = G + ((size_t)t * PEER_H + h) * TOPK + 8 * hi;
        *(GAS v4u*)ip = (v4u){(unsigned)oi[0], (unsigned)oi[1], (unsigned)oi[2], (unsigned)oi[3]}; *(GAS v4u*)(ip + 4) = (v4u){(unsigned)oi[4], (unsigned)oi[5], (unsigned)oi[6], (unsigned)oi[7]};
        *(GAS f32x4*)gp = (f32x4){og[0], og[1], og[2], og[3]}; *(GAS f32x4*)(gp + 4) = (f32x4){og[4], og[5], og[6], og[7]};
        asm volatile("" :: "v"(pf0), "v"(pf1), "v"(pf2), "v"(pf3));
        asm volatile("; TOPK_END");
    }
}
#undef CE
}


namespace ex {
typedef float f32x2 __attribute__((ext_vector_type(2)));
typedef _Float16 h16x2 __attribute__((ext_vector_type(2)));
__device__ __forceinline__ float gelu_erf(float v) {
    const float av = fabsf(v), t = __builtin_amdgcn_rcpf(fmaf(av, 0.2316418882f, 1.0f));
    float q = fmaf(t, 0.5307027145f, -0.7265760135f); q = fmaf(q, t, 0.7107068705f); q = fmaf(q, t, -0.142248368f); q = fmaf(q, t, 0.127414796f); q = q * t;
    const float ee = __builtin_amdgcn_exp2f(v * v * -0.72134752044f);
    const float mm = v * (q * ee);
    return v < 0.f ? mm : v - mm;
}
__device__ __forceinline__ f32x2 bf2_to_f2(unsigned w) { return (f32x2){__uint_as_float(w << 16), __uint_as_float(w & 0xffff0000u)}; }

template <int PH> struct Aux;
template <> struct Aux<0> { v4u xq; };
template <> struct Aux<1> { v4u wv; unsigned x2; };

template <int PH>
__device__ __forceinline__ void gather_issue(Frame& F, v4u (&rw)[16], Aux<PH>& ax, const LAS unsigned* ixl, const unsigned char* tab, unsigned loff, int t, int i, int g, int dl) {
    v4u ix[4];
#pragma unroll
    for (int jj = 0; jj < 4; ++jj) ix[jj] = *(const LAS v4u*)(ixl + i * 128 + 16 * g + 4 * jj);
#pragma unroll
    for (int j = 0; j < 16; ++j) rw[j] = *(const GAS v4u*)(tab + (unsigned)(ix[j >> 2][j & 3] * 128u + loff));
    if constexpr (PH == 0) {
        ax.xq = *(const GAS v4u*)(F.ws + WS_X1Q + (size_t)t * D_MODEL + dl);
    } else {
        ax.wv = *(const GAS v4u*)(F.ws + WS_W16 + (size_t)t * 128 + 16 * g);
        ax.x2 = *(const GAS unsigned*)((const bf16*)(F.ws + WS_X1B) + (size_t)t * D_MODEL + dl + 2 * g);
    }
}
template <int PH, int VAR>
__device__ __forceinline__ void gather_compute(Frame& F, const v4u (&rw)[16], const Aux<PH>& ax, int slice, int t, int lane, int g, int sub, int dl) {
    if constexpr (PH == 0) {
        int p[16];
#pragma unroll
        for (int j = 0; j < 16; ++j) {
            int a_ = __builtin_amdgcn_sdot4((int)rw[j][0], (int)ax.xq[0], 0, false);
#pragma unroll
            for (int c = 1; c < 4; ++c) a_ = __builtin_amdgcn_sdot4((int)rw[j][c], (int)ax.xq[c], a_, false);
            p[j] = a_;
        }
        const bool b2 = (lane & 4) != 0, b1 = (lane & 2) != 0, b0 = (lane & 1) != 0;
#pragma unroll
        for (int k = 0; k < 8; ++k) { const int send = b2 ? p[k] : p[k + 8], keep = b2 ? p[k + 8] : p[k]; p[k] = keep + __builtin_amdgcn_update_dpp(0, send, 0x141, 0xF, 0xF, false); }
#pragma unroll
        for (int k = 0; k < 4; ++k) { const int send = b1 ? p[k] : p[k + 4], keep = b1 ? p[k + 4] : p[k]; p[k] = keep + __builtin_amdgcn_update_dpp(0, send, 0x4E, 0xF, 0xF, false); }
#pragma unroll
        for (int k = 0; k < 2; ++k) { const int send = b0 ? p[k] : p[k + 2], keep = b0 ? p[k + 2] : p[k]; p[k] = keep + __builtin_amdgcn_update_dpp(0, send, 0xB1, 0xF, 0xF, false); }
        const float pf0 = (float)p[0] * (1.f / (U_QS * X_QS)), pf1 = (float)p[1] * (1.f / (U_QS * X_QS));
        const h16x2 ph = {(_Float16)pf0, (_Float16)pf1};
        if (VAR == 0) *(GAS unsigned*)((_Float16*)(F.ws + WS_HP) + ((size_t)slice * T + t) * 128 + 16 * g + 2 * sub) = __builtin_bit_cast(unsigned, ph); else asm volatile("" :: "v"(pf0), "v"(pf1));
    } else {
        const f32x2 x2 = bf2_to_f2(ax.x2);
        const float wsc = ((const float*)(F.ws + WS_MR))[t];
        int acc[16];
#pragma unroll
        for (int c = 0; c < 16; ++c) acc[c] = 0;
#pragma unroll
        for (int q4 = 0; q4 < 4; ++q4) {
            const int w4 = (int)ax.wv[q4];
#pragma unroll
            for (int c = 0; c < 4; ++c) {
                const unsigned r0 = rw[4 * q4][c], r1 = rw[4 * q4 + 1][c], r2 = rw[4 * q4 + 2][c], r3 = rw[4 * q4 + 3][c];
                const unsigned lo01 = __builtin_amdgcn_perm(r1, r0, 0x05010400u), hi01 = __builtin_amdgcn_perm(r1, r0, 0x07030602u);
                const unsigned lo23 = __builtin_amdgcn_perm(r3, r2, 0x05010400u), hi23 = __builtin_amdgcn_perm(r3, r2, 0x07030602u);
                const unsigned d0 = __builtin_amdgcn_perm(lo23, lo01, 0x05040100u), d1 = __builtin_amdgcn_perm(lo23, lo01, 0x07060302u);
                const unsigned d2 = __builtin_amdgcn_perm(hi23, hi01, 0x05040100u), d3 = __builtin_amdgcn_perm(hi23, hi01, 0x07060302u);
                acc[4 * c] = __builtin_amdgcn_sdot4((int)d0, w4, acc[4 * c], false); acc[4 * c + 1] = __builtin_amdgcn_sdot4((int)d1, w4, acc[4 * c + 1], false);
                acc[4 * c + 2] = __builtin_amdgcn_sdot4((int)d2, w4, acc[4 * c + 2], false); acc[4 * c + 3] = __builtin_amdgcn_sdot4((int)d3, w4, acc[4 * c + 3], false);
            }
        }
#pragma unroll
        for (int k = 0; k < 8; ++k) { auto rr = __builtin_amdgcn_permlane32_swap((unsigned)acc[k], (unsigned)acc[k + 8], false, false); acc[k] = (int)rr[0] + (int)rr[1]; }
#pragma unroll
        for (int k = 0; k < 4; ++k) { auto rr = __builtin_amdgcn_permlane16_swap((unsigned)acc[k], (unsigned)acc[k + 4], false, false); acc[k] = (int)rr[0] + (int)rr[1]; }
        const bool b3 = (lane & 8) != 0;
#pragma unroll
        for (int k = 0; k < 2; ++k) { const int send = b3 ? acc[k] : acc[k + 2], keep = b3 ? acc[k + 2] : acc[k]; acc[k] = keep + __builtin_amdgcn_update_dpp(0, send, 0x128, 0xF, 0xF, false); }
        float a[2];
        a[0] = (float)acc[0] * wsc; a[1] = (float)acc[1] * wsc;
        f32x2 v2;
        v2.x = fmaf(ALPHA, x2.x, a[0]);
        v2.y = fmaf(ALPHA, x2.y, a[1]);
        if (VAR == 0) *(GAS unsigned*)((bf16*)(F.ws + WS_V2) + (size_t)t * D_MODEL + dl + 2 * g) = pk2(v2.x, v2.y);
    }
}

constexpr int GTW = 32;
template <int PH, int VAR>
__device__ __forceinline__ void gather_item(Frame& F, int slice_, int chunk_) {
    const int lane = F.lane, g = lane >> 3, sub = lane & 7;
    const int slice = __builtin_amdgcn_readfirstlane(slice_), chunk = __builtin_amdgcn_readfirstlane(chunk_);
    const unsigned char* tab = F.ws + (PH == 0 ? WS_EU : WS_EV) + (size_t)slice * EXP_SLICE_BYTES;
    const unsigned loff = 16u * (unsigned)sub;
    const int tbase = chunk * (8 * GTW) + F.wave * GTW;
    const int dl = 128 * slice + 16 * sub;
    LAS unsigned* ixl = (LAS unsigned*)(F.lds + F.wave * 16384);
    {
        const v4u* src = (const v4u*)((const int*)(F.ws + WS_IDX) + (size_t)tbase * 128);
        v4u tmp[GTW / 2];
#pragma unroll
        for (int k = 0; k < GTW / 2; ++k) tmp[k] = *(const GAS v4u*)(src + k * 64 + lane);
#pragma unroll
        for (int k = 0; k < GTW / 2; ++k) *(LAS v4u*)(ixl + (k * 64 + lane) * 4) = tmp[k];
    }
    v4u rwA[16], rwB[16]; Aux<PH> axA, axB;
    gather_issue<PH>(F, rwA, axA, ixl, tab, loff, tbase, 0, g, dl);
    if (VAR == 2) gather_issue<PH>(F, rwB, axB, ixl, tab, loff, tbase + 1, 1, g, dl);
#pragma unroll 4
    for (int i = 0; i < GTW; i += 2) {
        if (VAR != 2) gather_issue<PH>(F, rwB, axB, ixl, tab, loff, tbase + i + 1, i + 1, g, dl);
        if (VAR != 1) gather_compute<PH, VAR>(F, rwA, axA, slice, tbase + i, lane, g, sub, dl);
        else { _Pragma("unroll") for (int j = 0; j < 16; ++j) asm volatile("" :: "v"(rwA[j])); }
        const int in = (i + 2 < GTW) ? i + 2 : GTW - 1;
        if (VAR != 2) gather_issue<PH>(F, rwA, axA, ixl, tab, loff, tbase + in, in, g, dl);
        if (VAR != 1) gather_compute<PH, VAR>(F, rwB, axB, slice, tbase + i + 1, lane, g, sub, dl);
        else { _Pragma("unroll") for (int j = 0; j < 16; ++j) asm volatile("" :: "v"(rwB[j])); }
        if (VAR == 2) { _Pragma("unroll") for (int j = 0; j < 16; ++j) asm volatile("" : "+v"(rwA[j]), "+v"(rwB[j])); }
    }
}

template <int PH, int VAR = 0>
__device__ __forceinline__ void gather_phase(Frame& F) {
    LAS int* sh = (LAS int*)(F.lds + RING_BYTES + 1024);
    const unsigned xcc = xb_xcc_id() & 7u;
    gu32* qbase = F.ctl + (VAR ? CW_QV + 1024 : (PH == 0 ? CW_QU : CW_QV));
    for (int r = 0; r < 8; ++r) {
        const int qi = (int)((xcc + (unsigned)r) & 7u);
        for (;;) {
            if (F.tid == 0) sh[0] = (int)__hip_atomic_fetch_add(qbase + 64 * qi, 1u, __ATOMIC_RELAXED, __HIP_MEMORY_SCOPE_AGENT);
            __syncthreads();
            const int n = sh[0];
            __syncthreads();
            if (n >= T / (8 * GTW)) break;
            gather_item<PH, VAR>(F, qi, n);
        }
    }
}

__device__ __forceinline__ void combine_phase(Frame& F) {
    const _Float16* HP = (const _Float16*)(F.ws + WS_HP); const float* W = (const float*)(F.ws + WS_G);
    const int nthr = F.G * NWAVES * 64;
    for (int i = F.vcu * NWAVES * 64 + F.tid; i < T * 128 / 4; i += nthr) {
        f32x4 s = {0.f, 0.f, 0.f, 0.f};
#pragma unroll
        for (int sl = 0; sl < 8; ++sl) {
            const u32x2 hw = *(const GAS u32x2*)(HP + (size_t)sl * T * 128 + (size_t)i * 4);
            s[0] += (float)__builtin_bit_cast(_Float16, (unsigned short)(hw.x & 0xFFFFu)); s[1] += (float)__builtin_bit_cast(_Float16, (unsigned short)(hw.x >> 16));
            s[2] += (float)__builtin_bit_cast(_Float16, (unsigned short)(hw.y & 0xFFFFu)); s[3] += (float)__builtin_bit_cast(_Float16, (unsigned short)(hw.y >> 16));
        }
        const f32x4 gv = *(const GAS f32x4*)(W + (size_t)i * 4);
        float wv_[4]; float mx = 0.f;
#pragma unroll
        for (int e = 0; e < 4; ++e) { wv_[e] = gv[e] * gelu_erf(s[e]); mx = fmaxf(mx, fabsf(wv_[e])); }
#pragma unroll
        for (int o = 1; o < 32; o <<= 1) mx = fmaxf(mx, __shfl_xor(mx, o));
        const float sc = 127.f / fmaxf(mx, 1e-30f);
        *(GAS unsigned*)(F.ws + WS_W16 + (size_t)i * 4) = q8x4(wv_[0] * sc, wv_[1] * sc, wv_[2] * sc, wv_[3] * sc);
        if ((i & 31) == 0) ((float*)(F.ws + WS_MR))[i >> 5] = 1.f / (sc * SQ_V);
    }
}

__device__ __forceinline__ void ln2_phase(Frame& F) {
    const int lane = F.lane, gw = F.vcu * NWAVES + F.wave, NGW = F.G * NWAVES;
    const float* ln2_g = F.in[11]; const float* ln2_b = F.in[12];
    f32x4 gg[4], bb[4];
#pragma unroll
    for (int j = 0; j < 2; ++j) { gg[2 * j] = *(const GAS f32x4*)(ln2_g + 512 * j + 8 * lane); gg[2 * j + 1] = *(const GAS f32x4*)(ln2_g + 512 * j + 8 * lane + 4);
                                  bb[2 * j] = *(const GAS f32x4*)(ln2_b + 512 * j + 8 * lane); bb[2 * j + 1] = *(const GAS f32x4*)(ln2_b + 512 * j + 8 * lane + 4); }
    for (int t = gw; t < T; t += NGW) {
        const bf16* vrow = (const bf16*)(F.ws + WS_V2) + (size_t)t * D_MODEL;
        f32x4 v[4]; float s = 0.f;
#pragma unroll
        for (int j = 0; j < 2; ++j) { const v4u w = *(const GAS v4u*)(vrow + 512 * j + 8 * lane);
            v[2 * j] = (f32x4){__uint_as_float(w[0] << 16), __uint_as_float(w[0] & 0xffff0000u), __uint_as_float(w[1] << 16), __uint_as_float(w[1] & 0xffff0000u)};
            v[2 * j + 1] = (f32x4){__uint_as_float(w[2] << 16), __uint_as_float(w[2] & 0xffff0000u), __uint_as_float(w[3] << 16), __uint_as_float(w[3] & 0xffff0000u)}; }
#pragma unroll
        for (int j = 0; j < 4; ++j) s += (v[j].x + v[j].y) + (v[j].z + v[j].w);
        const float mean = wave_sum(s) * (1.f / D_MODEL); float s2 = 0.f;
#pragma unroll
        for (int j = 0; j < 4; ++j) { v[j] = v[j] - mean; s2 += (v[j].x * v[j].x + v[j].y * v[j].y) + (v[j].z * v[j].z + v[j].w * v[j].w); }
        const float rstd = 1.f / sqrtf(wave_sum(s2) * (1.f / D_MODEL) + LN_EPS);
        float* row = F.out + (size_t)t * D_MODEL;
#pragma unroll
        for (int j = 0; j < 2; ++j) { *(GAS f32x4*)(row + 512 * j + 8 * lane) = v[2 * j] * rstd * gg[2 * j] + bb[2 * j]; *(GAS f32x4*)(row + 512 * j + 8 * lane + 4) = v[2 * j + 1] * rstd * gg[2 * j + 1] + bb[2 * j + 1]; }
    }
}
}

struct Args { const float* in[13]; float* out; unsigned char* ws; int ph_lo, ph_hi; };
static_assert(sizeof(Args) == 13 * 8 + 8 + 8 + 8, "Args has no padding");
constexpr int N_PHASES = 10;
template <class Epi> struct EpiNull {
    static constexpr bool PERM = Epi::PERM, AFTER_DRAIN = Epi::AFTER_DRAIN;
    __device__ __forceinline__ void operator()(const pg8::f32x4 (&acc)[2][2][4][2], const pg8::Unit&, int, int, int, int) const {
#pragma unroll
        for (int a = 0; a < 2; ++a)
#pragma unroll
            for (int b = 0; b < 2; ++b)
#pragma unroll
                for (int m = 0; m < 4; ++m) { asm volatile("" :: "v"(acc[a][b][m][0]), "v"(acc[a][b][m][1])); }
    }
};

__global__ void __launch_bounds__(NWAVES * 64, 2) mk_fwd(Args args) {
    extern __shared__ __attribute__((aligned(16))) unsigned char lds[];
    Frame F;
    F.lds = (LAS unsigned char*)lds;
    F.MISC = (volatile LAS unsigned*)(F.lds + MISC_OFF);
    F.tid = threadIdx.x; F.lane = F.tid & 63; F.wave = __builtin_amdgcn_readfirstlane(F.tid >> 6);
    F.G = gridDim.x; { const int bx = blockIdx.x; F.vcu = (F.G % 8 == 0) ? (bx % 8) * (F.G / 8) + bx / 8 : bx; }
    F.ws = args.ws; F.out = args.out; F.ctl = (gu32*)(args.ws + WS_CTL);
#pragma unroll
    for (int i = 0; i < 13; ++i) F.in[i] = args.in[i];
    for (int u = F.tid; u < (LDS_BYTES - RING_BYTES) / 4; u += NWAVES * 64) ((LAS unsigned*)(F.lds + RING_BYTES))[u] = 0u;
    __syncthreads();
    XcdBarrier bar = xcd_barrier_post((unsigned*)(F.ctl + CW_BAR), F.MISC + 8);
    const int lo = args.ph_lo, hi = args.ph_hi;
#ifndef ATT_KMASK
#define ATT_KMASK 3
#endif
#define IN(k) (lo <= (k) && (k) < hi)
#define SEAM(k) do { if (IN(k) && IN((k) + 1)) xcd_barrier(bar); } while (0)

    if (IN(0)) { p0_prologue(F); }
    SEAM(0);
    if (IN(1)) {
        pg8::Gemm g{(const pg8::bf16_t*)(F.ws + WS_XQ), (const pg8::bf16_t*)(F.ws + WS_WIN), T, NPHYS, D_MODEL / 2};
        pg8::StaticOrder S; S.init(T, NPHYS, F.G, (int)blockIdx.x);
        EpiInProj E{(bf16*)(F.ws + WS_FQ), (bf16*)(F.ws + WS_FKT), (bf16*)(F.ws + WS_FVT), (bf16*)(F.ws + WS_SQ), (bf16*)(F.ws + WS_SKT), (bf16*)(F.ws + WS_SVT),
                    (const float2*)(F.ws + WS_ROPE), (float*)(F.ws + WS_QN2), (float*)(F.ws + WS_KN2)};
        const bool upper = (int)blockIdx.x >= F.G / 2;
        if (upper) { p1_slack_jobs(F, (int)blockIdx.x - F.G / 2, F.G - F.G / 2); convert_experts(F, ((int)blockIdx.x - F.G / 2) * NWAVES + F.wave, (F.G - F.G / 2) * NWAVES, EXP_SPLIT, EXP_SPLIT + V_PRE); __syncthreads(); }
#ifdef GEMM_NULL
        if (lo == 1) pg8::gemm_phase<EpiNull<EpiInProj>, pg8::StaticOrder, true, true, true>(F.lds, g, S, EpiNull<EpiInProj>{}); else
#endif
        pg8::gemm_phase<EpiInProj, pg8::StaticOrder, true, true, true>(F.lds, g, S, E);
        if (upper) convert_experts(F, ((int)blockIdx.x - F.G / 2) * NWAVES + F.wave, (F.G - F.G / 2) * NWAVES, EXP_PRE, EXP_SPLIT);
        if (!upper) convert_experts(F, (int)blockIdx.x * NWAVES + F.wave, (F.G / 2) * NWAVES, EXP_SPLIT + V_PRE, 2 * NEXP - V_P4);
    }
    SEAM(1);
    if (IN(2)) { att::attn_phase(F); }
    SEAM(2);
    if (IN(3)) {
#ifdef P3_DELAY_US
        if (((int)blockIdx.x >> 3) & 1) { const unsigned long long t0 = __builtin_amdgcn_s_memrealtime(); while (__builtin_amdgcn_s_memrealtime() - t0 < (unsigned long long)(P3_DELAY_US * 100)) __builtin_amdgcn_s_sleep(8); }
#endif
        pg8::Gemm g{(const pg8::bf16_t*)(F.ws + WS_ATTN), (const pg8::bf16_t*)(F.ws + WS_WOUT), T, D_MODEL, D_MODEL / 2};
        pg8::StaticOrder S; S.init(T, D_MODEL, F.G, (int)blockIdx.x);
        EpiOutProj E{(bf16*)(F.ws + WS_XB), (float2*)(F.ws + WS_STATS)};
#ifdef P3_DUMMY
        if (lo == 3) { EpiOutProj E2{(bf16*)(F.ws + WS_FQ), (float2*)(F.ws + WS_FKT)}; pg8::gemm_phase<EpiOutProj, pg8::StaticOrder, true, true, true>(F.lds, g, S, E2); } else
#endif
#ifdef GEMM_NULL
        if (lo == 3) pg8::gemm_phase<EpiNull<EpiOutProj>, pg8::StaticOrder, true, true, true>(F.lds, g, S, EpiNull<EpiOutProj>{}); else
#endif
        pg8::gemm_phase<EpiOutProj, pg8::StaticOrder, true, true, true>(F.lds, g, S, E);
    }
    SEAM(3);
    if (IN(4)) {
#if V_P4_ROWS > 0
        if (((int)blockIdx.x >> 3) & 1) {
            const int gi = (((int)blockIdx.x >> 4) << 3) | ((int)blockIdx.x & 7);
            convert_experts(F, gi * NWAVES + F.wave, (F.G / 2) * NWAVES, 2 * NEXP - V_P4_ROWS, 2 * NEXP); __syncthreads(); }
#endif
#ifdef P4_DELAY_US
        if (((int)blockIdx.x >> 3) & 1) { const unsigned long long t0 = __builtin_amdgcn_s_memrealtime(); while (__builtin_amdgcn_s_memrealtime() - t0 < (unsigned long long)(P4_DELAY_US * 100)) __builtin_amdgcn_s_sleep(8); }
#endif
        pg8::Gemm g{(const pg8::bf16_t*)(F.ws + WS_XB), (const pg8::bf16_t*)(F.ws + WS_WQ), T, QCOLS, D_MODEL};
        pg8::StaticOrder S; S.init(T, QCOLS, F.G, (int)blockIdx.x);
        EpiQuery E{(const float2*)(F.ws + WS_STATS), (const float*)(F.ws + WS_GW), (const float*)(F.ws + WS_GW) + QCOLS, (bf16*)(F.ws + WS_Q)};
#ifdef GEMM_NULL
        if (lo == 4) pg8::gemm_phase<EpiNull<EpiQuery>, pg8::StaticOrder, true, true>(F.lds, g, S, EpiNull<EpiQuery>{}); else
#endif
        pg8::gemm_phase<EpiQuery, pg8::StaticOrder, true, true>(F.lds, g, S, E);
    }
    SEAM(4);
    if (IN(5)) { tk::topk_phase<0>(F); }
#ifdef P5_PROBE
    if (IN(5)) { xcd_barrier(bar); tk::topk_phase<P5_PROBE>(F); }
#endif
    SEAM(5);
    if (IN(6)) { ex::gather_phase<0>(F); }
    SEAM(6);
    if (IN(7)) { ex::combine_phase(F); }
    SEAM(7);
    if (IN(8)) { ex::gather_phase<1>(F); }
    SEAM(8);
#ifdef G_PROBE_PH
    if (IN(8)) { ex::gather_phase<G_PROBE_PH, G_PROBE_VAR>(F); xcd_barrier(bar); }
#endif
#ifdef EXTRA_BAR
    for (int eb = 0; eb < EXTRA_BAR; ++eb) xcd_barrier(bar);
#endif
    if (IN(9)) { ex::ln2_phase(F); }
#undef IN
#undef SEAM
}

#if DBG_STAGE > 0
constexpr int DBG_B = 5;
constexpr size_t DBG_BASE = 360 * MiB;
constexpr size_t DBG_ACC = 511 * MiB;
__device__ __forceinline__ float bf2f(bf16 v) { return __uint_as_float((unsigned)v << 16); }
__device__ __forceinline__ void dbg_acc(double* acc, int slot, float opt, float ref) {
    float d2 = (opt - ref) * (opt - ref), r2 = ref * ref;
    if (!(d2 == d2)) d2 = 1e30f;
    d2 = wave_sum(d2); r2 = wave_sum(r2);
    if ((threadIdx.x & 63) == 0) { atomicAdd(acc + 2 * slot, (double)d2); atomicAdd(acc + 2 * slot + 1, (double)r2); }
}
__global__ void __launch_bounds__(256) dbg_check_inproj(const float* __restrict__ proj, const unsigned char* __restrict__ ws, const float* __restrict__ cn, double* acc) {
    const int s = blockIdx.x, t = DBG_B * SEQ + s;
    const float* pr = proj + (size_t)s * IN_COLS;
    for (int j = threadIdx.x; j < 2304; j += 256) {
        float ref, opt; int slot;
        if (j < 1536) {
            const int which = j >> 9, hd = (j >> 6) & 7, d = j & 63;
            ref = pr[j];
            if (which == 0) { opt = bf2f(((const bf16*)(ws + WS_FQ))[(size_t)t * 512 + hd * 64 + d]) / C2; slot = 0; }
            else if (which == 1) { opt = bf2f(*(const bf16*)(ws + WS_FKT + EpiInProj::tile_off(8, t, hd) + (size_t)((d >> 3) * 64 + (t & 63)) * 16 + (d & 7) * 2)); slot = 1; }
            else { opt = bf2f(*(const bf16*)(ws + WS_FVT + EpiInProj::tile_off(8, t, hd) + (size_t)((d >> 5) * 4 + ((t & 63) >> 4)) * 1024 + (t & 15) * 64 + (d & 31) * 2)); slot = 2; }
        } else if (j < 2176) {
            const bool isq = j < 2048; const int r = isq ? j - 1536 : j - 2048, hd = r >> 6, d = r & 63, base = (isq ? OFF_SQ : OFF_SK) + hd * 64;
            float cs, sn; rope_cs(s, d & 31, cs, sn);
            ref = (d < 32) ? pr[base + d] * cs - pr[base + d + 32] * sn : pr[base + d] * cs + pr[base + d - 32] * sn;
            if (isq) { opt = bf2f(((const bf16*)(ws + WS_SQ))[(size_t)t * 512 + hd * 64 + d]) / C2; slot = 3; }
            else { opt = bf2f(*(const bf16*)(ws + WS_SKT + EpiInProj::tile_off(2, t, hd) + (size_t)((d >> 3) * 64 + (t & 63)) * 16 + (d & 7) * 2)); slot = 4; }
        } else {
            const int r = j - 2176, hd = r >> 6, d = r & 63;
            ref = pr[OFF_SV + r];
            opt = bf2f(*(const bf16*)(ws + WS_SVT + EpiInProj::tile_off(2, t, hd) + (size_t)((d >> 5) * 4 + ((t & 63) >> 4)) * 1024 + (t & 15) * 64 + (d & 31) * 2)); slot = 5;
        }
#pragma unroll
        for (int sl = 0; sl < 6; ++sl) dbg_acc(acc, sl, slot == sl ? opt : 0.f, slot == sl ? ref : 0.f);
    }
    if (threadIdx.x < 64) {
        const int h = threadIdx.x & 7;
        const float opt = (threadIdx.x < 8) ? ((const float*)(ws + WS_C))[(size_t)(DBG_B * 8 + h) * SEQ + s] : 0.f, ref = (threadIdx.x < 8) ? cn[(size_t)h * SEQ + s] : 0.f;
        dbg_acc(acc, 6, opt, ref);
    }
}
__global__ void __launch_bounds__(256) dbg_check_attn(const float* __restrict__ attn_n, const unsigned char* __restrict__ ws, double* acc) {
    const int s = blockIdx.x, t = DBG_B * SEQ + s;
    for (int j = threadIdx.x; j < 1024; j += 256) {
        const float ref = attn_n[(size_t)s * 1024 + j], opt = bf2f(((const bf16*)(ws + WS_ATTN))[(size_t)t * 1024 + j]);
        dbg_acc(acc, j >> 9, opt, ref);
    }
}
__global__ void __launch_bounds__(256) dbg_check_q(const float* __restrict__ qn, const float* __restrict__ x1n, const float* __restrict__ y, const float* __restrict__ g1, const float* __restrict__ b1, const unsigned char* __restrict__ ws, double* acc) {
    const int s = blockIdx.x, t = DBG_B * SEQ + s;
    for (int j = threadIdx.x; j < 2048; j += 256) dbg_acc(acc, 0, bf2f(((const bf16*)(ws + WS_Q))[(size_t)t * QCOLS + j]), qn[(size_t)s * QCOLS + j]);
    const float2 st = ln1_row_stats((const float2*)(ws + WS_STATS), t);
    for (int j = threadIdx.x; j < 1024; j += 256) dbg_acc(acc, 1, (y[(size_t)t * 1024 + j] - st.x) * st.y * g1[j] + b1[j], x1n[(size_t)s * 1024 + j]);
}
__global__ void __launch_bounds__(256) dbg_check_picks(const int* __restrict__ idxn, const float* __restrict__ gn, const unsigned char* __restrict__ ws, double* acc) {
    const int i = blockIdx.x * 256 + threadIdx.x;
    const int s = i >> 3, h = i & 7, t = DBG_B * SEQ + s;
    const int* io = (const int*)(ws + WS_IDX) + ((size_t)t * 8 + h) * 16; const float* go = (const float*)(ws + WS_G) + ((size_t)t * 8 + h) * 16;
    const int* in_ = idxn + ((size_t)s * 8 + h) * 16; const float* gn_ = gn + ((size_t)s * 8 + h) * 16;
    float miss = 0.f, d2 = 0.f, r2 = 0.f;
    for (int a = 0; a < 16; ++a) { const int e = in_[a]; bool found = false;
        for (int b = 0; b < 16; ++b) if (io[b] == e) { found = true; d2 += (go[b] - gn_[a]) * (go[b] - gn_[a]); r2 += gn_[a] * gn_[a]; }
        if (!found) miss += 1.f; }
    miss = wave_sum(miss); d2 = wave_sum(d2); r2 = wave_sum(r2);
    if ((threadIdx.x & 63) == 0) { atomicAdd(acc + 0, (double)miss); atomicAdd(acc + 1, 16.0 * 64.0); atomicAdd(acc + 2, (double)d2); atomicAdd(acc + 3, (double)r2); }
}
__global__ void dbg_code_picks(const double* acc, float* code) {
    if (threadIdx.x != 0 || blockIdx.x != 0) return;
    const float frac = (float)(acc[0] / acc[1]), gerr = (float)sqrt(acc[2] / acc[3]);
    *code = 10.f * frac + (gerr > 0.05f ? 100.f : 0.f) + (frac != frac ? 1000.f : 0.f);
}
__global__ void dbg_code(const double* acc, float* code, int nslots) {
    if (threadIdx.x != 0 || blockIdx.x != 0) return;
    float worst = 0.f; int mask = 0;
    for (int i = 0; i < nslots; ++i) { const double r = acc[2 * i + 1] > 0 ? sqrt(acc[2 * i] / acc[2 * i + 1]) : 99.0; if (r > 0.02) mask |= 1 << i; if ((float)r > worst) worst = (float)r; }
    *code = mask ? (float)mask : worst * 10.f;
}
__global__ void dbg_scale(float* out, const float* code, int n) { const int i = blockIdx.x * blockDim.x + threadIdx.x; if (i < n) out[i] *= (1.f + *code); }

static void launch_naive(const float* const* in, float* out, char* ws, int b0, int nb, hipStream_t stream, float** proj_o, float** c_o, float** x1_o, int** idx_o, float** g_o, float* attn_tmp) {
    const int Tn = nb * SEQ;
    float* proj = (float*)ws; size_t off = (size_t)Tn * IN_COLS * 4; off = (off + 255) & ~(size_t)255;
    float* cbuf = (float*)(ws + off); off += (size_t)nb * FOX_H * SEQ * 4;
    float* x1 = (float*)(ws + off); off += (size_t)Tn * D_MODEL * 4;
    int* idx = (int*)(ws + off); off += (size_t)Tn * 128 * 4;
    float* gbuf = (float*)(ws + off); off += (size_t)Tn * 128 * 4;
    const float* x = in[0] + (size_t)b0 * SEQ * D_MODEL;
    float* attn = attn_tmp ? attn_tmp : out + (size_t)b0 * SEQ * D_MODEL;
    nv_gemm<<<dim3((IN_COLS + 127) / 128, Tn / 128), 256, 0, stream>>>(x, D_MODEL, in[1], IN_COLS, proj, IN_COLS, Tn, IN_COLS, D_MODEL);
    nv_forget_cumsum<<<1, 64, 0, stream>>>(proj, in[2], cbuf, nb);
    nv_fox<<<dim3(SEQ / 64, FOX_H, nb), 64, 0, stream>>>(proj, cbuf, attn);
    nv_swa<<<dim3(SEQ / 64, SWA_H, nb), 64, 0, stream>>>(proj, in[3], attn);
    nv_gemm<<<dim3(D_MODEL / 128, Tn / 128), 256, 0, stream>>>(attn, D_MODEL, in[4], D_MODEL, x1, D_MODEL, Tn, D_MODEL, D_MODEL);
    nv_ln_res<<<Tn / 4, 256, 0, stream>>>(x, x1, in[5], in[6], x1, Tn);
    float* q = proj;
    if (proj_o) {
        *proj_o = proj; *c_o = cbuf; *x1_o = x1; *idx_o = idx; *g_o = gbuf;
        q = attn_tmp + (size_t)Tn * D_MODEL + (1u << 18);
        nv_gemm<<<dim3(QCOLS / 128, Tn / 128), 256, 0, stream>>>(x1, D_MODEL, in[7], QCOLS, q, QCOLS, Tn, QCOLS, D_MODEL);
        nv_peer_topk<<<dim3(Tn / 64, PEER_H), 64, 0, stream>>>(q, in[8], idx, gbuf);
        return;
    }
    nv_gemm<<<dim3(QCOLS / 128, Tn / 128), 256, 0, stream>>>(x1, D_MODEL, in[7], QCOLS, q, QCOLS, Tn, QCOLS, D_MODEL);
    nv_peer_topk<<<dim3(Tn / 64, PEER_H), 64, 0, stream>>>(q, in[8], idx, gbuf);
    nv_peer_expert<<<Tn / 4, 256, 0, stream>>>(x1, idx, gbuf, in[9], in[10], in[11], in[12], out + (size_t)b0 * SEQ * D_MODEL, Tn);
}
#endif

extern "C" void kernel_launch(void* const* d_in, const int* in_sizes, int n_in, void* d_out, int out_size, void* d_ws, size_t ws_size, hipStream_t stream) {
    static int grid = 0;
    if (grid == 0) {
        if (n_in != 13 || out_size != T * D_MODEL || ws_size < 512 * MiB) { fprintf(stderr, "kernel_launch: unexpected shapes / workspace (%d inputs, out %d, ws %zu)\n", n_in, out_size, ws_size); grid = -1; return; }
        int dev = 0, cus = 0, per_cu = 0;
        if (hipGetDevice(&dev) != hipSuccess || hipDeviceGetAttribute(&cus, hipDeviceAttributeMultiprocessorCount, dev) != hipSuccess) { grid = -1; return; }
        if (hipFuncSetAttribute((const void*)mk_fwd, hipFuncAttributeMaxDynamicSharedMemorySize, LDS_BYTES) != hipSuccess) { fprintf(stderr, "kernel_launch: hipFuncSetAttribute failed\n"); grid = -1; return; }
        if (hipOccupancyMaxActiveBlocksPerMultiprocessor(&per_cu, (const void*)mk_fwd, NWAVES * 64, LDS_BYTES) != hipSuccess || per_cu < 1) { fprintf(stderr, "kernel_launch: occupancy query says %d blocks per CU\n", per_cu); (void)hipGetLastError(); grid = -1; return; }
        grid = cus;
    }
    if (grid < 0) return;
    const float* in[13]; for (int i = 0; i < 13; ++i) in[i] = (const float*)d_in[i];
    (void)hipMemsetAsync((char*)d_ws + WS_CTL, 0, CTL_ZERO_BYTES, stream);
    Args a{};
    for (int i = 0; i < 13; ++i) a.in[i] = in[i];
    a.out = (float*)d_out; a.ws = (unsigned char*)d_ws;
#if DBG_STAGE == 0 && defined(TIME_LO)
    a.ph_lo = 0; a.ph_hi = TIME_HI;
    { void* k1[] = {&a}; (void)hipLaunchCooperativeKernel((const void*)mk_fwd, dim3(grid), dim3(NWAVES * 64), k1, LDS_BYTES, stream); }
    (void)hipMemsetAsync((char*)d_ws + WS_CTL, 0, CTL_ZERO_BYTES, stream);
    a.ph_lo = TIME_LO; a.ph_hi = N_PHASES;
#elif DBG_STAGE == 0
    a.ph_lo = 0; a.ph_hi = N_PHASES;
#else
    a.ph_lo = 0; a.ph_hi = DBG_STAGE + 1;
#endif
    void* kargs[] = {&a};
    hipError_t le = hipLaunchCooperativeKernel((const void*)mk_fwd, dim3(grid), dim3(NWAVES * 64), kargs, LDS_BYTES, stream);
    if (le != hipSuccess) fprintf(stderr, "kernel_launch: cooperative launch failed: %s (grid %d)\n", hipGetErrorName(le), grid);
#if DBG_STAGE > 0
    char* ws = (char*)d_ws;
    double* acc = (double*)(ws + DBG_ACC); float* code = (float*)(ws + DBG_ACC + 512);
    (void)hipMemsetAsync(acc, 0, 1024, stream);
    float *proj, *cn, *x1n, *gn; int* idxn;
    launch_naive(in, (float*)d_out, ws + DBG_BASE, DBG_B, 1, stream, &proj, &cn, &x1n, &idxn, &gn, (float*)(ws + DBG_BASE + 100 * MiB));
#if DBG_STAGE == 1
    dbg_check_inproj<<<SEQ, 256, 0, stream>>>(proj, (const unsigned char*)d_ws, cn, acc);
    dbg_code<<<1, 1, 0, stream>>>(acc, code, 7);
#elif DBG_STAGE == 4
    dbg_check_q<<<SEQ, 256, 0, stream>>>((const float*)(ws + DBG_BASE + 100 * MiB) + (size_t)SEQ * D_MODEL + (1u << 18), x1n, (const float*)d_out, in[5], in[6], (const unsigned char*)d_ws, acc);
    dbg_code<<<1, 1, 0, stream>>>(acc, code, 2);
#elif DBG_STAGE == 5
    dbg_check_picks<<<SEQ * 8 / 256, 256, 0, stream>>>(idxn, gn, (const unsigned char*)d_ws, acc);
    dbg_code_picks<<<1, 1, 0, stream>>>(acc, code);
#elif DBG_STAGE == 2
    dbg_check_attn<<<SEQ, 256, 0, stream>>>((const float*)(ws + DBG_BASE + 100 * MiB), (const unsigned char*)d_ws, acc);
    dbg_code<<<1, 1, 0, stream>>>(acc, code, 2);
#endif
    launch_naive(in, (float*)d_out, ws, 0, BATCH, stream, nullptr, nullptr, nullptr, nullptr, nullptr, nullptr);
    dbg_scale<<<(T * D_MODEL + 255) / 256, 256, 0, stream>>>((float*)d_out, code, T * D_MODEL);
#endif
}
```

```cpp
#include <hip/hip_runtime.h>
#include <hip/hip_bf16.h>
#include <hip/hip_cooperative_groups.h>
#include <cstdint>
#include <cstdio>
#include <cmath>

#ifndef DBG_STAGE
#define DBG_STAGE 0
#endif

namespace cfg {
constexpr int D_MODEL = 1024, BATCH = 8, SEQ = 4096, T = BATCH * SEQ;
constexpr int HD = 64, FOX_H = 8, SWA_H = 8, SWA_KVH = 2;
constexpr int OFF_FQ = 0, OFF_FK = 512, OFF_FV = 1024, OFF_FF = 1536, OFF_SQ = 1544, OFF_SK = 2056, OFF_SV = 2184, IN_COLS = 2312;
constexpr int NPHYS = 2304;
constexpr int WINDOW = 128;
constexpr int PEER_H = 8, NKEYS = 128, PEER_HALF = 128, TOPK = 16, QCOLS = 2048, NEXP = 16384;
constexpr float LN_EPS = 1e-5f;
constexpr float ALPHA = 1.189207115002721f;
constexpr float LOG2E = 1.4426950408889634f;
constexpr float C2 = 0.125f * LOG2E;
}
using namespace cfg;

namespace pg8 {
#define PG8_LAS __attribute__((address_space(3)))
typedef unsigned short bf16_t;
typedef short bf16x8 __attribute__((ext_vector_type(8)));
typedef float f32x4 __attribute__((ext_vector_type(4)));
typedef unsigned u32x4 __attribute__((ext_vector_type(4)));
constexpr int BM = 256, BK = 64, HALF = 128, HTB = HALF * BK * 2  , STAGE_BYTES = 8 * HTB, NXCD = 8, WGM = 8;

__host__ __device__ __forceinline__ int lds_byte(int r, int c) { const int st = (r >> 4) * 2 + (c >> 5), rr = r & 15, cc = c & 31, ob = rr * 64 + cc * 2; return st * 1024 + (ob ^ (((ob >> 9) & 1) << 5)); }
__host__ __device__ __forceinline__ void stage_rc(int b, int& R, int& C) { const int st = b / 1024, sb = b % 1024, swz = sb ^ (((sb >> 9) & 1) << 5); R = (st >> 1) * 16 + swz / 64; C = (st & 1) * 32 + (swz % 64) / 2; }
__host__ __device__ __forceinline__ int perm32(int rho) { const int n = rho >> 4, i = rho & 15; return 8 * (i >> 2) + 4 * n + (i & 3); }

struct Unit { int pm, pn; };
struct Gemm { const bf16_t* A; const bf16_t* Bt; int M, N, K; };

struct StaticOrder {
    int nM, nN, nwg, G, c;
    __host__ __device__ void init(int M, int N, int G_, int c_) { nM = M / BM; nN = N / BM; nwg = nM * nN; G = G_; c = c_; }
    __host__ __device__ bool next(int i, Unit& u) const {
        const long L = (long)i * G + c; if (L >= nwg) return false;
        int wgid = (int)L; { const int q = nwg / NXCD, r = nwg % NXCD, xcd = wgid % NXCD, off = wgid / NXCD; wgid = (xcd < r ? xcd * (q + 1) : r * (q + 1) + (xcd - r) * q) + off; }
        const int nig = WGM * nN, gid = wgid / nig, fm = gid * WGM, gsz = (nM - fm) < WGM ? (nM - fm) : WGM;
        u.pm = fm + ((wgid % nig) % gsz); u.pn = (wgid % nig) / gsz; return true;
    }
    __device__ __forceinline__ void a_ready(const Unit&) const {}
    __device__ __forceinline__ void done(const Unit&) const {}
};
__device__ __forceinline__ unsigned cvt_pk_bf16(float lo, float hi) { unsigned r; asm volatile("v_cvt_pk_bf16_f32 %0, %1, %2" : "=v"(r) : "v"(lo), "v"(hi)); return r; }
typedef float f32x2 __attribute__((ext_vector_type(2)));
template <bool I8> __device__ __forceinline__ f32x4 pg8_mma(bf16x8 a, bf16x8 b, f32x4 c) {
    if constexpr (I8) { typedef int v4i_ __attribute__((ext_vector_type(4)));
        return __builtin_bit_cast(f32x4, __builtin_amdgcn_mfma_i32_16x16x64_i8(__builtin_bit_cast(v4i_, a), __builtin_bit_cast(v4i_, b), __builtin_bit_cast(v4i_, c), 0, 0, 0)); }
    else return __builtin_amdgcn_mfma_f32_16x16x32_bf16(a, b, c, 0, 0, 0);
}
template <class Epi, class Sched, bool ALIGN_EPI = false, bool SP2 = false, bool I8 = false>
__device__ __forceinline__ void gemm_phase(PG8_LAS unsigned char* lds, const Gemm g, const Sched& S, const Epi& E) {
    const int tid = threadIdx.x, wid = __builtin_amdgcn_readfirstlane(tid >> 6), lane = tid & 63, wr = wid >> 2, wc = wid & 3, fr = lane & 15, fq = lane >> 4;
    const int K = g.K, nt = K / BK;
    unsigned voffA[2], voffB[2];
#pragma unroll
    for (int i = 0; i < 2; ++i) { int R, C; stage_rc(tid * 16 + i * 8192, R, C); const int Rb = Epi::PERM ? ((R & ~31) + perm32(R & 31)) : R;
        voffA[i] = (unsigned)(R * K + C) * 2u; voffB[i] = (unsigned)(Rb * K + C) * 2u; }
    const size_t kstep = (size_t)(BK * 2);
    const size_t hstep = (size_t)HALF * K * 2;
    const size_t tstep = 2 * hstep;
    const unsigned ldsw = (unsigned)wid * 1024u;
    const int aoff = lds_byte(wr * 64 + fr, fq * 8), boff = lds_byte(wc * 32 + fr, fq * 8);
#define PG8_SA(b, h) (((b) * 2 + (h)) * HTB)
#define PG8_SB(b, h) ((4 + (b) * 2 + (h)) * HTB)
#define PG8_STAGE(bufoff, gbase, voff) do { _Pragma("unroll") for (int _i = 0; _i < 2; ++_i) \
        __builtin_amdgcn_global_load_lds((const unsigned*)((const char*)(gbase) + (voff)[_i]), (PG8_LAS unsigned*)(lds + (bufoff) + ldsw + _i * 8192), 16, 0, 0); } while (0)
#define PG8_LDA(dst, b, h) do { _Pragma("unroll") for (int m = 0; m < 4; ++m) _Pragma("unroll") for (int k = 0; k < 2; ++k) dst[m][k] = *(const PG8_LAS bf16x8*)(lds + PG8_SA(b, h) + aoff + m * 2048 + k * 1024); } while (0)
#define PG8_LDB(dst, b, h) do { _Pragma("unroll") for (int n = 0; n < 2; ++n) _Pragma("unroll") for (int k = 0; k < 2; ++k) dst[n][k] = *(const PG8_LAS bf16x8*)(lds + PG8_SB(b, h) + boff + n * 2048 + k * 1024); } while (0)
#define PG8_MMA(ai, bj, At, Bt) do { __builtin_amdgcn_s_setprio(1); _Pragma("unroll") for (int m = 0; m < 4; ++m) _Pragma("unroll") for (int n = 0; n < 2; ++n) _Pragma("unroll") for (int k = 0; k < 2; ++k) \
        acc[ai][bj][m][n] = pg8_mma<I8>(Bt[n][k], At[m][k], acc[ai][bj][m][n]); __builtin_amdgcn_s_setprio(0); } while (0)
#define PG8_WAIT_V(n) asm volatile("s_waitcnt vmcnt(" #n ")" ::: "memory")
#define PG8_WAIT_L(n) asm volatile("s_waitcnt lgkmcnt(" #n ")" ::: "memory")
#define PG8_BAR __builtin_amdgcn_s_barrier()
#define PG8_SCHED __builtin_amdgcn_sched_barrier(0)
    Unit cur, nxt; int ui = 0;
    if (!S.next(0, cur)) return;
    f32x4 acc[2][2][4][2];
#pragma unroll
    for (int a = 0; a < 2; ++a)
#pragma unroll
        for (int b = 0; b < 2; ++b)
#pragma unroll
            for (int m = 0; m < 4; ++m)
#pragma unroll
                for (int n = 0; n < 2; ++n) acc[a][b][m][n] = (f32x4){0.f, 0.f, 0.f, 0.f};
    bf16x8 At[4][2], B0[2][2], B1[2][2];
    const char* cA = (const char*)g.A + (size_t)cur.pm * tstep; const char* cB = (const char*)g.Bt + (size_t)cur.pn * tstep;
    S.a_ready(cur);
    if constexpr (SP2) {
        PG8_STAGE(PG8_SB(0, 0), cB, voffB); PG8_STAGE(PG8_SB(0, 1), cB + hstep, voffB); PG8_STAGE(PG8_SA(0, 0), cA, voffA); PG8_STAGE(PG8_SA(0, 1), cA + hstep, voffA);
        if (wr == 1) PG8_BAR;
        PG8_WAIT_V(2); PG8_BAR;
        PG8_STAGE(PG8_SB(1, 0), cB + kstep, voffB); PG8_STAGE(PG8_SA(1, 0), cA + kstep, voffA); PG8_STAGE(PG8_SB(1, 1), cB + hstep + kstep, voffB);
        PG8_WAIT_V(6); PG8_BAR;
    } else {
        PG8_STAGE(PG8_SB(0, 0), cB, voffB); PG8_STAGE(PG8_SA(0, 0), cA, voffA); PG8_STAGE(PG8_SB(0, 1), cB + hstep, voffB); PG8_STAGE(PG8_SA(0, 1), cA + hstep, voffA);
        if (wr == 1) PG8_BAR;
        PG8_WAIT_V(4); PG8_BAR;
        PG8_STAGE(PG8_SB(1, 0), cB + kstep, voffB); PG8_STAGE(PG8_SA(1, 0), cA + kstep, voffA); PG8_STAGE(PG8_SB(1, 1), cB + hstep + kstep, voffB);
        PG8_WAIT_V(6); PG8_BAR;
    }
    for (;;) {
        const bool has_next = S.next(ui + 1, nxt);
        const char* nA = has_next ? (const char*)g.A + (size_t)nxt.pm * tstep : cA; const char* nB = has_next ? (const char*)g.Bt + (size_t)nxt.pn * tstep : cB;
        for (int t = 0; t < nt; t += 2) {
            const bool last = (t == nt - 2);
            const char* a1 = cA + (size_t)(t + 1) * kstep;
            const char* a2 = last ? nA : cA + (size_t)(t + 2) * kstep; const char* b2 = last ? nB : cB + (size_t)(t + 2) * kstep;
            const char* a3 = a2 + kstep; const char* b3 = b2 + kstep;
            if (last && has_next) S.a_ready(nxt);
            if constexpr (SP2) {
            PG8_LDB(B0, 0, 0); PG8_LDB(B1, 0, 1); PG8_SCHED; PG8_LDA(At, 0, 0); PG8_STAGE(PG8_SA(1, 1), a1 + hstep, voffA);
            PG8_WAIT_V(8); PG8_WAIT_L(0); PG8_BAR; PG8_MMA(0, 0, At, B0); PG8_MMA(0, 1, At, B1); PG8_BAR; PG8_SCHED;
            PG8_LDA(At, 0, 1); PG8_STAGE(PG8_SB(0, 0), b2, voffB); PG8_STAGE(PG8_SB(0, 1), b2 + hstep, voffB); PG8_STAGE(PG8_SA(0, 0), a2, voffA);
            PG8_WAIT_V(8); PG8_WAIT_L(0); PG8_BAR; PG8_MMA(1, 0, At, B0); PG8_MMA(1, 1, At, B1); PG8_BAR; PG8_SCHED;
            PG8_LDB(B0, 1, 0); PG8_LDB(B1, 1, 1); PG8_SCHED; PG8_LDA(At, 1, 0); PG8_STAGE(PG8_SA(0, 1), a2 + hstep, voffA);
            PG8_WAIT_V(8); PG8_WAIT_L(0); PG8_BAR; PG8_MMA(0, 0, At, B0); PG8_MMA(0, 1, At, B1); PG8_BAR; PG8_SCHED;
            PG8_LDA(At, 1, 1); PG8_STAGE(PG8_SB(1, 0), b3, voffB); PG8_STAGE(PG8_SB(1, 1), b3 + hstep, voffB); PG8_STAGE(PG8_SA(1, 0), a3, voffA);
            PG8_WAIT_V(8); PG8_WAIT_L(0); PG8_BAR; PG8_MMA(1, 0, At, B0); PG8_MMA(1, 1, At, B1); PG8_BAR; PG8_SCHED;
            } else {
            PG8_LDB(B0, 0, 0); PG8_SCHED; PG8_LDA(At, 0, 0); PG8_STAGE(PG8_SA(1, 1), a1 + hstep, voffA);
            PG8_WAIT_L(8); PG8_BAR; PG8_WAIT_L(0); PG8_MMA(0, 0, At, B0); PG8_BAR; PG8_SCHED;
            PG8_LDB(B1, 0, 1); PG8_STAGE(PG8_SB(0, 0), b2, voffB);
            PG8_BAR; PG8_WAIT_L(0); PG8_MMA(0, 1, At, B1); PG8_BAR;
            PG8_LDA(At, 0, 1); PG8_STAGE(PG8_SA(0, 0), a2, voffA);
            PG8_BAR; PG8_WAIT_L(0); PG8_MMA(1, 0, At, B0); PG8_BAR; PG8_SCHED;
            PG8_STAGE(PG8_SB(0, 1), b2 + hstep, voffB);
            PG8_WAIT_V(6); PG8_BAR; PG8_MMA(1, 1, At, B1); PG8_BAR;
            PG8_LDB(B0, 1, 0); PG8_SCHED; PG8_LDA(At, 1, 0); PG8_STAGE(PG8_SA(0, 1), a2 + hstep, voffA);
            PG8_WAIT_L(8); PG8_BAR; PG8_WAIT_L(0); PG8_MMA(0, 0, At, B0); PG8_BAR; PG8_SCHED;
            PG8_LDB(B1, 1, 1); PG8_STAGE(PG8_SB(1, 0), b3, voffB);
            PG8_BAR; PG8_WAIT_L(0); PG8_MMA(0, 1, At, B1); PG8_BAR;
            PG8_LDA(At, 1, 1); PG8_STAGE(PG8_SA(1, 0), a3, voffA);
            PG8_BAR; PG8_WAIT_L(0); PG8_MMA(1, 0, At, B0); PG8_BAR; PG8_SCHED;
            PG8_STAGE(PG8_SB(1, 1), b3 + hstep, voffB);
            PG8_WAIT_V(6); PG8_BAR; PG8_MMA(1, 1, At, B1); PG8_BAR;
            }
        }
        if constexpr (ALIGN_EPI) { if (wr == 0) PG8_BAR; }
        if constexpr (!Epi::AFTER_DRAIN) { E(acc, cur, wr, wc, fr, fq); S.done(cur); }
        if (!has_next) break;
#pragma unroll
        for (int a = 0; a < 2; ++a)
#pragma unroll
            for (int b = 0; b < 2; ++b)
#pragma unroll
                for (int m = 0; m < 4; ++m)
#pragma unroll
                    for (int n = 0; n < 2; ++n) acc[a][b][m][n] = (f32x4){0.f, 0.f, 0.f, 0.f};
        cur = nxt; cA = nA; cB = nB; ++ui;
        if constexpr (ALIGN_EPI) { if (wr == 1) PG8_BAR; }
    }
    PG8_WAIT_V(0);
    if constexpr (!ALIGN_EPI) { if (wr == 0) PG8_BAR; }
    PG8_BAR;
    if constexpr (Epi::AFTER_DRAIN) { E.fused(acc, cur, wr, wc, fr, fq, lds, wid, lane); S.done(cur); }
#undef PG8_SA
#undef PG8_SB
#undef PG8_STAGE
#undef PG8_LDA
#undef PG8_LDB
#undef PG8_MMA
#undef PG8_WAIT_V
#undef PG8_WAIT_L
#undef PG8_BAR
#undef PG8_SCHED
}
}
#define GAS __attribute__((address_space(1)))
#define LAS __attribute__((address_space(3)))
typedef unsigned short bf16;
typedef unsigned v4u __attribute__((ext_vector_type(4)));
typedef float f32x4 __attribute__((ext_vector_type(4)));
typedef short bf16x8 __attribute__((ext_vector_type(8)));
typedef GAS unsigned gu32;
typedef GAS unsigned long long gu64;
#define RLX_AGENT __ATOMIC_RELAXED, __HIP_MEMORY_SCOPE_AGENT
#define LDS_WAIT() asm volatile("s_waitcnt lgkmcnt(0)" ::: "memory")
#define VM_WAIT() asm volatile("s_waitcnt vmcnt(0)" ::: "memory")
__device__ __forceinline__ unsigned long long rt() { return __builtin_amdgcn_s_memrealtime(); }
__device__ __forceinline__ unsigned f2bf(float f) { unsigned u = __builtin_bit_cast(unsigned, f); return (u + 0x7fffu + ((u >> 16) & 1u)) >> 16; }
__device__ __forceinline__ unsigned pk2(float lo, float hi) { return f2bf(lo) | (f2bf(hi) << 16); }
#define XB_TMO      128
#define XB_XCNT(j)  (256  + 64 * (j))
#define XB_XSUB(j)  (1280 + 64 * (j))
#define XB_XGEN(j)  (2304 + 64 * (j))
#define XB_TOP      3328
#define XB_TOPGEN   3392
#define XCD_BAR_WORDS 3456
#define XB_SPIN_CAP (1u << 18)

__device__ __forceinline__ unsigned xb_ld(unsigned* p)              { return __hip_atomic_load(p, __ATOMIC_RELAXED, __HIP_MEMORY_SCOPE_AGENT); }
__device__ __forceinline__ unsigned xb_add(unsigned* p, unsigned v) { return __hip_atomic_fetch_add(p, v, __ATOMIC_RELAXED, __HIP_MEMORY_SCOPE_AGENT); }
__device__ __forceinline__ unsigned xb_xcc_id() { return (unsigned)__builtin_amdgcn_s_getreg((3 << 11) | 20) & 0xFu; }
#define XB_SPIN(cond, bar) do { unsigned _sp = 0; while (cond) { __builtin_amdgcn_s_sleep(1); \
    if ((++_sp & 255u) == 0u) { if (xb_ld(&(bar)[XB_TMO])) break; if (_sp > XB_SPIN_CAP) { atomicAdd(&(bar)[XB_TMO], 1u); break; } } } } while (0)

struct XcdBarrier {
    unsigned* bar; unsigned x;
    volatile LAS unsigned* st;
};

__device__ __forceinline__ XcdBarrier xcd_barrier_post(unsigned* bar, volatile LAS unsigned* st) {
    XcdBarrier b; b.bar = bar; b.x = xb_xcc_id(); b.st = st;
    if (threadIdx.x == 0) (void)xb_add(&bar[XB_XCNT(b.x)], 1u);
    return b;
}
__device__ __forceinline__ void xcd_barrier_complete(unsigned* bar, unsigned x, unsigned& nloc, unsigned& nx) {
    const unsigned G = gridDim.x * gridDim.y * gridDim.z;
    unsigned sum, cnt, mine, sp = 0u;
    for (;;) {
        sum = 0u; cnt = 0u; mine = 0u;
#pragma unroll
        for (unsigned j = 0; j < 16; ++j) { const unsigned c = xb_ld(&bar[XB_XCNT(j)]); sum += c; cnt += (c > 0u) ? 1u : 0u; mine = (j == x) ? c : mine; }
        if (sum == G) break;
        __builtin_amdgcn_s_sleep(1);
        if ((++sp & 255u) == 0u) { if (xb_ld(&bar[XB_TMO])) break; if (sp > XB_SPIN_CAP) { atomicAdd(&bar[XB_TMO], 1u); break; } }
    }
    nloc = mine > 0u ? mine : 1u; nx = cnt > 0u ? cnt : 1u;
}

__device__ __forceinline__ void xcd_barrier(const XcdBarrier& b) {
    asm volatile("s_waitcnt vmcnt(0)" ::: "memory");
    __syncthreads();
    if (threadIdx.x == 0) {
        unsigned* bar = b.bar;
        __builtin_amdgcn_s_waitcnt(0);
        unsigned nloc = b.st[0], nx = b.st[1];
        if (nloc == 0u) { xcd_barrier_complete(bar, b.x, nloc, nx); b.st[0] = nloc; b.st[1] = nx; }
        const unsigned old = xb_add(&bar[XB_XSUB(b.x)], 1u);
        const unsigned gen = old / nloc;
        if (old + 1u == (gen + 1u) * nloc) {
            __builtin_amdgcn_fence(__ATOMIC_RELEASE, "agent");
            asm volatile("s_waitcnt vmcnt(0)" ::: "memory");
            const unsigned og = xb_add(&bar[XB_TOP], 1u);
            const unsigned tg = og / nx;
            if (og + 1u == (tg + 1u) * nx) xb_add(&bar[XB_TOPGEN], 1u);
            else XB_SPIN(xb_ld(&bar[XB_TOPGEN]) == tg, bar);
            __builtin_amdgcn_fence(__ATOMIC_ACQUIRE, "agent");
            xb_add(&bar[XB_XGEN(b.x)], 1u);
            asm volatile("s_waitcnt vmcnt(0)" ::: "memory");
        } else {
            XB_SPIN(xb_ld(&bar[XB_XGEN(b.x)]) == gen, bar);
            __builtin_amdgcn_fence(__ATOMIC_ACQUIRE, "agent");
            asm volatile("s_waitcnt vmcnt(0)" ::: "memory");
        }
    }
    __syncthreads();
}

constexpr size_t MiB = 1u << 20;
constexpr size_t WS_CTL = 0, CTL_ZERO_BYTES = 64 * 1024;
constexpr size_t WS_GW = 1 * MiB;
constexpr size_t WS_ROPE = 2 * MiB;
constexpr size_t WS_LF = 3 * MiB;
constexpr size_t WS_C = 4 * MiB;
constexpr size_t WS_QN2 = 5 * MiB, WS_KN2 = 5 * MiB + 64 * 1024;
constexpr size_t WS_STATS = 6 * MiB;
constexpr size_t WS_WIN = 10 * MiB;
constexpr size_t WS_WOUT = 15 * MiB;
constexpr size_t WS_WQ = 17 * MiB;
constexpr size_t WS_SUBK = 21 * MiB;
constexpr size_t WS_EU = 22 * MiB, WS_EV = 54 * MiB;
constexpr size_t WS_XB = 86 * MiB;
constexpr size_t WS_FQ = 150 * MiB, WS_FKT = 182 * MiB, WS_FVT = 214 * MiB, WS_SQ = 246 * MiB, WS_SKT = 278 * MiB, WS_SVT = 286 * MiB;
constexpr size_t WS_Q = 150 * MiB;
constexpr size_t WS_ATTN = 294 * MiB;
constexpr size_t WS_IDX = 294 * MiB, WS_G = 310 * MiB;
constexpr size_t WS_END = 358 * MiB;
constexpr size_t WS_MR = 5 * MiB + 128 * 1024;
constexpr size_t WS_STATS2 = 10 * MiB;
constexpr size_t WS_X1B = 86 * MiB;
constexpr size_t WS_HP = 150 * MiB;
constexpr size_t WS_V2 = 214 * MiB;
constexpr size_t EXP_SLICE_BYTES = (size_t)NEXP * 128;
constexpr float UQ4 = 95.5f;
constexpr float U_QS = 768.f, X_QS = 20.f, VQ4 = 5.02f;
constexpr size_t WS_XQ = 326 * MiB;
constexpr float SQ_X = 24.f, SQ_A = 24.f, SQ_WIN = 768.f, SQ_WOUT = 1280.f, SQ_Y = 24.f, SQ_WQ = 896.f;
constexpr size_t WS_W16 = 358 * MiB;
constexpr size_t WS_X1Q = 326 * MiB;
constexpr int CW_QU = 8192, CW_QV = 8192 + 1024;
#ifndef EXP_PRE_ROWS
#define EXP_PRE_ROWS 16384
#endif
constexpr int EXP_PRE = EXP_PRE_ROWS;
#ifndef V_PRE_ROWS
#define V_PRE_ROWS 6144
#endif
constexpr int V_PRE = V_PRE_ROWS;
#ifndef V_P4_ROWS
#define V_P4_ROWS 8192
#endif
constexpr int V_P4 = V_P4_ROWS;
constexpr int EXP_SPLIT = 16384;
constexpr int CW_BAR = 1024;
static_assert((CW_BAR + XCD_BAR_WORDS) * 4 <= (int)CTL_ZERO_BYTES, "ctl");

constexpr int NWAVES = 8;
constexpr int RING_BYTES = 131072, MISC_OFF = RING_BYTES + 320, LDS_BYTES = 147456;

struct Frame {
    LAS unsigned char* lds;
    volatile LAS unsigned* MISC;
    gu32* ctl;
    int tid, lane, wave, vcu, G;
    const float* in[13]; float* out; unsigned char* ws;
};

__device__ __forceinline__ float wave_sum(float v) {
#pragma unroll
    for (int o = 1; o < 64; o <<= 1) v += __shfl_xor(v, o);
    return v;
}
__device__ __forceinline__ float wave_max(float v) {
#pragma unroll
    for (int o = 1; o < 64; o <<= 1) v = fmaxf(v, __shfl_xor(v, o));
    return v;
}

typedef unsigned u32x2 __attribute__((ext_vector_type(2)));
__device__ __forceinline__ unsigned q8x4(float a, float b, float c, float d_) {
    const int ia = (int)fminf(fmaxf(rintf(a), -127.f), 127.f), ib = (int)fminf(fmaxf(rintf(b), -127.f), 127.f), ic = (int)fminf(fmaxf(rintf(c), -127.f), 127.f), id = (int)fminf(fmaxf(rintf(d_), -127.f), 127.f);
    return ((unsigned)ia & 0xFFu) | (((unsigned)ib & 0xFFu) << 8) | (((unsigned)ic & 0xFFu) << 16) | ((unsigned)id << 24);
}
__device__ __forceinline__ int win_src_col(int pc) {
    if (pc < 1536) return pc;
    int r, base;
    if (pc < 2048) { r = pc - 1536; base = OFF_SQ; }
    else if (pc < 2176) { r = pc - 2048; base = OFF_SK; }
    else return OFF_SV + (pc - 2176);
    const int hd = r >> 6, p = r & 63;
    const int g = p >> 5, fq = (p >> 3) & 3, n = (p >> 2) & 1, e = p & 3;
    return base + hd * 64 + 16 * g + 4 * fq + e + 32 * n;
}
template <bool I8, class SrcCol, class Scale>
__device__ __forceinline__ void p0_transpose_item(const float* W, int ldw, int K, bf16* WT, LAS float* scr, int nblk, int item, int lane, SrcCol sc, Scale sk) {
    const int kb = item / nblk, nb = item % nblk, k0 = 64 * kb, n0 = 32 * nb;
    const int scol = sc(n0 + (lane & 31));
#pragma unroll 8
    for (int i = 0; i < 32; ++i) { const int kk = 2 * i + (lane >> 5); scr[kk * 33 + (lane & 31)] = W[(size_t)(k0 + kk) * ldw + scol] * sk(k0 + kk); }
    LDS_WAIT(); asm volatile("" ::: "memory");
    const int c = lane & 7;
#pragma unroll
    for (int j = 0; j < 4; ++j) { const int n = (lane >> 3) + 8 * j; const LAS float* s = scr + (8 * c) * 33 + n;
        if constexpr (I8) { u32x2 o; o.x = q8x4(s[0 * 33], s[1 * 33], s[2 * 33], s[3 * 33]); o.y = q8x4(s[4 * 33], s[5 * 33], s[6 * 33], s[7 * 33]);
            *(GAS u32x2*)((unsigned char*)WT + (size_t)(n0 + n) * K + k0 + 8 * c) = o; }
        else { v4u o; o.x = pk2(s[0 * 33], s[1 * 33]); o.y = pk2(s[2 * 33], s[3 * 33]); o.z = pk2(s[4 * 33], s[5 * 33]); o.w = pk2(s[6 * 33], s[7 * 33]);
            *(GAS v4u*)(WT + (size_t)(n0 + n) * K + k0 + 8 * c) = o; } }
    LDS_WAIT(); asm volatile("" ::: "memory");
}
__device__ __forceinline__ float log_sigmoid(float z) { return fminf(z, 0.f) - log1pf(__expf(-fabsf(z))); }

__device__ __forceinline__ void p0_prologue(Frame& F) {
    LAS float* scr = (LAS float*)(F.lds + F.wave * 16384);
    const int gw = F.vcu * NWAVES + F.wave, NGW = F.G * NWAVES, lane = F.lane;
    const float* x = F.in[0]; const float* w_in = F.in[1]; const float* b_forget = F.in[2]; const float* w_out = F.in[4]; const float* ln1_g = F.in[5];
    const float* w_query = F.in[7]; const float* sub_keys = F.in[8];
    bf16* WIN = (bf16*)(F.ws + WS_WIN); bf16* WOUT = (bf16*)(F.ws + WS_WOUT); bf16* WQ = (bf16*)(F.ws + WS_WQ); bf16* SUBK = (bf16*)(F.ws + WS_SUBK);
    bf16* XB = (bf16*)(F.ws + WS_XB);
    float2* ROPE = (float2*)(F.ws + WS_ROPE); float* LF = (float*)(F.ws + WS_LF);
    constexpr int I_IN = 16 * (NPHYS / 32), I_OUT = 16 * 32, I_Q = 16 * 64;
    for (int it = gw; it < I_IN + I_OUT + I_Q; it += NGW) {
        if (it < I_IN) p0_transpose_item<true>(w_in, IN_COLS, 1024, WIN, scr, NPHYS / 32, it, lane, [](int pc) { return win_src_col(pc); }, [](int) { return SQ_WIN; });
        else if (it < I_IN + I_OUT) p0_transpose_item<true>(w_out, 1024, 1024, WOUT, scr, 32, it - I_IN, lane, [](int pc) { return pc; }, [](int) { return SQ_WOUT; });
        else p0_transpose_item<true>(w_query, QCOLS, 1024, WQ, scr, 64, it - I_IN - I_OUT, lane, [](int pc) { return pc; }, [=](int k) { return ln1_g[k] * SQ_WQ; });
    }
    for (int it = gw; it < (PEER_H * 2 * NKEYS * PEER_HALF) / 512; it += NGW) {
        const size_t o = (size_t)it * 512 + lane * 8; const f32x4 a = *(const GAS f32x4*)(sub_keys + o), b = *(const GAS f32x4*)(sub_keys + o + 4);
        v4u w; w.x = pk2(a.x, a.y); w.y = pk2(a.z, a.w); w.z = pk2(b.x, b.y); w.w = pk2(b.z, b.w); *(GAS v4u*)(SUBK + o) = w;
    }
    for (int it = gw; it < (SEQ * 32) / 64; it += NGW) {
        const int e = it * 64 + lane, pos = e >> 5, i = e & 31;
        const float inv = powf(10000.0f, -(float)i / 32.0f), ang = (float)pos * inv;
        double rev = (double)ang * 0.15915494309189535; rev -= floor(rev);
        const float r = (float)rev;
        ROPE[e] = make_float2(__builtin_amdgcn_cosf(r), __builtin_amdgcn_sinf(r));
    }
    {
        float wff[16][8];
#pragma unroll
        for (int j = 0; j < 2; ++j)
#pragma unroll
            for (int e = 0; e < 8; ++e) { const float* wr_ = w_in + (size_t)(512 * j + 8 * lane + e) * IN_COLS + OFF_FF; const f32x4 a = *(const GAS f32x4*)wr_, b = *(const GAS f32x4*)(wr_ + 4);
                wff[j * 8 + e][0] = a.x; wff[j * 8 + e][1] = a.y; wff[j * 8 + e][2] = a.z; wff[j * 8 + e][3] = a.w; wff[j * 8 + e][4] = b.x; wff[j * 8 + e][5] = b.y; wff[j * 8 + e][6] = b.z; wff[j * 8 + e][7] = b.w; }
        const float bfl = b_forget[lane & 7];
        for (int m = gw; m < T; m += NGW) {
            const float* src = x + (size_t)m * D_MODEL; bf16* dst = XB + (size_t)m * D_MODEL;
            float xv[16];
#pragma unroll
            for (int j = 0; j < 2; ++j) { const f32x4 a = __builtin_nontemporal_load((const GAS f32x4*)(src + 512 * j + 8 * lane)), b = __builtin_nontemporal_load((const GAS f32x4*)(src + 512 * j + 8 * lane + 4));
                xv[8 * j + 0] = a.x; xv[8 * j + 1] = a.y; xv[8 * j + 2] = a.z; xv[8 * j + 3] = a.w; xv[8 * j + 4] = b.x; xv[8 * j + 5] = b.y; xv[8 * j + 6] = b.z; xv[8 * j + 7] = b.w;
                v4u w; w.x = pk2(a.x, a.y); w.y = pk2(a.z, a.w); w.z = pk2(b.x, b.y); w.w = pk2(b.z, b.w); __builtin_nontemporal_store(w, (GAS v4u*)(dst + 512 * j + 8 * lane));
                u32x2 wq; wq.x = q8x4(a.x * SQ_X, a.y * SQ_X, a.z * SQ_X, a.w * SQ_X); wq.y = q8x4(b.x * SQ_X, b.y * SQ_X, b.z * SQ_X, b.w * SQ_X);
                __builtin_nontemporal_store(wq, (GAS u32x2*)(F.ws + WS_XQ + (size_t)m * D_MODEL + 512 * j + 8 * lane)); }
            float acc[8];
#pragma unroll
            for (int h = 0; h < 8; ++h) { float s = 0.f;
#pragma unroll
                for (int d = 0; d < 16; ++d) s = fmaf(xv[d], wff[d][h], s);
                acc[h] = wave_sum(s); }
            float mine = acc[0];
#pragma unroll
            for (int h = 1; h < 8; ++h) mine = ((lane & 7) == h) ? acc[h] : mine;
            if (lane < 8) LF[(size_t)m * 8 + lane] = log_sigmoid(mine + bfl);
        }
    }
}

__device__ __forceinline__ pg8::f32x4 iacc(pg8::f32x4 a, float s) { typedef int v4i_ __attribute__((ext_vector_type(4))); const v4i_ i = __builtin_bit_cast(v4i_, a); return (pg8::f32x4){(float)i[0] * s, (float)i[1] * s, (float)i[2] * s, (float)i[3] * s}; }
struct EpiInProj {
    static constexpr bool PERM = true, AFTER_DRAIN = false;
    static constexpr float SI = 1.f / (SQ_X * SQ_WIN);
    bf16 *fq, *fkt, *fvt, *sq, *skt, *svt; const float2* rope; float *qn2, *kn2;
    static __device__ __forceinline__ size_t tile_off(int nh, int t, int head) { const int b = t >> 12, s = t & 4095; return ((size_t)(b * nh + head) * 64 + (s >> 6)) * 8192; }
    __device__ __forceinline__ void operator()(const pg8::f32x4 (&acc)[2][2][4][2], const pg8::Unit& u, int wr, int wc, int fr, int fq_) const {
        const int pn = u.pn, g = wc & 1, hsub = wc >> 1;
        const int trow0 = u.pm * 256 + wr * 64 + fr;
        const bool lane0 = (fr == 0) && (fq_ == 0);
#pragma unroll
        for (int ai = 0; ai < 2; ++ai)
#pragma unroll
            for (int bj = 0; bj < 2; ++bj) {
                const int blk64 = (u.pm * 256 + ai * 128 + wr * 64) >> 6;
                if (pn < 6) {
                    const int head = 4 * (pn & 1) + 2 * bj + hsub;
                    float nrm = 0.f;
#pragma unroll
                    for (int m = 0; m < 4; ++m) {
                        const int t = trow0 + ai * 128 + m * 16;
                        pg8::f32x4 v0 = iacc(acc[ai][bj][m][0], SI), v1 = iacc(acc[ai][bj][m][1], SI);
                        if (pn < 2) { v0 = v0 * C2; v1 = v1 * C2; }
                        v4u w; w.x = pg8::cvt_pk_bf16(v0[0], v0[1]); w.y = pg8::cvt_pk_bf16(v0[2], v0[3]); w.z = pg8::cvt_pk_bf16(v1[0], v1[1]); w.w = pg8::cvt_pk_bf16(v1[2], v1[3]);
                        if (pn < 4) { float ss = (v0[0] * v0[0] + v0[1] * v0[1]) + (v0[2] * v0[2] + v0[3] * v0[3]) + (v1[0] * v1[0] + v1[1] * v1[1]) + (v1[2] * v1[2] + v1[3] * v1[3]);
                            ss += __shfl_xor(ss, 16); ss += __shfl_xor(ss, 32); nrm = fmaxf(nrm, ss); }
                        if (pn < 2) *(GAS v4u*)(fq + (size_t)t * 512 + head * 64 + 32 * g + 8 * fq_) = w;
                        else if (pn < 4) *(GAS v4u*)((GAS unsigned char*)fkt + tile_off(8, t, head) + (size_t)((4 * g + fq_) * 64 + (t & 63)) * 16) = w;
                        else *(GAS v4u*)((GAS unsigned char*)fvt + tile_off(8, t, head) + (size_t)(g * 4 + ((t & 63) >> 4)) * 1024 + (t & 15) * 64 + fq_ * 16) = w;
                    }
                    if (pn < 4) {
                        nrm = fmaxf(nrm, __shfl_xor(nrm, 1)); nrm = fmaxf(nrm, __shfl_xor(nrm, 2)); nrm = fmaxf(nrm, __shfl_xor(nrm, 4)); nrm = fmaxf(nrm, __shfl_xor(nrm, 8));
                        if (lane0) (pn < 2 ? qn2 : kn2)[(blk64 * 8 + head) * 2 + g] = nrm;
                    }
                } else if (pn < 8 || bj == 0) {
                    const int head = (pn < 8) ? 4 * (pn & 1) + 2 * bj + hsub : hsub;
                    const int i0 = 16 * g + 4 * fq_;
#pragma unroll
                    for (int m = 0; m < 4; ++m) {
                        const int t = trow0 + ai * 128 + m * 16, pos = t & 4095;
                        const pg8::f32x4 x1 = iacc(acc[ai][bj][m][0], SI), x2 = iacc(acc[ai][bj][m][1], SI);
                        const f32x4 cs01 = *(const GAS f32x4*)(rope + pos * 32 + i0), cs23 = *(const GAS f32x4*)(rope + pos * 32 + i0 + 2);
                        float o1[4], o2[4];
                        o1[0] = x1[0] * cs01.x - x2[0] * cs01.y; o2[0] = x2[0] * cs01.x + x1[0] * cs01.y;
                        o1[1] = x1[1] * cs01.z - x2[1] * cs01.w; o2[1] = x2[1] * cs01.z + x1[1] * cs01.w;
                        o1[2] = x1[2] * cs23.x - x2[2] * cs23.y; o2[2] = x2[2] * cs23.x + x1[2] * cs23.y;
                        o1[3] = x1[3] * cs23.z - x2[3] * cs23.w; o2[3] = x2[3] * cs23.z + x1[3] * cs23.w;
                        if (pn < 8) {
#pragma unroll
                            for (int e = 0; e < 4; ++e) { o1[e] *= C2; o2[e] *= C2; }
                        }
                        u32x2 w1, w2; w1.x = pg8::cvt_pk_bf16(o1[0], o1[1]); w1.y = pg8::cvt_pk_bf16(o1[2], o1[3]); w2.x = pg8::cvt_pk_bf16(o2[0], o2[1]); w2.y = pg8::cvt_pk_bf16(o2[2], o2[3]);
                        if (pn < 8) { bf16* p = sq + (size_t)t * 512 + head * 64 + i0; *(GAS u32x2*)p = w1; *(GAS u32x2*)(p + 32) = w2; }
                        else { GAS unsigned char* p = (GAS unsigned char*)skt + tile_off(2, t, head) + (size_t)((2 * g + (fq_ >> 1)) * 64 + (t & 63)) * 16 + (fq_ & 1) * 8;
                            *(GAS u32x2*)p = w1; *(GAS u32x2*)(p + 4 * 1024) = w2; }
                    }
                } else {
                    const int head = hsub;
#pragma unroll
                    for (int m = 0; m < 4; ++m) {
                        const int t = trow0 + ai * 128 + m * 16;
                        const pg8::f32x4 v0 = iacc(acc[ai][bj][m][0], SI), v1 = iacc(acc[ai][bj][m][1], SI);
                        v4u w; w.x = pg8::cvt_pk_bf16(v0[0], v0[1]); w.y = pg8::cvt_pk_bf16(v0[2], v0[3]); w.z = pg8::cvt_pk_bf16(v1[0], v1[1]); w.w = pg8::cvt_pk_bf16(v1[2], v1[3]);
                        *(GAS v4u*)((GAS unsigned char*)svt + tile_off(2, t, head) + (size_t)(g * 4 + ((t & 63) >> 4)) * 1024 + (t & 15) * 64 + fq_ * 16) = w;
                    }
                }
            }
    }
};

__device__ __forceinline__ void convert_experts(Frame& F, int w, int nw, int r0, int r1) {
    const float* eu = F.in[9]; const float* ev = F.in[10]; const int lane = F.lane;
    for (int m0 = r0 + 4 * w; m0 < r1; m0 += 4 * nw) {
        const bool isu = m0 < NEXP; const int e0 = m0 % NEXP;
        const float* src = (isu ? eu : ev) + (size_t)e0 * D_MODEL; unsigned char* dst = F.ws + (isu ? WS_EU : WS_EV); const float sc = isu ? UQ4 : VQ4;
        f32x4 va[4][2], vb[4][2];
#pragma unroll
        for (int r = 0; r < 4; ++r)
#pragma unroll
            for (int j = 0; j < 2; ++j) { va[r][j] = *(const GAS f32x4*)(src + r * D_MODEL + 512 * j + 8 * lane); vb[r][j] = *(const GAS f32x4*)(src + r * D_MODEL + 512 * j + 8 * lane + 4); }
#pragma unroll
        for (int r = 0; r < 4; ++r)
#pragma unroll
            for (int j = 0; j < 2; ++j) {
                unsigned wd4 = 0;
#pragma unroll
                for (int e = 0; e < 4; ++e) {
                    const unsigned nl = (unsigned)fminf(fmaxf(rintf(va[r][j][e] * sc + 7.5f), 0.f), 15.f), nh = (unsigned)fminf(fmaxf(rintf(vb[r][j][e] * sc + 7.5f), 0.f), 15.f);
                    wd4 |= ((isu ? (nl ^ 8u) : nl) | ((nh ^ 8u) << 4)) << (8 * e);
                }
                *(GAS unsigned*)(dst + (size_t)(2 * j + (lane >> 5)) * EXP_SLICE_BYTES + (size_t)(e0 + r) * 128 + 4 * (lane & 31)) = wd4;
            }
    }
}
__device__ __forceinline__ void p1_slack_jobs(Frame& F, int sb, int nsb) {
    const float* LF = (const float*)(F.ws + WS_LF); float* C = (float*)(F.ws + WS_C);
    LAS float* red = (LAS float*)F.lds;
    const int lane = F.lane;
    for (int job = sb; job < BATCH * FOX_H; job += nsb) {
        const int b = job >> 3, h = job & 7;
        float v[8]; float run = 0.f;
#pragma unroll
        for (int i = 0; i < 8; ++i) { run += LF[(size_t)(b * SEQ + F.tid * 8 + i) * 8 + h]; v[i] = run; }
        float inc = run;
#pragma unroll
        for (int o = 1; o < 64; o <<= 1) { const float n = __shfl_up(inc, o); if (lane >= o) inc += n; }
        __syncthreads();
        if (lane == 63) red[F.wave] = inc;
        __syncthreads();
        float base = inc - run;
        for (int w = 0; w < F.wave; ++w) base += red[w];
#pragma unroll
        for (int i = 0; i < 8; ++i) C[(size_t)job * SEQ + F.tid * 8 + i] = (base + v[i]) * LOG2E;
    }
    const int w = sb * NWAVES + F.wave, nw = nsb * NWAVES;
    {
        const unsigned char* WQ = F.ws + WS_WQ;
        float* GW = (float*)(F.ws + WS_GW);
        for (int n = w; n < QCOLS; n += nw) {
            const v4u a = *(const GAS v4u*)(WQ + (size_t)n * 1024 + 16 * lane);
            int si = 0;
#pragma unroll
            for (int i = 0; i < 4; ++i) si = __builtin_amdgcn_sdot4((int)a[i], 0x01010101, si, false);
            const float s = wave_sum((float)si);
            if (lane == 0) GW[n] = s * (1.f / SQ_WQ);
        }
    }
    for (int c64 = sb; c64 < QCOLS / 64; c64 += nsb) {
        const float* w_query = F.in[7]; const float* ln1_b = F.in[6]; float* BW = (float*)(F.ws + WS_GW) + QCOLS;
        const int n = c64 * 64 + lane; float s = 0.f;
        for (int k0 = F.wave * 128; k0 < F.wave * 128 + 128; k0 += 16) {
            float wv_[16];
#pragma unroll
            for (int i = 0; i < 16; ++i) wv_[i] = w_query[(size_t)(k0 + i) * QCOLS + n];
#pragma unroll
            for (int i = 0; i < 16; ++i) s = fmaf(ln1_b[k0 + i], wv_[i], s);
        }
        __syncthreads();
        red[F.wave * 64 + lane] = s;
        __syncthreads();
        if (F.wave == 0) { float t_ = 0.f;
#pragma unroll
            for (int w8 = 0; w8 < 8; ++w8) t_ += red[w8 * 64 + lane];
            BW[n] = t_; }
    }
    convert_experts(F, w, nw, 0, EXP_PRE);
}

namespace att {
typedef float f32x16 __attribute__((ext_vector_type(16)));
typedef short s16x4 __attribute__((ext_vector_type(4)));
constexpr float DEFER_THR = 8.f;
constexpr int LDS_K = 0, LDS_V = 16384, LDS_H2 = 32768, LDS_WS = 65536, LDS_OST = LDS_WS + 8 * 256, LDS_TOTAL = LDS_OST + 8 * 2048;
static_assert(LDS_TOTAL <= RING_BYTES, "attention LDS");
__device__ __forceinline__ int crow(int r, int hi) { return (r & 3) + 8 * (r >> 2) + 4 * hi; }
__device__ __forceinline__ float max3f(float a, float b, float c) { float r; asm("v_max3_f32 %0, %1, %2, %3" : "=v"(r) : "v"(a), "v"(b), "v"(c)); return r; }
__device__ __forceinline__ unsigned cvtpk(float lo, float hi) { unsigned r; asm("v_cvt_pk_bf16_f32 %0, %1, %2" : "=v"(r) : "v"(lo), "v"(hi)); return r; }
__device__ __forceinline__ float rowmax(const f32x16& p0, const f32x16& p1) {
    float a = max3f(p0[0], p0[1], p1[0]), b = max3f(p0[2], p0[3], p1[1]); a = max3f(a, p1[2], p1[3]);
#pragma unroll
    for (int r = 4; r < 16; r += 4) { a = max3f(a, p0[r], p0[r + 1]); b = max3f(b, p0[r + 2], p0[r + 3]); a = max3f(a, p1[r], p1[r + 1]); b = max3f(b, p1[r + 2], p1[r + 3]); }
    const float m = fmaxf(a, b);
    auto rr = __builtin_amdgcn_permlane32_swap(__float_as_uint(m), __float_as_uint(m), false, false);
    return fmaxf(__uint_as_float(rr[0]), __uint_as_float(rr[1]));
}
__device__ __forceinline__ void qkt(f32x16& p0, f32x16& p1, const LAS unsigned char* Kslot, const bf16x8* qr, int r32, int hi) {
    const LAS unsigned char* kb = Kslot + hi * 1024 + r32 * 16;
#pragma unroll
    for (int d0 = 0; d0 < 4; ++d0) {
        const bf16x8 b0 = *(const LAS bf16x8*)(kb + d0 * 2048), b1 = *(const LAS bf16x8*)(kb + d0 * 2048 + 512);
        p0 = __builtin_amdgcn_mfma_f32_32x32x16_bf16(b0, qr[d0], p0, 0, 0, 0);
        p1 = __builtin_amdgcn_mfma_f32_32x32x16_bf16(b1, qr[d0], p1, 0, 0, 0);
    }
}
__device__ __forceinline__ void pv(f32x16* o, int vb, bf16x8 pa0, bf16x8 pa1, bf16x8 pa2, bf16x8 pa3) {
#pragma unroll
    for (int d0 = 0; d0 < 2; ++d0) {
        s16x4 lo[4], hi[4];
#pragma unroll
        for (int ks = 0; ks < 4; ++ks) {
            asm volatile("ds_read_b64_tr_b16 %0,%1 offset:%c2" : "=&v"(lo[ks]) : "v"(vb), "i"(d0 * 4096 + ks * 1024) : "memory");
            asm volatile("ds_read_b64_tr_b16 %0,%1 offset:%c2" : "=&v"(hi[ks]) : "v"(vb), "i"(d0 * 4096 + ks * 1024 + 512) : "memory");
        }
        asm volatile("s_waitcnt lgkmcnt(0)" ::: "memory"); __builtin_amdgcn_sched_barrier(0);
#define ATT_PK(k) (bf16x8){lo[k][0], lo[k][1], lo[k][2], lo[k][3], hi[k][0], hi[k][1], hi[k][2], hi[k][3]}
        o[d0] = __builtin_amdgcn_mfma_f32_32x32x16_bf16(pa0, ATT_PK(0), o[d0], 0, 0, 0);
        o[d0] = __builtin_amdgcn_mfma_f32_32x32x16_bf16(pa1, ATT_PK(1), o[d0], 0, 0, 0);
        o[d0] = __builtin_amdgcn_mfma_f32_32x32x16_bf16(pa2, ATT_PK(2), o[d0], 0, 0, 0);
        o[d0] = __builtin_amdgcn_mfma_f32_32x32x16_bf16(pa3, ATT_PK(3), o[d0], 0, 0, 0);
#undef ATT_PK
    }
}

template <int KIND>
__device__ __forceinline__ void attn_unit(Frame& F, int b, int h, int qb) {
    const int tid = F.tid, lane = F.lane, r32 = lane & 31, hi = lane >> 5, wid = F.wave;
    const int hh = wid >> 2;
    const int q0 = (KIND == 0) ? qb * 128 : qb * 64, w0 = (KIND == 0) ? q0 + 32 * (hh ? 3 - (wid & 3) : (wid & 3)) : q0 + (wid >> 2) * 32, myq = w0 + r32;
    const int hq = (KIND == 0) ? 2 * h + hh : h * 4 + (wid & 3);
    const bf16* Qg = (const bf16*)(F.ws + (KIND == 0 ? WS_FQ : WS_SQ)) + (size_t)(b * SEQ + myq) * 512 + hq * 64;
    const int kvh = (KIND == 0) ? 2 * h : h, nkv = (KIND == 0) ? 8 : 2;
    const unsigned char* KT = F.ws + (KIND == 0 ? WS_FKT : WS_SKT) + (size_t)(b * nkv + kvh) * 64 * 8192;
    const unsigned char* VT = F.ws + (KIND == 0 ? WS_FVT : WS_SVT) + (size_t)(b * nkv + kvh) * 64 * 8192;
    const float* Cg = (const float*)(F.ws + WS_C) + (size_t)(b * 8 + hq) * SEQ;
    LAS unsigned char* lds = F.lds;
    LAS float* wsf = (LAS float*)(lds + LDS_WS) + wid * 64;
#define ATT_LOAD(j, buf) do { \
        __builtin_amdgcn_global_load_lds((const unsigned*)(KT + (size_t)(j) * 8192 + tid * 16), (LAS unsigned*)(lds + LDS_K + (buf) * 8192 + wid * 1024), 16, 0, 0); \
        __builtin_amdgcn_global_load_lds((const unsigned*)(VT + (size_t)(j) * 8192 + tid * 16), (LAS unsigned*)(lds + LDS_V + (buf) * 8192 + wid * 1024), 16, 0, 0); \
        if (KIND == 0) { \
        __builtin_amdgcn_global_load_lds((const unsigned*)(KT + (size_t)(64 + (j)) * 8192 + tid * 16), (LAS unsigned*)(lds + LDS_H2 + LDS_K + (buf) * 8192 + wid * 1024), 16, 0, 0); \
        __builtin_amdgcn_global_load_lds((const unsigned*)(VT + (size_t)(64 + (j)) * 8192 + tid * 16), (LAS unsigned*)(lds + LDS_H2 + LDS_V + (buf) * 8192 + wid * 1024), 16, 0, 0); } } while (0)
    const int jhi = (KIND == 0) ? qb * 2 + 1 : qb; int jlo; float cref = 0.f, cw0 = 0.f, TH = 0.f;
    ATT_LOAD(jhi, 0);
    bf16x8 qr[4];
#pragma unroll
    for (int d0 = 0; d0 < 4; ++d0) qr[d0] = *(const GAS bf16x8*)(Qg + d0 * 16 + hi * 8);
    if (KIND == 0) {
        const float* QN2 = (const float*)(F.ws + WS_QN2); const float* KN2 = (const float*)(F.ws + WS_KN2);
        int jl2[2];
#pragma unroll
        for (int s = 0; s < 2; ++s) {
            const int hs = 2 * h + s;
            const float* Cs = (const float*)(F.ws + WS_C) + (size_t)(b * 8 + hs) * SEQ;
            const int kblk = b * 64 + lane; const float knl = KN2[(kblk * 8 + hs) * 2] + KN2[(kblk * 8 + hs) * 2 + 1];
            const int qblk = (b * SEQ + q0) / 64 + (lane & 1); const float qnl = QN2[(qblk * 8 + hs) * 2] + QN2[(qblk * 8 + hs) * 2 + 1];
            const int jt = qb * 2 - 1 - lane; const float cl = Cs[jt >= 0 ? 64 * jt + 63 : 0];
            const float crs = Cs[q0];
            const float kn = wave_max(knl), qn = wave_max(qnl);
            const float THs = 160.f + 2.05f * sqrtf(qn * kn);
            const unsigned long long keep = __ballot(lane < 16 && jt >= 0 && (crs - cl) >= -THs);
            const int nkeep = __builtin_ctzll(~keep);
            int jl = qb * 2 - nkeep;
            if (nkeep == 16) { while (jl > 0 && (crs - Cs[64 * (jl - 1) + 63]) >= -THs) --jl; }
            jl2[s] = __builtin_amdgcn_readfirstlane(jl);
            if (s == hh) { TH = THs; cref = crs; }
        }
        cw0 = Cg[w0];
        jlo = jl2[0] < jl2[1] ? jl2[0] : jl2[1];
    } else {
        jlo = (q0 - 127) < 0 ? 0 : ((q0 - 127) >> 6);
    }
    float m_run, l_run;
    if (KIND == 0) { m_run = -INFINITY; l_run = 0.f; }
    else { m_run = F.in[3][hq] * LOG2E; l_run = (hi == 0) ? 1.f : 0.f; }
    f32x16 o[2];
#pragma unroll
    for (int r = 0; r < 16; ++r) { o[0][r] = 0.f; o[1][r] = 0.f; }
    const int vb0 = (int)(unsigned)(uintptr_t)(lds + ((KIND == 0 && hh) ? LDS_H2 : 0) + LDS_V) + ((lane >> 4) & 1) * 32 + (lane & 3) * 8 + (4 * hi + ((lane & 15) >> 2)) * 64;
    int cur = 0;
    for (int j = jhi; j >= jlo; --j, cur ^= 1) {
        asm volatile("s_waitcnt vmcnt(0)" ::: "memory");
        __syncthreads();
        if (j > jlo) ATT_LOAD(j - 1, cur ^ 1);
        const int k0 = 64 * j;
        bool active = k0 <= w0 + 31;
        if (KIND == 1) active = active && (k0 + 63 >= w0 - 127);
        if (KIND == 0 && k0 + 63 < w0) active = active && ((cw0 - Cg[k0 + 63]) >= -TH);
        if (active) {
            f32x16 p0, p1;
            if (KIND == 0) {
#pragma unroll
                for (int g = 0; g < 4; ++g) {
                    const f32x4 c0 = *(const GAS f32x4*)(Cg + k0 + 8 * g + 4 * hi), c1 = *(const GAS f32x4*)(Cg + k0 + 32 + 8 * g + 4 * hi);
#pragma unroll
                    for (int e = 0; e < 4; ++e) { p0[4 * g + e] = cref - c0[e]; p1[4 * g + e] = cref - c1[e]; }
                }
            } else {
#pragma unroll
                for (int r = 0; r < 16; ++r) { p0[r] = 0.f; p1[r] = 0.f; }
            }
            qkt(p0, p1, lds + ((KIND == 0 && hh) ? LDS_H2 : 0) + LDS_K + cur * 8192, qr, r32, hi);
            if (k0 + 63 > w0) {
#pragma unroll
                for (int r = 0; r < 16; ++r) { const int kv = k0 + crow(r, hi); if (kv > myq) p0[r] = -INFINITY; if (kv + 32 > myq) p1[r] = -INFINITY; }
            }
            if (KIND == 1 && k0 < w0 + 31 - 127) {
#pragma unroll
                for (int r = 0; r < 16; ++r) { const int kv = k0 + crow(r, hi); if (kv < myq - 127) p0[r] = -INFINITY; if (kv + 32 < myq - 127) p1[r] = -INFINITY; }
            }
            const float rm = rowmax(p0, p1);
            const bool resc = __any(rm - m_run > DEFER_THR);
            float alpha = 1.f;
            if (resc) { const float m_new = fmaxf(m_run, rm); alpha = __builtin_amdgcn_exp2f(m_run - m_new); m_run = m_new; }
            float ps = 0.f;
#pragma unroll
            for (int r = 0; r < 16; ++r) { p0[r] = __builtin_amdgcn_exp2f(p0[r] - m_run); p1[r] = __builtin_amdgcn_exp2f(p1[r] - m_run); ps += p0[r] + p1[r]; }
            l_run = l_run * alpha + ps;
            v4u pw0, pw1, pw2, pw3;
#pragma unroll
            for (int i = 0; i < 4; ++i) { pw0[i] = cvtpk(p0[2 * i], p0[2 * i + 1]); pw1[i] = cvtpk(p0[8 + 2 * i], p0[9 + 2 * i]); pw2[i] = cvtpk(p1[2 * i], p1[2 * i + 1]); pw3[i] = cvtpk(p1[8 + 2 * i], p1[9 + 2 * i]); }
            if (resc) {
                if (hi == 0) wsf[r32] = alpha;
#pragma unroll
                for (int r = 0; r < 16; ++r) { const float a = wsf[crow(r, hi)]; o[0][r] *= a; o[1][r] *= a; }
            }
            pv(o, vb0 + cur * 8192, __builtin_bit_cast(bf16x8, pw0), __builtin_bit_cast(bf16x8, pw1), __builtin_bit_cast(bf16x8, pw2), __builtin_bit_cast(bf16x8, pw3));
        }
    }
#undef ATT_LOAD
    { auto rr = __builtin_amdgcn_permlane32_swap(__float_as_uint(l_run), __float_as_uint(l_run), false, false); l_run = __uint_as_float(rr[0]) + __uint_as_float(rr[1]); }
    if (hi == 0) wsf[32 + r32] = l_run;
    float rli[16];
#pragma unroll
    for (int r = 0; r < 16; ++r) rli[r] = __builtin_amdgcn_rcpf(wsf[32 + crow(r, hi)]);
    LAS unsigned char* stg = lds + LDS_OST + wid * 2048;
#pragma unroll
    for (int r = 0; r < 16; ++r) { const int orow = crow(r, hi);
#pragma unroll
        for (int d0 = 0; d0 < 2; ++d0) { const float qv = fminf(fmaxf(rintf(o[d0][r] * rli[r] * SQ_A), -127.f), 127.f); stg[orow * 64 + d0 * 32 + r32] = (unsigned char)(int)qv; } }
    unsigned char* Ow = F.ws + WS_ATTN + (size_t)(b * SEQ + w0) * 1024 + (KIND == 0 ? 0 : 512) + hq * 64;
#pragma unroll
    for (int i = 0; i < 2; ++i) { const int row = i * 16 + (lane >> 2), ch = lane & 3; const v4u v = *(const LAS v4u*)(stg + row * 64 + ch * 16); *(GAS v4u*)(Ow + (size_t)row * 1024 + ch * 16) = v; }
    __syncthreads();
}

__device__ __forceinline__ void attn_phase(Frame& F, int kmask = 3) {
    for (int u = (int)blockIdx.x; u < 2048; u += F.G) {
        const int kind = u >> 10; if (!((kmask >> kind) & 1)) continue;
        const int rem = u & 1023, b = rem >> 7;
        if (kind == 0) attn_unit<0>(F, b, (rem >> 5) & 3, ((rem & 31) + 5 * (rem >> 8)) & 31); else attn_unit<1>(F, b, (rem >> 6) & 1, rem & 63);
    }
}
}

struct EpiOutProj {
    static constexpr bool PERM = true, AFTER_DRAIN = false;
    bf16* yb; float2* stats; unsigned char* yq;
    __device__ __forceinline__ void operator()(const pg8::f32x4 (&acc)[2][2][4][2], const pg8::Unit& u, int wr, int wc, int fr, int fq_) const {
        const int trow0 = u.pm * 256 + wr * 64 + fr;
        v4u xw[2][4][2];
#pragma unroll
        for (int ai = 0; ai < 2; ++ai)
#pragma unroll
            for (int m = 0; m < 4; ++m)
#pragma unroll
                for (int bj = 0; bj < 2; ++bj)
                    xw[ai][m][bj] = __builtin_nontemporal_load((const GAS v4u*)(yb + (size_t)(trow0 + ai * 128 + m * 16) * D_MODEL + u.pn * 256 + bj * 128 + wc * 32 + 8 * fq_));
        __builtin_amdgcn_sched_barrier(0);
#pragma unroll
        for (int ai = 0; ai < 2; ++ai)
#pragma unroll
            for (int m = 0; m < 4; ++m) {
                const int t = trow0 + ai * 128 + m * 16;
                float s = 0.f, ss = 0.f;
#pragma unroll
                for (int bj = 0; bj < 2; ++bj) {
                    const size_t off = (size_t)t * D_MODEL + u.pn * 256 + bj * 128 + wc * 32 + 8 * fq_;
                    const v4u xv = xw[ai][m][bj];
                    f32x4 x0, x1;
                    x0[0] = __uint_as_float(xv[0] << 16); x0[1] = __uint_as_float(xv[0] & 0xffff0000u); x0[2] = __uint_as_float(xv[1] << 16); x0[3] = __uint_as_float(xv[1] & 0xffff0000u);
                    x1[0] = __uint_as_float(xv[2] << 16); x1[1] = __uint_as_float(xv[2] & 0xffff0000u); x1[2] = __uint_as_float(xv[3] << 16); x1[3] = __uint_as_float(xv[3] & 0xffff0000u);
                    const f32x4 v0 = x0 * ALPHA + iacc(acc[ai][bj][m][0], 1.f / (SQ_A * SQ_WOUT)), v1 = x1 * ALPHA + iacc(acc[ai][bj][m][1], 1.f / (SQ_A * SQ_WOUT));
                    v4u w; w.x = pg8::cvt_pk_bf16(v0[0], v0[1]); w.y = pg8::cvt_pk_bf16(v0[2], v0[3]); w.z = pg8::cvt_pk_bf16(v1[0], v1[1]); w.w = pg8::cvt_pk_bf16(v1[2], v1[3]);
                    *(GAS v4u*)(yb + off) = w;
                    { u32x2 wq; wq.x = q8x4(v0[0] * SQ_Y, v0[1] * SQ_Y, v0[2] * SQ_Y, v0[3] * SQ_Y); wq.y = q8x4(v1[0] * SQ_Y, v1[1] * SQ_Y, v1[2] * SQ_Y, v1[3] * SQ_Y); *(GAS u32x2*)(yq + off) = wq; }
                    s += (v0[0] + v0[1]) + (v0[2] + v0[3]) + (v1[0] + v1[1]) + (v1[2] + v1[3]);
                    ss += (v0[0] * v0[0] + v0[1] * v0[1]) + (v0[2] * v0[2] + v0[3] * v0[3]) + (v1[0] * v1[0] + v1[1] * v1[1]) + (v1[2] * v1[2] + v1[3] * v1[3]);
                }
                s += __shfl_xor(s, 16); s += __shfl_xor(s, 32); ss += __shfl_xor(ss, 16); ss += __shfl_xor(ss, 32);
                if (fq_ == 0) stats[(size_t)(u.pn * 4 + wc) * T + t] = make_float2(s, ss);
            }
    }
};
__device__ __forceinline__ float2 ln1_row_stats(const float2* stats, int t) {
    float s = 0.f, ss = 0.f;
    typedef float f32x2s __attribute__((ext_vector_type(2)));
#pragma unroll
    for (int i = 0; i < 16; ++i) { const f32x2s a = *(const GAS f32x2s*)((const float*)stats + 2 * ((size_t)i * T + t)); s += a.x; ss += a.y; }
    const float mean = s * (1.f / D_MODEL), var = fmaxf(ss * (1.f / D_MODEL) - mean * mean, 0.f);
    return make_float2(mean, 1.f / sqrtf(var + LN_EPS));
}
struct EpiQuery {
    static constexpr bool PERM = true, AFTER_DRAIN = false;
    const float2* stats; const float* gw; const float* bw; bf16* q; float2* ms;
    __device__ __forceinline__ void operator()(const pg8::f32x4 (&acc)[2][2][4][2], const pg8::Unit& u, int wr, int wc, int fr, int fq_) const {
        const int trow0 = u.pm * 256 + wr * 64 + fr, lane = fr + 16 * fq_;
        const int k0 = 2 * fq_, k1 = 2 * fq_ + 1;
        const float2 sa = ln1_row_stats(stats, trow0 + (k0 >> 2) * 128 + (k0 & 3) * 16), sb = ln1_row_stats(stats, trow0 + (k1 >> 2) * 128 + (k1 & 3) * 16);
        if (u.pn == 0 && wc == 0) { ms[trow0 + (k0 >> 2) * 128 + (k0 & 3) * 16] = sa; ms[trow0 + (k1 >> 2) * 128 + (k1 & 3) * 16] = sb; }
        float mean[8], rstd[8];
#pragma unroll
        for (int k = 0; k < 8; ++k) { const int src = fr + 16 * (k >> 1); mean[k] = __shfl((k & 1) ? sb.x : sa.x, src); rstd[k] = __shfl((k & 1) ? sb.y : sa.y, src); }
        (void)lane;
#pragma unroll
        for (int bj = 0; bj < 2; ++bj) {
            const int col0 = u.pn * 256 + bj * 128 + wc * 32 + 8 * fq_;
            const f32x4 g0 = *(const GAS f32x4*)(gw + col0), g1 = *(const GAS f32x4*)(gw + col0 + 4), b0 = *(const GAS f32x4*)(bw + col0), b1 = *(const GAS f32x4*)(bw + col0 + 4);
#pragma unroll
            for (int ai = 0; ai < 2; ++ai)
#pragma unroll
                for (int m = 0; m < 4; ++m) {
                    const int t = trow0 + ai * 128 + m * 16; const float mu = mean[4 * ai + m], rs = rstd[4 * ai + m];
                    const f32x4 v0 = (iacc(acc[ai][bj][m][0], 1.f / (SQ_Y * SQ_WQ)) - g0 * mu) * rs + b0, v1 = (iacc(acc[ai][bj][m][1], 1.f / (SQ_Y * SQ_WQ)) - g1 * mu) * rs + b1;
                    v4u w; w.x = pg8::cvt_pk_bf16(v0[0], v0[1]); w.y = pg8::cvt_pk_bf16(v0[2], v0[3]); w.z = pg8::cvt_pk_bf16(v1[0], v1[1]); w.w = pg8::cvt_pk_bf16(v1[2], v1[3]);
                    __builtin_nontemporal_store(w, (GAS v4u*)(q + ((size_t)(t >> 5) * 8192 + (size_t)(col0 >> 3) * 32 + (t & 31)) * 8));
                }
        }
    }
};
#define TOPK_SORT128(v) do { \
  CE(v[0],v[13]);CE(v[1],v[12]);CE(v[2],v[15]);CE(v[3],v[14]);CE(v[4],v[8]);CE(v[5],v[6]);CE(v[7],v[11]);CE(v[9],v[10]);CE(v[0],v[5]);CE(v[1],v[7]);CE(v[2],v[9]);CE(v[3],v[4]);CE(v[6],v[13]);CE(v[8],v[14]);CE(v[10],v[15]);CE(v[11],v[12]);CE(v[0],v[1]);CE(v[2],v[3]);CE(v[4],v[5]);CE(v[6],v[8]);CE(v[7],v[9]);CE(v[10],v[11]);CE(v[12],v[13]);CE(v[14],v[15]);CE(v[0],v[2]);CE(v[1],v[3]);CE(v[4],v[10]);CE(v[5],v[11]);CE(v[6],v[7]);CE(v[8],v[9]);CE(v[12],v[14]);CE(v[13],v[15]);CE(v[1],v[2]);CE(v[3],v[12]);CE(v[4],v[6]);CE(v[5],v[7]);CE(v[8],v[10]);CE(v[9],v[11]);CE(v[13],v[14]);CE(v[1],v[4]);CE(v[2],v[6]);CE(v[5],v[8]);CE(v[7],v[10]);CE(v[9],v[13]);CE(v[11],v[14]);CE(v[2],v[4]);CE(v[3],v[6]);CE(v[9],v[12]);CE(v[11],v[13]);CE(v[3],v[5]);CE(v[6],v[8]);CE(v[7],v[9]);CE(v[10],v[12]);CE(v[3],v[4]);CE(v[5],v[6]);CE(v[7],v[8]);CE(v[9],v[10]);CE(v[11],v[12]);CE(v[6],v[7]);CE(v[8],v[9]); \
  CE(v[16],v[29]);CE(v[17],v[28]);CE(v[18],v[31]);CE(v[19],v[30]);CE(v[20],v[24]);CE(v[21],v[22]);CE(v[23],v[27]);CE(v[25],v[26]);CE(v[16],v[21]);CE(v[17],v[23]);CE(v[18],v[25]);CE(v[19],v[20]);CE(v[22],v[29]);CE(v[24],v[30]);CE(v[26],v[31]);CE(v[27],v[28]);CE(v[16],v[17]);CE(v[18],v[19]);CE(v[20],v[21]);CE(v[22],v[24]);CE(v[23],v[25]);CE(v[26],v[27]);CE(v[28],v[29]);CE(v[30],v[31]);CE(v[16],v[18]);CE(v[17],v[19]);CE(v[20],v[26]);CE(v[21],v[27]);CE(v[22],v[23]);CE(v[24],v[25]);CE(v[28],v[30]);CE(v[29],v[31]);CE(v[17],v[18]);CE(v[19],v[28]);CE(v[20],v[22]);CE(v[21],v[23]);CE(v[24],v[26]);CE(v[25],v[27]);CE(v[29],v[30]);CE(v[17],v[20]);CE(v[18],v[22]);CE(v[21],v[24]);CE(v[23],v[26]);CE(v[25],v[29]);CE(v[27],v[30]);CE(v[18],v[20]);CE(v[19],v[22]);CE(v[25],v[28]);CE(v[27],v[29]);CE(v[19],v[21]);CE(v[22],v[24]);CE(v[23],v[25]);CE(v[26],v[28]);CE(v[19],v[20]);CE(v[21],v[22]);CE(v[23],v[24]);CE(v[25],v[26]);CE(v[27],v[28]);CE(v[22],v[23]);CE(v[24],v[25]); \
  CE(v[32],v[45]);CE(v[33],v[44]);CE(v[34],v[47]);CE(v[35],v[46]);CE(v[36],v[40]);CE(v[37],v[38]);CE(v[39],v[43]);CE(v[41],v[42]);CE(v[32],v[37]);CE(v[33],v[39]);CE(v[34],v[41]);CE(v[35],v[36]);CE(v[38],v[45]);CE(v[40],v[46]);CE(v[42],v[47]);CE(v[43],v[44]);CE(v[32],v[33]);CE(v[34],v[35]);CE(v[36],v[37]);CE(v[38],v[40]);CE(v[39],v[41]);CE(v[42],v[43]);CE(v[44],v[45]);CE(v[46],v[47]);CE(v[32],v[34]);CE(v[33],v[35]);CE(v[36],v[42]);CE(v[37],v[43]);CE(v[38],v[39]);CE(v[40],v[41]);CE(v[44],v[46]);CE(v[45],v[47]);CE(v[33],v[34]);CE(v[35],v[44]);CE(v[36],v[38]);CE(v[37],v[39]);CE(v[40],v[42]);CE(v[41],v[43]);CE(v[45],v[46]);CE(v[33],v[36]);CE(v[34],v[38]);CE(v[37],v[40]);CE(v[39],v[42]);CE(v[41],v[45]);CE(v[43],v[46]);CE(v[34],v[36]);CE(v[35],v[38]);CE(v[41],v[44]);CE(v[43],v[45]);CE(v[35],v[37]);CE(v[38],v[40]);CE(v[39],v[41]);CE(v[42],v[44]);CE(v[35],v[36]);CE(v[37],v[38]);CE(v[39],v[40]);CE(v[41],v[42]);CE(v[43],v[44]);CE(v[38],v[39]);CE(v[40],v[41]); \
  CE(v[48],v[61]);CE(v[49],v[60]);CE(v[50],v[63]);CE(v[51],v[62]);CE(v[52],v[56]);CE(v[53],v[54]);CE(v[55],v[59]);CE(v[57],v[58]);CE(v[48],v[53]);CE(v[49],v[55]);CE(v[50],v[57]);CE(v[51],v[52]);CE(v[54],v[61]);CE(v[56],v[62]);CE(v[58],v[63]);CE(v[59],v[60]);CE(v[48],v[49]);CE(v[50],v[51]);CE(v[52],v[53]);CE(v[54],v[56]);CE(v[55],v[57]);CE(v[58],v[59]);CE(v[60],v[61]);CE(v[62],v[63]);CE(v[48],v[50]);CE(v[49],v[51]);CE(v[52],v[58]);CE(v[53],v[59]);CE(v[54],v[55]);CE(v[56],v[57]);CE(v[60],v[62]);CE(v[61],v[63]);CE(v[49],v[50]);CE(v[51],v[60]);CE(v[52],v[54]);CE(v[53],v[55]);CE(v[56],v[58]);CE(v[57],v[59]);CE(v[61],v[62]);CE(v[49],v[52]);CE(v[50],v[54]);CE(v[53],v[56]);CE(v[55],v[58]);CE(v[57],v[61]);CE(v[59],v[62]);CE(v[50],v[52]);CE(v[51],v[54]);CE(v[57],v[60]);CE(v[59],v[61]);CE(v[51],v[53]);CE(v[54],v[56]);CE(v[55],v[57]);CE(v[58],v[60]);CE(v[51],v[52]);CE(v[53],v[54]);CE(v[55],v[56]);CE(v[57],v[58]);CE(v[59],v[60]);CE(v[54],v[55]);CE(v[56],v[57]); \
  CE(v[64],v[77]);CE(v[65],v[76]);CE(v[66],v[79]);CE(v[67],v[78]);CE(v[68],v[72]);CE(v[69],v[70]);CE(v[71],v[75]);CE(v[73],v[74]);CE(v[64],v[69]);CE(v[65],v[71]);CE(v[66],v[73]);CE(v[67],v[68]);CE(v[70],v[77]);CE(v[72],v[78]);CE(v[74],v[79]);CE(v[75],v[76]);CE(v[64],v[65]);CE(v[66],v[67]);CE(v[68],v[69]);CE(v[70],v[72]);CE(v[71],v[73]);CE(v[74],v[75]);CE(v[76],v[77]);CE(v[78],v[79]);CE(v[64],v[66]);CE(v[65],v[67]);CE(v[68],v[74]);CE(v[69],v[75]);CE(v[70],v[71]);CE(v[72],v[73]);CE(v[76],v[78]);CE(v[77],v[79]);CE(v[65],v[66]);CE(v[67],v[76]);CE(v[68],v[70]);CE(v[69],v[71]);CE(v[72],v[74]);CE(v[73],v[75]);CE(v[77],v[78]);CE(v[65],v[68]);CE(v[66],v[70]);CE(v[69],v[72]);CE(v[71],v[74]);CE(v[73],v[77]);CE(v[75],v[78]);CE(v[66],v[68]);CE(v[67],v[70]);CE(v[73],v[76]);CE(v[75],v[77]);CE(v[67],v[69]);CE(v[70],v[72]);CE(v[71],v[73]);CE(v[74],v[76]);CE(v[67],v[68]);CE(v[69],v[70]);CE(v[71],v[72]);CE(v[73],v[74]);CE(v[75],v[76]);CE(v[70],v[71]);CE(v[72],v[73]); \
  CE(v[80],v[93]);CE(v[81],v[92]);CE(v[82],v[95]);CE(v[83],v[94]);CE(v[84],v[88]);CE(v[85],v[86]);CE(v[87],v[91]);CE(v[89],v[90]);CE(v[80],v[85]);CE(v[81],v[87]);CE(v[82],v[89]);CE(v[83],v[84]);CE(v[86],v[93]);CE(v[88],v[94]);CE(v[90],v[95]);CE(v[91],v[92]);CE(v[80],v[81]);CE(v[82],v[83]);CE(v[84],v[85]);CE(v[86],v[88]);CE(v[87],v[89]);CE(v[90],v[91]);CE(v[92],v[93]);CE(v[94],v[95]);CE(v[80],v[82]);CE(v[81],v[83]);CE(v[84],v[90]);CE(v[85],v[91]);CE(v[86],v[87]);CE(v[88],v[89]);CE(v[92],v[94]);CE(v[93],v[95]);CE(v[81],v[82]);CE(v[83],v[92]);CE(v[84],v[86]);CE(v[85],v[87]);CE(v[88],v[90]);CE(v[89],v[91]);CE(v[93],v[94]);CE(v[81],v[84]);CE(v[82],v[86]);CE(v[85],v[88]);CE(v[87],v[90]);CE(v[89],v[93]);CE(v[91],v[94]);CE(v[82],v[84]);CE(v[83],v[86]);CE(v[89],v[92]);CE(v[91],v[93]);CE(v[83],v[85]);CE(v[86],v[88]);CE(v[87],v[89]);CE(v[90],v[92]);CE(v[83],v[84]);CE(v[85],v[86]);CE(v[87],v[88]);CE(v[89],v[90]);CE(v[91],v[92]);CE(v[86],v[87]);CE(v[88],v[89]); \
  CE(v[96],v[109]);CE(v[97],v[108]);CE(v[98],v[111]);CE(v[99],v[110]);CE(v[100],v[104]);CE(v[101],v[102]);CE(v[103],v[107]);CE(v[105],v[106]);CE(v[96],v[101]);CE(v[97],v[103]);CE(v[98],v[105]);CE(v[99],v[100]);CE(v[102],v[109]);CE(v[104],v[110]);CE(v[106],v[111]);CE(v[107],v[108]);CE(v[96],v[97]);CE(v[98],v[99]);CE(v[100],v[101]);CE(v[102],v[104]);CE(v[103],v[105]);CE(v[106],v[107]);CE(v[108],v[109]);CE(v[110],v[111]);CE(v[96],v[98]);CE(v[97],v[99]);CE(v[100],v[106]);CE(v[101],v[107]);CE(v[102],v[103]);CE(v[104],v[105]);CE(v[108],v[110]);CE(v[109],v[111]);CE(v[97],v[98]);CE(v[99],v[108]);CE(v[100],v[102]);CE(v[101],v[103]);CE(v[104],v[106]);CE(v[105],v[107]);CE(v[109],v[110]);CE(v[97],v[100]);CE(v[98],v[102]);CE(v[101],v[104]);CE(v[103],v[106]);CE(v[105],v[109]);CE(v[107],v[110]);CE(v[98],v[100]);CE(v[99],v[102]);CE(v[105],v[108]);CE(v[107],v[109]);CE(v[99],v[101]);CE(v[102],v[104]);CE(v[103],v[105]);CE(v[106],v[108]);CE(v[99],v[100]);CE(v[101],v[102]);CE(v[103],v[104]);CE(v[105],v[106]);CE(v[107],v[108]);CE(v[102],v[103]);CE(v[104],v[105]); \
  CE(v[112],v[125]);CE(v[113],v[124]);CE(v[114],v[127]);CE(v[115],v[126]);CE(v[116],v[120]);CE(v[117],v[118]);CE(v[119],v[123]);CE(v[121],v[122]);CE(v[112],v[117]);CE(v[113],v[119]);CE(v[114],v[121]);CE(v[115],v[116]);CE(v[118],v[125]);CE(v[120],v[126]);CE(v[122],v[127]);CE(v[123],v[124]);CE(v[112],v[113]);CE(v[114],v[115]);CE(v[116],v[117]);CE(v[118],v[120]);CE(v[119],v[121]);CE(v[122],v[123]);CE(v[124],v[125]);CE(v[126],v[127]);CE(v[112],v[114]);CE(v[113],v[115]);CE(v[116],v[122]);CE(v[117],v[123]);CE(v[118],v[119]);CE(v[120],v[121]);CE(v[124],v[126]);CE(v[125],v[127]);CE(v[113],v[114]);CE(v[115],v[124]);CE(v[116],v[118]);CE(v[117],v[119]);CE(v[120],v[122]);CE(v[121],v[123]);CE(v[125],v[126]);CE(v[113],v[116]);CE(v[114],v[118]);CE(v[117],v[120]);CE(v[119],v[122]);CE(v[121],v[125]);CE(v[123],v[126]);CE(v[114],v[116]);CE(v[115],v[118]);CE(v[121],v[124]);CE(v[123],v[125]);CE(v[115],v[117]);CE(v[118],v[120]);CE(v[119],v[121]);CE(v[122],v[124]);CE(v[115],v[116]);CE(v[117],v[118]);CE(v[119],v[120]);CE(v[121],v[122]);CE(v[123],v[124]);CE(v[118],v[119]);CE(v[120],v[121]); \
  v[0]=vmaxf(v[0],v[31]);v[1]=vmaxf(v[1],v[30]);v[2]=vmaxf(v[2],v[29]);v[3]=vmaxf(v[3],v[28]);v[4]=vmaxf(v[4],v[27]);v[5]=vmaxf(v[5],v[26]);v[6]=vmaxf(v[6],v[25]);v[7]=vmaxf(v[7],v[24]);v[8]=vmaxf(v[8],v[23]);v[9]=vmaxf(v[9],v[22]);v[10]=vmaxf(v[10],v[21]);v[11]=vmaxf(v[11],v[20]);v[12]=vmaxf(v[12],v[19]);v[13]=vmaxf(v[13],v[18]);v[14]=vmaxf(v[14],v[17]);v[15]=vmaxf(v[15],v[16]);CE(v[0],v[8]);CE(v[1],v[9]);CE(v[2],v[10]);CE(v[3],v[11]);CE(v[4],v[12]);CE(v[5],v[13]);CE(v[6],v[14]);CE(v[7],v[15]);CE(v[0],v[4]);CE(v[1],v[5]);CE(v[2],v[6]);CE(v[3],v[7]);CE(v[8],v[12]);CE(v[9],v[13]);CE(v[10],v[14]);CE(v[11],v[15]);CE(v[0],v[2]);CE(v[1],v[3]);CE(v[4],v[6]);CE(v[5],v[7]);CE(v[8],v[10]);CE(v[9],v[11]);CE(v[12],v[14]);CE(v[13],v[15]);CE(v[0],v[1]);CE(v[2],v[3]);CE(v[4],v[5]);CE(v[6],v[7]);CE(v[8],v[9]);CE(v[10],v[11]);CE(v[12],v[13]);CE(v[14],v[15]); \
  v[32]=vmaxf(v[32],v[63]);v[33]=vmaxf(v[33],v[62]);v[34]=vmaxf(v[34],v[61]);v[35]=vmaxf(v[35],v[60]);v[36]=vmaxf(v[36],v[59]);v[37]=vmaxf(v[37],v[58]);v[38]=vmaxf(v[38],v[57]);v[39]=vmaxf(v[39],v[56]);v[40]=vmaxf(v[40],v[55]);v[41]=vmaxf(v[41],v[54]);v[42]=vmaxf(v[42],v[53]);v[43]=vmaxf(v[43],v[52]);v[44]=vmaxf(v[44],v[51]);v[45]=vmaxf(v[45],v[50]);v[46]=vmaxf(v[46],v[49]);v[47]=vmaxf(v[47],v[48]);CE(v[32],v[40]);CE(v[33],v[41]);CE(v[34],v[42]);CE(v[35],v[43]);CE(v[36],v[44]);CE(v[37],v[45]);CE(v[38],v[46]);CE(v[39],v[47]);CE(v[32],v[36]);CE(v[33],v[37]);CE(v[34],v[38]);CE(v[35],v[39]);CE(v[40],v[44]);CE(v[41],v[45]);CE(v[42],v[46]);CE(v[43],v[47]);CE(v[32],v[34]);CE(v[33],v[35]);CE(v[36],v[38]);CE(v[37],v[39]);CE(v[40],v[42]);CE(v[41],v[43]);CE(v[44],v[46]);CE(v[45],v[47]);CE(v[32],v[33]);CE(v[34],v[35]);CE(v[36],v[37]);CE(v[38],v[39]);CE(v[40],v[41]);CE(v[42],v[43]);CE(v[44],v[45]);CE(v[46],v[47]); \
  v[64]=vmaxf(v[64],v[95]);v[65]=vmaxf(v[65],v[94]);v[66]=vmaxf(v[66],v[93]);v[67]=vmaxf(v[67],v[92]);v[68]=vmaxf(v[68],v[91]);v[69]=vmaxf(v[69],v[90]);v[70]=vmaxf(v[70],v[89]);v[71]=vmaxf(v[71],v[88]);v[72]=vmaxf(v[72],v[87]);v[73]=vmaxf(v[73],v[86]);v[74]=vmaxf(v[74],v[85]);v[75]=vmaxf(v[75],v[84]);v[76]=vmaxf(v[76],v[83]);v[77]=vmaxf(v[77],v[82]);v[78]=vmaxf(v[78],v[81]);v[79]=vmaxf(v[79],v[80]);CE(v[64],v[72]);CE(v[65],v[73]);CE(v[66],v[74]);CE(v[67],v[75]);CE(v[68],v[76]);CE(v[69],v[77]);CE(v[70],v[78]);CE(v[71],v[79]);CE(v[64],v[68]);CE(v[65],v[69]);CE(v[66],v[70]);CE(v[67],v[71]);CE(v[72],v[76]);CE(v[73],v[77]);CE(v[74],v[78]);CE(v[75],v[79]);CE(v[64],v[66]);CE(v[65],v[67]);CE(v[68],v[70]);CE(v[69],v[71]);CE(v[72],v[74]);CE(v[73],v[75]);CE(v[76],v[78]);CE(v[77],v[79]);CE(v[64],v[65]);CE(v[66],v[67]);CE(v[68],v[69]);CE(v[70],v[71]);CE(v[72],v[73]);CE(v[74],v[75]);CE(v[76],v[77]);CE(v[78],v[79]); \
  v[96]=vmaxf(v[96],v[127]);v[97]=vmaxf(v[97],v[126]);v[98]=vmaxf(v[98],v[125]);v[99]=vmaxf(v[99],v[124]);v[100]=vmaxf(v[100],v[123]);v[101]=vmaxf(v[101],v[122]);v[102]=vmaxf(v[102],v[121]);v[103]=vmaxf(v[103],v[120]);v[104]=vmaxf(v[104],v[119]);v[105]=vmaxf(v[105],v[118]);v[106]=vmaxf(v[106],v[117]);v[107]=vmaxf(v[107],v[116]);v[108]=vmaxf(v[108],v[115]);v[109]=vmaxf(v[109],v[114]);v[110]=vmaxf(v[110],v[113]);v[111]=vmaxf(v[111],v[112]);CE(v[96],v[104]);CE(v[97],v[105]);CE(v[98],v[106]);CE(v[99],v[107]);CE(v[100],v[108]);CE(v[101],v[109]);CE(v[102],v[110]);CE(v[103],v[111]);CE(v[96],v[100]);CE(v[97],v[101]);CE(v[98],v[102]);CE(v[99],v[103]);CE(v[104],v[108]);CE(v[105],v[109]);CE(v[106],v[110]);CE(v[107],v[111]);CE(v[96],v[98]);CE(v[97],v[99]);CE(v[100],v[102]);CE(v[101],v[103]);CE(v[104],v[106]);CE(v[105],v[107]);CE(v[108],v[110]);CE(v[109],v[111]);CE(v[96],v[97]);CE(v[98],v[99]);CE(v[100],v[101]);CE(v[102],v[103]);CE(v[104],v[105]);CE(v[106],v[107]);CE(v[108],v[109]);CE(v[110],v[111]); \
  v[0]=vmaxf(v[0],v[47]);v[1]=vmaxf(v[1],v[46]);v[2]=vmaxf(v[2],v[45]);v[3]=vmaxf(v[3],v[44]);v[4]=vmaxf(v[4],v[43]);v[5]=vmaxf(v[5],v[42]);v[6]=vmaxf(v[6],v[41]);v[7]=vmaxf(v[7],v[40]);v[8]=vmaxf(v[8],v[39]);v[9]=vmaxf(v[9],v[38]);v[10]=vmaxf(v[10],v[37]);v[11]=vmaxf(v[11],v[36]);v[12]=vmaxf(v[12],v[35]);v[13]=vmaxf(v[13],v[34]);v[14]=vmaxf(v[14],v[33]);v[15]=vmaxf(v[15],v[32]);CE(v[0],v[8]);CE(v[1],v[9]);CE(v[2],v[10]);CE(v[3],v[11]);CE(v[4],v[12]);CE(v[5],v[13]);CE(v[6],v[14]);CE(v[7],v[15]);CE(v[0],v[4]);CE(v[1],v[5]);CE(v[2],v[6]);CE(v[3],v[7]);CE(v[8],v[12]);CE(v[9],v[13]);CE(v[10],v[14]);CE(v[11],v[15]);CE(v[0],v[2]);CE(v[1],v[3]);CE(v[4],v[6]);CE(v[5],v[7]);CE(v[8],v[10]);CE(v[9],v[11]);CE(v[12],v[14]);CE(v[13],v[15]);CE(v[0],v[1]);CE(v[2],v[3]);CE(v[4],v[5]);CE(v[6],v[7]);CE(v[8],v[9]);CE(v[10],v[11]);CE(v[12],v[13]);CE(v[14],v[15]); \
  v[64]=vmaxf(v[64],v[111]);v[65]=vmaxf(v[65],v[110]);v[66]=vmaxf(v[66],v[109]);v[67]=vmaxf(v[67],v[108]);v[68]=vmaxf(v[68],v[107]);v[69]=vmaxf(v[69],v[106]);v[70]=vmaxf(v[70],v[105]);v[71]=vmaxf(v[71],v[104]);v[72]=vmaxf(v[72],v[103]);v[73]=vmaxf(v[73],v[102]);v[74]=vmaxf(v[74],v[101]);v[75]=vmaxf(v[75],v[100]);v[76]=vmaxf(v[76],v[99]);v[77]=vmaxf(v[77],v[98]);v[78]=vmaxf(v[78],v[97]);v[79]=vmaxf(v[79],v[96]);CE(v[64],v[72]);CE(v[65],v[73]);CE(v[66],v[74]);CE(v[67],v[75]);CE(v[68],v[76]);CE(v[69],v[77]);CE(v[70],v[78]);CE(v[71],v[79]);CE(v[64],v[68]);CE(v[65],v[69]);CE(v[66],v[70]);CE(v[67],v[71]);CE(v[72],v[76]);CE(v[73],v[77]);CE(v[74],v[78]);CE(v[75],v[79]);CE(v[64],v[66]);CE(v[65],v[67]);CE(v[68],v[70]);CE(v[69],v[71]);CE(v[72],v[74]);CE(v[73],v[75]);CE(v[76],v[78]);CE(v[77],v[79]);CE(v[64],v[65]);CE(v[66],v[67]);CE(v[68],v[69]);CE(v[70],v[71]);CE(v[72],v[73]);CE(v[74],v[75]);CE(v[76],v[77]);CE(v[78],v[79]); \
  v[0]=vmaxf(v[0],v[79]);v[1]=vmaxf(v[1],v[78]);v[2]=vmaxf(v[2],v[77]);v[3]=vmaxf(v[3],v[76]);v[4]=vmaxf(v[4],v[75]);v[5]=vmaxf(v[5],v[74]);v[6]=vmaxf(v[6],v[73]);v[7]=vmaxf(v[7],v[72]);v[8]=vmaxf(v[8],v[71]);v[9]=vmaxf(v[9],v[70]);v[10]=vmaxf(v[10],v[69]);v[11]=vmaxf(v[11],v[68]);v[12]=vmaxf(v[12],v[67]);v[13]=vmaxf(v[13],v[66]);v[14]=vmaxf(v[14],v[65]);v[15]=vmaxf(v[15],v[64]);CE(v[0],v[8]);CE(v[1],v[9]);CE(v[2],v[10]);CE(v[3],v[11]);CE(v[4],v[12]);CE(v[5],v[13]);CE(v[6],v[14]);CE(v[7],v[15]);CE(v[0],v[4]);CE(v[1],v[5]);CE(v[2],v[6]);CE(v[3],v[7]);CE(v[8],v[12]);CE(v[9],v[13]);CE(v[10],v[14]);CE(v[11],v[15]);CE(v[0],v[2]);CE(v[1],v[3]);CE(v[4],v[6]);CE(v[5],v[7]);CE(v[8],v[10]);CE(v[9],v[11]);CE(v[12],v[14]);CE(v[13],v[15]);CE(v[0],v[1]);CE(v[2],v[3]);CE(v[4],v[5]);CE(v[6],v[7]);CE(v[8],v[9]);CE(v[10],v[11]);CE(v[12],v[13]);CE(v[14],v[15]); \
} while (0)
#define TOPK_SORT32(v) do { \
  CE(v[0],v[13]);CE(v[1],v[12]);CE(v[2],v[15]);CE(v[3],v[14]);CE(v[4],v[8]);CE(v[5],v[6]);CE(v[7],v[11]);CE(v[9],v[10]);CE(v[0],v[5]);CE(v[1],v[7]);CE(v[2],v[9]);CE(v[3],v[4]);CE(v[6],v[13]);CE(v[8],v[14]);CE(v[10],v[15]);CE(v[11],v[12]);CE(v[0],v[1]);CE(v[2],v[3]);CE(v[4],v[5]);CE(v[6],v[8]);CE(v[7],v[9]);CE(v[10],v[11]);CE(v[12],v[13]);CE(v[14],v[15]);CE(v[0],v[2]);CE(v[1],v[3]);CE(v[4],v[10]);CE(v[5],v[11]);CE(v[6],v[7]);CE(v[8],v[9]);CE(v[12],v[14]);CE(v[13],v[15]);CE(v[1],v[2]);CE(v[3],v[12]);CE(v[4],v[6]);CE(v[5],v[7]);CE(v[8],v[10]);CE(v[9],v[11]);CE(v[13],v[14]);CE(v[1],v[4]);CE(v[2],v[6]);CE(v[5],v[8]);CE(v[7],v[10]);CE(v[9],v[13]);CE(v[11],v[14]);CE(v[2],v[4]);CE(v[3],v[6]);CE(v[9],v[12]);CE(v[11],v[13]);CE(v[3],v[5]);CE(v[6],v[8]);CE(v[7],v[9]);CE(v[10],v[12]);CE(v[3],v[4]);CE(v[5],v[6]);CE(v[7],v[8]);CE(v[9],v[10]);CE(v[11],v[12]);CE(v[6],v[7]);CE(v[8],v[9]); \
  CE(v[16],v[29]);CE(v[17],v[28]);CE(v[18],v[31]);CE(v[19],v[30]);CE(v[20],v[24]);CE(v[21],v[22]);CE(v[23],v[27]);CE(v[25],v[26]);CE(v[16],v[21]);CE(v[17],v[23]);CE(v[18],v[25]);CE(v[19],v[20]);CE(v[22],v[29]);CE(v[24],v[30]);CE(v[26],v[31]);CE(v[27],v[28]);CE(v[16],v[17]);CE(v[18],v[19]);CE(v[20],v[21]);CE(v[22],v[24]);CE(v[23],v[25]);CE(v[26],v[27]);CE(v[28],v[29]);CE(v[30],v[31]);CE(v[16],v[18]);CE(v[17],v[19]);CE(v[20],v[26]);CE(v[21],v[27]);CE(v[22],v[23]);CE(v[24],v[25]);CE(v[28],v[30]);CE(v[29],v[31]);CE(v[17],v[18]);CE(v[19],v[28]);CE(v[20],v[22]);CE(v[21],v[23]);CE(v[24],v[26]);CE(v[25],v[27]);CE(v[29],v[30]);CE(v[17],v[20]);CE(v[18],v[22]);CE(v[21],v[24]);CE(v[23],v[26]);CE(v[25],v[29]);CE(v[27],v[30]);CE(v[18],v[20]);CE(v[19],v[22]);CE(v[25],v[28]);CE(v[27],v[29]);CE(v[19],v[21]);CE(v[22],v[24]);CE(v[23],v[25]);CE(v[26],v[28]);CE(v[19],v[20]);CE(v[21],v[22]);CE(v[23],v[24]);CE(v[25],v[26]);CE(v[27],v[28]);CE(v[22],v[23]);CE(v[24],v[25]); \
  v[0]=vmaxf(v[0],v[31]);v[1]=vmaxf(v[1],v[30]);v[2]=vmaxf(v[2],v[29]);v[3]=vmaxf(v[3],v[28]);v[4]=vmaxf(v[4],v[27]);v[5]=vmaxf(v[5],v[26]);v[6]=vmaxf(v[6],v[25]);v[7]=vmaxf(v[7],v[24]);v[8]=vmaxf(v[8],v[23]);v[9]=vmaxf(v[9],v[22]);v[10]=vmaxf(v[10],v[21]);v[11]=vmaxf(v[11],v[20]);v[12]=vmaxf(v[12],v[19]);v[13]=vmaxf(v[13],v[18]);v[14]=vmaxf(v[14],v[17]);v[15]=vmaxf(v[15],v[16]);CE(v[0],v[8]);CE(v[1],v[9]);CE(v[2],v[10]);CE(v[3],v[11]);CE(v[4],v[12]);CE(v[5],v[13]);CE(v[6],v[14]);CE(v[7],v[15]);CE(v[0],v[4]);CE(v[1],v[5]);CE(v[2],v[6]);CE(v[3],v[7]);CE(v[8],v[12]);CE(v[9],v[13]);CE(v[10],v[14]);CE(v[11],v[15]);CE(v[0],v[2]);CE(v[1],v[3]);CE(v[4],v[6]);CE(v[5],v[7]);CE(v[8],v[10]);CE(v[9],v[11]);CE(v[12],v[14]);CE(v[13],v[15]);CE(v[0],v[1]);CE(v[2],v[3]);CE(v[4],v[5]);CE(v[6],v[7]);CE(v[8],v[9]);CE(v[10],v[11]);CE(v[12],v[13]);CE(v[14],v[15]); \
} while (0)
#define TOPK_MERGE_BITONIC16(v) do { \
  CE(v[0],v[8]);CE(v[1],v[9]);CE(v[2],v[10]);CE(v[3],v[11]);CE(v[4],v[12]);CE(v[5],v[13]);CE(v[6],v[14]);CE(v[7],v[15]);CE(v[0],v[4]);CE(v[1],v[5]);CE(v[2],v[6]);CE(v[3],v[7]);CE(v[8],v[12]);CE(v[9],v[13]);CE(v[10],v[14]);CE(v[11],v[15]);CE(v[0],v[2]);CE(v[1],v[3]);CE(v[4],v[6]);CE(v[5],v[7]);CE(v[8],v[10]);CE(v[9],v[11]);CE(v[12],v[14]);CE(v[13],v[15]);CE(v[0],v[1]);CE(v[2],v[3]);CE(v[4],v[5]);CE(v[6],v[7]);CE(v[8],v[9]);CE(v[10],v[11]);CE(v[12],v[13]);CE(v[14],v[15]); \
} while (0)
#define TOPK_PAIRS(X) \
  X(0,0,0) X(1,0,1) X(2,0,2) X(3,0,3) X(4,0,4) X(5,0,5) X(6,0,6) X(7,0,7) X(8,0,8) X(9,0,9) X(10,0,10) X(11,0,11) X(12,0,12) X(13,0,13) X(14,0,14) X(15,0,15) X(16,1,1) X(17,1,2) X(18,1,3) X(19,1,4) X(20,1,5) X(21,1,6) X(22,1,7) X(23,2,2) X(24,2,3) X(25,2,4) X(26,3,3)

namespace tk {
typedef float f32x16 __attribute__((ext_vector_type(16)));
__device__ __forceinline__ float vmaxf(float a, float b) { float r; asm("v_max_f32 %0, %1, %2" : "=v"(r) : "v"(a), "v"(b)); return r; }
__device__ __forceinline__ float vminf(float a, float b) { float r; asm("v_min_f32 %0, %1, %2" : "=v"(r) : "v"(a), "v"(b)); return r; }
#define CE(x, y) do { const float h_ = vmaxf(x, y); y = vminf(x, y); x = h_; } while (0)
__device__ __forceinline__ unsigned fbits(float f) { return __float_as_uint(f); }
__device__ __forceinline__ float bitsf(unsigned u) { return __uint_as_float(u); }
__device__ __forceinline__ unsigned byte_lookup(const unsigned (&pk)[4], unsigned i) {
    const unsigned long long lo = (unsigned long long)pk[0] | ((unsigned long long)pk[1] << 32), hi_ = (unsigned long long)pk[2] | ((unsigned long long)pk[3] << 32);
    const unsigned long long s = (i & 8u) ? hi_ : lo;
    return (unsigned)(s >> ((i & 7u) * 8u)) & 0x7Fu;
}
constexpr float PADV = -3.0e38f;

template <int VAR>
__device__ __forceinline__ void topk_phase(Frame& F) {
    const int lane = F.lane, r32 = lane & 31, hi = lane >> 5, wid = F.wave, tid = F.tid;
    LAS unsigned char* lds = F.lds;
    const unsigned char* SUBK = F.ws + WS_SUBK; const bf16* Q = (const bf16*)(F.ws + WS_Q);
    int* IDX = (int*)(F.ws + (VAR ? 360 * MiB : WS_IDX)); float* G = (float*)(F.ws + (VAR ? 376 * MiB : WS_G));
    int cur_h = -1;
#ifdef P5_WAVE_DELAY_US
    bool delayed = false;
#endif
    for (int it = (int)blockIdx.x; it < 8 * (T / 256); it += F.G) {
        const int h = it & 7, chunk = it >> 3;
        if (h != cur_h) {
            __syncthreads();
            for (int i = tid; i < 4096; i += NWAVES * 64) { const int ch = i & 15, pn = i >> 4;
                *(LAS v4u*)(lds + (pn >> 7) * 32768 + ch * 2048 + (pn & 127) * 16) = *(const GAS v4u*)(SUBK + (size_t)h * 65536 + (size_t)pn * 256 + ch * 16); }
            __syncthreads();
            cur_h = h;
        }
#ifdef P5_WAVE_DELAY_US
        if (!delayed && wid >= 4) { const unsigned long long t0 = __builtin_amdgcn_s_memrealtime(); while (__builtin_amdgcn_s_memrealtime() - t0 < (unsigned long long)(P5_WAVE_DELAY_US * 100)) __builtin_amdgcn_s_sleep(8); }
        delayed = true;
#endif
        asm volatile("; TOPK_BEGIN");
        const int t = chunk * 256 + wid * 32 + r32;
        if (VAR == 0 || VAR == 1 || VAR == 4 || VAR == 8)
        {
            const float2 st = ((const float2*)(F.ws + WS_STATS2))[t];
            const int dcol = 128 * h + 4 * r32;
            const f32x4 g1 = *(const GAS f32x4*)(F.in[5] + dcol), b1 = *(const GAS f32x4*)(F.in[6] + dcol);
            bf16* X1B = (bf16*)(F.ws + WS_X1B);
            u32x2 yw[16];
#pragma unroll
            for (int i = 0; i < 16; ++i) yw[i] = *(const GAS u32x2*)(X1B + (size_t)(chunk * 256 + wid * 32 + 2 * i + hi) * D_MODEL + dcol);
            __builtin_amdgcn_sched_barrier(0);
#pragma unroll
            for (int i = 0; i < 16; ++i) {
                const float m0_ = __uint_as_float(__builtin_amdgcn_readlane(__float_as_uint(st.x), 2 * i)), m1_ = __uint_as_float(__builtin_amdgcn_readlane(__float_as_uint(st.x), 2 * i + 1));
                const float r0_ = __uint_as_float(__builtin_amdgcn_readlane(__float_as_uint(st.y), 2 * i)), r1_ = __uint_as_float(__builtin_amdgcn_readlane(__float_as_uint(st.y), 2 * i + 1));
                const float mu = hi ? m1_ : m0_, rs = hi ? r1_ : r0_;
                const size_t off = (size_t)(chunk * 256 + wid * 32 + 2 * i + hi) * D_MODEL + dcol;
                const f32x4 y4 = {__uint_as_float(yw[i].x << 16), __uint_as_float(yw[i].x & 0xffff0000u), __uint_as_float(yw[i].y << 16), __uint_as_float(yw[i].y & 0xffff0000u)};
                const f32x4 x4 = (y4 - mu) * rs * g1 + b1;
                u32x2 w; w.x = pk2(x4.x, x4.y); w.y = pk2(x4.z, x4.w);
                const unsigned wq = q8x4(fmaf(x4.x, X_QS, 8.f), fmaf(x4.y, X_QS, 8.f), fmaf(x4.z, X_QS, 8.f), fmaf(x4.w, X_QS, 8.f)) ^ 0x08080808u;
                if (VAR == 0) { *(GAS u32x2*)(X1B + off) = w; *(GAS unsigned*)(F.ws + WS_X1Q + off) = wq; } else asm volatile("" :: "v"(w.x), "v"(w.y), "v"(wq));
            }
        }
        float v[128];
        if (VAR == 9 || VAR == 10) {
#pragma unroll
            for (int i_ = 0; i_ < 128; ++i_) v[i_] = bitsf((unsigned)(t * 2654435761u + i_ * 40503u) | 0x3F000000u);
            if (VAR == 9) { TOPK_SORT128(v); }
            _Pragma("unroll") for (int i_ = 0; i_ < 128; ++i_) asm volatile("" :: "v"(v[i_]));
            continue;
        }
        {
            f32x16 acc[2][4];
#pragma unroll
            for (int p = 0; p < 2; ++p)
#pragma unroll
                for (int nt = 0; nt < 4; ++nt)
#pragma unroll
                    for (int r = 0; r < 16; ++r) acc[p][nt][r] = 0.f;
#pragma unroll
            for (int p = 0; p < 2; ++p) {
                bf16x8 bq[8];
#pragma unroll
                for (int ks = 0; ks < 8; ++ks) bq[ks] = *(const GAS bf16x8*)(Q + ((size_t)(t >> 5) * 8192 + (size_t)(h * 32 + p * 16 + ks * 2 + hi) * 32 + r32) * 8);
#pragma unroll
                for (int ks = 0; ks < 8; ++ks)
#pragma unroll
                    for (int nt = 0; nt < 4; ++nt) {
                        const bf16x8 a = *(const LAS bf16x8*)(lds + p * 32768 + (2 * ks + hi) * 2048 + (nt * 32 + r32) * 16);
                        acc[p][nt] = __builtin_amdgcn_mfma_f32_32x32x16_bf16(a, bq[ks], acc[p][nt], 0, 0, 0);
                    }
            }
#pragma unroll
            for (int nt = 0; nt < 4; ++nt)
#pragma unroll
                for (int r = 0; r < 16; ++r) {
                    auto rr = __builtin_amdgcn_permlane32_swap(fbits(acc[0][nt][r]), fbits(acc[1][nt][r]), false, false);
                    const unsigned n0 = 32 * nt + (r & 3) + 8 * (r >> 2);
                    v[nt * 32 + r] = bitsf((rr[0] & 0xFFFFFF80u) | n0);
                    v[nt * 32 + 16 + r] = bitsf((rr[1] & 0xFFFFFF80u) | (n0 + 4u));
                }
        }
        if (VAR == 6) { _Pragma("unroll") for (int i_ = 0; i_ < 128; ++i_) asm volatile("" :: "v"(v[i_])); continue; }
        unsigned pf0 = 0, pf1 = 0, pf2 = 0, pf3 = 0;
        if (it + F.G < 8 * (T / 256)) {
            const int hn = (it + F.G) & 7, chn = (it + F.G) >> 3, tgn = chn * 8 + wid;
            const unsigned char* qn_ = (const unsigned char*)Q + ((size_t)tgn * 8192 + (size_t)hn * 1024) * 16;
            pf0 = *(const GAS unsigned*)(qn_ + lane * 128); pf1 = *(const GAS unsigned*)(qn_ + (64 + lane) * 128);
            pf2 = *(const GAS unsigned*)((const unsigned char*)(F.ws + WS_X1B) + ((size_t)(tgn * 32 + (lane >> 1)) * D_MODEL + 128 * hn) * 2 + (lane & 1) * 128);
            pf3 = *(const GAS unsigned*)((const unsigned char*)(F.ws + WS_STATS2) + (size_t)(tgn * 32 + (lane & 31)) * 8);
        }
        if (VAR == 2 || VAR == 4 || VAR == 5) { _Pragma("unroll") for (int i_ = 16; i_ < 128; ++i_) asm volatile("" :: "v"(v[i_])); } else
        TOPK_SORT128(v);
        unsigned ak[16], bk[16]; float uval[16], wval[16];
#pragma unroll
        for (int i = 0; i < 16; ++i) {
            auto rr = __builtin_amdgcn_permlane32_swap(fbits(v[i]), fbits(v[i]), false, false);
            ak[i] = rr[0]; bk[i] = rr[1];
            const unsigned oth = hi ? rr[0] : rr[1];
            uval[i] = bitsf(fbits(v[i]) & 0xFFFFFF80u); wval[i] = bitsf(oth & 0xFFFFFF80u);
        }
        unsigned na_pack[4], nb_pack[4];
#pragma unroll
        for (int q = 0; q < 4; ++q) {
            na_pack[q] = (ak[4 * q] & 0x7Fu) | ((ak[4 * q + 1] & 0x7Fu) << 8) | ((ak[4 * q + 2] & 0x7Fu) << 16) | ((ak[4 * q + 3] & 0x7Fu) << 24);
            nb_pack[q] = (bk[4 * q] & 0x7Fu) | ((bk[4 * q + 1] & 0x7Fu) << 8) | ((bk[4 * q + 2] & 0x7Fu) << 16) | ((bk[4 * q + 3] & 0x7Fu) << 24);
        }
        float cand[32];
        const unsigned hb = (unsigned)hi << 8;
#define TK_X(k, i, j) { const float s_ = uval[i] + wval[j]; unsigned kb_ = (fbits(s_) & 0xFFFFFE00u) | hb | (unsigned)((i) * 16 + (j)); if ((i) == (j)) kb_ = hi ? fbits(PADV) : kb_; cand[k] = bitsf(kb_); }
        TOPK_PAIRS(TK_X)
#undef TK_X
#pragma unroll
        for (int k = 27; k < 32; ++k) cand[k] = PADV;
        if (VAR == 3 || VAR == 4 || VAR == 5) { _Pragma("unroll") for (int i_ = 16; i_ < 32; ++i_) asm volatile("" :: "v"(cand[i_])); } else
        TOPK_SORT32(cand);
        float fin[16];
        {
            unsigned oc[16];
#pragma unroll
            for (int i = 0; i < 16; ++i) { auto rr = __builtin_amdgcn_permlane32_swap(fbits(cand[i]), fbits(cand[i]), false, false); oc[i] = hi ? rr[0] : rr[1]; }
#pragma unroll
            for (int i = 0; i < 16; ++i) fin[i] = vmaxf(cand[i], bitsf(oc[15 - i]));
        }
        TOPK_MERGE_BITONIC16(fin);
        float e[16]; float esum = 0.f; const float m0 = bitsf(fbits(fin[0]) & 0xFFFFFE00u);
#pragma unroll
        for (int k = 0; k < 16; ++k) { e[k] = __builtin_amdgcn_exp2f((bitsf(fbits(fin[k]) & 0xFFFFFE00u) - m0) * LOG2E); esum += e[k]; }
        const float inv = 1.f / esum;
        int oi[8]; float og[8];
#pragma unroll
        for (int kk = 0; kk < 8; ++kk) {
            const unsigned key = hi ? fbits(fin[8 + kk]) : fbits(fin[kk]); og[kk] = (hi ? e[8 + kk] : e[kk]) * inv;
            const unsigned code = key & 0x1FFu, f = code >> 8, ci = (code >> 4) & 15u, cj = code & 15u;
            const unsigned ia = f ? cj : ci, jb = f ? ci : cj;
            oi[kk] = (int)(byte_lookup(na_pack, ia) * 128u + byte_lookup(nb_pack, jb));
        }
        int* ip = IDX + ((size_t)h * T + t) * TOPK + 8 * hi; float* gp = G + ((size_t)h * T + t) * TOPK + 8 * hi;
        if (VAR == 8) { _Pragma("unroll") for (int i_ = 0; i_ < 8; ++i_) asm volatile("" :: "v"(oi[i_]), "v"(og[i_])); } else {
        *(GAS v4u*)((unsigned short*)IDX + ((size_t)h * T + t) * TOPK + 8 * hi) = (v4u){(unsigned)oi[0] | ((unsigned)oi[1] << 16), (unsigned)oi[2] | ((unsigned)oi[3] << 16), (unsigned)oi[4] | ((unsigned)oi[5] << 16), (unsigned)oi[6] | ((unsigned)oi[7] << 16)};
        { typedef _Float16 h2_ __attribute__((ext_vector_type(2)));
          v4u gw_;
#pragma unroll
          for (int q_ = 0; q_ < 4; ++q_) { const h2_ hh_ = {(_Float16)og[2 * q_], (_Float16)og[2 * q_ + 1]}; gw_[q_] = __builtin_bit_cast(unsigned, hh_); }
          *(GAS v4u*)((_Float16*)G + ((size_t)h * T + t) * TOPK + 8 * hi) = gw_; } }
        asm volatile("" :: "v"(pf0), "v"(pf1), "v"(pf2), "v"(pf3));
        asm volatile("; TOPK_END");
    }
}
#undef CE
}


namespace ex {
typedef float f32x2 __attribute__((ext_vector_type(2)));
typedef _Float16 h16x2 __attribute__((ext_vector_type(2)));
__device__ __forceinline__ float gelu_erf(float v) {
    const float av = fabsf(v), t = __builtin_amdgcn_rcpf(fmaf(av, 0.2316418882f, 1.0f));
    float q = fmaf(t, 0.5307027145f, -0.7265760135f); q = fmaf(q, t, 0.7107068705f); q = fmaf(q, t, -0.142248368f); q = fmaf(q, t, 0.127414796f); q = q * t;
    const float ee = __builtin_amdgcn_exp2f(v * v * -0.72134752044f);
    const float mm = v * (q * ee);
    return v < 0.f ? mm : v - mm;
}
__device__ __forceinline__ f32x2 bf2_to_f2(unsigned w) { return (f32x2){__uint_as_float(w << 16), __uint_as_float(w & 0xffff0000u)}; }

template <int PH> struct Aux;
template <> struct Aux<0> { v4u xq[2]; };
template <> struct Aux<1> { v4u wv; u32x2 x4; };

template <int PH>
__device__ __forceinline__ void gather_issue(Frame& F, v4u (&rw)[16], Aux<PH>& ax, const LAS unsigned* ixl, const unsigned char* tab, unsigned loff, int t, int i, int g, int dl) {
    v4u ix[4];
#pragma unroll
    for (int jj = 0; jj < 4; ++jj) ix[jj] = *(const LAS v4u*)(ixl + i * 128 + 16 * g + 4 * jj);
#pragma unroll
    for (int j = 0; j < 16; ++j) rw[j] = *(const GAS v4u*)(tab + (unsigned)(ix[j >> 2][j & 3] * 128u + loff));
    if constexpr (PH == 0) {
        ax.xq[0] = __builtin_nontemporal_load((const GAS v4u*)(F.ws + WS_X1Q + (size_t)t * D_MODEL + dl)); ax.xq[1] = __builtin_nontemporal_load((const GAS v4u*)(F.ws + WS_X1Q + (size_t)t * D_MODEL + dl + 16));
    } else {
        ax.wv = __builtin_nontemporal_load((const GAS v4u*)(F.ws + WS_W16 + (size_t)t * 128 + 16 * g));
        ax.x4 = __builtin_nontemporal_load((const GAS u32x2*)((const bf16*)(F.ws + WS_X1B) + (size_t)t * D_MODEL + dl + 4 * g));
    }
}
template <int PH, int VAR>
__device__ __forceinline__ void gather_compute(Frame& F, const v4u (&rw)[16], const Aux<PH>& ax, int slice, int t, int lane, int g, int sub, int dl) {
    if constexpr (PH == 0) {
        unsigned XH[4], XL[4];
#pragma unroll
        for (int c = 0; c < 4; ++c) {
            const unsigned za = ax.xq[c >> 1][2 * (c & 1)], zb = ax.xq[c >> 1][2 * (c & 1) + 1];
            XL[c] = (za & 0x0F0F0F0Fu) | ((zb & 0x0F0F0F0Fu) << 4);
            XH[c] = ((za >> 4) & 0x0F0F0F0Fu) | (zb & 0xF0F0F0F0u);
        }
        int p[16];
#pragma unroll
        for (int j = 0; j < 16; ++j) {
            int ah = 0, al = 0;
#pragma unroll
            for (int c = 0; c < 4; ++c) { ah = __builtin_amdgcn_sdot8((int)rw[j][c], (int)XH[c], ah, false); al = __builtin_amdgcn_sdot8((int)rw[j][c], (int)XL[c], al, false); }
            p[j] = 16 * ah + al;
        }
        int sxh = 0, sxl = 0;
#pragma unroll
        for (int c = 0; c < 4; ++c) { sxh = __builtin_amdgcn_sdot8((int)XH[c], 0x11111111, sxh, false); sxl = __builtin_amdgcn_sdot8((int)XL[c], 0x11111111, sxl, false); }
        int sx = 16 * sxh + sxl;
        sx += __builtin_amdgcn_update_dpp(0, sx, 0xB1, 0xF, 0xF, false); sx += __builtin_amdgcn_update_dpp(0, sx, 0x4E, 0xF, 0xF, false); sx += __builtin_amdgcn_update_dpp(0, sx, 0x141, 0xF, 0xF, false);
        const bool b2 = (lane & 4) != 0, b1 = (lane & 2) != 0, b0 = (lane & 1) != 0;
#pragma unroll
        for (int k = 0; k < 8; ++k) { const int send = b2 ? p[k] : p[k + 8], keep = b2 ? p[k + 8] : p[k]; p[k] = keep + __builtin_amdgcn_update_dpp(0, send, 0x141, 0xF, 0xF, false); }
#pragma unroll
        for (int k = 0; k < 4; ++k) { const int send = b1 ? p[k] : p[k + 4], keep = b1 ? p[k + 4] : p[k]; p[k] = keep + __builtin_amdgcn_update_dpp(0, send, 0x4E, 0xF, 0xF, false); }
#pragma unroll
        for (int k = 0; k < 2; ++k) { const int send = b0 ? p[k] : p[k + 2], keep = b0 ? p[k + 2] : p[k]; p[k] = keep + __builtin_amdgcn_update_dpp(0, send, 0xB1, 0xF, 0xF, false); }
        const float pf0 = (float)(2 * p[0] + sx) * (1.f / (2.f * UQ4 * X_QS)), pf1 = (float)(2 * p[1] + sx) * (1.f / (2.f * UQ4 * X_QS));
        const h16x2 ph = {(_Float16)pf0, (_Float16)pf1};
        if (VAR == 0) *(GAS unsigned*)((_Float16*)(F.ws + WS_HP) + ((size_t)slice * T + t) * 128 + 16 * g + 2 * sub) = __builtin_bit_cast(unsigned, ph); else asm volatile("" :: "v"(pf0), "v"(pf1));
    } else {
        const float wsc = ((const float*)(F.ws + WS_MR))[t];
        const int sw = ((const int*)(F.ws + WS_MR))[T + t];
        int acc[32];
#pragma unroll
        for (int c = 0; c < 32; ++c) acc[c] = 0;
#pragma unroll
        for (int q4 = 0; q4 < 4; ++q4) {
            const int w4 = (int)ax.wv[q4];
#pragma unroll
            for (int c = 0; c < 4; ++c) {
                const unsigned r0 = rw[4 * q4][c], r1 = rw[4 * q4 + 1][c], r2 = rw[4 * q4 + 2][c], r3 = rw[4 * q4 + 3][c];
                const unsigned lo01 = __builtin_amdgcn_perm(r1, r0, 0x05010400u), hi01 = __builtin_amdgcn_perm(r1, r0, 0x07030602u);
                const unsigned lo23 = __builtin_amdgcn_perm(r3, r2, 0x05010400u), hi23 = __builtin_amdgcn_perm(r3, r2, 0x07030602u);
                unsigned dq[4];
                dq[0] = __builtin_amdgcn_perm(lo23, lo01, 0x05040100u); dq[1] = __builtin_amdgcn_perm(lo23, lo01, 0x07060302u);
                dq[2] = __builtin_amdgcn_perm(hi23, hi01, 0x05040100u); dq[3] = __builtin_amdgcn_perm(hi23, hi01, 0x07060302u);
#pragma unroll
                for (int b = 0; b < 4; ++b) {
                    acc[8 * c + b] = __builtin_amdgcn_sdot4((int)dq[b], w4, acc[8 * c + b], false);
                    acc[8 * c + 4 + b] = __builtin_amdgcn_sdot4((int)(dq[b] & 0xF0F0F0F0u), w4, acc[8 * c + 4 + b], false);
                }
            }
        }
#pragma unroll
        for (int c = 0; c < 4; ++c)
#pragma unroll
            for (int b = 0; b < 4; ++b) acc[8 * c + b] -= acc[8 * c + 4 + b];
#pragma unroll
        for (int k = 0; k < 16; ++k) { auto rr = __builtin_amdgcn_permlane32_swap((unsigned)acc[k], (unsigned)acc[k + 16], false, false); acc[k] = (int)rr[0] + (int)rr[1]; }
#pragma unroll
        for (int k = 0; k < 8; ++k) { auto rr = __builtin_amdgcn_permlane16_swap((unsigned)acc[k], (unsigned)acc[k + 8], false, false); acc[k] = (int)rr[0] + (int)rr[1]; }
        const bool b3 = (lane & 8) != 0;
#pragma unroll
        for (int k = 0; k < 4; ++k) { const int send = b3 ? acc[k] : acc[k + 4], keep = b3 ? acc[k + 4] : acc[k]; acc[k] = keep + __builtin_amdgcn_update_dpp(0, send, 0x128, 0xF, 0xF, false); }
        const bool hig = (g & 1) != 0;
        const float fs = hig ? wsc * (1.f / 16.f) : wsc * 0.5f;
        float a[4];
#pragma unroll
        for (int i = 0; i < 4; ++i) a[i] = (float)(hig ? acc[i] + 8 * sw : 2 * acc[i] - 15 * sw) * fs;
        const f32x2 xa = bf2_to_f2(ax.x4.x), xb = bf2_to_f2(ax.x4.y);
        u32x2 o; o.x = pk2(fmaf(ALPHA, xa.x, a[0]), fmaf(ALPHA, xa.y, a[1])); o.y = pk2(fmaf(ALPHA, xb.x, a[2]), fmaf(ALPHA, xb.y, a[3]));
        if (VAR == 0) *(GAS u32x2*)((bf16*)(F.ws + WS_V2) + (size_t)t * D_MODEL + dl + 4 * g) = o; else asm volatile("" :: "v"(o.x), "v"(o.y));
    }
}

#ifndef GTW_V
#define GTW_V 16
#endif
constexpr int GTW = GTW_V, GTU = 16;
template <int PH> constexpr int gtw_of() { return PH == 0 ? GTU : GTW; }
template <int PH, int VAR>
__device__ __forceinline__ void gather_item(Frame& F, int slice_, int chunk_) {
    const int lane = F.lane, g = lane >> 3, sub = lane & 7;
    const int slice = __builtin_amdgcn_readfirstlane(slice_), chunk = __builtin_amdgcn_readfirstlane(chunk_);
    const unsigned char* tab = F.ws + (PH == 0 ? WS_EU : WS_EV) + (size_t)slice * EXP_SLICE_BYTES;
    const unsigned loff = 16u * (unsigned)sub;
    constexpr int GT = gtw_of<PH>();
    const int tbase = chunk * (8 * GT) + F.wave * GT;
    const int dl = 256 * slice + 32 * sub;
    LAS unsigned* ixl = (LAS unsigned*)(F.lds + F.wave * 16384);
    {
        constexpr int PER = GT / 16;
        u32x2 tmp[8 * PER];
#pragma unroll
        for (int k = 0; k < 8 * PER; ++k) tmp[k] = __builtin_nontemporal_load((const GAS u32x2*)((const unsigned short*)(F.ws + WS_IDX) + ((size_t)(k / PER) * T + tbase) * 16 + ((k % PER) * 64 + lane) * 4));
#pragma unroll
        for (int k = 0; k < 8 * PER; ++k) { const int q = (k % PER) * 64 + lane; *(LAS v4u*)(ixl + (q >> 2) * 128 + 16 * (k / PER) + 4 * (q & 3)) = (v4u){tmp[k].x & 0xFFFFu, tmp[k].x >> 16, tmp[k].y & 0xFFFFu, tmp[k].y >> 16}; }
    }
    v4u rwA[16], rwB[16]; Aux<PH> axA, axB;
    gather_issue<PH>(F, rwA, axA, ixl, tab, loff, tbase, 0, g, dl);
    if (VAR == 2) gather_issue<PH>(F, rwB, axB, ixl, tab, loff, tbase + 1, 1, g, dl);
#pragma unroll 4
    for (int i = 0; i < GT; i += 2) {
        if (VAR != 2) gather_issue<PH>(F, rwB, axB, ixl, tab, loff, tbase + i + 1, i + 1, g, dl);
        if (VAR != 1) gather_compute<PH, VAR>(F, rwA, axA, slice, tbase + i, lane, g, sub, dl);
        else { _Pragma("unroll") for (int j = 0; j < 16; ++j) asm volatile("" :: "v"(rwA[j])); }
        const int in = (i + 2 < GT) ? i + 2 : GT - 1;
        if (VAR != 2) gather_issue<PH>(F, rwA, axA, ixl, tab, loff, tbase + in, in, g, dl);
        if (VAR != 1) gather_compute<PH, VAR>(F, rwB, axB, slice, tbase + i + 1, lane, g, sub, dl);
        else { _Pragma("unroll") for (int j = 0; j < 16; ++j) asm volatile("" :: "v"(rwB[j])); }
        if (VAR == 2) { _Pragma("unroll") for (int j = 0; j < 16; ++j) asm volatile("" : "+v"(rwA[j]), "+v"(rwB[j])); }
    }
}

struct VAux { v4u wv; };
__device__ __forceinline__ void vtok_issue(Frame& F, v4u (&rw)[16], VAux& ax, const LAS unsigned* ixl, const unsigned char* tab, unsigned loff, int tl, int t, int h) {
    v4u ix[4];
#pragma unroll
    for (int jj = 0; jj < 4; ++jj) ix[jj] = *(const LAS v4u*)(ixl + tl * 128 + 16 * h + 4 * jj);
#pragma unroll
    for (int j = 0; j < 16; ++j) rw[j] = *(const GAS v4u*)(tab + (unsigned)(ix[j >> 2][j & 3] * 128u + loff));
    ax.wv = __builtin_nontemporal_load((const GAS v4u*)(F.ws + WS_W16 + (size_t)t * 128 + 16 * h));
}
__device__ __forceinline__ void vtok_compute(const v4u (&rw)[16], const VAux& ax, int (&acc)[32], bool first) {
#pragma unroll
    for (int q4 = 0; q4 < 4; ++q4) {
        const int w4 = (int)ax.wv[q4];
#pragma unroll
        for (int c = 0; c < 4; ++c) {
            const unsigned r0 = rw[4 * q4][c], r1 = rw[4 * q4 + 1][c], r2 = rw[4 * q4 + 2][c], r3 = rw[4 * q4 + 3][c];
            const unsigned lo01 = __builtin_amdgcn_perm(r1, r0, 0x05010400u), hi01 = __builtin_amdgcn_perm(r1, r0, 0x07030602u);
            const unsigned lo23 = __builtin_amdgcn_perm(r3, r2, 0x05010400u), hi23 = __builtin_amdgcn_perm(r3, r2, 0x07030602u);
            unsigned dq[4];
            dq[0] = __builtin_amdgcn_perm(lo23, lo01, 0x05040100u); dq[1] = __builtin_amdgcn_perm(lo23, lo01, 0x07060302u);
            dq[2] = __builtin_amdgcn_perm(hi23, hi01, 0x05040100u); dq[3] = __builtin_amdgcn_perm(hi23, hi01, 0x07060302u);
#pragma unroll
            for (int b = 0; b < 4; ++b) {
                const int a0 = (first && q4 == 0) ? 0 : acc[8 * c + b], a1 = (first && q4 == 0) ? 0 : acc[8 * c + 4 + b];
                acc[8 * c + b] = __builtin_amdgcn_sdot4((int)dq[b], w4, a0, false);
                acc[8 * c + 4 + b] = __builtin_amdgcn_sdot4((int)(dq[b] & 0xF0F0F0F0u), w4, a1, false);
            }
        }
    }
}
struct VFin { float wsc; int sw; v4u xv[4]; };
__device__ __forceinline__ void vtok_finload(Frame& F, VFin& fi, int t, int dl) {
    fi.wsc = ((const float*)(F.ws + WS_MR))[t];
    fi.sw = ((const int*)(F.ws + WS_MR))[T + t];
    const bf16* xr = (const bf16*)(F.ws + WS_X1B) + (size_t)t * D_MODEL + dl;
#pragma unroll
    for (int c = 0; c < 4; ++c) fi.xv[c] = __builtin_nontemporal_load((const GAS v4u*)(xr + 8 * c));
}
template <int VAR>
__device__ __forceinline__ void vtok_finish(Frame& F, const int (&acc)[32], const VFin& fi, int t, int dl) {
    const float wsc = fi.wsc; const int sw = fi.sw; const v4u (&xv)[4] = fi.xv;
    bf16* vr = (bf16*)(F.ws + WS_V2) + (size_t)t * D_MODEL + dl;
    const float fl = wsc * 0.5f, fh = wsc * (1.f / 16.f);
#pragma unroll
    for (int c = 0; c < 4; ++c) {
        float o[8];
#pragma unroll
        for (int b = 0; b < 4; ++b) {
            o[b] = (float)(2 * (acc[8 * c + b] - acc[8 * c + 4 + b]) - 15 * sw) * fl;
            o[4 + b] = (float)(acc[8 * c + 4 + b] + 8 * sw) * fh;
        }
        v4u w;
#pragma unroll
        for (int i = 0; i < 4; ++i) { const f32x2 xx = bf2_to_f2(xv[c][i]); w[i] = pk2(fmaf(ALPHA, xx.x, o[2 * i]), fmaf(ALPHA, xx.y, o[2 * i + 1])); }
        if (VAR == 0) *(GAS v4u*)(vr + 8 * c) = w; else asm volatile("" :: "v"(w));
    }
}
template <int VAR>
__device__ __forceinline__ void gather_item_v(Frame& F, int slice_, int chunk_) {
    const int lane = F.lane, g = lane >> 3, sub = lane & 7;
    const int slice = __builtin_amdgcn_readfirstlane(slice_), chunk = __builtin_amdgcn_readfirstlane(chunk_);
    const unsigned char* tab = F.ws + WS_EV + (size_t)slice * EXP_SLICE_BYTES;
    const unsigned loff = 16u * (unsigned)sub;
    constexpr int GT = 16;
    const int tbase = chunk * (8 * GT) + F.wave * GT;
    const int dl = 256 * slice + 32 * sub;
    LAS unsigned* ixl = (LAS unsigned*)(F.lds + F.wave * 16384);
    {
        u32x2 tmp[8];
#pragma unroll
        for (int k = 0; k < 8; ++k) tmp[k] = __builtin_nontemporal_load((const GAS u32x2*)((const unsigned short*)(F.ws + WS_IDX) + ((size_t)k * T + tbase) * 16 + lane * 4));
#pragma unroll
        for (int k = 0; k < 8; ++k) *(LAS v4u*)(ixl + (lane >> 2) * 128 + 16 * k + 4 * (lane & 3)) = (v4u){tmp[k].x & 0xFFFFu, tmp[k].x >> 16, tmp[k].y & 0xFFFFu, tmp[k].y >> 16};
    }
    v4u rwA[16], rwB[16]; VAux axA, axB; int acc[32]; VFin fin;
    vtok_issue(F, rwA, axA, ixl, tab, loff, g, tbase + g, 0);
#pragma unroll 1
    for (int oc = 0; oc < 2; ++oc) {
        const int tl = oc * 8 + g, t = tbase + tl;
#pragma unroll
        for (int h = 0; h < 8; h += 2) {
            vtok_issue(F, rwB, axB, ixl, tab, loff, tl, t, h + 1);
            vtok_compute(rwA, axA, acc, h == 0);
            if (h + 2 < 8) vtok_issue(F, rwA, axA, ixl, tab, loff, tl, t, h + 2);
            else { const int tn = (oc == 0) ? tl + 8 : tl; vtok_issue(F, rwA, axA, ixl, tab, loff, tn, tbase + tn, 0); vtok_finload(F, fin, t, dl); }
            vtok_compute(rwB, axB, acc, false);
        }
        vtok_finish<VAR>(F, acc, fin, t, dl);
    }
}

template <int PH, int VAR = 0>
__device__ __forceinline__ void gather_phase(Frame& F) {
    LAS int* sh = (LAS int*)(F.lds + RING_BYTES + 1024);
    const unsigned xcc = xb_xcc_id() & 7u;
    gu32* qbase = F.ctl + (VAR ? CW_QV + 1024 : (PH == 0 ? CW_QU : CW_QV));
    for (int r = 0; r < 8; ++r) {
        const int qi = (int)((xcc + (unsigned)r) & 7u);
        for (;;) {
            if (F.tid == 0) sh[0] = (int)__hip_atomic_fetch_add(qbase + 64 * qi, 1u, __ATOMIC_RELAXED, __HIP_MEMORY_SCOPE_AGENT);
            __syncthreads();
            const int n = sh[0];
            __syncthreads();
            if (n >= T / (16 * gtw_of<PH>())) break;
            if (PH == 1 && VAR == 0) gather_item_v<0>(F, qi >> 1, 2 * n + (qi & 1));
            else gather_item<PH, VAR>(F, qi >> 1, 2 * n + (qi & 1));
        }
    }
}

__device__ __forceinline__ void combine_phase(Frame& F) {
    const _Float16* HP = (const _Float16*)(F.ws + WS_HP); const float* W = (const float*)(F.ws + WS_G);
    const int nthr = F.G * NWAVES * 64;
    for (int i = F.vcu * NWAVES * 64 + F.tid; i < T * 128 / 4; i += nthr) {
        f32x4 s = {0.f, 0.f, 0.f, 0.f};
#pragma unroll
        for (int sl = 0; sl < 4; ++sl) {
            const u32x2 hw = __builtin_nontemporal_load((const GAS u32x2*)(HP + (size_t)sl * T * 128 + (size_t)i * 4));
            s[0] += (float)__builtin_bit_cast(_Float16, (unsigned short)(hw.x & 0xFFFFu)); s[1] += (float)__builtin_bit_cast(_Float16, (unsigned short)(hw.x >> 16));
            s[2] += (float)__builtin_bit_cast(_Float16, (unsigned short)(hw.y & 0xFFFFu)); s[3] += (float)__builtin_bit_cast(_Float16, (unsigned short)(hw.y >> 16));
        }
        const u32x2 gh_ = *(const GAS u32x2*)((const _Float16*)W + ((size_t)((i & 31) >> 2) * T + (i >> 5)) * 16 + (i & 3) * 4);
        const f32x4 gv = {(float)__builtin_bit_cast(_Float16, (unsigned short)(gh_.x & 0xFFFFu)), (float)__builtin_bit_cast(_Float16, (unsigned short)(gh_.x >> 16)),
                          (float)__builtin_bit_cast(_Float16, (unsigned short)(gh_.y & 0xFFFFu)), (float)__builtin_bit_cast(_Float16, (unsigned short)(gh_.y >> 16))};
        float wv_[4]; float mx = 0.f;
#pragma unroll
        for (int e = 0; e < 4; ++e) { wv_[e] = gv[e] * gelu_erf(s[e]); mx = fmaxf(mx, fabsf(wv_[e])); }
#pragma unroll
        for (int o = 1; o < 32; o <<= 1) mx = fmaxf(mx, __shfl_xor(mx, o));
        const float sc = 127.f / fmaxf(mx, 1e-30f);
        const unsigned wq8 = q8x4(wv_[0] * sc, wv_[1] * sc, wv_[2] * sc, wv_[3] * sc);
        *(GAS unsigned*)(F.ws + WS_W16 + (size_t)i * 4) = wq8;
        int sw = __builtin_amdgcn_sdot4((int)wq8, 0x01010101, 0, false);
#pragma unroll
        for (int o = 1; o < 32; o <<= 1) sw += __shfl_xor(sw, o);
        if ((i & 31) == 0) { ((float*)(F.ws + WS_MR))[i >> 5] = 1.f / (sc * VQ4); ((int*)(F.ws + WS_MR))[T + (i >> 5)] = sw; }
    }
}

__device__ __forceinline__ void ln2_phase(Frame& F) {
    const int lane = F.lane, gw = F.vcu * NWAVES + F.wave, NGW = F.G * NWAVES;
    const float* ln2_g = F.in[11]; const float* ln2_b = F.in[12];
    f32x4 gg[4], bb[4];
#pragma unroll
    for (int j = 0; j < 2; ++j) { gg[2 * j] = *(const GAS f32x4*)(ln2_g + 512 * j + 8 * lane); gg[2 * j + 1] = *(const GAS f32x4*)(ln2_g + 512 * j + 8 * lane + 4);
                                  bb[2 * j] = *(const GAS f32x4*)(ln2_b + 512 * j + 8 * lane); bb[2 * j + 1] = *(const GAS f32x4*)(ln2_b + 512 * j + 8 * lane + 4); }
    for (int t = gw; t < T; t += NGW) {
        const bf16* vrow = (const bf16*)(F.ws + WS_V2) + (size_t)t * D_MODEL;
        f32x4 v[4]; float s = 0.f;
#pragma unroll
        for (int j = 0; j < 2; ++j) { const v4u w = __builtin_nontemporal_load((const GAS v4u*)(vrow + 512 * j + 8 * lane));
            v[2 * j] = (f32x4){__uint_as_float(w[0] << 16), __uint_as_float(w[0] & 0xffff0000u), __uint_as_float(w[1] << 16), __uint_as_float(w[1] & 0xffff0000u)};
            v[2 * j + 1] = (f32x4){__uint_as_float(w[2] << 16), __uint_as_float(w[2] & 0xffff0000u), __uint_as_float(w[3] << 16), __uint_as_float(w[3] & 0xffff0000u)}; }
#pragma unroll
        for (int j = 0; j < 4; ++j) s += (v[j].x + v[j].y) + (v[j].z + v[j].w);
        const float mean = wave_sum(s) * (1.f / D_MODEL); float s2 = 0.f;
#pragma unroll
        for (int j = 0; j < 4; ++j) { v[j] = v[j] - mean; s2 += (v[j].x * v[j].x + v[j].y * v[j].y) + (v[j].z * v[j].z + v[j].w * v[j].w); }
        const float rstd = 1.f / sqrtf(wave_sum(s2) * (1.f / D_MODEL) + LN_EPS);
        float* row = F.out + (size_t)t * D_MODEL;
#pragma unroll
        for (int j = 0; j < 2; ++j) { *(GAS f32x4*)(row + 512 * j + 8 * lane) = v[2 * j] * rstd * gg[2 * j] + bb[2 * j]; *(GAS f32x4*)(row + 512 * j + 8 * lane + 4) = v[2 * j + 1] * rstd * gg[2 * j + 1] + bb[2 * j + 1]; }
    }
}
}

struct Args { const float* in[13]; float* out; unsigned char* ws; int ph_lo, ph_hi; };
static_assert(sizeof(Args) == 13 * 8 + 8 + 8 + 8, "Args has no padding");
constexpr int N_PHASES = 10;
template <class Epi> struct EpiNull {
    static constexpr bool PERM = Epi::PERM, AFTER_DRAIN = Epi::AFTER_DRAIN;
    __device__ __forceinline__ void operator()(const pg8::f32x4 (&acc)[2][2][4][2], const pg8::Unit&, int, int, int, int) const {
#pragma unroll
        for (int a = 0; a < 2; ++a)
#pragma unroll
            for (int b = 0; b < 2; ++b)
#pragma unroll
                for (int m = 0; m < 4; ++m) { asm volatile("" :: "v"(acc[a][b][m][0]), "v"(acc[a][b][m][1])); }
    }
};

__global__ void __launch_bounds__(NWAVES * 64, 2) mk_fwd(Args args) {
    extern __shared__ __attribute__((aligned(16))) unsigned char lds[];
    Frame F;
    F.lds = (LAS unsigned char*)lds;
    F.MISC = (volatile LAS unsigned*)(F.lds + MISC_OFF);
    F.tid = threadIdx.x; F.lane = F.tid & 63; F.wave = __builtin_amdgcn_readfirstlane(F.tid >> 6);
    F.G = gridDim.x; { const int bx = blockIdx.x; F.vcu = (F.G % 8 == 0) ? (bx % 8) * (F.G / 8) + bx / 8 : bx; }
    F.ws = args.ws; F.out = args.out; F.ctl = (gu32*)(args.ws + WS_CTL);
#pragma unroll
    for (int i = 0; i < 13; ++i) F.in[i] = args.in[i];
    for (int u = F.tid; u < (LDS_BYTES - RING_BYTES) / 4; u += NWAVES * 64) ((LAS unsigned*)(F.lds + RING_BYTES))[u] = 0u;
    __syncthreads();
    XcdBarrier bar = xcd_barrier_post((unsigned*)(F.ctl + CW_BAR), F.MISC + 8);
    const int lo = args.ph_lo, hi = args.ph_hi;
#ifndef ATT_KMASK
#define ATT_KMASK 3
#endif
#define IN(k) (lo <= (k) && (k) < hi)
#define SEAM(k) do { if (IN(k) && IN((k) + 1)) xcd_barrier(bar); } while (0)

    if (IN(0)) { p0_prologue(F); }
    SEAM(0);
    if (IN(1)) {
        pg8::Gemm g{(const pg8::bf16_t*)(F.ws + WS_XQ), (const pg8::bf16_t*)(F.ws + WS_WIN), T, NPHYS, D_MODEL / 2};
        pg8::StaticOrder S; S.init(T, NPHYS, F.G, (int)blockIdx.x);
        EpiInProj E{(bf16*)(F.ws + WS_FQ), (bf16*)(F.ws + WS_FKT), (bf16*)(F.ws + WS_FVT), (bf16*)(F.ws + WS_SQ), (bf16*)(F.ws + WS_SKT), (bf16*)(F.ws + WS_SVT),
                    (const float2*)(F.ws + WS_ROPE), (float*)(F.ws + WS_QN2), (float*)(F.ws + WS_KN2)};
        const bool upper = (int)blockIdx.x >= F.G / 2;
        if (upper) { p1_slack_jobs(F, (int)blockIdx.x - F.G / 2, F.G - F.G / 2); convert_experts(F, ((int)blockIdx.x - F.G / 2) * NWAVES + F.wave, (F.G - F.G / 2) * NWAVES, EXP_SPLIT, EXP_SPLIT + V_PRE); __syncthreads(); }
#ifdef GEMM_NULL
        if (lo == 1) pg8::gemm_phase<EpiNull<EpiInProj>, pg8::StaticOrder, true, true, true>(F.lds, g, S, EpiNull<EpiInProj>{}); else
#endif
        pg8::gemm_phase<EpiInProj, pg8::StaticOrder, true, true, true>(F.lds, g, S, E);
        if (upper) convert_experts(F, ((int)blockIdx.x - F.G / 2) * NWAVES + F.wave, (F.G - F.G / 2) * NWAVES, EXP_PRE, EXP_SPLIT);
        if (!upper) convert_experts(F, (int)blockIdx.x * NWAVES + F.wave, (F.G / 2) * NWAVES, EXP_SPLIT + V_PRE, 2 * NEXP - V_P4);
    }
    SEAM(1);
    if (IN(2)) { att::attn_phase(F); }
    SEAM(2);
    if (IN(3)) {
#ifdef P3_DELAY_US
        if (((int)blockIdx.x >> 3) & 1) { const unsigned long long t0 = __builtin_amdgcn_s_memrealtime(); while (__builtin_amdgcn_s_memrealtime() - t0 < (unsigned long long)(P3_DELAY_US * 100)) __builtin_amdgcn_s_sleep(8); }
#endif
        pg8::Gemm g{(const pg8::bf16_t*)(F.ws + WS_ATTN), (const pg8::bf16_t*)(F.ws + WS_WOUT), T, D_MODEL, D_MODEL / 2};
        pg8::StaticOrder S; S.init(T, D_MODEL, F.G, (int)blockIdx.x);
        EpiOutProj E{(bf16*)(F.ws + WS_XB), (float2*)(F.ws + WS_STATS), F.ws + WS_XQ};
#ifdef P3_DUMMY
        if (lo == 3) { EpiOutProj E2{(bf16*)(F.ws + WS_FQ), (float2*)(F.ws + WS_FKT), F.ws + WS_FVT}; pg8::gemm_phase<EpiOutProj, pg8::StaticOrder, true, true, true>(F.lds, g, S, E2); } else
#endif
#ifdef GEMM_NULL
        if (lo == 3) pg8::gemm_phase<EpiNull<EpiOutProj>, pg8::StaticOrder, true, true, true>(F.lds, g, S, EpiNull<EpiOutProj>{}); else
#endif
        pg8::gemm_phase<EpiOutProj, pg8::StaticOrder, true, true, true>(F.lds, g, S, E);
    }
    SEAM(3);
    if (IN(4)) {
#if V_P4_ROWS > 0
        {
            const bool pat = (F.G % 16) == 0; const int bx = (int)blockIdx.x;
            if (!pat || ((bx >> 3) & 1)) {
                const int gi = pat ? (((bx >> 4) << 3) | (bx & 7)) : bx, ng = pat ? F.G / 2 : F.G;
                convert_experts(F, gi * NWAVES + F.wave, ng * NWAVES, 2 * NEXP - V_P4_ROWS, 2 * NEXP); __syncthreads(); }
        }
#endif
#ifdef P4_DELAY_US
        if (((int)blockIdx.x >> 3) & 1) { const unsigned long long t0 = __builtin_amdgcn_s_memrealtime(); while (__builtin_amdgcn_s_memrealtime() - t0 < (unsigned long long)(P4_DELAY_US * 100)) __builtin_amdgcn_s_sleep(8); }
#endif
        pg8::Gemm g{(const pg8::bf16_t*)(F.ws + WS_XQ), (const pg8::bf16_t*)(F.ws + WS_WQ), T, QCOLS, D_MODEL / 2};
        pg8::StaticOrder S; S.init(T, QCOLS, F.G, (int)blockIdx.x);
        EpiQuery E{(const float2*)(F.ws + WS_STATS), (const float*)(F.ws + WS_GW), (const float*)(F.ws + WS_GW) + QCOLS, (bf16*)(F.ws + WS_Q), (float2*)(F.ws + WS_STATS2)};
#ifdef GEMM_NULL
        if (lo == 4) pg8::gemm_phase<EpiNull<EpiQuery>, pg8::StaticOrder, true, true, true>(F.lds, g, S, EpiNull<EpiQuery>{}); else
#endif
        pg8::gemm_phase<EpiQuery, pg8::StaticOrder, true, true, true>(F.lds, g, S, E);
    }
    SEAM(4);
#ifdef P5_SECOND
    if (IN(5)) { if (lo == 5) tk::topk_phase<P5_SECOND>(F); else tk::topk_phase<0>(F); }
#else
    if (IN(5)) { tk::topk_phase<0>(F); }
#endif
#ifdef P5_PROBE
    if (IN(5)) { xcd_barrier(bar); tk::topk_phase<P5_PROBE>(F); }
#endif
    SEAM(5);
    if (IN(6)) { ex::gather_phase<0>(F); }
    SEAM(6);
    if (IN(7)) { ex::combine_phase(F); }
    SEAM(7);
    if (IN(8)) { ex::gather_phase<1>(F); }
    SEAM(8);
#ifdef G_PROBE_PH
    if (IN(8)) { ex::gather_phase<G_PROBE_PH, G_PROBE_VAR>(F); xcd_barrier(bar); }
#endif
#ifdef EXTRA_BAR
    for (int eb = 0; eb < EXTRA_BAR; ++eb) xcd_barrier(bar);
#endif
    if (IN(9)) { ex::ln2_phase(F); }
#undef IN
#undef SEAM
}

#if DBG_STAGE > 0
constexpr int DBG_B = 5;
constexpr size_t DBG_BASE = 360 * MiB;
constexpr size_t DBG_ACC = 511 * MiB;
__device__ __forceinline__ float bf2f(bf16 v) { return __uint_as_float((unsigned)v << 16); }
__device__ __forceinline__ void dbg_acc(double* acc, int slot, float opt, float ref) {
    float d2 = (opt - ref) * (opt - ref), r2 = ref * ref;
    if (!(d2 == d2)) d2 = 1e30f;
    d2 = wave_sum(d2); r2 = wave_sum(r2);
    if ((threadIdx.x & 63) == 0) { atomicAdd(acc + 2 * slot, (double)d2); atomicAdd(acc + 2 * slot + 1, (double)r2); }
}
__global__ void __launch_bounds__(256) dbg_check_inproj(const float* __restrict__ proj, const unsigned char* __restrict__ ws, const float* __restrict__ cn, double* acc) {
    const int s = blockIdx.x, t = DBG_B * SEQ + s;
    const float* pr = proj + (size_t)s * IN_COLS;
    for (int j = threadIdx.x; j < 2304; j += 256) {
        float ref, opt; int slot;
        if (j < 1536) {
            const int which = j >> 9, hd = (j >> 6) & 7, d = j & 63;
            ref = pr[j];
            if (which == 0) { opt = bf2f(((const bf16*)(ws + WS_FQ))[(size_t)t * 512 + hd * 64 + d]) / C2; slot = 0; }
            else if (which == 1) { opt = bf2f(*(const bf16*)(ws + WS_FKT + EpiInProj::tile_off(8, t, hd) + (size_t)((d >> 3) * 64 + (t & 63)) * 16 + (d & 7) * 2)); slot = 1; }
            else { opt = bf2f(*(const bf16*)(ws + WS_FVT + EpiInProj::tile_off(8, t, hd) + (size_t)((d >> 5) * 4 + ((t & 63) >> 4)) * 1024 + (t & 15) * 64 + (d & 31) * 2)); slot = 2; }
        } else if (j < 2176) {
            const bool isq = j < 2048; const int r = isq ? j - 1536 : j - 2048, hd = r >> 6, d = r & 63, base = (isq ? OFF_SQ : OFF_SK) + hd * 64;
            float cs, sn; rope_cs(s, d & 31, cs, sn);
            ref = (d < 32) ? pr[base + d] * cs - pr[base + d + 32] * sn : pr[base + d] * cs + pr[base + d - 32] * sn;
            if (isq) { opt = bf2f(((const bf16*)(ws + WS_SQ))[(size_t)t * 512 + hd * 64 + d]) / C2; slot = 3; }
            else { opt = bf2f(*(const bf16*)(ws + WS_SKT + EpiInProj::tile_off(2, t, hd) + (size_t)((d >> 3) * 64 + (t & 63)) * 16 + (d & 7) * 2)); slot = 4; }
        } else {
            const int r = j - 2176, hd = r >> 6, d = r & 63;
            ref = pr[OFF_SV + r];
            opt = bf2f(*(const bf16*)(ws + WS_SVT + EpiInProj::tile_off(2, t, hd) + (size_t)((d >> 5) * 4 + ((t & 63) >> 4)) * 1024 + (t & 15) * 64 + (d & 31) * 2)); slot = 5;
        }
#pragma unroll
        for (int sl = 0; sl < 6; ++sl) dbg_acc(acc, sl, slot == sl ? opt : 0.f, slot == sl ? ref : 0.f);
    }
    if (threadIdx.x < 64) {
        const int h = threadIdx.x & 7;
        const float opt = (threadIdx.x < 8) ? ((const float*)(ws + WS_C))[(size_t)(DBG_B * 8 + h) * SEQ + s] : 0.f, ref = (threadIdx.x < 8) ? cn[(size_t)h * SEQ + s] : 0.f;
        dbg_acc(acc, 6, opt, ref);
    }
}
__global__ void __launch_bounds__(256) dbg_check_attn(const float* __restrict__ attn_n, const unsigned char* __restrict__ ws, double* acc) {
    const int s = blockIdx.x, t = DBG_B * SEQ + s;
    for (int j = threadIdx.x; j < 1024; j += 256) {
        const float ref = attn_n[(size_t)s * 1024 + j], opt = bf2f(((const bf16*)(ws + WS_ATTN))[(size_t)t * 1024 + j]);
        dbg_acc(acc, j >> 9, opt, ref);
    }
}
__global__ void __launch_bounds__(256) dbg_check_q(const float* __restrict__ qn, const float* __restrict__ x1n, const float* __restrict__ y, const float* __restrict__ g1, const float* __restrict__ b1, const unsigned char* __restrict__ ws, double* acc) {
    const int s = blockIdx.x, t = DBG_B * SEQ + s;
    for (int j = threadIdx.x; j < 2048; j += 256) dbg_acc(acc, 0, bf2f(((const bf16*)(ws + WS_Q))[(size_t)t * QCOLS + j]), qn[(size_t)s * QCOLS + j]);
    const float2 st = ln1_row_stats((const float2*)(ws + WS_STATS), t);
    for (int j = threadIdx.x; j < 1024; j += 256) dbg_acc(acc, 1, (y[(size_t)t * 1024 + j] - st.x) * st.y * g1[j] + b1[j], x1n[(size_t)s * 1024 + j]);
}
__global__ void __launch_bounds__(256) dbg_check_picks(const int* __restrict__ idxn, const float* __restrict__ gn, const unsigned char* __restrict__ ws, double* acc) {
    const int i = blockIdx.x * 256 + threadIdx.x;
    const int s = i >> 3, h = i & 7, t = DBG_B * SEQ + s;
    const int* io = (const int*)(ws + WS_IDX) + ((size_t)t * 8 + h) * 16; const float* go = (const float*)(ws + WS_G) + ((size_t)t * 8 + h) * 16;
    const int* in_ = idxn + ((size_t)s * 8 + h) * 16; const float* gn_ = gn + ((size_t)s * 8 + h) * 16;
    float miss = 0.f, d2 = 0.f, r2 = 0.f;
    for (int a = 0; a < 16; ++a) { const int e = in_[a]; bool found = false;
        for (int b = 0; b < 16; ++b) if (io[b] == e) { found = true; d2 += (go[b] - gn_[a]) * (go[b] - gn_[a]); r2 += gn_[a] * gn_[a]; }
        if (!found) miss += 1.f; }
    miss = wave_sum(miss); d2 = wave_sum(d2); r2 = wave_sum(r2);
    if ((threadIdx.x & 63) == 0) { atomicAdd(acc + 0, (double)miss); atomicAdd(acc + 1, 16.0 * 64.0); atomicAdd(acc + 2, (double)d2); atomicAdd(acc + 3, (double)r2); }
}
__global__ void dbg_code_picks(const double* acc, float* code) {
    if (threadIdx.x != 0 || blockIdx.x != 0) return;
    const float frac = (float)(acc[0] / acc[1]), gerr = (float)sqrt(acc[2] / acc[3]);
    *code = 10.f * frac + (gerr > 0.05f ? 100.f : 0.f) + (frac != frac ? 1000.f : 0.f);
}
__global__ void dbg_code(const double* acc, float* code, int nslots) {
    if (threadIdx.x != 0 || blockIdx.x != 0) return;
    float worst = 0.f; int mask = 0;
    for (int i = 0; i < nslots; ++i) { const double r = acc[2 * i + 1] > 0 ? sqrt(acc[2 * i] / acc[2 * i + 1]) : 99.0; if (r > 0.02) mask |= 1 << i; if ((float)r > worst) worst = (float)r; }
    *code = mask ? (float)mask : worst * 10.f;
}
__global__ void dbg_scale(float* out, const float* code, int n) { const int i = blockIdx.x * blockDim.x + threadIdx.x; if (i < n) out[i] *= (1.f + *code); }

static void launch_naive(const float* const* in, float* out, char* ws, int b0, int nb, hipStream_t stream, float** proj_o, float** c_o, float** x1_o, int** idx_o, float** g_o, float* attn_tmp) {
    const int Tn = nb * SEQ;
    float* proj = (float*)ws; size_t off = (size_t)Tn * IN_COLS * 4; off = (off + 255) & ~(size_t)255;
    float* cbuf = (float*)(ws + off); off += (size_t)nb * FOX_H * SEQ * 4;
    float* x1 = (float*)(ws + off); off += (size_t)Tn * D_MODEL * 4;
    int* idx = (int*)(ws + off); off += (size_t)Tn * 128 * 4;
    float* gbuf = (float*)(ws + off); off += (size_t)Tn * 128 * 4;
    const float* x = in[0] + (size_t)b0 * SEQ * D_MODEL;
    float* attn = attn_tmp ? attn_tmp : out + (size_t)b0 * SEQ * D_MODEL;
    nv_gemm<<<dim3((IN_COLS + 127) / 128, Tn / 128), 256, 0, stream>>>(x, D_MODEL, in[1], IN_COLS, proj, IN_COLS, Tn, IN_COLS, D_MODEL);
    nv_forget_cumsum<<<1, 64, 0, stream>>>(proj, in[2], cbuf, nb);
    nv_fox<<<dim3(SEQ / 64, FOX_H, nb), 64, 0, stream>>>(proj, cbuf, attn);
    nv_swa<<<dim3(SEQ / 64, SWA_H, nb), 64, 0, stream>>>(proj, in[3], attn);
    nv_gemm<<<dim3(D_MODEL / 128, Tn / 128), 256, 0, stream>>>(attn, D_MODEL, in[4], D_MODEL, x1, D_MODEL, Tn, D_MODEL, D_MODEL);
    nv_ln_res<<<Tn / 4, 256, 0, stream>>>(x, x1, in[5], in[6], x1, Tn);
    float* q = proj;
    if (proj_o) {
        *proj_o = proj; *c_o = cbuf; *x1_o = x1; *idx_o = idx; *g_o = gbuf;
        q = attn_tmp + (size_t)Tn * D_MODEL + (1u << 18);
        nv_gemm<<<dim3(QCOLS / 128, Tn / 128), 256, 0, stream>>>(x1, D_MODEL, in[7], QCOLS, q, QCOLS, Tn, QCOLS, D_MODEL);
        nv_peer_topk<<<dim3(Tn / 64, PEER_H), 64, 0, stream>>>(q, in[8], idx, gbuf);
        return;
    }
    nv_gemm<<<dim3(QCOLS / 128, Tn / 128), 256, 0, stream>>>(x1, D_MODEL, in[7], QCOLS, q, QCOLS, Tn, QCOLS, D_MODEL);
    nv_peer_topk<<<dim3(Tn / 64, PEER_H), 64, 0, stream>>>(q, in[8], idx, gbuf);
    nv_peer_expert<<<Tn / 4, 256, 0, stream>>>(x1, idx, gbuf, in[9], in[10], in[11], in[12], out + (size_t)b0 * SEQ * D_MODEL, Tn);
}
#endif

extern "C" void kernel_launch(void* const* d_in, const int* in_sizes, int n_in, void* d_out, int out_size, void* d_ws, size_t ws_size, hipStream_t stream) {
    static int grid = 0;
    if (grid == 0) {
        if (n_in != 13 || out_size != T * D_MODEL || ws_size < 512 * MiB) { fprintf(stderr, "kernel_launch: unexpected shapes / workspace (%d inputs, out %d, ws %zu)\n", n_in, out_size, ws_size); grid = -1; return; }
        int dev = 0, cus = 0, per_cu = 0;
        if (hipGetDevice(&dev) != hipSuccess || hipDeviceGetAttribute(&cus, hipDeviceAttributeMultiprocessorCount, dev) != hipSuccess) { grid = -1; return; }
        if (hipFuncSetAttribute((const void*)mk_fwd, hipFuncAttributeMaxDynamicSharedMemorySize, LDS_BYTES) != hipSuccess) { fprintf(stderr, "kernel_launch: hipFuncSetAttribute failed\n"); grid = -1; return; }
        if (hipOccupancyMaxActiveBlocksPerMultiprocessor(&per_cu, (const void*)mk_fwd, NWAVES * 64, LDS_BYTES) != hipSuccess || per_cu < 1) { fprintf(stderr, "kernel_launch: occupancy query says %d blocks per CU\n", per_cu); (void)hipGetLastError(); grid = -1; return; }
        grid = cus;
    }
    if (grid < 0) return;
    const float* in[13]; for (int i = 0; i < 13; ++i) in[i] = (const float*)d_in[i];
    (void)hipMemsetAsync((char*)d_ws + WS_CTL, 0, CTL_ZERO_BYTES, stream);
    Args a{};
    for (int i = 0; i < 13; ++i) a.in[i] = in[i];
    a.out = (float*)d_out; a.ws = (unsigned char*)d_ws;
#if DBG_STAGE == 0 && defined(TIME_LO)
    a.ph_lo = 0; a.ph_hi = TIME_HI;
    { void* k1[] = {&a}; (void)hipLaunchCooperativeKernel((const void*)mk_fwd, dim3(grid), dim3(NWAVES * 64), k1, LDS_BYTES, stream); }
    (void)hipMemsetAsync((char*)d_ws + WS_CTL, 0, CTL_ZERO_BYTES, stream);
    a.ph_lo = TIME_LO; a.ph_hi = N_PHASES;
#elif DBG_STAGE == 0
    a.ph_lo = 0; a.ph_hi = N_PHASES;
#else
    a.ph_lo = 0; a.ph_hi = DBG_STAGE + 1;
#endif
    void* kargs[] = {&a};
    hipError_t le = hipLaunchCooperativeKernel((const void*)mk_fwd, dim3(grid), dim3(NWAVES * 64), kargs, LDS_BYTES, stream);
    if (le != hipSuccess) fprintf(stderr, "kernel_launch: cooperative launch failed: %s (grid %d)\n", hipGetErrorName(le), grid);
#if DBG_STAGE > 0
    char* ws = (char*)d_ws;
    double* acc = (double*)(ws + DBG_ACC); float* code = (float*)(ws + DBG_ACC + 512);
    (void)hipMemsetAsync(acc, 0, 1024, stream);
    float *proj, *cn, *x1n, *gn; int* idxn;
    launch_naive(in, (float*)d_out, ws + DBG_BASE, DBG_B, 1, stream, &proj, &cn, &x1n, &idxn, &gn, (float*)(ws + DBG_BASE + 100 * MiB));
#if DBG_STAGE == 1
    dbg_check_inproj<<<SEQ, 256, 0, stream>>>(proj, (const unsigned char*)d_ws, cn, acc);
    dbg_code<<<1, 1, 0, stream>>>(acc, code, 7);
#elif DBG_STAGE == 4
    dbg_check_q<<<SEQ, 256, 0, stream>>>((const float*)(ws + DBG_BASE + 100 * MiB) + (size_t)SEQ * D_MODEL + (1u << 18), x1n, (const float*)d_out, in[5], in[6], (const unsigned char*)d_ws, acc);
    dbg_code<<<1, 1, 0, stream>>>(acc, code, 2);
#elif DBG_STAGE == 5
    dbg_check_picks<<<SEQ * 8 / 256, 256, 0, stream>>>(idxn, gn, (const unsigned char*)d_ws, acc);
    dbg_code_picks<<<1, 1, 0, stream>>>(acc, code);
#elif DBG_STAGE == 2
    dbg_check_attn<<<SEQ, 256, 0, stream>>>((const float*)(ws + DBG_BASE + 100 * MiB), (const unsigned char*)d_ws, acc);
    dbg_code<<<1, 1, 0, stream>>>(acc, code, 2);
#endif
    launch_naive(in, (float*)d_out, ws, 0, BATCH, stream, nullptr, nullptr, nullptr, nullptr, nullptr, nullptr);
    dbg_scale<<<(T * D_MODEL + 255) / 256, 256, 0, stream>>>((float*)d_out, code, T * D_MODEL);
#endif
}
```
